# Optimizing an MI355X kernel written in HIP

```python
import math
import jax, jax.numpy as jnp
from jax import lax
import numpy as np

D_MODEL = 2048
BATCH = 4
SEQ = 8192
DEPTH = 2

GRID_W = 64
CTX_LEN = 256
N_EVEN = (DEPTH + 1) // 2
N_ODD = DEPTH // 2

CONV_DIM = D_MODEL // 2
CONV_WIDTH = 3
DA_HEADS = 8
DA_HEAD_DIM = D_MODEL // (4 * DA_HEADS)
DA_V_DIM = 2 * DA_HEAD_DIM
Q_DIM = DA_HEADS * 2 * DA_HEAD_DIM
DA_WIDTH = DA_HEADS * DA_V_DIM
CONV_COLS = 3 * CONV_DIM
Q_START = CONV_COLS
K_START = Q_START + Q_DIM
V_START = K_START + Q_DIM
IN_E_COLS = V_START + DA_WIDTH
MIX_E_WIDTH = CONV_DIM + DA_WIDTH
ROPE_AXIS_DIM = DA_HEAD_DIM // 2
ROPE_BASE = 10000.0
Q_BLOCK = 128

GMLP_DIM = D_MODEL
CHUNK = 128
GMLP_GROUPS = 16
GMLP_GROUP_DIM = GMLP_DIM // GMLP_GROUPS

N_EXPERTS = 16
N_GROUPS = 4
EXPERTS_PER_GROUP = N_EXPERTS // N_GROUPS
TOPK_GROUPS = 1
TOP_K = 2
EXPERT_DIM = D_MODEL // 4

DEEPNORM_ALPHA = (2 * DEPTH) ** 0.25
DEEPNORM_BETA = (8 * DEPTH) ** -0.25
LN_EPS = 1e-5

kernel_name = "hybrid_diffusion_conv_diffattn_gmlp_moe"


def layer_norm(x, g, b):
    xf = x.astype(jnp.float32)
    mu = jnp.mean(xf, axis=-1, keepdims=True)
    var = jnp.mean(jnp.square(xf - mu), axis=-1, keepdims=True)
    y = (xf - mu) * lax.rsqrt(var + LN_EPS)
    return (y * g.astype(jnp.float32) + b.astype(jnp.float32)).astype(x.dtype)


def rms_norm(x, g):
    xf = x.astype(jnp.float32)
    y = xf * lax.rsqrt(jnp.mean(jnp.square(xf), axis=-1, keepdims=True) + LN_EPS)
    return (y * g.astype(jnp.float32)).astype(x.dtype)


def modulate(x, shift, scale):
    return x * (1 + scale) + shift


def axial_rope_tables(n, dtype):
    rows = n // GRID_W
    half = ROPE_AXIS_DIM // 2
    inv = jnp.power(ROPE_BASE, -jnp.arange(half, dtype=jnp.float32) / half)
    ang_r = jnp.arange(rows, dtype=jnp.float32)[:, None, None] * inv
    ang_c = jnp.arange(GRID_W, dtype=jnp.float32)[None, :, None] * inv
    ang = jnp.stack(jnp.broadcast_arrays(ang_r, ang_c), axis=2).reshape(n, 2, half)
    return jnp.cos(ang).astype(dtype), jnp.sin(ang).astype(dtype)


def apply_axial_rope(t, cos, sin):
    tt = t.reshape(t.shape[:-1] + (2, 2, ROPE_AXIS_DIM // 2))
    t1, t2 = tt[..., 0, :], tt[..., 1, :]
    cs, sn = cos[:, None, None], sin[:, None, None]
    r = jnp.stack([t1 * cs - t2 * sn, t2 * cs + t1 * sn], axis=-2)
    return r.reshape(t.shape)


def short_gated_conv(p3, conv_w):
    xa, bg, cg = jnp.split(p3, 3, axis=-1)
    z = jnp.pad(cg * xa, ((0, 0), (1, 1), (0, 0)))
    conv = conv_w[0] * z[:, :-2] + conv_w[1] * z[:, 1:-1] + conv_w[2] * z[:, 2:]
    return bg * conv


def qk_heads(t):
    return t.reshape(t.shape[:2] + (DA_HEADS, 2, DA_HEAD_DIM))


def v_heads(t):
    return t.reshape(t.shape[:2] + (DA_HEADS, DA_V_DIM))


def diff_softmax_mix(q, k, v, lam):
    s = jnp.einsum("bqhmd,bkhmd->bhmqk", q, k).astype(jnp.float32)
    p = jax.nn.softmax(s, axis=-1)
    a = p[:, :, 0] - lam * p[:, :, 1]
    return jnp.einsum("bhqk,bkhe->bqhe", a.astype(v.dtype), v)


def blocked_diff_attention(q, k, v, lam):
    b, n = q.shape[:2]
    qb = q.reshape((b, n // Q_BLOCK, Q_BLOCK) + q.shape[2:]).swapaxes(0, 1)
    out = lax.map(lambda qblk: diff_softmax_mix(qblk, k, v, lam), qb)
    return out.swapaxes(0, 1).reshape((b, n) + out.shape[3:])


def diff_attn_output(o, subln_g, lam_init):
    o = rms_norm(o, subln_g) * (1.0 - lam_init)
    return o.reshape(o.shape[:2] + (DA_WIDTH,))


def even_mixer(h, hc, w_in, conv_w, lam, lam_init, subln_g, w_out, cos, sin, need_ctx):
    scale = DA_HEAD_DIM ** -0.5
    proj = h @ w_in
    a = short_gated_conv(proj[..., :CONV_COLS], conv_w)
    q = apply_axial_rope(qk_heads(proj[..., Q_START:K_START]), cos, sin) * scale
    k = apply_axial_rope(qk_heads(proj[..., K_START:V_START]), cos, sin)
    v = v_heads(proj[..., V_START:])
    proj_c = hc @ w_in if need_ctx else None
    kv_c = proj_c[..., K_START:] if need_ctx else hc @ w_in[:, K_START:]
    kc = qk_heads(kv_c[..., :Q_DIM])
    vc = v_heads(kv_c[..., Q_DIM:])
    o = blocked_diff_attention(q, jnp.concatenate([kc, k], axis=1), jnp.concatenate([vc, v], axis=1), lam)
    y = jnp.concatenate([a, diff_attn_output(o, subln_g, lam_init)], axis=-1) @ w_out
    if not need_ctx:
        return y, None
    ac = short_gated_conv(proj_c[..., :CONV_COLS], conv_w)
    qc = qk_heads(proj_c[..., Q_START:K_START]) * scale
    oc = diff_softmax_mix(qc, kc, vc, lam)
    yc = jnp.concatenate([ac, diff_attn_output(oc, subln_g, lam_init)], axis=-1) @ w_out
    return y, yc


def chunk_gmlp(h, w_in, v_g, v_b, w_s, b_s, w_out):
    b, n, _ = h.shape
    u, v = jnp.split(jax.nn.gelu(h @ w_in), 2, axis=-1)
    v = layer_norm(v, v_g, v_b).reshape(b, n // CHUNK, CHUNK, GMLP_GROUPS, GMLP_GROUP_DIM)
    s = jnp.einsum("gpq,bnqgc->bnpgc", w_s, v) + b_s.T[None, None, :, :, None]
    return (u * s.reshape(b, n, GMLP_DIM)) @ w_out


def moe(h, w_router, router_bias, w_gate, w_up, w_down):
    t = h.shape[0]
    scores = jax.nn.sigmoid((h @ w_router).astype(jnp.float32))
    sel = scores + router_bias.astype(jnp.float32)
    grp_score = lax.top_k(sel.reshape(t, N_GROUPS, EXPERTS_PER_GROUP), 2)[0].sum(-1)
    _, gidx = lax.top_k(grp_score, TOPK_GROUPS)
    gmask = jnp.any(gidx[:, :, None] == jnp.arange(N_GROUPS)[None, None, :], axis=1)
    emask = jnp.repeat(gmask, EXPERTS_PER_GROUP, axis=1)
    _, eidx = lax.top_k(jnp.where(emask, sel, -jnp.inf), TOP_K)
    wsel = jnp.take_along_axis(scores, eidx, axis=1)
    wsel = wsel / jnp.sum(wsel, axis=-1, keepdims=True)
    combine = jnp.sum(jax.nn.one_hot(eidx, N_EXPERTS, dtype=jnp.float32) * wsel[..., None], axis=1).astype(h.dtype)
    out = jnp.zeros_like(h)
    for e in range(N_EXPERTS):
        hid = jax.nn.silu(h @ w_gate[e]) * (h @ w_up[e])
        out = out + combine[:, e:e + 1] * (hid @ w_down[e])
    return out


def setup_inputs(seed: int = 0) -> dict:
    key = jax.random.key(seed)
    ks = jax.random.split(key, 32)
    f32 = jnp.float32

    def nrm(k, shape, scale):
        return jax.random.normal(k, shape, f32) * scale

    d = D_MODEL
    return {
        "x": nrm(ks[0], (BATCH, SEQ, d), 1.0),
        "c": nrm(ks[1], (BATCH, d), 1.0),
        "ctx": nrm(ks[2], (BATCH, CTX_LEN, d), 1.0),
        "c_ctx": nrm(ks[3], (d,), 1.0),
        "w_mod": nrm(ks[4], (DEPTH, d, 6 * d), 0.5 * d ** -0.5),
        "b_mod": nrm(ks[5], (DEPTH, 6 * d), 0.02),
        "ln_g": 1.0 + nrm(ks[6], (DEPTH, 2, d), 0.02),
        "ln_b": nrm(ks[7], (DEPTH, 2, d), 0.02),
        "w_in_e": nrm(ks[8], (N_EVEN, d, IN_E_COLS), d ** -0.5),
        "conv_w": nrm(ks[9], (N_EVEN, CONV_WIDTH, CONV_DIM), CONV_WIDTH ** -0.5),
        "lambda_q1": nrm(ks[10], (N_EVEN, DA_HEAD_DIM), 0.1),
        "lambda_k1": nrm(ks[11], (N_EVEN, DA_HEAD_DIM), 0.1),
        "lambda_q2": nrm(ks[12], (N_EVEN, DA_HEAD_DIM), 0.1),
        "lambda_k2": nrm(ks[13], (N_EVEN, DA_HEAD_DIM), 0.1),
        "subln_g": 1.0 + nrm(ks[14], (N_EVEN, DA_V_DIM), 0.02),
        "w_out_e": nrm(ks[15], (N_EVEN, MIX_E_WIDTH, d), DEEPNORM_BETA * MIX_E_WIDTH ** -0.5),
        "w_in_o": nrm(ks[16], (N_ODD, d, 2 * GMLP_DIM), d ** -0.5),
        "v_ln_g": 1.0 + nrm(ks[17], (N_ODD, GMLP_DIM), 0.02),
        "v_ln_b": nrm(ks[18], (N_ODD, GMLP_DIM), 0.02),
        "w_spatial": nrm(ks[19], (N_ODD, GMLP_GROUPS, CHUNK, CHUNK), CHUNK ** -0.5),
        "b_spatial": 1.0 + nrm(ks[20], (N_ODD, GMLP_GROUPS, CHUNK), 0.02),
        "w_out_o": nrm(ks[21], (N_ODD, GMLP_DIM, d), DEEPNORM_BETA * GMLP_DIM ** -0.5),
        "w_router": nrm(ks[22], (d, N_EXPERTS), d ** -0.5),
        "router_bias": nrm(ks[23], (N_EXPERTS,), 0.01),
        "w_gate": nrm(ks[24], (DEPTH, N_EXPERTS, d, EXPERT_DIM), d ** -0.5),
        "w_up": nrm(ks[25], (DEPTH, N_EXPERTS, d, EXPERT_DIM), d ** -0.5),
        "w_down": nrm(ks[26], (DEPTH, N_EXPERTS, EXPERT_DIM, d), DEEPNORM_BETA * EXPERT_DIM ** -0.5),
    }


def reference(x, c, ctx, c_ctx, w_mod, b_mod, ln_g, ln_b, w_in_e, conv_w, lambda_q1, lambda_k1,
              lambda_q2, lambda_k2, subln_g, w_out_e, w_in_o, v_ln_g, v_ln_b, w_spatial, b_spatial,
              w_out_o, w_router, router_bias, w_gate, w_up, w_down):
    bsz, n, d = x.shape
    cos, sin = axial_rope_tables(n, x.dtype)
    xc = ctx
    for l in range(DEPTH):
        need_ctx = any(j % 2 == 0 for j in range(l + 1, DEPTH))
        mod = (jax.nn.silu(c) @ w_mod[l] + b_mod[l]).reshape(bsz, 6, 1, d)
        sh1, sc1, g1, sh2, sc2, g2 = (mod[:, i] for i in range(6))
        modc = (jax.nn.silu(c_ctx) @ w_mod[l] + b_mod[l]).reshape(6, d)

        h = modulate(x, sh1, sc1)
        hc = modulate(xc, modc[0], modc[1])
        if l % 2 == 0:
            e = l // 2
            lam_init = 0.8 - 0.6 * math.exp(-0.3 * l)
            lam = (jnp.exp(jnp.sum(lambda_q1[e].astype(jnp.float32) * lambda_k1[e].astype(jnp.float32)))
                   - jnp.exp(jnp.sum(lambda_q2[e].astype(jnp.float32) * lambda_k2[e].astype(jnp.float32)))
                   + lam_init)
            y, yc = even_mixer(h, hc, w_in_e[e], conv_w[e], lam, lam_init, subln_g[e], w_out_e[e],
                               cos, sin, need_ctx)
        else:
            o = l // 2
            y = chunk_gmlp(h, w_in_o[o], v_ln_g[o], v_ln_b[o], w_spatial[o], b_spatial[o], w_out_o[o])
            yc = (chunk_gmlp(hc, w_in_o[o], v_ln_g[o], v_ln_b[o], w_spatial[o], b_spatial[o], w_out_o[o])
                  if need_ctx else None)
        x = layer_norm(DEEPNORM_ALPHA * x + g1 * y, ln_g[l, 0], ln_b[l, 0])
        if need_ctx:
            xc = layer_norm(DEEPNORM_ALPHA * xc + modc[2] * yc, ln_g[l, 0], ln_b[l, 0])

        h = modulate(x, sh2, sc2)
        y = moe(h.reshape(-1, d), w_router, router_bias, w_gate[l], w_up[l], w_down[l]).reshape(x.shape)
        x = layer_norm(DEEPNORM_ALPHA * x + g2 * y, ln_g[l, 1], ln_b[l, 1])
        if need_ctx:
            hc = modulate(xc, modc[3], modc[4])
            yc = moe(hc.reshape(-1, d), w_router, router_bias, w_gate[l], w_up[l], w_down[l]).reshape(xc.shape)
            xc = layer_norm(DEEPNORM_ALPHA * xc + modc[5] * yc, ln_g[l, 1], ln_b[l, 1])
    return x
```

```cpp
#include <hip/hip_runtime.h>
#include <cstdio>
#include <cstdint>

#ifndef MK_N_LAUNCHES
#define MK_N_LAUNCHES 1
#endif
#ifndef DUP_PHASE
#define ATT_OVF_LIMIT __builtin_inff()
#define DUP_PHASE -1
#endif
#ifndef USE_FAST_GEMM
#define USE_FAST_GEMM 1
#endif
#ifndef USE_FAST_ATTN
#define USE_FAST_ATTN 1
#endif
#ifndef USE_FAST_SPATIAL
#define USE_FAST_SPATIAL 1
#endif

#define GAS __attribute__((address_space(1)))
#define LAS __attribute__((address_space(3)))
typedef unsigned short bf16;
typedef short bf16x8 __attribute__((ext_vector_type(8)));
typedef float f32x4 __attribute__((ext_vector_type(4)));
typedef float f32x2 __attribute__((ext_vector_type(2)));
typedef unsigned u32x4 __attribute__((ext_vector_type(4)));
typedef unsigned u32x2 __attribute__((ext_vector_type(2)));
typedef GAS unsigned gu32;

constexpr int D = 2048, BATCH = 4, SEQ = 8192, M = BATCH * SEQ, CTXL = 256, MC = BATCH * CTXL, KV = SEQ + CTXL;
constexpr int NE = 16, ED = 512, CAP = 32768;
constexpr float ALPHA = 1.41421356237309515f, LN_EPS = 1e-5f;
constexpr int NWAVES = 8;
constexpr float QSCALE = 0.125f * 1.4426950408889634f;

constexpr size_t MiB = 1u << 20;
constexpr size_t WS_CTL = 0, CTL_ZERO_BYTES = 64 * 1024;
constexpr size_t WS_MOD = 2 * MiB;
constexpr size_t WS_TAB = 3 * MiB;
constexpr size_t WS_WRT = 3 * MiB + 64 * 1024;
constexpr size_t WS_WSB = 3 * MiB + 256 * 1024;
constexpr size_t WS_WRT2 = 24 * MiB;
constexpr size_t WS_RC = 25 * MiB;
constexpr size_t WS_LIST = 4 * MiB;
constexpr size_t WS_WINE = 8 * MiB;
constexpr size_t WS_WOUTE = 32 * MiB;
constexpr size_t WS_WINO = 40 * MiB;
constexpr size_t WS_WOUTO = 56 * MiB;
constexpr size_t WS_WGU = 64 * MiB;
constexpr size_t WS_WDN = 192 * MiB;
constexpr size_t WS_A = 256 * MiB;
constexpr size_t WS_PROJ = WS_A;
constexpr size_t WS_Q = WS_A + 192 * MiB;
constexpr size_t WS_KB = WS_A + 256 * MiB;
constexpr size_t WS_VB = WS_A + 322 * MiB;
constexpr size_t WS_HID = WS_A;
constexpr size_t WS_H8 = WS_A + 324 * MiB;
constexpr size_t WS_YB = WS_A + 68 * MiB;
constexpr size_t WS_UV = WS_A;
constexpr size_t WS_VSTP = WS_A + 256 * MiB;
constexpr size_t WS_H = WS_A + 388 * MiB;
constexpr size_t WS_X = WS_H + 128 * MiB;
constexpr size_t WS_HC = WS_X + 128 * MiB;
constexpr size_t WS_END = WS_HC + 4 * MiB;
static_assert(WS_VB + (size_t)BATCH * KV * 1024 * 2 <= WS_H && WS_YB + (size_t)M * 2 * 2048 * 2 <= WS_H && WS_END <= 1024 * MiB, "ws map");
constexpr int CW_BAR = 4096;
constexpr int CW_CNT = 8192;
constexpr int CW_VST = 262144;
constexpr int RING_BYTES = 131072, LDSX_OFF = RING_BYTES, MISC_OFF = LDSX_OFF + 24576, LDS_BYTES = 163840;

#define RLX_AGENT __ATOMIC_RELAXED, __HIP_MEMORY_SCOPE_AGENT
#define LDS_WAIT() asm volatile("s_waitcnt lgkmcnt(0)" ::: "memory")
#define VM_WAIT() asm volatile("s_waitcnt vmcnt(0)" ::: "memory")
__device__ __forceinline__ unsigned f2bf(float f) { unsigned u = __builtin_bit_cast(unsigned, f); return (u + 0x7fffu + ((u >> 16) & 1u)) >> 16; }
__device__ __forceinline__ unsigned pk2(float lo, float hi) { unsigned r; asm("v_cvt_pk_bf16_f32 %0, %1, %2" : "=v"(r) : "v"(lo), "v"(hi)); return r; }
__device__ __forceinline__ float bf_lo(unsigned u) { return __uint_as_float(u << 16); }
__device__ __forceinline__ float bf_hi(unsigned u) { return __uint_as_float(u & 0xffff0000u); }
__device__ __forceinline__ float bf2f(bf16 h) { return __uint_as_float((unsigned)h << 16); }
__device__ __forceinline__ f32x4 ld_bf4(const bf16* p) { const u32x2 w = *(const u32x2*)p; return (f32x4){bf_lo(w.x), bf_hi(w.x), bf_lo(w.y), bf_hi(w.y)}; }
__device__ __forceinline__ void st_bf4(bf16* p, f32x4 v) { u32x2 w; w.x = pk2(v.x, v.y); w.y = pk2(v.z, v.w); *(u32x2*)p = w; }
__device__ __forceinline__ float wave_sum(float v) {
#pragma unroll
    for (int o = 1; o < 64; o <<= 1) v += __shfl_xor(v, o);
    return v;
}
__device__ __forceinline__ __amdgpu_buffer_rsrc_t make_rsrc(const void* p, int bytes) {
    const unsigned long long v = (unsigned long long)p; const unsigned lo = __builtin_amdgcn_readfirstlane((unsigned)v), hi = __builtin_amdgcn_readfirstlane((unsigned)(v >> 32));
    return __builtin_amdgcn_make_buffer_rsrc((void*)(((unsigned long long)hi << 32) | lo), 0, bytes, 0x00020000);
}
__device__ __forceinline__ bf16x8 bufld16(__amdgpu_buffer_rsrc_t r, unsigned voff, unsigned soff) { return __builtin_bit_cast(bf16x8, __builtin_amdgcn_raw_buffer_load_b128(r, (int)voff, (int)soff, 0)); }
__device__ __forceinline__ unsigned pk4_fp8(float a, float b, float c, float d) {
    a = __builtin_amdgcn_fmed3f(a, -448.f, 448.f); b = __builtin_amdgcn_fmed3f(b, -448.f, 448.f); c = __builtin_amdgcn_fmed3f(c, -448.f, 448.f); d = __builtin_amdgcn_fmed3f(d, -448.f, 448.f);
    int v = __builtin_amdgcn_cvt_pk_fp8_f32(a, b, 0, false); v = __builtin_amdgcn_cvt_pk_fp8_f32(c, d, v, true); return (unsigned)v; }
__device__ __forceinline__ void st_f8x8(unsigned char* p, f32x4 a, f32x4 b) { u32x2 w; w.x = pk4_fp8(a.x, a.y, a.z, a.w); w.y = pk4_fp8(b.x, b.y, b.z, b.w); *(u32x2*)p = w; }
constexpr float W8_SCALE = 32.0f;
__device__ __forceinline__ float silu_f(float x) { return x * __builtin_amdgcn_rcpf(1.0f + __builtin_amdgcn_exp2f(-1.4426950408889634f * x)); }
__device__ __forceinline__ float gelu_tanh_f(float x) {
    const float w = x * __builtin_fmaf(x * x, -0.1029432396f, -2.3022081981f); return x * __builtin_amdgcn_rcpf(1.0f + __builtin_amdgcn_exp2f(w)); }

#define XB_TMO      128
#define XB_XCNT(j)  (256  + 64 * (j))
#define XB_XSUB(j)  (1280 + 64 * (j))
#define XB_XGEN(j)  (2304 + 64 * (j))
#define XB_TOP      3328
#define XB_TOPGEN   3392
#define XCD_BAR_WORDS 3456
#define XB_SPIN_CAP (1u << 21)
__device__ __forceinline__ unsigned xb_ld(unsigned* p)              { return __hip_atomic_load(p, __ATOMIC_RELAXED, __HIP_MEMORY_SCOPE_AGENT); }
__device__ __forceinline__ unsigned xb_add(unsigned* p, unsigned v) { return __hip_atomic_fetch_add(p, v, __ATOMIC_RELAXED, __HIP_MEMORY_SCOPE_AGENT); }
__device__ __forceinline__ unsigned xb_xcc_id() { return (unsigned)__builtin_amdgcn_s_getreg((3 << 11) | 20) & 0xFu; }
#define XB_SPIN(cond, bar) do { unsigned _sp = 0; while (cond) { __builtin_amdgcn_s_sleep(1); \
    if ((++_sp & 255u) == 0u) { if (xb_ld(&(bar)[XB_TMO])) break; if (_sp > XB_SPIN_CAP) { atomicAdd(&(bar)[XB_TMO], 1u); break; } } } } while (0)
struct XcdBarrier { unsigned* bar; unsigned x; volatile LAS unsigned* st; };
__device__ __forceinline__ XcdBarrier xcd_barrier_post(unsigned* bar, volatile LAS unsigned* st, bool t0) {
    XcdBarrier b; b.bar = bar; b.x = xb_xcc_id(); b.st = st;
    if (t0) (void)xb_add(&bar[XB_XCNT(b.x)], 1u);
    return b;
}
__device__ __forceinline__ void xcd_barrier_complete(unsigned* bar, unsigned x, unsigned& nloc, unsigned& nx) {
    const unsigned G = gridDim.x * gridDim.y * gridDim.z;
    unsigned sum, cnt, mine, sp = 0u;
    for (;;) {
        sum = 0u; cnt = 0u; mine = 0u;
#pragma unroll
        for (unsigned j = 0; j < 16; ++j) { const unsigned c = xb_ld(&bar[XB_XCNT(j)]); sum += c; cnt += (c > 0u) ? 1u : 0u; mine = (j == x) ? c : mine; }
        if (sum == G) break;
        __builtin_amdgcn_s_sleep(1);
        if ((++sp & 255u) == 0u) { if (xb_ld(&bar[XB_TMO])) break; if (sp > XB_SPIN_CAP) { atomicAdd(&bar[XB_TMO], 1u); break; } }
    }
    nloc = mine > 0u ? mine : 1u; nx = cnt > 0u ? cnt : 1u;
}
__device__ __forceinline__ void xcd_barrier(const XcdBarrier& b, bool t0) {
    asm volatile("s_waitcnt vmcnt(0)" ::: "memory");
    __syncthreads();
    if (t0) {
        unsigned* bar = b.bar;
        __builtin_amdgcn_s_waitcnt(0);
        unsigned nloc = b.st[0], nx = b.st[1];
        if (nloc == 0u) { xcd_barrier_complete(bar, b.x, nloc, nx); b.st[0] = nloc; b.st[1] = nx; }
        const unsigned old = xb_add(&bar[XB_XSUB(b.x)], 1u);
        const unsigned gen = old / nloc;
        if (old + 1u == (gen + 1u) * nloc) {
            __builtin_amdgcn_fence(__ATOMIC_RELEASE, "agent");
            asm volatile("s_waitcnt vmcnt(0)" ::: "memory");
            const unsigned og = xb_add(&bar[XB_TOP], 1u);
            const unsigned tg = og / nx;
            if (og + 1u == (tg + 1u) * nx) xb_add(&bar[XB_TOPGEN], 1u);
            else XB_SPIN(xb_ld(&bar[XB_TOPGEN]) == tg, bar);
            __builtin_amdgcn_fence(__ATOMIC_ACQUIRE, "agent");
            xb_add(&bar[XB_XGEN(b.x)], 1u);
            asm volatile("s_waitcnt vmcnt(0)" ::: "memory");
        } else {
            XB_SPIN(xb_ld(&bar[XB_XGEN(b.x)]) == gen, bar);
            __builtin_amdgcn_fence(__ATOMIC_ACQUIRE, "agent");
            asm volatile("s_waitcnt vmcnt(0)" ::: "memory");
        }
    }
    __syncthreads();
}

namespace pg8 {
constexpr int BM = 256, BK = 64, HALF = 128, HTB = HALF * BK * 2, STAGE_BYTES = 8 * HTB, NXCD = 8, WGM = 8;
__host__ __device__ __forceinline__ int lds_byte(int r, int c) { const int st = (r >> 4) * 2 + (c >> 5), rr = r & 15, cc = c & 31, ob = rr * 64 + cc * 2; return st * 1024 + (ob ^ (((ob >> 9) & 1) << 5)); }
__host__ __device__ __forceinline__ void stage_rc(int b, int& R, int& C) { const int st = b / 1024, sb = b % 1024, swz = sb ^ (((sb >> 9) & 1) << 5); R = (st >> 1) * 16 + swz / 64; C = (st & 1) * 32 + (swz % 64) / 2; }
__host__ __device__ __forceinline__ int perm32(int rho) { const int n = rho >> 4, i = rho & 15; return 8 * (i >> 2) + 4 * n + (i & 3); }

struct Unit { int pm, pn, e, lbase, nvalid; };
struct Gemm { const bf16* A; const bf16* Bt; int M, N, K; };

struct StaticOrder {
    static constexpr bool GATHER = false;
    int nM, nN, nwg, G, c;
    __device__ void init(int M_, int N_, int G_, int c_) { nM = M_ / BM; nN = N_ / BM; nwg = nM * nN; G = G_; c = c_; }
    __device__ bool next(int i, Unit& u) const {
        const long L = (long)i * G + c; if (L >= nwg) return false;
        int wgid = (int)L; { const int q = nwg / NXCD, r = nwg % NXCD, xcd = wgid % NXCD, off = wgid / NXCD; wgid = (xcd < r ? xcd * (q + 1) : r * (q + 1) + (xcd - r) * q) + off; }
        const int nig = WGM * nN, gid = wgid / nig, fm = gid * WGM, gsz = (nM - fm) < WGM ? (nM - fm) : WGM;
        u.pm = fm + ((wgid % nig) % gsz); u.pn = (wgid % nig) / gsz; u.e = 0; u.lbase = 0; u.nvalid = 256; return true;
    }
    __device__ __forceinline__ int arow(const Unit& u, int r) const { return u.pm * BM + r; }
};
template <bool GATHER_> struct MoeOrder {
    static constexpr bool GATHER = GATHER_;
    const LAS int* tp; const LAS int* cnt; const int2* list; int NT, nwg, G, c; const LAS int* ord;
    __device__ bool next(int i, Unit& u) const {
        const long L = (long)i * G + c; if (L >= nwg) return false;
        int w = (int)L; { const int q = nwg / NXCD, r = nwg % NXCD, xcd = w % NXCD, off = w / NXCD; w = (xcd < r ? xcd * (q + 1) : r * (q + 1) + (xcd - r) * q) + off; }
        const int po = w / NT, pnl = w - po * NT, pmg = ord[po];
        typedef int i32x4 __attribute__((ext_vector_type(4)));
        const i32x4 t0 = *(const LAS i32x4*)tp, t1 = *(const LAS i32x4*)(tp + 4), t2 = *(const LAS i32x4*)(tp + 8), t3 = *(const LAS i32x4*)(tp + 12);
        const int e = (pmg >= t0.y) + (pmg >= t0.z) + (pmg >= t0.w) + (pmg >= t1.x) + (pmg >= t1.y) + (pmg >= t1.z) + (pmg >= t1.w)
                    + (pmg >= t2.x) + (pmg >= t2.y) + (pmg >= t2.z) + (pmg >= t2.w) + (pmg >= t3.x) + (pmg >= t3.y) + (pmg >= t3.z) + (pmg >= t3.w);
        static_assert(NE == 16, "MoeOrder::next reads tp[0..15]");
        const int tile = pmg - tp[e];
        u.pm = pmg; u.pn = e * NT + pnl; u.e = e; u.lbase = e * CAP + tile * 256; const int nv = cnt[e] - tile * 256; u.nvalid = nv < 256 ? nv : 256; return true;
    }
    __device__ __forceinline__ int arow(const Unit& u, int r) const { if (!GATHER_) return u.pm * BM + r; return r < u.nvalid ? (list[u.lbase + r].x >> 1) : 0; }
};

template <class Epi, class Sched>
__device__ __forceinline__ void gemm_simple(int wid, int lane, const Gemm g, const Sched& S, const Epi& E) {
    const int wr = wid >> 2, wc = wid & 3, fr = lane & 15, fq = lane >> 4;
    const int K = g.K;
    for (int ui = 0;; ++ui) {
        Unit u; if (!S.next(ui, u)) break;
        f32x4 acc[2][2][4][2];
#pragma unroll
        for (int a = 0; a < 2; ++a)
#pragma unroll
            for (int b = 0; b < 2; ++b)
#pragma unroll
                for (int m = 0; m < 4; ++m)
#pragma unroll
                    for (int n = 0; n < 2; ++n) acc[a][b][m][n] = (f32x4){0.f, 0.f, 0.f, 0.f};
        unsigned ap[2][4], bp[2][2];
#pragma unroll
        for (int a = 0; a < 2; ++a)
#pragma unroll
            for (int m = 0; m < 4; ++m) ap[a][m] = (unsigned)S.arow(u, a * HALF + wr * 64 + m * 16 + fr) * (unsigned)K + fq * 8;
#pragma unroll
        for (int b = 0; b < 2; ++b)
#pragma unroll
            for (int n = 0; n < 2; ++n) { const int rho = 16 * n + fr; bp[b][n] = (unsigned)(u.pn * BM + b * HALF + wc * 32 + (Epi::PERM ? perm32(rho) : rho)) * (unsigned)K + fq * 8; }
#pragma unroll 1
        for (int k = 0; k < K; k += 32) {
            bf16x8 Af[2][4], Bf[2][2];
#pragma unroll
            for (int a = 0; a < 2; ++a)
#pragma unroll
                for (int m = 0; m < 4; ++m) Af[a][m] = *(const bf16x8*)(g.A + ap[a][m] + k);
#pragma unroll
            for (int b = 0; b < 2; ++b)
#pragma unroll
                for (int n = 0; n < 2; ++n) Bf[b][n] = *(const bf16x8*)(g.Bt + bp[b][n] + k);
#pragma unroll
            for (int a = 0; a < 2; ++a)
#pragma unroll
                for (int b = 0; b < 2; ++b)
#pragma unroll
                    for (int m = 0; m < 4; ++m)
#pragma unroll
                        for (int n = 0; n < 2; ++n) acc[a][b][m][n] = __builtin_amdgcn_mfma_f32_16x16x32_bf16(Bf[b][n], Af[a][m], acc[a][b][m][n], 0, 0, 0);
        }
        E(acc, u, wr, wc, fr, fq);
    }
}

typedef int v8i32 __attribute__((ext_vector_type(8)));
typedef int v4i32 __attribute__((ext_vector_type(4)));
template <class Epi, class Sched, bool F8 = false>
__device__ __forceinline__ void gemm_phase(int wid, int lane, LAS unsigned char* lds, const Gemm g, const Sched& S, const Epi& E) {
    const int tid = wid * 64 + lane, wr = wid >> 2, wc = wid & 3, fr = lane & 15, fq = lane >> 4;
    const int K = F8 ? g.K / 2 : g.K  , nt = K / BK;
    unsigned voffA[2], voffB[2]; int Rr[2], Cc[2];
#pragma unroll
    for (int i = 0; i < 2; ++i) { int R, C; stage_rc(tid * 16 + i * 8192, R, C); const int Rb = Epi::PERM ? ((R & ~31) + perm32(R & 31)) : R;
        voffA[i] = (unsigned)(R * K + C) * 2u; voffB[i] = (unsigned)(Rb * K + C) * 2u; Rr[i] = R; Cc[i] = C; }
    const unsigned kstep = (unsigned)(BK * 2);
    const unsigned hstep = (unsigned)HALF * (unsigned)K * 2u;
    const unsigned tstep = 2 * hstep;
    const __amdgpu_buffer_rsrc_t rsA = make_rsrc(g.A, 0x7fffffff), rsB = make_rsrc(g.Bt, 0x7fffffff);
    const unsigned ldsw = (unsigned)wid * 1024u;
    const int aoff0 = lds_byte(wr * 64 + fr, F8 ? fq * 16 : fq * 8), aoff1 = F8 ? lds_byte(wr * 64 + fr, fq * 16 + 8) : aoff0 + 1024;
    const int boff0 = lds_byte(wc * 32 + fr, F8 ? fq * 16 : fq * 8), boff1 = F8 ? lds_byte(wc * 32 + fr, fq * 16 + 8) : boff0 + 1024;
#define PG8_SA(b, h) (((b) * 2 + (h)) * HTB)
#define PG8_SB(b, h) ((4 + (b) * 2 + (h)) * HTB)
#define PG8_STAGE(bufoff, soff, voff) do { _Pragma("unroll") for (int _i = 0; _i < 2; ++_i) \
        __builtin_amdgcn_raw_ptr_buffer_load_lds(rsB, (LAS void*)(lds + (bufoff) + ldsw + _i * 8192), 16, (int)(voff)[_i], (int)(soff), 0, 0); } while (0)
#define PG8_STAGE_A(bufoff, h, contig_off, kt_bytes, use_next) do { _Pragma("unroll") for (int _i = 0; _i < 2; ++_i) { \
        const unsigned vo_ = Sched::GATHER ? ((use_next) ? gN[h][_i] : gC[h][_i]) : voffA[_i]; const unsigned so_ = Sched::GATHER ? (unsigned)(kt_bytes) : (unsigned)(contig_off); \
        __builtin_amdgcn_raw_ptr_buffer_load_lds(rsA, (LAS void*)(lds + (bufoff) + ldsw + _i * 8192), 16, (int)vo_, (int)so_, 0, 0); } } while (0)
#define PG8_GOFF(u_, o_) do { _Pragma("unroll") for (int _h = 0; _h < 2; ++_h) _Pragma("unroll") for (int _i = 0; _i < 2; ++_i) \
        o_[_h][_i] = ((unsigned)S.arow(u_, _h * HALF + Rr[_i]) * (unsigned)K + (unsigned)Cc[_i]) * 2u; } while (0)
#define PG8_LDA(dst, b, h) do { _Pragma("unroll") for (int m = 0; m < 4; ++m) { dst[m][0] = *(const LAS bf16x8*)(lds + PG8_SA(b, h) + aoff0 + m * 2048); dst[m][1] = *(const LAS bf16x8*)(lds + PG8_SA(b, h) + aoff1 + m * 2048); } } while (0)
#define PG8_LDB(dst, b, h) do { _Pragma("unroll") for (int n = 0; n < 2; ++n) { dst[n][0] = *(const LAS bf16x8*)(lds + PG8_SB(b, h) + boff0 + n * 2048); dst[n][1] = *(const LAS bf16x8*)(lds + PG8_SB(b, h) + boff1 + n * 2048); } } while (0)
#define PG8_V8(x_) __builtin_shufflevector(__builtin_bit_cast(v4i32, (x_)[0]), __builtin_bit_cast(v4i32, (x_)[1]), 0, 1, 2, 3, 4, 5, 6, 7)
#define PG8_MMA(ai, bj, At, Bt) do { __builtin_amdgcn_s_setprio(1); _Pragma("unroll") for (int m = 0; m < 4; ++m) _Pragma("unroll") for (int n = 0; n < 2; ++n) { \
        if constexpr (F8) { const v8i32 b8_ = PG8_V8(Bt[n]), a8_ = PG8_V8(At[m]);   \
            asm volatile("v_mfma_scale_f32_16x16x128_f8f6f4 %0, %1, %2, %0, %3, %4 op_sel_hi:[0,0,0]" : "+v"(acc[ai][bj][m][n]) : "v"(b8_), "v"(a8_), "v"(sc_w), "v"(sc_a)); } \
        else { _Pragma("unroll") for (int k = 0; k < 2; ++k) acc[ai][bj][m][n] = __builtin_amdgcn_mfma_f32_16x16x32_bf16(Bt[n][k], At[m][k], acc[ai][bj][m][n], 0, 0, 0); } } \
        __builtin_amdgcn_s_setprio(0); } while (0)
#define PG8_WAIT_V(n) asm volatile("s_waitcnt vmcnt(" #n ")" ::: "memory")
#define PG8_WAIT_L(n) asm volatile("s_waitcnt lgkmcnt(" #n ")" ::: "memory")
#define PG8_BAR __builtin_amdgcn_s_barrier()
#define PG8_SCHED __builtin_amdgcn_sched_barrier(0)
    const int sc_w = 0x7a7a7a7a  , sc_a = 0x7f7f7f7f  ; (void)sc_w; (void)sc_a;
    Unit cur, nxt; int ui = 0; int relaxN = 0;
    if (!S.next(0, cur)) return;
    unsigned gC[2][2], gN[2][2];
    int2 lreg = make_int2(0, 0);
    if constexpr (Epi::LISTPRE) { if (tid < 256) { const int2 t_ = E.list[cur.lbase + (tid < cur.nvalid ? tid : 0)]; E.lb[tid] = (u32x2){(unsigned)t_.x, (unsigned)t_.y}; } }
    if constexpr (Sched::GATHER) { PG8_GOFF(cur, gC); }
    else {
#pragma unroll
        for (int h = 0; h < 2; ++h)
#pragma unroll
            for (int i = 0; i < 2; ++i) { gC[h][i] = 0u; gN[h][i] = 0u; } }
    f32x4 acc[2][2][4][2];
#pragma unroll
    for (int a = 0; a < 2; ++a)
#pragma unroll
        for (int b = 0; b < 2; ++b)
#pragma unroll
            for (int m = 0; m < 4; ++m)
#pragma unroll
                for (int n = 0; n < 2; ++n) acc[a][b][m][n] = (f32x4){0.f, 0.f, 0.f, 0.f};
    bf16x8 At[4][2], B0[2][2], B1[2][2];
    unsigned cA = Sched::GATHER ? 0u : (unsigned)cur.pm * tstep, cB = (unsigned)cur.pn * tstep;
    PG8_STAGE(PG8_SB(0, 0), cB, voffB); PG8_STAGE(PG8_SB(0, 1), cB + hstep, voffB); PG8_STAGE_A(PG8_SA(0, 0), 0, cA, 0, false); PG8_STAGE_A(PG8_SA(0, 1), 1, cA + hstep, 0, false);
    if (wr == 1) PG8_BAR;
    PG8_WAIT_V(2); PG8_BAR;
    PG8_STAGE(PG8_SB(1, 0), cB + kstep, voffB); PG8_STAGE_A(PG8_SA(1, 0), 0, cA + kstep, kstep, false); PG8_STAGE(PG8_SB(1, 1), cB + hstep + kstep, voffB);
    PG8_WAIT_V(6); PG8_BAR;
    for (;;) {
        const bool has_next = S.next(ui + 1, nxt);
        if constexpr (Epi::LISTPRE) { if (has_next && tid < 256) lreg = E.list[nxt.lbase + (tid < nxt.nvalid ? tid : 0)]; }
        if constexpr (Sched::GATHER) { if (has_next) { PG8_GOFF(nxt, gN); } else {
#pragma unroll
            for (int h = 0; h < 2; ++h)
#pragma unroll
                for (int i = 0; i < 2; ++i) gN[h][i] = gC[h][i]; } }
        const unsigned nA = (has_next && !Sched::GATHER) ? (unsigned)nxt.pm * tstep : cA, nB = has_next ? (unsigned)nxt.pn * tstep : cB;
        for (int t = 0; t < nt; t += 2) {
            const bool last = (t == nt - 2);
            const unsigned a1 = cA + (unsigned)(t + 1) * kstep;
            const unsigned a2 = last ? nA : cA + (unsigned)(t + 2) * kstep, b2 = last ? nB : cB + (unsigned)(t + 2) * kstep;
            const unsigned a3 = a2 + kstep, b3 = b2 + kstep;
            const unsigned k1 = (unsigned)(t + 1) * kstep, k2 = last ? 0u : (unsigned)(t + 2) * kstep, k3 = k2 + kstep;
            const bool first = (t == 0), rlx = first && relaxN > 0, halfu = cur.nvalid <= 128;
#define PG8_WAIT_VR() do { if (rlx) { if (relaxN == 8) PG8_WAIT_V(16); else if (relaxN == 16) PG8_WAIT_V(24); else PG8_WAIT_V(8); } else PG8_WAIT_V(8); } while (0)
            PG8_LDB(B0, 0, 0); PG8_LDB(B1, 0, 1); PG8_SCHED; PG8_LDA(At, 0, 0); if (!(first && ui > 0)) PG8_STAGE_A(PG8_SA(1, 1), 1, a1 + hstep, k1, false);
            PG8_WAIT_VR(); PG8_WAIT_L(0); PG8_BAR; PG8_MMA(0, 0, At, B0); PG8_MMA(0, 1, At, B1); PG8_BAR; PG8_SCHED;
            PG8_LDA(At, 0, 1); PG8_STAGE(PG8_SB(0, 0), b2, voffB); PG8_STAGE(PG8_SB(0, 1), b2 + hstep, voffB); PG8_STAGE_A(PG8_SA(0, 0), 0, a2, k2, last);
            PG8_WAIT_VR(); PG8_WAIT_L(0); PG8_BAR; if (!halfu) { PG8_MMA(1, 0, At, B0); PG8_MMA(1, 1, At, B1); } PG8_BAR; PG8_SCHED;
            PG8_LDB(B0, 1, 0); PG8_LDB(B1, 1, 1); PG8_SCHED; PG8_LDA(At, 1, 0); PG8_STAGE_A(PG8_SA(0, 1), 1, a2 + hstep, k2, last);
            PG8_WAIT_VR(); PG8_WAIT_L(0); PG8_BAR; PG8_MMA(0, 0, At, B0); PG8_MMA(0, 1, At, B1); PG8_BAR; PG8_SCHED;
            PG8_LDA(At, 1, 1); PG8_STAGE(PG8_SB(1, 0), b3, voffB); PG8_STAGE(PG8_SB(1, 1), b3 + hstep, voffB); PG8_STAGE_A(PG8_SA(1, 0), 0, a3, k3, last);
            PG8_WAIT_V(8); PG8_WAIT_L(0); PG8_BAR; if (!halfu) { PG8_MMA(1, 0, At, B0); PG8_MMA(1, 1, At, B1); } PG8_BAR; PG8_SCHED;
            if (last && has_next) { PG8_STAGE_A(PG8_SA(1, 1), 1, a3 + hstep, k3, true); PG8_SCHED; }
#undef PG8_WAIT_VR
        }
        if (wr == 0) PG8_BAR;
        if constexpr (F8) asm volatile("s_nop 15\n\ts_nop 15" ::: "memory");
        if constexpr (Epi::LISTPRE) { if (has_next && tid < 256) E.lb[((ui + 1) & 1) * 256 + tid] = (u32x2){(unsigned)lreg.x, (unsigned)lreg.y}; E.sel = ui & 1; }
        E(acc, cur, wr, wc, fr, fq);
        relaxN = has_next ? E.stores_lb(cur) : 0;
        if (!has_next) break;
#pragma unroll
        for (int a = 0; a < 2; ++a)
#pragma unroll
            for (int b = 0; b < 2; ++b)
#pragma unroll
                for (int m = 0; m < 4; ++m)
#pragma unroll
                    for (int n = 0; n < 2; ++n) acc[a][b][m][n] = (f32x4){0.f, 0.f, 0.f, 0.f};
        cur = nxt; cA = nA; cB = nB; ++ui;
#pragma unroll
        for (int h = 0; h < 2; ++h)
#pragma unroll
            for (int i = 0; i < 2; ++i) gC[h][i] = gN[h][i];
        if (wr == 1) PG8_BAR;
    }
    PG8_WAIT_V(0);
    PG8_BAR;
#undef PG8_SA
#undef PG8_SB
#undef PG8_STAGE
#undef PG8_STAGE_A
#undef PG8_GOFF
#undef PG8_LDA
#undef PG8_LDB
#undef PG8_MMA
#undef PG8_V8
#undef PG8_WAIT_V
#undef PG8_WAIT_L
#undef PG8_BAR
#undef PG8_SCHED
}
}
using pg8::Unit; using pg8::Gemm; using pg8::HALF; using pg8::BM;

#if USE_FAST_GEMM
#define GEMM_PHASE(EpiT, SchedT, lds, g, S, E) pg8::gemm_phase<EpiT, SchedT>(F.wave0, fresh_lane(), lds, g, S, E)
#define GEMM_PHASE_F8(EpiT, SchedT, lds, g, S, E) pg8::gemm_phase<EpiT, SchedT, true>(F.wave0, fresh_lane(), lds, g, S, E)
#else
#define GEMM_PHASE(EpiT, SchedT, lds, g, S, E) pg8::gemm_simple<EpiT, SchedT>(F.wave0, fresh_lane(), g, S, E)
#endif

__device__ __forceinline__ void st_bf8(bf16* p, f32x4 a, f32x4 b) { u32x4 w; w.x = pk2(a.x, a.y); w.y = pk2(a.z, a.w); w.z = pk2(b.x, b.y); w.w = pk2(b.z, b.w); *(u32x4*)p = w; }
__device__ __forceinline__ float lane32_partner(float v, bool upper) {
    auto rr = __builtin_amdgcn_permlane32_swap(__float_as_uint(v), __float_as_uint(v), false, false); return __uint_as_float(upper ? rr[0] : rr[1]);
}
struct EpiInProj {
    static constexpr bool PERM = true, AFTER_DRAIN = false, LISTPRE = false;
    bf16* PROJ; bf16* Q; bf16* KB; bf16* VB; const LAS float* tabc; const LAS float* tabs; int pn_off;
    __device__ __forceinline__ int stores_lb(const Unit& u) const { return (u.pn + pn_off) < 8 ? 8 : 16; }
    __device__ __forceinline__ void operator()(const f32x4 (&acc)[2][2][4][2], const Unit& u, int wr, int wc, int fr, int fq) const {
        const int pn = u.pn + pn_off;
        if (pn < 8) {
#pragma unroll
            for (int ai = 0; ai < 2; ++ai)
#pragma unroll
                for (int m = 0; m < 4; ++m) { const int row = u.pm * BM + ai * HALF + wr * 64 + m * 16 + fr;
                    st_bf8(PROJ + (size_t)row * 2048 + pn * 128 + wc * 32 + 8 * fq, acc[ai][0][m][0] * acc[ai][1][m][0], acc[ai][0][m][1] * acc[ai][1][m][1]); }
        } else if (pn < 12) {
#pragma unroll
            for (int ai = 0; ai < 2; ++ai)
#pragma unroll
                for (int m = 0; m < 4; ++m) { const int row = u.pm * BM + ai * HALF + wr * 64 + m * 16 + fr; bf16* rp = PROJ + (size_t)row * 2048 + 1024 + (pn - 8) * 256 + wc * 32 + 8 * fq;
#pragma unroll
                    for (int bj = 0; bj < 2; ++bj) st_bf8(rp + bj * HALF, acc[ai][bj][m][0], acc[ai][bj][m][1]); }
        } else if (pn < 20) {
            const bool isq = pn < 16; const int cb = (pn - (isq ? 12 : 16)) * 256 + wc * 32 + 8 * fq; const size_t kb_minus_q = (size_t)((unsigned char*)KB - (unsigned char*)Q); const int axis = wc & 1; const bool upper = fq >= 2; const int fo = 8 * (fq & 1);
#pragma unroll
            for (int ai = 0; ai < 2; ++ai)
#pragma unroll
                for (int m = 0; m < 4; ++m) { const int row = u.pm * BM + ai * HALF + wr * 64 + m * 16 + fr; const int t = row & (SEQ - 1), b = row >> 13;
                    const int pos = axis ? (t & 63) : (t >> 6);
                    f32x4 cs0 = *(const LAS f32x4*)(tabc + pos * 16 + fo), cs1 = *(const LAS f32x4*)(tabc + pos * 16 + fo + 4); f32x4 sn0 = *(const LAS f32x4*)(tabs + pos * 16 + fo), sn1 = *(const LAS f32x4*)(tabs + pos * 16 + fo + 4);
                    if (!upper) { sn0 = -sn0; sn1 = -sn1; }
                    unsigned char* rp = (unsigned char*)Q + (isq ? ((size_t)row * 1024 + cb) : (kb_minus_q + ((size_t)b * KV + CTXL + t) * 1024 + cb));
                    if (isq) { cs0 = cs0 * QSCALE; cs1 = cs1 * QSCALE; sn0 = sn0 * QSCALE; sn1 = sn1 * QSCALE; }
#pragma unroll
                    for (int bj = 0; bj < 2; ++bj) { const f32x4 a0 = acc[ai][bj][m][0], a1 = acc[ai][bj][m][1];
                        const f32x4 p0 = (f32x4){lane32_partner(a0.x, upper), lane32_partner(a0.y, upper), lane32_partner(a0.z, upper), lane32_partner(a0.w, upper)};
                        const f32x4 p1 = (f32x4){lane32_partner(a1.x, upper), lane32_partner(a1.y, upper), lane32_partner(a1.z, upper), lane32_partner(a1.w, upper)};
                        st_f8x8(rp + bj * HALF, a0 * cs0 + p0 * sn0, a1 * cs1 + p1 * sn1); } }
        } else {
            const int cb = (pn - 20) * 256 + wc * 32 + 8 * fq;
#pragma unroll
            for (int ai = 0; ai < 2; ++ai)
#pragma unroll
                for (int m = 0; m < 4; ++m) { const int row = u.pm * BM + ai * HALF + wr * 64 + m * 16 + fr; const int t = row & (SEQ - 1), b = row >> 13;
                    unsigned char* rp = (unsigned char*)VB + ((size_t)b * KV + CTXL + t) * 1024 + cb;
#pragma unroll
                    for (int bj = 0; bj < 2; ++bj) st_f8x8(rp + bj * HALF, acc[ai][bj][m][0], acc[ai][bj][m][1]); }
        }
    }
};
struct EpiCtx {
    static constexpr bool PERM = true, AFTER_DRAIN = false, LISTPRE = false;
    bf16* KB; bf16* VB;
    __device__ __forceinline__ int stores_lb(const Unit&) const { return 16; }
    __device__ __forceinline__ void operator()(const f32x4 (&acc)[2][2][4][2], const Unit& u, int wr, int wc, int fr, int fq) const {
        const bool isk = u.pn < 4; const int cb = (u.pn & 3) * 256 + wc * 32 + 8 * fq;
#pragma unroll
        for (int ai = 0; ai < 2; ++ai)
#pragma unroll
            for (int m = 0; m < 4; ++m) { const int row = u.pm * BM + ai * HALF + wr * 64 + m * 16 + fr; const int t = row & (CTXL - 1), b = row >> 8;
                const size_t eo = ((size_t)b * KV + t) * 1024 + cb;
#pragma unroll
                for (int bj = 0; bj < 2; ++bj) st_f8x8((unsigned char*)(isk ? KB : VB) + eo + bj * HALF, acc[ai][bj][m][0], acc[ai][bj][m][1]); }
    }
};
template <bool RES_F32> struct EpiRes {
    static constexpr bool PERM = true, AFTER_DRAIN = false, LISTPRE = false;
    const float* xf; const bf16* xb; const float* gate  ; bf16* R;
    __device__ __forceinline__ int stores_lb(const Unit&) const { return 16; }
    struct Raw { f32x4 f[2][2][2]; u32x4 h[2][2]; };
    __device__ __forceinline__ void load(Raw& r, const Unit& u, int st, int wr, int fr, int cb) const {
        const int ai = st >> 1, mp = (st & 1) * 2;
#pragma unroll
        for (int mm = 0; mm < 2; ++mm) { const size_t off = (size_t)(u.pm * BM + ai * HALF + wr * 64 + (mp + mm) * 16 + fr) * D + cb;
#pragma unroll
            for (int bj = 0; bj < 2; ++bj) {
                if (RES_F32) { r.f[mm][bj][0] = *(const f32x4*)(xf + off + bj * HALF); r.f[mm][bj][1] = *(const f32x4*)(xf + off + bj * HALF + 4); }
                else r.h[mm][bj] = *(const u32x4*)(xb + off + bj * HALF); } }
    }
    __device__ __forceinline__ void operator()(const f32x4 (&acc)[2][2][4][2], const Unit& u, int wr, int wc, int fr, int fq) const {
        const int cb = u.pn * BM + wc * 32 + 8 * fq; const int b = (u.pm * BM) >> 13;
        f32x4 gv[2][2];
#pragma unroll
        for (int bj = 0; bj < 2; ++bj)
#pragma unroll
            for (int n = 0; n < 2; ++n) gv[bj][n] = *(const f32x4*)(gate + (size_t)b * (6 * D) + cb + bj * HALF + 4 * n);
        Raw ra, rb2; load(ra, u, 0, wr, fr, cb);
#pragma unroll
        for (int st = 0; st < 4; ++st) {
            Raw& cur = (st & 1) ? rb2 : ra; Raw& nxt = (st & 1) ? ra : rb2;
            if (st < 3) load(nxt, u, st + 1, wr, fr, cb);
            const int ai = st >> 1, mp = (st & 1) * 2;
#pragma unroll
            for (int mm = 0; mm < 2; ++mm) { const size_t off = (size_t)(u.pm * BM + ai * HALF + wr * 64 + (mp + mm) * 16 + fr) * D + cb;
#pragma unroll
                for (int bj = 0; bj < 2; ++bj) { f32x4 r0, r1;
                    if (RES_F32) { r0 = cur.f[mm][bj][0]; r1 = cur.f[mm][bj][1]; }
                    else { const u32x4 w = cur.h[mm][bj]; r0 = (f32x4){bf_lo(w.x), bf_hi(w.x), bf_lo(w.y), bf_hi(w.y)}; r1 = (f32x4){bf_lo(w.z), bf_hi(w.z), bf_lo(w.w), bf_hi(w.w)}; }
                    st_bf8(R + off + bj * HALF, r0 * ALPHA + gv[bj][0] * acc[ai][bj][mp + mm][0], r1 * ALPHA + gv[bj][1] * acc[ai][bj][mp + mm][1]); } }
        }
    }
};
struct EpiGU {
    static constexpr bool PERM = true, AFTER_DRAIN = false, LISTPRE = false;
    unsigned char* HID;
    __device__ __forceinline__ int stores_lb(const Unit&) const { return 8; }
    __device__ __forceinline__ void operator()(const f32x4 (&acc)[2][2][4][2], const Unit& u, int wr, int wc, int fr, int fq) const {
        const int cb = (u.pn & 3) * 128 + wc * 32 + 8 * fq;
#pragma unroll
        for (int ai = 0; ai < 2; ++ai)
#pragma unroll
            for (int m = 0; m < 4; ++m) { const int row = u.pm * BM + ai * HALF + wr * 64 + m * 16 + fr;
                const f32x4 g0 = acc[ai][0][m][0], g1 = acc[ai][0][m][1], u0 = acc[ai][1][m][0], u1 = acc[ai][1][m][1]; u32x2 w;
                w.x = pk4_fp8(silu_f(g0.x) * u0.x, silu_f(g0.y) * u0.y, silu_f(g0.z) * u0.z, silu_f(g0.w) * u0.w); w.y = pk4_fp8(silu_f(g1.x) * u1.x, silu_f(g1.y) * u1.y, silu_f(g1.z) * u1.z, silu_f(g1.w) * u1.w);
                *(u32x2*)(HID + (size_t)row * ED + cb) = w; }
    }
};
struct EpiDown {
    static constexpr bool PERM = true, AFTER_DRAIN = false, LISTPRE = true;
    const int2* list; bf16* YB; LAS u32x2* lb; mutable int sel = 0;
    __device__ __forceinline__ int stores_lb(const Unit& u) const { return u.nvalid == 256 ? 16 : 0; }
    __device__ __forceinline__ void operator()(const f32x4 (&acc)[2][2][4][2], const Unit& u, int wr, int wc, int fr, int fq) const {
        const int cb = (u.pn & 7) * 256 + wc * 32 + 8 * fq;
        int2 le[2][4];
#pragma unroll
        for (int ai = 0; ai < 2; ++ai)
#pragma unroll
            for (int m = 0; m < 4; ++m) { const int rl = ai * HALF + wr * 64 + m * 16 + fr; const u32x2 t_ = lb[sel * 256 + rl]; le[ai][m] = make_int2((int)t_.x, (int)t_.y); }
#pragma unroll
        for (int ai = 0; ai < 2; ++ai)
#pragma unroll
            for (int m = 0; m < 4; ++m) { const int rl = ai * HALF + wr * 64 + m * 16 + fr;
                if (rl < u.nvalid) { const float w = __int_as_float(le[ai][m].y); bf16* rp = YB + (size_t)le[ai][m].x * D + cb;
#pragma unroll
                    for (int bj = 0; bj < 2; ++bj) st_bf8(rp + bj * HALF, acc[ai][bj][m][0] * w, acc[ai][bj][m][1] * w); } }
    }
};
struct EpiGelu {
    static constexpr bool PERM = true, AFTER_DRAIN = false, LISTPRE = false;
    bf16* UV; float* vst;
    __device__ __forceinline__ int stores_lb(const Unit&) const { return 16; }
    __device__ __forceinline__ void operator()(const f32x4 (&acc)[2][2][4][2], const Unit& u, int wr, int wc, int fr, int fq) const {
        const int cb = u.pn * BM + wc * 32 + 8 * fq; const bool isv = u.pn >= 8;
#pragma unroll
        for (int ai = 0; ai < 2; ++ai)
#pragma unroll
            for (int m = 0; m < 4; ++m) { const int row = u.pm * BM + ai * HALF + wr * 64 + m * 16 + fr; bf16* rp = UV + (size_t)row * 4096 + cb; float s = 0.f, s2 = 0.f;
#pragma unroll
                for (int bj = 0; bj < 2; ++bj) { f32x4 v[2];
#pragma unroll
                    for (int n = 0; n < 2; ++n) { const f32x4 a = acc[ai][bj][m][n]; v[n] = (f32x4){gelu_tanh_f(a.x), gelu_tanh_f(a.y), gelu_tanh_f(a.z), gelu_tanh_f(a.w)};
                        s += (v[n].x + v[n].y) + (v[n].z + v[n].w); s2 += (v[n].x * v[n].x + v[n].y * v[n].y) + (v[n].z * v[n].z + v[n].w * v[n].w); }
                    st_bf8(rp + bj * HALF, v[0], v[1]); }
                if (isv) { s += __shfl_xor(s, 16); s += __shfl_xor(s, 32); s2 += __shfl_xor(s2, 16); s2 += __shfl_xor(s2, 32);
                    if (fq == 0) *(f32x2*)(vst + (((size_t)row * 8 + (u.pn - 8)) * 4 + wc) * 2) = (f32x2){s, s2}; } }
    }
};

__device__ __forceinline__ int fresh_lane() { int l; asm volatile("v_mbcnt_lo_u32_b32 %0, -1, 0\n\tv_mbcnt_hi_u32_b32 %0, -1, %0" : "=v"(l)); return l; }
#define fresh_tid() (F.wave0 * 64 + fresh_lane())
#define PH_IDS const int lane = fresh_lane(), wave = F.wave0, tid = wave * 64 + lane; (void)tid; (void)lane; (void)wave
struct Frame {
    LAS unsigned char* lds; volatile LAS unsigned* MISC; unsigned* ctl;
    int vcu, G, wave0;
    const float* in[27]; float* out; unsigned char* ws;
};
#define WSP(T, off) ((T*)(F.ws + (off)))
#define MODP(l, r, i) (WSP(float, WS_MOD) + (((l) * 5 + (r)) * 6 + (i)) * D)

__device__ __forceinline__ void tr_item(const float* W, int N, bf16* WT, int Kd, int item, int mode, LAS float* scr, int lane) {
    const int nblk = N / 32, kb = item / nblk, nb = item - kb * nblk, k0 = 64 * kb, n0 = 32 * nb;
    int d0 = mode ? (((n0 >> 7) << 8) + (n0 & 127) + (mode == 2 ? 128 : 0)) : n0;
    if (mode == 3) { const int c = n0 & 1023; d0 = n0 >= 3072 ? n0 : n0 < 1024 ? (((c >> 7) << 8) + (c & 127)) : n0 < 2048 ? 2048 + c : (((c >> 7) << 8) + 128 + (c & 127)); }
#pragma unroll 8
    for (int i = 0; i < 32; ++i) { const int kk = 2 * i + (lane >> 5); scr[kk * 33 + (lane & 31)] = W[(size_t)(k0 + kk) * N + n0 + (lane & 31)]; }
    LDS_WAIT(); asm volatile("" ::: "memory");
    const int c = lane & 7;
#pragma unroll
    for (int j = 0; j < 4; ++j) { const int n = (lane >> 3) + 8 * j; const LAS float* s = scr + (8 * c) * 33 + n;
        u32x4 o; o.x = pk2(s[0 * 33], s[1 * 33]); o.y = pk2(s[2 * 33], s[3 * 33]); o.z = pk2(s[4 * 33], s[5 * 33]); o.w = pk2(s[6 * 33], s[7 * 33]);
        *(u32x4*)(WT + (size_t)(d0 + n) * Kd + k0 + 8 * c) = o; }
    LDS_WAIT(); asm volatile("" ::: "memory");
}
constexpr int CW_I_EXP = 512, CW_I_GU = 16 * CW_I_EXP, CW_I_SQ = 32 * 64;
struct TrDesc { const float* src; bf16* dst; int N, Kd; bool f8; };
template <int L> __device__ __forceinline__ TrDesc tr_desc(Frame& F, int it) {
    constexpr int I_IN = L == 0 ? 32 * 192 : 32 * 128;
    const float* W; bf16* WT; int N, Kd, mode, q; int r = it;
    bool f8 = false;
    if (r < CW_I_GU) { const int le = L * 16 + (r >> 9); q = r & 511; W = F.in[24] + (size_t)le * D * ED; N = ED; WT = (bf16*)(WSP(unsigned char, WS_WGU) + (size_t)le * 1024 * D); Kd = D; mode = 1; f8 = true; }
    else if (r < 2 * CW_I_GU) { r -= CW_I_GU; const int le = L * 16 + (r >> 9); q = r & 511; W = F.in[25] + (size_t)le * D * ED; N = ED; WT = (bf16*)(WSP(unsigned char, WS_WGU) + (size_t)le * 1024 * D); Kd = D; mode = 2; f8 = true; }
    else if (r < 2 * CW_I_GU + I_IN) { q = r - 2 * CW_I_GU; W = L == 0 ? F.in[8] : F.in[16]; N = L == 0 ? 6144 : 4096; WT = L == 0 ? WSP(bf16, WS_WINE) : WSP(bf16, WS_WINO); Kd = D; mode = L == 0 ? 3 : 0; f8 = L == 1; }
    else if (r < 2 * CW_I_GU + I_IN + CW_I_SQ) { q = r - 2 * CW_I_GU - I_IN; W = L == 0 ? F.in[15] : F.in[21]; N = D; WT = L == 0 ? WSP(bf16, WS_WOUTE) : WSP(bf16, WS_WOUTO); Kd = D; mode = 0; f8 = true; }
    else { r -= 2 * CW_I_GU + I_IN + CW_I_SQ; const int le = L * 16 + (r >> 9); q = r & 511; W = F.in[26] + (size_t)le * ED * D; N = D; WT = (bf16*)(WSP(unsigned char, WS_WDN) + (size_t)le * D * ED); Kd = ED; mode = 0; f8 = true; }
    const int nblk = N / 32, kb = q / nblk, nb = q - kb * nblk, k0 = 64 * kb, n0 = 32 * nb;
    int d0 = mode ? (((n0 >> 7) << 8) + (n0 & 127) + (mode == 2 ? 128 : 0)) : n0;
    if (mode == 3) { const int c = n0 & 1023; d0 = n0 >= 3072 ? n0 : n0 < 1024 ? (((c >> 7) << 8) + (c & 127)) : n0 < 2048 ? 2048 + c : (((c >> 7) << 8) + 128 + (c & 127)); }
    if (mode == 3) f8 = true;
    TrDesc d; d.src = W + (size_t)k0 * N + n0; d.dst = f8 ? (bf16*)((unsigned char*)WT + (size_t)d0 * Kd + k0) : WT + (size_t)d0 * Kd + k0; d.N = N; d.Kd = Kd; d.f8 = f8; return d;
}
template <int L> __device__ __forceinline__ void convert_weights(Frame& F, int gw, int NGW, int wave, int lane, int lo, int hi) {
    LAS float* scr = (LAS float*)(F.lds + wave * 16384);
    int it = lo + gw; if (it >= hi) return;
    float rg[32]; TrDesc cur = tr_desc<L>(F, it);
#pragma unroll
    for (int i = 0; i < 32; ++i) rg[i] = cur.src[(size_t)(2 * i + (lane >> 5)) * cur.N + (lane & 31)];
    for (;;) {
#pragma unroll
        for (int i = 0; i < 32; ++i) scr[(2 * i + (lane >> 5)) * 33 + (lane & 31)] = rg[i];
        LDS_WAIT(); asm volatile("" ::: "memory");
        const int nit = it + NGW; const bool more = nit < hi; TrDesc nx = cur;
        if (more) { nx = tr_desc<L>(F, nit);
#pragma unroll
            for (int i = 0; i < 32; ++i) rg[i] = nx.src[(size_t)(2 * i + (lane >> 5)) * nx.N + (lane & 31)]; }
        if (cur.f8) {
            const int c = lane & 3;
#pragma unroll
            for (int j = 0; j < 2; ++j) { const int n = (lane >> 2) + 16 * j; const LAS float* sp = scr + (16 * c) * 33 + n; u32x4 o;
                o.x = pk4_fp8(sp[0 * 33] * W8_SCALE, sp[1 * 33] * W8_SCALE, sp[2 * 33] * W8_SCALE, sp[3 * 33] * W8_SCALE); o.y = pk4_fp8(sp[4 * 33] * W8_SCALE, sp[5 * 33] * W8_SCALE, sp[6 * 33] * W8_SCALE, sp[7 * 33] * W8_SCALE);
                o.z = pk4_fp8(sp[8 * 33] * W8_SCALE, sp[9 * 33] * W8_SCALE, sp[10 * 33] * W8_SCALE, sp[11 * 33] * W8_SCALE); o.w = pk4_fp8(sp[12 * 33] * W8_SCALE, sp[13 * 33] * W8_SCALE, sp[14 * 33] * W8_SCALE, sp[15 * 33] * W8_SCALE);
                *(u32x4*)((unsigned char*)cur.dst + (size_t)n * cur.Kd + 16 * c) = o; }
        } else {
        const int c = lane & 7;
#pragma unroll
        for (int j = 0; j < 4; ++j) { const int n = (lane >> 3) + 8 * j; const LAS float* sp = scr + (8 * c) * 33 + n;
            u32x4 o; o.x = pk2(sp[0 * 33], sp[1 * 33]); o.y = pk2(sp[2 * 33], sp[3 * 33]); o.z = pk2(sp[4 * 33], sp[5 * 33]); o.w = pk2(sp[6 * 33], sp[7 * 33]);
            *(u32x4*)(cur.dst + (size_t)n * cur.Kd + 8 * c) = o; }
        }
        LDS_WAIT(); asm volatile("" ::: "memory");
        if (!more) break;
        it = nit; cur = nx;
    }
}
constexpr int CW_N0 = 3 * CW_I_GU + 32 * 192 + CW_I_SQ, CW_N1 = 3 * CW_I_GU + 32 * 128 + CW_I_SQ, CW_SPLIT1 = 2 * CW_I_GU;
__device__ __forceinline__ void p0_prologue(Frame& F) {
    PH_IDS;
    {
        LAS float* sl = (LAS float*)F.lds;
        LAS float* part = (LAS float*)(F.lds + 40960);
        for (int i = tid; i < 5 * D; i += 512) { const int r = i >> 11, k = i & (D - 1); const float v = r < 4 ? F.in[1][r * D + k] : F.in[3][k]; sl[i] = silu_f(v); }
        __syncthreads();
        const int kg = tid >> 3, cg = tid & 7;
        for (int it = F.vcu; it < 768; it += F.G) {
            const int l = it / 384, c0 = (it - l * 384) * 32;
            const float* wm = F.in[4] + (size_t)l * D * 12288 + c0 + 4 * cg;
            f32x4 a0 = {0, 0, 0, 0}, a1 = a0, a2 = a0, a3 = a0, a4 = a0;
#pragma unroll 8
            for (int i = 0; i < 32; ++i) { const int k = kg + 64 * i; const f32x4 w = *(const f32x4*)(wm + (size_t)k * 12288);
                a0 += w * sl[k]; a1 += w * sl[D + k]; a2 += w * sl[2 * D + k]; a3 += w * sl[3 * D + k]; a4 += w * sl[4 * D + k]; }
            LAS float* pp = part + kg * 160 + 4 * cg;
            *(LAS f32x4*)(pp) = a0; *(LAS f32x4*)(pp + 32) = a1; *(LAS f32x4*)(pp + 64) = a2; *(LAS f32x4*)(pp + 96) = a3; *(LAS f32x4*)(pp + 128) = a4;
            __syncthreads();
            if (tid < 160) { float s = 0.f;
#pragma unroll 8
                for (int g = 0; g < 64; ++g) s += part[g * 160 + tid];
                const int r = tid >> 5, cc = tid & 31;
                WSP(float, WS_MOD)[(size_t)(l * 5 + r) * 12288 + c0 + cc] = s + F.in[5][l * 12288 + c0 + cc]; }
            __syncthreads();
        }
    }
    {
        const int gid = F.vcu * 512 + tid;
        if (gid < 2048) { const int pos = gid >> 4, f = gid & 15;
            const float inv = exp2f(-(float)f * (13.287712379549449f / 16.0f)); const float ang = (float)pos * inv;
            const float k = rintf(ang * 0.15915494309189535f); float r = fmaf(-k, 6.2831854820251465f, ang); r = fmaf(-k, -1.7484555e-7f, r);
            WSP(float, WS_TAB)[gid] = __cosf(r); WSP(float, WS_TAB)[2048 + gid] = __sinf(r); }
        for (int i = gid; i < 16 * 128 * 128; i += F.G * 512) WSP(bf16, WS_WSB)[i] = (bf16)f2bf(F.in[19][i]);
    }
    convert_weights<0>(F, F.vcu * NWAVES + wave, F.G * NWAVES, wave, lane, 0, CW_N0);
}
__device__ __forceinline__ void p1_modulate(Frame& F) {
    PH_IDS;
    LAS float* P_s = (LAS float*)F.lds; LAS float* P_h = P_s + D;
    for (int rw = F.vcu * NWAVES + wave; rw < 128; rw += F.G * NWAVES) { const int Lr = rw >> 6, br = (rw >> 4) & 3, e = rw & 15; const float* sh = MODP(Lr, br, 3); const float* sc = MODP(Lr, br, 4);
        bf16* wh = WSP(bf16, WS_WRT2) + (size_t)((Lr * 4 + br) * 32 + e) * D; bf16* wl = wh + 16 * D; float cs = 0.f;
        for (int k = lane; k < D; k += 64) { const float w0 = F.in[22][k * 16 + e]; const float w = w0 * (1.0f + sc[k]); cs += sh[k] * w0; const unsigned hb = f2bf(w); wh[k] = (bf16)hb; wl[k] = (bf16)f2bf(w - __uint_as_float(hb << 16)); }
#pragma unroll
        for (int o = 1; o < 64; o <<= 1) cs += __shfl_xor(cs, o);
        if (lane == 0) WSP(float, WS_RC)[(Lr * 4 + br) * 16 + e] = cs; }
    for (int blk = F.vcu; blk < M / 128; blk += F.G) {
        const int rowb = blk * 128 + wave * 16, b = rowb >> 13;
        __syncthreads();
        for (int i = tid; i < D; i += 512) { P_s[i] = 1.0f + MODP(0, b, 1)[i]; P_h[i] = MODP(0, b, 0)[i]; }
        __syncthreads();
        f32x4 rx[8];
#define P1_LOAD(r_) do { _Pragma("unroll") for (int j = 0; j < 4; ++j) { const float* p_ = F.in[0] + (size_t)(r_) * D + 512 * j + 8 * lane; rx[2 * j] = *(const f32x4*)p_; rx[2 * j + 1] = *(const f32x4*)(p_ + 4); } } while (0)
        P1_LOAD(rowb);
#pragma unroll 1
        for (int rr = 0; rr < 16; ++rr) {
            const int row = rowb + rr; u32x2 w8[4];
#pragma unroll
            for (int j = 0; j < 4; ++j) { const int c = 512 * j + 8 * lane;
                const f32x4 sa = *(const LAS f32x4*)(P_s + c), sb = *(const LAS f32x4*)(P_s + c + 4), ha = *(const LAS f32x4*)(P_h + c), hb = *(const LAS f32x4*)(P_h + c + 4);
                const f32x4 y0 = rx[2 * j] * sa + ha, y1 = rx[2 * j + 1] * sb + hb;
                w8[j].x = pk4_fp8(y0.x, y0.y, y0.z, y0.w); w8[j].y = pk4_fp8(y1.x, y1.y, y1.z, y1.w); }
            if (rr < 15) P1_LOAD(row + 1);
#pragma unroll
            for (int j = 0; j < 4; ++j) *(u32x2*)((unsigned char*)F.out + (size_t)M * D * 2 + (size_t)row * D + 512 * j + 8 * lane) = w8[j];
        }
#undef P1_LOAD
    }
    { const int gw = F.vcu * NWAVES + wave, NGW = F.G * NWAVES; const float* sh = MODP(0, 4, 0); const float* sc = MODP(0, 4, 1);
      for (int row = gw; row < MC; row += NGW) { const float* src = F.in[2] + (size_t)row * D; unsigned char* dst = (unsigned char*)F.out + (size_t)M * D * 2 + (size_t)M * D + (size_t)row * D;
#pragma unroll
          for (int j = 0; j < 8; ++j) { const int c = 256 * j + 4 * lane; const f32x4 v = *(const f32x4*)(src + c), s = *(const f32x4*)(sc + c), t = *(const f32x4*)(sh + c); const f32x4 y = v * (1.0f + s) + t; *(unsigned*)(dst + c) = pk4_fp8(y.x, y.y, y.z, y.w); } } }
}
__device__ __forceinline__ void conv_z(const bf16* proj, size_t row, int ch, float (&z)[8]) {
    const u32x4 w = *(const u32x4*)(proj + row * 2048 + ch);
    z[0] = bf_lo(w.x); z[1] = bf_hi(w.x); z[2] = bf_lo(w.y); z[3] = bf_hi(w.y); z[4] = bf_lo(w.z); z[5] = bf_hi(w.z); z[6] = bf_lo(w.w); z[7] = bf_hi(w.w);
}
__device__ __forceinline__ void conv_pass(Frame& F) {
    PH_IDS; const int gw = F.vcu * NWAVES + wave, NGW = F.G * NWAVES;
    const bf16* proj = WSP(bf16, WS_PROJ); unsigned char* mix = (unsigned char*)F.out;
    for (int it = gw; it < 2048; it += NGW) {
        const int run = it >> 1, ch = (it & 1) * 512 + lane * 8; const int r0 = run * 32;
        float w0[8], w1[8], w2[8];
#pragma unroll
        for (int i = 0; i < 8; ++i) { w0[i] = F.in[9][ch + i]; w1[i] = F.in[9][1024 + ch + i]; w2[i] = F.in[9][2048 + ch + i]; }
        float zp[8], zc[8], zn[8];
        if ((r0 & (SEQ - 1)) == 0) {
#pragma unroll
            for (int i = 0; i < 8; ++i) zp[i] = 0.f;
        } else conv_z(proj, (size_t)r0 - 1, ch, zp);
        conv_z(proj, (size_t)r0, ch, zc);
#pragma unroll 2
        for (int t = 0; t < 32; ++t) { const size_t row = (size_t)r0 + t;
            if (((row + 1) & (SEQ - 1)) == 0) {
#pragma unroll
                for (int i = 0; i < 8; ++i) zn[i] = 0.f;
            } else conv_z(proj, row + 1, ch, zn);
            const u32x4 bg = *(const u32x4*)(proj + row * 2048 + 1024 + ch);
            float o[8];
#pragma unroll
            for (int i = 0; i < 8; ++i) o[i] = w0[i] * zp[i] + w1[i] * zc[i] + w2[i] * zn[i];
            u32x2 w; w.x = pk4_fp8(bf_lo(bg.x) * o[0], bf_hi(bg.x) * o[1], bf_lo(bg.y) * o[2], bf_hi(bg.y) * o[3]);
            w.y = pk4_fp8(bf_lo(bg.z) * o[4], bf_hi(bg.z) * o[5], bf_lo(bg.w) * o[6], bf_hi(bg.w) * o[7]);
            *(u32x2*)(mix + row * D + ch) = w;
#pragma unroll
            for (int i = 0; i < 8; ++i) { zp[i] = zc[i]; zc[i] = zn[i]; } }
    }
}
__device__ __forceinline__ float lam_value(Frame& F, int lane) {
    const float a = wave_sum(F.in[10][lane] * F.in[11][lane]), b = wave_sum(F.in[12][lane] * F.in[13][lane]);
    return __expf(a) - __expf(b) + 0.2f;
}
__device__ __forceinline__ void attn_simple(Frame& F) {
    PH_IDS; const int gw = F.vcu * NWAVES + wave, NGW = F.G * NWAVES;
    const float lam = lam_value(F, lane);
    const bf16* Q = WSP(bf16, WS_Q); const bf16* KBp = WSP(bf16, WS_KB); const bf16* VBp = WSP(bf16, WS_VB); float* TMP = WSP(float, WS_H);
    for (int it = gw; it < 8192; it += NGW) {
        const int qb = it & 127, vc = (it >> 7) & 1, h = (it >> 8) & 7, b = it >> 11;
        const size_t qrow = (size_t)b * SEQ + qb * 64 + lane;
        float* tmp = TMP + (qrow * 8 + h) * 128 + vc * 64;
#pragma unroll 1
        for (int m = 0; m < 2; ++m) {
            float q[64], acc[64];
#pragma unroll
            for (int c = 0; c < 8; ++c) { const u32x4 w = *(const u32x4*)(Q + qrow * 1024 + h * 128 + m * 64 + c * 8); const float sc = 1.0f;
                q[8 * c + 0] = bf_lo(w.x) * sc; q[8 * c + 1] = bf_hi(w.x) * sc; q[8 * c + 2] = bf_lo(w.y) * sc; q[8 * c + 3] = bf_hi(w.y) * sc;
                q[8 * c + 4] = bf_lo(w.z) * sc; q[8 * c + 5] = bf_hi(w.z) * sc; q[8 * c + 6] = bf_lo(w.w) * sc; q[8 * c + 7] = bf_hi(w.w) * sc; }
#pragma unroll
            for (int i = 0; i < 64; ++i) acc[i] = 0.f;
            float mx = -1e30f, l = 0.f;
            const bf16* kp = KBp + (size_t)b * KV * 1024 + h * 128 + m * 64; const bf16* vp = VBp + (size_t)b * KV * 1024 + h * 128 + vc * 64;
#pragma unroll 1
            for (int j = 0; j < KV; ++j) {
                float s = 0.f;
#pragma unroll
                for (int c = 0; c < 8; ++c) { const u32x4 w = *(const u32x4*)(kp + (size_t)j * 1024 + c * 8);
                    s += q[8 * c + 0] * bf_lo(w.x) + q[8 * c + 1] * bf_hi(w.x) + q[8 * c + 2] * bf_lo(w.y) + q[8 * c + 3] * bf_hi(w.y)
                       + q[8 * c + 4] * bf_lo(w.z) + q[8 * c + 5] * bf_hi(w.z) + q[8 * c + 6] * bf_lo(w.w) + q[8 * c + 7] * bf_hi(w.w); }
                const float mn = fmaxf(mx, s), sc = exp2f(mx - mn), p = exp2f(s - mn); l = l * sc + p; mx = mn;
#pragma unroll
                for (int c = 0; c < 8; ++c) { const u32x4 w = *(const u32x4*)(vp + (size_t)j * 1024 + c * 8);
                    acc[8 * c + 0] = acc[8 * c + 0] * sc + p * bf_lo(w.x); acc[8 * c + 1] = acc[8 * c + 1] * sc + p * bf_hi(w.x);
                    acc[8 * c + 2] = acc[8 * c + 2] * sc + p * bf_lo(w.y); acc[8 * c + 3] = acc[8 * c + 3] * sc + p * bf_hi(w.y);
                    acc[8 * c + 4] = acc[8 * c + 4] * sc + p * bf_lo(w.z); acc[8 * c + 5] = acc[8 * c + 5] * sc + p * bf_hi(w.z);
                    acc[8 * c + 6] = acc[8 * c + 6] * sc + p * bf_lo(w.w); acc[8 * c + 7] = acc[8 * c + 7] * sc + p * bf_hi(w.w); }
            }
            const float inv = 1.0f / l;
            if (m == 0) {
#pragma unroll
                for (int i = 0; i < 64; i += 4) *(f32x4*)(tmp + i) = (f32x4){acc[i] * inv, acc[i + 1] * inv, acc[i + 2] * inv, acc[i + 3] * inv};
            } else {
#pragma unroll
                for (int i = 0; i < 64; i += 4) { const f32x4 t0 = *(const f32x4*)(tmp + i);
                    *(f32x4*)(tmp + i) = (f32x4){t0.x - lam * acc[i] * inv, t0.y - lam * acc[i + 1] * inv, t0.z - lam * acc[i + 2] * inv, t0.w - lam * acc[i + 3] * inv}; }
            }
        }
    }
}
__device__ __forceinline__ void attn_finish(Frame& F) {
    PH_IDS; const int gw = F.vcu * NWAVES + wave, NGW = F.G * NWAVES;
    const float* TMP = WSP(float, WS_H); bf16* mix = (bf16*)F.out;
    for (int row = gw; row < M; row += NGW) {
        f32x4 v[4]; float ss = 0.f;
#pragma unroll
        for (int i = 0; i < 4; ++i) { v[i] = *(const f32x4*)(TMP + (size_t)row * 1024 + lane * 16 + 4 * i); ss += (v[i].x * v[i].x + v[i].y * v[i].y) + (v[i].z * v[i].z + v[i].w * v[i].w); }
        ss += __shfl_xor(ss, 1); ss += __shfl_xor(ss, 2); ss += __shfl_xor(ss, 4);
        const float rs = 0.8f / sqrtf(ss * (1.0f / 128.0f) + LN_EPS);
#pragma unroll
        for (int i = 0; i < 4; ++i) { const f32x4 g = *(const f32x4*)(F.in[14] + ((lane * 16 + 4 * i) & 127)); st_bf4(mix + (size_t)row * D + 1024 + lane * 16 + 4 * i, v[i] * g * rs); }
    }
}
namespace att {
using f32x16 = __attribute__((ext_vector_type(16))) float;
using s16x4 = __attribute__((ext_vector_type(4))) short;
constexpr int QBLK = 32, KVBLK = 64, SHM_V = 16384, SHM_K = 8192, L_K = 0, L_V = 4 * SHM_K, L_WS = L_V + 4 * SHM_V, L_OST = 0, OST_LD = 136;
constexpr float SCALE = 0.125f, THR = 8.f;
#define ATT_KSW(row, c) ((row) * 128 + ((((c) ^ ((row) >> 1)) & 7) << 4))
#define ATT_SBAR() __builtin_amdgcn_sched_barrier(0)
__device__ __forceinline__ int crow(int r, int hi) { return (r & 3) + 8 * (r >> 2) + 4 * hi; }
__device__ __forceinline__ unsigned cvtpk(float lo, float hi) { unsigned r; asm volatile("v_cvt_pk_bf16_f32 %0, %1, %2" : "=v"(r) : "v"(lo), "v"(hi)); return r; }
template <bool FIRST> __device__ __forceinline__ void partialSM(f32x16& p0, f32x16& p1, f32x16& negm, float& alpha) {
    constexpr float THR2 = 8.0f, PBIAS = 4.0f;
    float m0 = fmaxf(fmaxf(p0[0], p0[1]), p0[2]), m1 = fmaxf(fmaxf(p1[0], p1[1]), p1[2]);
#pragma unroll
    for (int r = 3; r < 15; r += 2) { m0 = fmaxf(fmaxf(m0, p0[r]), p0[r + 1]); m1 = fmaxf(fmaxf(m1, p1[r]), p1[r + 1]); }
    float pmax = fmaxf(fmaxf(m0, p0[15]), fmaxf(m1, p1[15]));
    { auto rr = __builtin_amdgcn_permlane32_swap(__float_as_uint(pmax), __float_as_uint(pmax), false, false);
      pmax = fmaxf(__uint_as_float(rr[0]), __uint_as_float(rr[1])); }
    if (!FIRST && __builtin_expect(__all(pmax <= THR2), 1)) { alpha = 1.f; }
    else { const float dl = FIRST ? pmax - PBIAS : fmaxf(pmax - PBIAS, 0.f); alpha = __builtin_amdgcn_exp2f(-dl);
#pragma unroll
        for (int r = 0; r < 16; ++r) { p0[r] -= dl; p1[r] -= dl; negm[r] -= dl; } }
#pragma unroll
    for (int r = 0; r < 16; ++r) p0[r] = __builtin_amdgcn_exp2f(p0[r]);
}
__device__ __forceinline__ void finishSM(f32x16& p0, f32x16& p1, float alpha, float& l_reg, bf16x8& pa0, bf16x8& pa1, bf16x8& pa2, bf16x8& pa3) {
#pragma unroll
    for (int r = 0; r < 16; ++r) p1[r] = __builtin_amdgcn_exp2f(p1[r]);
    float s0 = p0[0] + p0[1], s1 = p0[2] + p0[3], s2 = p1[0] + p1[1], s3 = p1[2] + p1[3];
#pragma unroll
    for (int r = 4; r < 16; r += 4) { s0 += p0[r]; s1 += p0[r + 1]; s2 += p0[r + 2]; s3 += p0[r + 3]; s0 += p1[r]; s1 += p1[r + 1]; s2 += p1[r + 2]; s3 += p1[r + 3]; }
    float ps = (s0 + s1) + (s2 + s3);
    { auto rr = __builtin_amdgcn_permlane32_swap(__float_as_uint(ps), __float_as_uint(ps), false, false); ps = __uint_as_float(rr[0]) + __uint_as_float(rr[1]); }
    l_reg = l_reg * alpha + ps;
#define ATT_PK4(P, BASE, OUT) do { unsigned a0 = cvtpk(P[BASE + 0], P[BASE + 1]), a1 = cvtpk(P[BASE + 2], P[BASE + 3]);   \
    unsigned b0 = cvtpk(P[BASE + 4], P[BASE + 5]), b1 = cvtpk(P[BASE + 6], P[BASE + 7]);                              \
    auto r0 = __builtin_amdgcn_permlane32_swap(a0, b0, false, false); auto r1 = __builtin_amdgcn_permlane32_swap(a1, b1, false, false); \
    u32x4 w = {r0[0], r1[0], r0[1], r1[1]}; OUT = __builtin_bit_cast(bf16x8, w); } while (0)
    ATT_PK4(p0, 0, pa0); ATT_PK4(p0, 8, pa1); ATT_PK4(p1, 0, pa2); ATT_PK4(p1, 8, pa3);
#undef ATT_PK4
}
#define ATT_K8(row, c) ((row) * 64 + ((((c) ^ ((row) >> 2)) & 3) << 4))
__device__ __forceinline__ void qkt(f32x16& p0, f32x16& p1, const LAS char* Ks, const pg8::v8i32& qf, const f32x16& negm, int r32, int hi) {
    const pg8::v4i32 a0 = *(const LAS pg8::v4i32*)(Ks + ATT_K8(r32, 2 * hi)), a1 = *(const LAS pg8::v4i32*)(Ks + ATT_K8(r32, 2 * hi + 1));
    const pg8::v4i32 b0 = *(const LAS pg8::v4i32*)(Ks + ATT_K8(32 + r32, 2 * hi)), b1 = *(const LAS pg8::v4i32*)(Ks + ATT_K8(32 + r32, 2 * hi + 1));
    p0 = __builtin_amdgcn_mfma_scale_f32_32x32x64_f8f6f4(__builtin_shufflevector(a0, a1, 0, 1, 2, 3, 4, 5, 6, 7), qf, negm, 0, 0, 0, 0x7f7f7f7f, 0, 0x7f7f7f7f);
    p1 = __builtin_amdgcn_mfma_scale_f32_32x32x64_f8f6f4(__builtin_shufflevector(b0, b1, 0, 1, 2, 3, 4, 5, 6, 7), qf, negm, 0, 0, 0, 0x7f7f7f7f, 0, 0x7f7f7f7f);
}
__device__ __forceinline__ int v_st(int k, int c) { const int kk = (k & ~0xC) | ((k & 4) << 1) | ((k & 8) >> 1); return ((kk >> 3) * 4 + (c >> 5)) * 512 + ((kk & 7) * 32 + (c & 31)) * 2; }
__device__ __forceinline__ int v_rd_base(int lane) { return ((lane & 3) << 3) | (((lane >> 2) & 3) << 6) | (((lane >> 4) & 1) << 5) | (((lane >> 5) & 1) << 8); }
constexpr int v_rd_off(int d0, int ks, int half) { return d0 * 512 + ks * 4096 + half * 2048; }
template <int OFF> __device__ __forceinline__ s16x4 tr_read(int vb) { s16x4 r; asm volatile("ds_read_b64_tr_b16 %0, %1 offset:%2" : "=&v"(r) : "v"(vb), "i"(OFF) : "memory"); return r; }
template <int D0> __device__ __forceinline__ void pv_one(f32x16& od, int vb, bf16x8 pa0, bf16x8 pa1, bf16x8 pa2, bf16x8 pa3) {
    const s16x4 l0 = tr_read<v_rd_off(D0, 0, 0)>(vb), h0 = tr_read<v_rd_off(D0, 0, 1)>(vb), l1 = tr_read<v_rd_off(D0, 1, 0)>(vb), h1 = tr_read<v_rd_off(D0, 1, 1)>(vb);
    const s16x4 l2 = tr_read<v_rd_off(D0, 2, 0)>(vb), h2 = tr_read<v_rd_off(D0, 2, 1)>(vb), l3 = tr_read<v_rd_off(D0, 3, 0)>(vb), h3 = tr_read<v_rd_off(D0, 3, 1)>(vb);
    asm volatile("s_waitcnt lgkmcnt(0)" ::: "memory"); ATT_SBAR();
#define ATT_PK(L, H) (bf16x8){L[0], L[1], L[2], L[3], H[0], H[1], H[2], H[3]}
    od = __builtin_amdgcn_mfma_f32_32x32x16_bf16(pa0, ATT_PK(l0, h0), od, 0, 0, 0);
    od = __builtin_amdgcn_mfma_f32_32x32x16_bf16(pa1, ATT_PK(l1, h1), od, 0, 0, 0);
    od = __builtin_amdgcn_mfma_f32_32x32x16_bf16(pa2, ATT_PK(l2, h2), od, 0, 0, 0);
    od = __builtin_amdgcn_mfma_f32_32x32x16_bf16(pa3, ATT_PK(l3, h3), od, 0, 0, 0);
#undef ATT_PK
}
__device__ __forceinline__ void pv_d0(f32x16* o, int vb, bf16x8 pa0, bf16x8 pa1, bf16x8 pa2, bf16x8 pa3) {
    pv_one<0>(o[0], vb, pa0, pa1, pa2, pa3); pv_one<1>(o[1], vb, pa0, pa1, pa2, pa3); pv_one<2>(o[2], vb, pa0, pa1, pa2, pa3); pv_one<3>(o[3], vb, pa0, pa1, pa2, pa3);
}
__device__ __forceinline__ void psum(f32x16& osum, bf16x8 pa0, bf16x8 pa1, bf16x8 pa2, bf16x8 pa3) {
    const bf16x8 ones = {0x3F80, 0x3F80, 0x3F80, 0x3F80, 0x3F80, 0x3F80, 0x3F80, 0x3F80};
    osum = __builtin_amdgcn_mfma_f32_32x32x16_bf16(pa0, ones, osum, 0, 0, 0); osum = __builtin_amdgcn_mfma_f32_32x32x16_bf16(pa1, ones, osum, 0, 0, 0);
    osum = __builtin_amdgcn_mfma_f32_32x32x16_bf16(pa2, ones, osum, 0, 0, 0); osum = __builtin_amdgcn_mfma_f32_32x32x16_bf16(pa3, ones, osum, 0, 0, 0);
}
struct VFrag { s16x4 l0, h0, l1, h1, l2, h2, l3, h3; };
__device__ __forceinline__ void pv_rd0(VFrag& f, int vb) {
    f.l0 = tr_read<v_rd_off(0, 0, 0)>(vb); f.h0 = tr_read<v_rd_off(0, 0, 1)>(vb); f.l1 = tr_read<v_rd_off(0, 1, 0)>(vb); f.h1 = tr_read<v_rd_off(0, 1, 1)>(vb);
    f.l2 = tr_read<v_rd_off(0, 2, 0)>(vb); f.h2 = tr_read<v_rd_off(0, 2, 1)>(vb); f.l3 = tr_read<v_rd_off(0, 3, 0)>(vb); f.h3 = tr_read<v_rd_off(0, 3, 1)>(vb);
}
__device__ __forceinline__ void pv_d0_pre(f32x16* o, int vb, const VFrag& f, bf16x8 pa0, bf16x8 pa1, bf16x8 pa2, bf16x8 pa3) {
    asm volatile("s_waitcnt lgkmcnt(0)" ::: "memory"); ATT_SBAR();
#define ATT_PK(L, H) (bf16x8){L[0], L[1], L[2], L[3], H[0], H[1], H[2], H[3]}
    o[0] = __builtin_amdgcn_mfma_f32_32x32x16_bf16(pa0, ATT_PK(f.l0, f.h0), o[0], 0, 0, 0);
    o[0] = __builtin_amdgcn_mfma_f32_32x32x16_bf16(pa1, ATT_PK(f.l1, f.h1), o[0], 0, 0, 0);
    o[0] = __builtin_amdgcn_mfma_f32_32x32x16_bf16(pa2, ATT_PK(f.l2, f.h2), o[0], 0, 0, 0);
    o[0] = __builtin_amdgcn_mfma_f32_32x32x16_bf16(pa3, ATT_PK(f.l3, f.h3), o[0], 0, 0, 0);
#undef ATT_PK
    pv_one<1>(o[1], vb, pa0, pa1, pa2, pa3); pv_one<2>(o[2], vb, pa0, pa1, pa2, pa3); pv_one<3>(o[3], vb, pa0, pa1, pa2, pa3);
}
__device__ __forceinline__ int v8_sw(int key) { return (((key >> 1) & 1) << 1) | (((key >> 3) & 1) << 2); }
__device__ __forceinline__ int v8_st(int key, int chunk) { return key * 128 + ((chunk ^ v8_sw(key)) << 4); }
__device__ __forceinline__ int v8_rd_base(int lane, int d0) { const int i = lane & 15, q = i >> 1, p = i & 1, g1 = (lane >> 4) & 1, hi = lane >> 5; const int key0 = (q & 3) + 8 * (q >> 2) + 4 * hi;
    return key0 * 128 + ((((2 * d0 + g1) ^ v8_sw(key0)) & 7) << 4) + 8 * p; }
template <int OFF> __device__ __forceinline__ u32x2 tr8_read(int vb) { u32x2 r; asm volatile("ds_read_b64_tr_b8 %0, %1 offset:%2" : "=&v"(r) : "v"(vb), "i"(OFF) : "memory"); return r; }
struct V8Frag { u32x2 r0, r1, r2, r3; };
__device__ __forceinline__ void pv8_rd(V8Frag& f, int vb) { f.r0 = tr8_read<0>(vb); f.r1 = tr8_read<2048>(vb); f.r2 = tr8_read<4096>(vb); f.r3 = tr8_read<6144>(vb); }
template <int SO> __device__ __forceinline__ void pv8_rds(V8Frag& f, int vb) { f.r0 = tr8_read<SO>(vb); f.r1 = tr8_read<SO + 2048>(vb); f.r2 = tr8_read<SO + 4096>(vb); f.r3 = tr8_read<SO + 6144>(vb); }
__device__ __forceinline__ void pv8_mm(f32x16& od, const V8Frag& f, const pg8::v8i32& pa, int sc1) {
    const pg8::v8i32 bf = {(int)f.r0.x, (int)f.r0.y, (int)f.r1.x, (int)f.r1.y, (int)f.r2.x, (int)f.r2.y, (int)f.r3.x, (int)f.r3.y};
    asm volatile("v_mfma_scale_f32_32x32x64_f8f6f4 %0, %1, %2, %0, %3, %3 op_sel_hi:[0,0,0]" : "+v"(od) : "v"(pa), "v"(bf), "v"(sc1));
}
__device__ __forceinline__ void pv8_one(f32x16& od, int vb, const pg8::v8i32& pa, int sc1) { V8Frag f; pv8_rd(f, vb); asm volatile("s_waitcnt lgkmcnt(0)" ::: "memory"); ATT_SBAR(); pv8_mm(od, f, pa, sc1); }
__device__ __forceinline__ void pv8_d0(f32x16* o, const int (&vb)[4], int so, const pg8::v8i32& pa, int sc1) {
    pv8_one(o[0], vb[0] + so, pa, sc1); pv8_one(o[1], vb[1] + so, pa, sc1); pv8_one(o[2], vb[2] + so, pa, sc1); pv8_one(o[3], vb[3] + so, pa, sc1); }
__device__ __forceinline__ void pv8_d0_pre(f32x16* o, const int (&vb)[4], int so, const V8Frag& f, const pg8::v8i32& pa, int sc1) {
    asm volatile("s_waitcnt lgkmcnt(0)" ::: "memory"); ATT_SBAR(); pv8_mm(o[0], f, pa, sc1);
    pv8_one(o[1], vb[1] + so, pa, sc1); pv8_one(o[2], vb[2] + so, pa, sc1); pv8_one(o[3], vb[3] + so, pa, sc1); }
__device__ __forceinline__ void finishSM8(f32x16& p0, f32x16& p1, pg8::v8i32& pa) {
#pragma unroll
    for (int r = 0; r < 16; ++r) p1[r] = __builtin_amdgcn_exp2f(p1[r]);
#define ATT_F8(P, B) __builtin_amdgcn_cvt_pk_fp8_f32(P[B + 2], P[B + 3], __builtin_amdgcn_cvt_pk_fp8_f32(P[B], P[B + 1], 0, false), true)
    pa = (pg8::v8i32){ATT_F8(p0, 0), ATT_F8(p0, 4), ATT_F8(p0, 8), ATT_F8(p0, 12), ATT_F8(p1, 0), ATT_F8(p1, 4), ATT_F8(p1, 8), ATT_F8(p1, 12)};
#undef ATT_F8
}
__device__ __forceinline__ void psum8(f32x4& lacc, const pg8::v8i32& mask, const pg8::v8i32& pa, int sc1) {
    asm volatile("v_mfma_scale_f32_16x16x128_f8f6f4 %0, %1, %2, %0, %3, %3 op_sel_hi:[0,0,0]" : "+v"(lacc) : "v"(mask), "v"(pa), "v"(sc1));
}
struct KFrag { pg8::v4i32 a0, a1, b0, b1; };
__device__ __forceinline__ void k_read(KFrag& k, const LAS char* Ks, int r32, int hi) {
    k.a0 = *(const LAS pg8::v4i32*)(Ks + ATT_K8(r32, 2 * hi)); k.a1 = *(const LAS pg8::v4i32*)(Ks + ATT_K8(r32, 2 * hi + 1));
    k.b0 = *(const LAS pg8::v4i32*)(Ks + ATT_K8(32 + r32, 2 * hi)); k.b1 = *(const LAS pg8::v4i32*)(Ks + ATT_K8(32 + r32, 2 * hi + 1)); }
__device__ __forceinline__ void qk_mm(f32x16& p0, f32x16& p1, const KFrag& k, const pg8::v8i32& qf, const f32x16& negm) {
    p0 = __builtin_amdgcn_mfma_scale_f32_32x32x64_f8f6f4(__builtin_shufflevector(k.a0, k.a1, 0, 1, 2, 3, 4, 5, 6, 7), qf, negm, 0, 0, 0, 0x7f7f7f7f, 0, 0x7f7f7f7f);
    p1 = __builtin_amdgcn_mfma_scale_f32_32x32x64_f8f6f4(__builtin_shufflevector(k.b0, k.b1, 0, 1, 2, 3, 4, 5, 6, 7), qf, negm, 0, 0, 0, 0x7f7f7f7f, 0, 0x7f7f7f7f); }
template <int LO, int N> __device__ __forceinline__ void exp_n(f32x16& p) {
#pragma unroll
    for (int r = LO; r < LO + N; ++r) p[r] = __builtin_amdgcn_exp2f(p[r]);
    asm volatile("" : "+v"(p)); }
__device__ __forceinline__ int cvt4_fp8(float a, float b, float c, float d) { int r;
    asm("v_cvt_pk_fp8_f32 %0, %1, %2\n\tv_cvt_pk_fp8_f32 %0, %3, %4 op_sel:[0,0,1]" : "=&v"(r) : "v"(a), "v"(b), "v"(c), "v"(d)); return r; }
__device__ __forceinline__ void cvt_pa(pg8::v8i32& pa, const f32x16& p0, const f32x16& p1) {
#define ATT_F8(P, B) cvt4_fp8(P[B], P[B + 1], P[B + 2], P[B + 3])
    pa = (pg8::v8i32){ATT_F8(p0, 0), ATT_F8(p0, 4), ATT_F8(p0, 8), ATT_F8(p0, 12), ATT_F8(p1, 0), ATT_F8(p1, 4), ATT_F8(p1, 8), ATT_F8(p1, 12)};
#undef ATT_F8
}
__device__ __forceinline__ void sm_decide(f32x16& p0, f32x16& p1, f32x16& negm, float& alpha) {
    constexpr float THR2 = 8.0f, PBIAS = 4.0f;
    float m0 = fmaxf(fmaxf(p0[0], p0[1]), p0[2]), m1 = fmaxf(fmaxf(p1[0], p1[1]), p1[2]);
#pragma unroll
    for (int r = 3; r < 15; r += 2) { m0 = fmaxf(fmaxf(m0, p0[r]), p0[r + 1]); m1 = fmaxf(fmaxf(m1, p1[r]), p1[r + 1]); }
    float pmax = fmaxf(fmaxf(m0, p0[15]), fmaxf(m1, p1[15]));
    { auto rr = __builtin_amdgcn_permlane32_swap(__float_as_uint(pmax), __float_as_uint(pmax), false, false);
      pmax = fmaxf(__uint_as_float(rr[0]), __uint_as_float(rr[1])); }
    if (__builtin_expect(__all(pmax <= THR2), 1)) { alpha = 1.f; }
    else { const float dl = fmaxf(pmax - PBIAS, 0.f); alpha = __builtin_amdgcn_exp2f(-dl);
#pragma unroll
        for (int r = 0; r < 16; ++r) { p0[r] -= dl; p1[r] -= dl; negm[r] -= dl; } }
}
__device__ __forceinline__ void psum8z(f32x4& ts, const pg8::v8i32& mask, const pg8::v8i32& pa, int sc1) {
    asm volatile("v_mfma_scale_f32_16x16x128_f8f6f4 %0, %1, %2, 0, %3, %3 op_sel_hi:[0,0,0]" : "=&v"(ts) : "v"(mask), "v"(pa), "v"(sc1));
}
__device__ __forceinline__ void sm_redo(f32x16& p0, f32x16& p1, f32x16& negm, float& alpha, float& dl) {
    constexpr float PBIAS = 4.0f;
    float m0 = fmaxf(fmaxf(p0[0], p0[1]), p0[2]), m1 = fmaxf(fmaxf(p1[0], p1[1]), p1[2]);
#pragma unroll
    for (int r = 3; r < 15; r += 2) { m0 = fmaxf(fmaxf(m0, p0[r]), p0[r + 1]); m1 = fmaxf(fmaxf(m1, p1[r]), p1[r + 1]); }
    float pmax = fmaxf(fmaxf(m0, p0[15]), fmaxf(m1, p1[15]));
    { auto rr = __builtin_amdgcn_permlane32_swap(__float_as_uint(pmax), __float_as_uint(pmax), false, false);
      pmax = fmaxf(__uint_as_float(rr[0]), __uint_as_float(rr[1])); }
    dl = fmaxf(pmax - PBIAS, 0.f); alpha = __builtin_amdgcn_exp2f(-dl);
#pragma unroll
    for (int r = 0; r < 16; ++r) { p0[r] -= dl; p1[r] -= dl; negm[r] -= dl; }
}
}
__device__ __forceinline__ void attn_fast(Frame& F) {
    using namespace att;
    PH_IDS; const int wid = wave, r32 = lane & 31, hi = lane >> 5;
    const float lam = __builtin_bit_cast(float, __builtin_amdgcn_readfirstlane(__builtin_bit_cast(int, lam_value(F, lane))));
    LAS char* lds = (LAS char*)F.lds; LAS char* V_lds = lds + L_V; LAS char* K_lds = lds + L_K;
    LAS float* wsf = (LAS float*)(lds + L_WS) + wid * 64; LAS float* li_l = wsf; LAS float* al_l = wsf + 32;
    const bf16* Qg = WSP(bf16, WS_Q); const bf16* KBp = WSP(bf16, WS_KB); const bf16* VBp = WSP(bf16, WS_VB); unsigned char* mix = (unsigned char*)F.out;
    const int vkey = tid >> 3, vst0 = v8_st(vkey, tid & 7);
    const int kr = (tid >> 2) & 63, kc = tid & 3, kst = ATT_K8(kr, kc);
    int vb8[4];
#pragma unroll
    for (int d0 = 0; d0 < 4; ++d0) vb8[d0] = (int)(unsigned)(uintptr_t)V_lds + v8_rd_base(lane, d0);
    const int sc1 = 0x7f7f7f7f;
    pg8::v8i32 lmask;
    { const int mk = (((lane >> 4) ^ lane) & 1) ? 0 : 0x38383838; int m0, m1, m2, m3, m4, m5, m6, m7;
      asm volatile("v_mov_b32 %0, %8\n\tv_mov_b32 %1, %8\n\tv_mov_b32 %2, %8\n\tv_mov_b32 %3, %8\n\tv_mov_b32 %4, %8\n\tv_mov_b32 %5, %8\n\tv_mov_b32 %6, %8\n\tv_mov_b32 %7, %8"
                   : "=&v"(m0), "=&v"(m1), "=&v"(m2), "=&v"(m3), "=&v"(m4), "=&v"(m5), "=&v"(m6), "=&v"(m7) : "v"(mk));
      lmask = (pg8::v8i32){m0, m1, m2, m3, m4, m5, m6, m7}; }
    const unsigned voffV0 = (unsigned)(vkey * 1024 + (tid & 7) * 16), voffK = (unsigned)(kr * 1024 + kc * 16);
    constexpr int NT = KV / KVBLK;
    const int bx = (int)blockIdx.x;
    for (int ui = 0;; ++ui) {
        int unit;
        if (F.G == 256) { if (ui >= 4) break; unit = (ui * 8 + (bx & 7)) * 32 + (bx >> 3); }
        else { unit = ui * F.G + bx; if (unit >= 1024) break; }
        const int bh = unit >> 5, qb = unit & 31, b = bh >> 3, h = bh & 7;
        const size_t row0 = (size_t)b * SEQ + qb * 256;
#pragma unroll 1
        for (int mp = 0; mp < 2; ++mp) {
            const unsigned char* Kh = (const unsigned char*)KBp + (size_t)b * KV * 1024 + h * 128 + mp * 64; const unsigned char* Vh = (const unsigned char*)VBp + (size_t)b * KV * 1024 + h * 128;
            const __amdgpu_buffer_rsrc_t rsK = make_rsrc(Kh, KV * 1024), rsV = make_rsrc(Vh, KV * 1024);
            f32x16 o[4] = {}; f32x16 negm = {}; float l0 = 0.f, l1 = 0.f; f32x4 ts;
            const __amdgpu_buffer_rsrc_t rsQ = make_rsrc((const unsigned char*)Qg + (row0 + wid * QBLK) * 1024 + h * 128 + mp * 64, 32 * 1024);
            const int lq = fresh_lane(); const unsigned qoff = (unsigned)((lq & 31) * 1024 + (lq >> 5) * 32);
            const pg8::v8i32 qr = __builtin_shufflevector(__builtin_bit_cast(pg8::v4i32, bufld16(rsQ, qoff, 0)), __builtin_bit_cast(pg8::v4i32, bufld16(rsQ, qoff + 16, 0)), 0, 1, 2, 3, 4, 5, 6, 7);
            struct { bf16x8 vs0, ks0; } sr_;
#define SLOAD(t_) do { const unsigned so_ = (unsigned)(t_) * (unsigned)(KVBLK * 1024); \
    sr_.vs0 = bufld16(rsV, voffV0, so_); if (wid < 4) sr_.ks0 = bufld16(rsK, voffK, so_); } while (0)
#define SWRITE(t_) do { const int sl_ = (t_) & 3; *(LAS bf16x8*)(V_lds + sl_ * SHM_V + vst0) = sr_.vs0; \
    if (wid < 4) *(LAS bf16x8*)(K_lds + sl_ * SHM_K + kst) = sr_.ks0; } while (0)
#define KSLOT(t_) (K_lds + ((t_) & 3) * SHM_K)
#define VSLOT(t_) (((t_) & 3) * SHM_V)
#define RESC(a) do { if (__any((a) < 1.f)) { if (hi == 0) al_l[r32] = (a); asm volatile("s_nop 15\n\ts_nop 15\n\ts_waitcnt lgkmcnt(0)" ::: "memory");   \
    _Pragma("unroll") for (int r = 0; r < 16; ++r) { const float f_ = al_l[crow(r, hi)]; _Pragma("unroll") for (int d = 0; d < 4; ++d) o[d][r] *= f_; } \
    l0 *= al_l[r32 & 15]; l1 *= al_l[16 + (r32 & 15)]; } } while (0)
            f32x16 pA0, pA1, pB0, pB1; float alA; pg8::v8i32 pa;
            __syncthreads();
            SLOAD(0); SWRITE(0); SLOAD(1); SWRITE(1);
            __syncthreads();
            if (wid >= 4) __syncthreads();
            SLOAD(2); qkt(pA0, pA1, KSLOT(0), qr, negm, r32, hi);
            __syncthreads();
            partialSM<true>(pA0, pA1, negm, alA); SWRITE(2);
            __syncthreads();
            V8Frag vf;
#define ATT_WAITL(n_) asm volatile("s_waitcnt lgkmcnt(" #n_ ")" ::: "memory")
#define OVF_CHECK(PY0, PY1, PX0, PX1, SLP_, HAVE_PX) do { \
    asm volatile("s_nop 7\n\ts_nop 3" ::: "memory");        \
    if (__builtin_expect(__any(!(ts[0] < ATT_OVF_LIMIT) || !(ts[1] < ATT_OVF_LIMIT)), 0)) { \
        KFrag kq_; k_read(kq_, K_lds + (SLP_) * SHM_K, r32, hi); qk_mm(PY0, PY1, kq_, qr, negm); \
        float al_, dl_; sm_redo(PY0, PY1, negm, al_, dl_); \
        if (HAVE_PX) { _Pragma("unroll") for (int r = 0; r < 16; ++r) { PX0[r] -= dl_; PX1[r] -= dl_; } } \
        exp_n<0, 16>(PY0); exp_n<0, 16>(PY1); cvt_pa(pa, PY0, PY1); psum8z(ts, lmask, pa, sc1); \
        RESC(al_); \
        asm volatile("s_nop 7\n\ts_nop 3" ::: "memory"); } \
    l0 += ts[0]; l1 += ts[1]; asm volatile("" :: "v"(ts));   } while (0)
#define SLOADT(t_) do { const unsigned so_ = (unsigned)(t_) * (unsigned)(KVBLK * 1024); sr_.vs0 = bufld16(rsV, voffV0, so_); if (wid < 4) sr_.ks0 = bufld16(rsK, voffK, so_); } while (0)
#define SWRITES(SL_) do { *(LAS bf16x8*)(V_lds + (SL_) * SHM_V + vst0) = sr_.vs0; if (wid < 4) *(LAS bf16x8*)(K_lds + (SL_) * SHM_K + kst) = sr_.ks0; } while (0)
#define SEG_A(PX0, PX1, PY0, PY1, t_, SL_, ld_) do { \
    if (ld_) SLOADT((t_) + 2); \
    ATT_SBAR(); KFrag kf_; k_read(kf_, K_lds + (SL_) * SHM_K, r32, hi); ATT_SBAR(); \
    exp_n<0, 16>(PY1); ATT_SBAR(); \
    qk_mm(PX0, PX1, kf_, qr, negm); ATT_SBAR(); \
    cvt_pa(pa, PY0, PY1); psum8z(ts, lmask, pa, sc1); ATT_SBAR(); \
    pv8_rds<(((SL_) + 3) & 3) * SHM_V>(vf, vb8[0]); \
    __syncthreads(); } while (0)
#define SEG_B(PX0, PX1, PY0, PY1, SL_, ld_) do { \
    V8Frag vg_; constexpr int so_ = (((SL_) + 3) & 3) * SHM_V; \
    pv8_rds<so_>(vg_, vb8[1]); ATT_SBAR(); \
    OVF_CHECK(PY0, PY1, PX0, PX1, ((SL_) + 3) & 3, true); ATT_SBAR(); \
    ATT_WAITL(4); ATT_SBAR(); pv8_mm(o[0], vf, pa, sc1); \
    pv8_rds<so_>(vf, vb8[2]); ATT_SBAR(); \
    exp_n<0, 8>(PX0); ATT_SBAR(); \
    ATT_WAITL(4); ATT_SBAR(); pv8_mm(o[1], vg_, pa, sc1); \
    pv8_rds<so_>(vg_, vb8[3]); ATT_SBAR(); \
    exp_n<8, 8>(PX0); ATT_SBAR(); \
    ATT_WAITL(4); ATT_SBAR(); pv8_mm(o[2], vf, pa, sc1); ATT_SBAR(); \
    ATT_WAITL(0); ATT_SBAR(); pv8_mm(o[3], vg_, pa, sc1); ATT_SBAR(); \
    if (ld_) SWRITES(((SL_) + 2) & 3); \
    __syncthreads(); } while (0)
            static_assert(NT % 4 == 0 && NT >= 8, "the tile loop is unrolled over the 4 ring slots");
            SEG_A(pB0, pB1, pA0, pA1, 1, 1, true); SEG_B(pB0, pB1, pA0, pA1, 1, true);
#pragma unroll 1
            for (int t = 2; t + 3 < NT; t += 4) {
                SEG_A(pA0, pA1, pB0, pB1, t, 2, true); SEG_B(pA0, pA1, pB0, pB1, 2, true);
                SEG_A(pB0, pB1, pA0, pA1, t + 1, 3, true); SEG_B(pB0, pB1, pA0, pA1, 3, true);
                SEG_A(pA0, pA1, pB0, pB1, t + 2, 0, true); SEG_B(pA0, pA1, pB0, pB1, 0, true);
                SEG_A(pB0, pB1, pA0, pA1, t + 3, 1, true); SEG_B(pB0, pB1, pA0, pA1, 1, true);
            }
            SEG_A(pA0, pA1, pB0, pB1, NT - 2, 2, false); SEG_B(pA0, pA1, pB0, pB1, 2, false);
            SEG_A(pB0, pB1, pA0, pA1, NT - 1, 3, false); SEG_B(pB0, pB1, pA0, pA1, 3, false);
#undef SEG_A
#undef SEG_B
            exp_n<0, 16>(pB1); cvt_pa(pa, pB0, pB1); psum8z(ts, lmask, pa, sc1); ATT_SBAR();
            OVF_CHECK(pB0, pB1, pB0, pB1, 3, false); ATT_SBAR();
            pv8_d0(o, vb8, VSLOT(NT - 1), pa, sc1);
#undef OVF_CHECK
            asm volatile("s_nop 15\n\ts_nop 15" ::: "memory");
            if (wid < 4) __syncthreads();
            __syncthreads();
#undef KSLOT
#undef VSLOT
#undef SLOAD
#undef SWRITE
#undef RESC
            const int lane2 = fresh_lane(), t2 = wid * 64 + lane2, r32b = lane2 & 31, hi2 = lane2 >> 5;
            if (hi2 == 0) li_l[r32b] = (lane2 & 16) ? l1 : l0; asm volatile("s_waitcnt lgkmcnt(0)" ::: "memory");
            float rli[16];
#pragma unroll
            for (int r = 0; r < 16; ++r) rli[r] = 1.0f / li_l[crow(r, hi2)];
            float* SCR = WSP(float, WS_H) + ((size_t)blockIdx.x * 512 + t2) * 64;
            if (mp == 0) {
#pragma unroll
                for (int d0 = 0; d0 < 4; ++d0)
#pragma unroll
                    for (int r = 0; r < 16; r += 4) *(f32x4*)(SCR + d0 * 16 + r) = (f32x4){o[d0][r] * rli[r], o[d0][r + 1] * rli[r + 1], o[d0][r + 2] * rli[r + 2], o[d0][r + 3] * rli[r + 3]};
            } else {
                LAS bf16* ot = (LAS bf16*)(lds + L_OST) + wid * (32 * OST_LD);
                float gsub[4];
#pragma unroll
                for (int d0 = 0; d0 < 4; ++d0) gsub[d0] = F.in[14][d0 * 32 + r32b];
#pragma unroll
                for (int r = 0; r < 16; ++r) { float a = 0.f;
#pragma unroll
                    for (int d0 = 0; d0 < 4; ++d0) { const float t = SCR[d0 * 16 + r] - lam * (o[d0][r] * rli[r]); o[d0][r] = t; a += t * t; }
#define SWZ_ADD(x_, k_) x_ += __builtin_bit_cast(float, __builtin_amdgcn_ds_swizzle(__builtin_bit_cast(int, x_), ((k_) << 10) | 0x1F))
                    SWZ_ADD(a, 1); SWZ_ADD(a, 2); SWZ_ADD(a, 4); SWZ_ADD(a, 8); SWZ_ADD(a, 16);
#undef SWZ_ADD
                    const float ssr = 0.8f / sqrtf(a * (1.0f / 128.0f) + LN_EPS);
#pragma unroll
                    for (int d0 = 0; d0 < 4; ++d0) ot[crow(r, hi2) * OST_LD + d0 * 32 + r32b] = (bf16)f2bf(o[d0][r] * ssr * gsub[d0]); }
                asm volatile("s_waitcnt lgkmcnt(0)" ::: "memory");
                unsigned char* Ow = mix + (row0 + wid * QBLK + (lane2 >> 4)) * D + 1024 + h * 128 + (lane2 & 15) * 8;
#pragma unroll
                for (int k = 0; k < 8; ++k) { const u32x4 w = *(const LAS u32x4*)(ot + (k * 4 + (lane2 >> 4)) * OST_LD + (lane2 & 15) * 8); u32x2 w8;
                    w8.x = pk4_fp8(bf_lo(w.x), bf_hi(w.x), bf_lo(w.y), bf_hi(w.y)); w8.y = pk4_fp8(bf_lo(w.z), bf_hi(w.z), bf_lo(w.w), bf_hi(w.w)); *(u32x2*)(Ow + (size_t)k * 4 * D) = w8; }
            }
        }
    }
}
template <int L> __device__ __forceinline__ void ln_route_pass(Frame& F) {
    PH_IDS;
    LAS float* P_g = (LAS float*)F.lds;
    LAS float* P_b = P_g + D;
    LAS float* P_s = P_b + D;
    LAS float* P_h = P_s + D;
    LAS int* lcnt = (LAS int*)(F.lds + LDSX_OFF + 1024);
    LAS int* lbase = lcnt + 16;
    LAS int* rec = lcnt + 32;
    LAS float* recw = (LAS float*)(lcnt + 32 + 256);
    LAS float* lgt = (LAS float*)(F.lds + LDSX_OFF + 8192);
    const bf16* R = (const bf16*)F.out + (size_t)M * D; bf16* X = WSP(bf16, WS_X); unsigned char* H8 = WSP(unsigned char, WS_H8);
    const float* lng = F.in[6] + (L * 2 + 0) * D; const float* lnb = F.in[7] + (L * 2 + 0) * D;
    unsigned* gcnt = F.ctl + CW_CNT + L * 16; int2* list = WSP(int2, WS_LIST);
    for (int blk = F.vcu; blk < M / 128; blk += F.G) {
        if (tid < 16) lcnt[tid] = 0;
        __syncthreads();
        const int rowb = blk * 128 + wave * 16, b = rowb >> 13;
        { const float* sh = MODP(L, b, 3); const float* sc = MODP(L, b, 4);
          for (int i = tid; i < D; i += 512) { P_g[i] = lng[i]; P_b[i] = lnb[i]; P_s[i] = 1.0f + sc[i]; P_h[i] = sh[i]; } }
        __syncthreads();
        u32x4 raw0[4], raw1[4];
#pragma unroll
        for (int j = 0; j < 4; ++j) { raw0[j] = *(const u32x4*)(R + (size_t)rowb * D + 512 * j + 8 * lane); raw1[j] = *(const u32x4*)(R + (size_t)(rowb + 1) * D + 512 * j + 8 * lane); }
#pragma unroll 1
        for (int pp = 0; pp < 8; ++pp) {
            const int row = rowb + 2 * pp;
            f32x2 v0[16], v1[16]; f32x2 s0 = {0.f, 0.f}, s1 = {0.f, 0.f};
#pragma unroll
            for (int j = 0; j < 4; ++j) {
                v0[4 * j + 0] = (f32x2){bf_lo(raw0[j].x), bf_hi(raw0[j].x)}; v0[4 * j + 1] = (f32x2){bf_lo(raw0[j].y), bf_hi(raw0[j].y)}; v0[4 * j + 2] = (f32x2){bf_lo(raw0[j].z), bf_hi(raw0[j].z)}; v0[4 * j + 3] = (f32x2){bf_lo(raw0[j].w), bf_hi(raw0[j].w)};
                v1[4 * j + 0] = (f32x2){bf_lo(raw1[j].x), bf_hi(raw1[j].x)}; v1[4 * j + 1] = (f32x2){bf_lo(raw1[j].y), bf_hi(raw1[j].y)}; v1[4 * j + 2] = (f32x2){bf_lo(raw1[j].z), bf_hi(raw1[j].z)}; v1[4 * j + 3] = (f32x2){bf_lo(raw1[j].w), bf_hi(raw1[j].w)}; }
#pragma unroll
            for (int i = 0; i < 16; ++i) { s0 += v0[i]; s1 += v1[i]; }
            if (pp < 7) {
#pragma unroll
                for (int j = 0; j < 4; ++j) { raw0[j] = *(const u32x4*)(R + (size_t)(row + 2) * D + 512 * j + 8 * lane); raw1[j] = *(const u32x4*)(R + (size_t)(row + 3) * D + 512 * j + 8 * lane); } }
            float t0 = s0.x + s0.y, t1 = s1.x + s1.y;
#pragma unroll
            for (int o = 1; o < 64; o <<= 1) { t0 += __shfl_xor(t0, o); t1 += __shfl_xor(t1, o); }
            const float mean0 = t0 * (1.0f / D), mean1 = t1 * (1.0f / D); f32x2 q0 = {0.f, 0.f}, q1 = {0.f, 0.f};
#pragma unroll
            for (int i = 0; i < 16; ++i) { v0[i] = v0[i] - mean0; v1[i] = v1[i] - mean1; q0 += v0[i] * v0[i]; q1 += v1[i] * v1[i]; }
            float u0 = q0.x + q0.y, u1 = q1.x + q1.y;
#pragma unroll
            for (int o = 1; o < 64; o <<= 1) { u0 += __shfl_xor(u0, o); u1 += __shfl_xor(u1, o); }
            const float rstd0 = 1.0f / sqrtf(u0 * (1.0f / D) + LN_EPS), rstd1 = 1.0f / sqrtf(u1 * (1.0f / D) + LN_EPS);
#pragma unroll
            for (int j = 0; j < 4; ++j) { const int c = 512 * j + 8 * lane; u32x4 xo0, xo1; u32x2 h80, h81;
#pragma unroll
                for (int h = 0; h < 2; ++h) { const f32x4 g = *(const LAS f32x4*)(P_g + c + 4 * h), bb = *(const LAS f32x4*)(P_b + c + 4 * h), scv = *(const LAS f32x4*)(P_s + c + 4 * h), shv = *(const LAS f32x4*)(P_h + c + 4 * h);
                    const f32x2 ga = {g.x, g.y}, gb = {g.z, g.w}, ba = {bb.x, bb.y}, bc = {bb.z, bb.w}, sa = {scv.x, scv.y}, sb = {scv.z, scv.w}, ha = {shv.x, shv.y}, hb = {shv.z, shv.w};
                    const f32x2 xa0 = v0[4 * j + 2 * h] * rstd0 * ga + ba, xb0 = v0[4 * j + 2 * h + 1] * rstd0 * gb + bc, xa1 = v1[4 * j + 2 * h] * rstd1 * ga + ba, xb1 = v1[4 * j + 2 * h + 1] * rstd1 * gb + bc;
                    const f32x2 ya0 = xa0 * sa + ha, yb0 = xb0 * sb + hb, ya1 = xa1 * sa + ha, yb1 = xb1 * sb + hb;
                    if (h == 0) { h80.x = pk4_fp8(ya0.x, ya0.y, yb0.x, yb0.y); h81.x = pk4_fp8(ya1.x, ya1.y, yb1.x, yb1.y); } else { h80.y = pk4_fp8(ya0.x, ya0.y, yb0.x, yb0.y); h81.y = pk4_fp8(ya1.x, ya1.y, yb1.x, yb1.y); }
                    if (h == 0) { xo0.x = pk2(xa0.x, xa0.y); xo0.y = pk2(xb0.x, xb0.y); xo1.x = pk2(xa1.x, xa1.y); xo1.y = pk2(xb1.x, xb1.y); }
                    else { xo0.z = pk2(xa0.x, xa0.y); xo0.w = pk2(xb0.x, xb0.y); xo1.z = pk2(xa1.x, xa1.y); xo1.w = pk2(xb1.x, xb1.y); } }
                *(u32x4*)(X + (size_t)row * D + c) = xo0; *(u32x4*)(X + (size_t)(row + 1) * D + c) = xo1;
                *(u32x2*)(H8 + (size_t)row * D + c) = h80; *(u32x2*)(H8 + (size_t)(row + 1) * D + c) = h81; }
        }
        VM_WAIT();
        {
            const int l2 = fresh_lane(), i16 = l2 & 15, kq = l2 >> 4;
            const bf16* hp = X + (size_t)(rowb + i16) * D + 8 * kq; const bf16* whp = WSP(bf16, WS_WRT2) + (size_t)((L * 4 + b) * 32 + i16) * D + 8 * kq; const bf16* wlp = whp + 16 * D;
            f32x4 lacc = {0.f, 0.f, 0.f, 0.f};
#pragma unroll 8
            for (int ks = 0; ks < 64; ++ks) { const bf16x8 af = *(const bf16x8*)(hp + 32 * ks); const bf16x8 bh = *(const bf16x8*)(whp + 32 * ks), bl = *(const bf16x8*)(wlp + 32 * ks);
                lacc = __builtin_amdgcn_mfma_f32_16x16x32_bf16(af, bh, lacc, 0, 0, 0); lacc = __builtin_amdgcn_mfma_f32_16x16x32_bf16(af, bl, lacc, 0, 0, 0); }
            LAS float* lp = lgt + (wave * 16 + 4 * kq) * 16 + i16; const float rc = WSP(float, WS_RC)[(L * 4 + b) * 16 + i16];
            lp[0] = lacc.x + rc; lp[16] = lacc.y + rc; lp[32] = lacc.z + rc; lp[48] = lacc.w + rc;
        }
        LDS_WAIT();
        if (lane < 16) {
            const int rl = wave * 16 + fresh_lane(); float sco[16], sel[16];
#pragma unroll
            for (int e4 = 0; e4 < 4; ++e4) { const f32x4 lg = *(const LAS f32x4*)(lgt + rl * 16 + 4 * e4);
                sco[4 * e4 + 0] = 1.0f / (1.0f + __expf(-lg.x)); sco[4 * e4 + 1] = 1.0f / (1.0f + __expf(-lg.y)); sco[4 * e4 + 2] = 1.0f / (1.0f + __expf(-lg.z)); sco[4 * e4 + 3] = 1.0f / (1.0f + __expf(-lg.w)); }
#pragma unroll
            for (int e = 0; e < 16; ++e) sel[e] = sco[e] + F.in[23][e];
            int bg = 0; float bgs = -1e30f;
#pragma unroll
            for (int g = 0; g < 4; ++g) { float m1 = -1e30f, m2 = -1e30f;
#pragma unroll
                for (int i = 0; i < 4; ++i) { const float x = sel[4 * g + i]; if (x > m1) { m2 = m1; m1 = x; } else if (x > m2) m2 = x; }
                const float gs = m1 + m2; if (gs > bgs) { bgs = gs; bg = g; } }
            float s4[4], c4[4];
#pragma unroll
            for (int i = 0; i < 4; ++i) { s4[i] = bg == 0 ? sel[i] : bg == 1 ? sel[4 + i] : bg == 2 ? sel[8 + i] : sel[12 + i]; c4[i] = bg == 0 ? sco[i] : bg == 1 ? sco[4 + i] : bg == 2 ? sco[8 + i] : sco[12 + i]; }
            int i1 = 0; float b1 = s4[0];
#pragma unroll
            for (int i = 1; i < 4; ++i) if (s4[i] > b1) { b1 = s4[i]; i1 = i; }
            int i2 = -1; float b2 = -1e30f;
#pragma unroll
            for (int i = 0; i < 4; ++i) if (i != i1 && s4[i] > b2) { b2 = s4[i]; i2 = i; }
            const float cw1 = i1 == 0 ? c4[0] : i1 == 1 ? c4[1] : i1 == 2 ? c4[2] : c4[3], cw2 = i2 == 0 ? c4[0] : i2 == 1 ? c4[1] : i2 == 2 ? c4[2] : c4[3];
            const float inv = 1.0f / (cw1 + cw2);
            const int e1 = bg * 4 + i1, e2 = bg * 4 + i2;
            const int r1 = atomicAdd((int*)(lcnt + e1), 1), r2 = atomicAdd((int*)(lcnt + e2), 1);
            rec[rl * 2] = e1 | (r1 << 8); rec[rl * 2 + 1] = e2 | (r2 << 8); recw[rl * 2] = cw1 * inv; recw[rl * 2 + 1] = cw2 * inv;
        }
        __syncthreads();
        if (tid < 16) lbase[tid] = (int)atomicAdd(gcnt + tid, (unsigned)lcnt[tid]);
        __syncthreads();
        if (tid < 256) { const int v = rec[tid], e = v & 255, rank = v >> 8; const int entry = (blk * 128 + (tid >> 1)) * 2 + (tid & 1);
            list[e * CAP + lbase[e] + rank] = make_int2(entry, __float_as_int(recw[tid])); }
        __syncthreads();
    }
}
template <int L> __device__ __forceinline__ int moe_tables(Frame& F, LAS int*& tp, LAS int*& cnt) {
    tp = (LAS int*)(F.lds + LDSX_OFF + 16384); cnt = tp + 32;
    LAS int* ord = tp + 64; LAS int* tpf = tp + 352  ; LAS int* pix = tp + 372  ;
    if (F.wave0 == 0 && fresh_lane() == 0) { int acc = 0, fa = 0, pa = 0;
        for (int e = 0; e < NE; ++e) { const int c = (int)__hip_atomic_load(F.ctl + CW_CNT + L * 16 + e, RLX_AGENT); cnt[e] = c; tp[e] = acc; acc += (c + 255) >> 8; tpf[e] = fa; fa += c >> 8; pix[e] = pa; pa += (c & 255) ? 1 : 0; }
        tp[NE] = acc; tpf[NE] = fa; }
    __syncthreads();
    { const int t_ = F.wave0 * 64 + fresh_lane();
      if (t_ < NE) { const int c = cnt[t_], full = c >> 8, base = tp[t_], fo = tpf[t_]; for (int k = 0; k < full; ++k) ord[fo + k] = base + k; if (c & 255) ord[tpf[NE] + pix[t_]] = base + full; } }
    __syncthreads();
    return tp[NE];
}
template <int L> __device__ __forceinline__ void ln_moe_pass(Frame& F) {
    PH_IDS;
    bf16* X = WSP(bf16, WS_X); unsigned char* H8 = WSP(unsigned char, WS_H8); const bf16* YB = WSP(bf16, WS_YB);
    LAS float* P_g2 = (LAS float*)F.lds; LAS float* P_g = P_g2 + D; LAS float* P_b = P_g + D; LAS float* P_s = P_b + D; LAS float* P_h = P_s + D;
    for (int blk = F.vcu; blk < M / 128; blk += F.G) {
        const int rowb = blk * 128 + wave * 16, b = rowb >> 13;
        __syncthreads();
        for (int i = tid; i < D; i += 512) { P_g2[i] = MODP(L, b, 5)[i]; P_g[i] = F.in[6][(L * 2 + 1) * D + i]; P_b[i] = F.in[7][(L * 2 + 1) * D + i];
            if (L == 0) { P_s[i] = 1.0f + MODP(1, b, 1)[i]; P_h[i] = MODP(1, b, 0)[i]; } }
        __syncthreads();
        u32x4 rx[4], ry0[4], ry1[4];
#define LNM_LOAD(r_) do { _Pragma("unroll") for (int j = 0; j < 4; ++j) { const int c = 512 * j + 8 * lane; rx[j] = *(const u32x4*)(X + (size_t)(r_) * D + c); \
            ry0[j] = *(const u32x4*)(YB + (size_t)(r_) * 2 * D + c); ry1[j] = *(const u32x4*)(YB + ((size_t)(r_) * 2 + 1) * D + c); } } while (0)
        LNM_LOAD(rowb);
#pragma unroll 1
        for (int rr = 0; rr < 16; ++rr) {
            const int row = rowb + rr;
            f32x2 v[16]; f32x2 s2 = {0.f, 0.f};
#pragma unroll
            for (int j = 0; j < 4; ++j) { const int c = 512 * j + 8 * lane;
                const f32x4 ga = *(const LAS f32x4*)(P_g2 + c), gb = *(const LAS f32x4*)(P_g2 + c + 4);
#define LNM_E(k_, W_, G0_, G1_) v[4 * j + k_] = (f32x2){bf_lo(rx[j].W_), bf_hi(rx[j].W_)} * ALPHA + (f32x2){G0_, G1_} * ((f32x2){bf_lo(ry0[j].W_), bf_hi(ry0[j].W_)} + (f32x2){bf_lo(ry1[j].W_), bf_hi(ry1[j].W_)})
                LNM_E(0, x, ga.x, ga.y); LNM_E(1, y, ga.z, ga.w); LNM_E(2, z, gb.x, gb.y); LNM_E(3, w, gb.z, gb.w);
#undef LNM_E
            }
#pragma unroll
            for (int i = 0; i < 16; ++i) s2 += v[i];
            if (rr < 15) LNM_LOAD(row + 1);
            float t = s2.x + s2.y;
#pragma unroll
            for (int o = 1; o < 64; o <<= 1) t += __shfl_xor(t, o);
            const float mean = t * (1.0f / D); f32x2 q2 = {0.f, 0.f};
#pragma unroll
            for (int i = 0; i < 16; ++i) { v[i] = v[i] - mean; q2 += v[i] * v[i]; }
            float u = q2.x + q2.y;
#pragma unroll
            for (int o = 1; o < 64; o <<= 1) u += __shfl_xor(u, o);
            const float rstd = 1.0f / sqrtf(u * (1.0f / D) + LN_EPS);
#pragma unroll
            for (int j = 0; j < 4; ++j) { const int c = 512 * j + 8 * lane; f32x2 xo[4];
#pragma unroll
                for (int h = 0; h < 2; ++h) { const f32x4 g = *(const LAS f32x4*)(P_g + c + 4 * h), bb = *(const LAS f32x4*)(P_b + c + 4 * h);
                    xo[2 * h] = v[4 * j + 2 * h] * rstd * (f32x2){g.x, g.y} + (f32x2){bb.x, bb.y}; xo[2 * h + 1] = v[4 * j + 2 * h + 1] * rstd * (f32x2){g.z, g.w} + (f32x2){bb.z, bb.w}; }
                if (L == 1) { *(f32x4*)(F.out + (size_t)row * D + c) = (f32x4){xo[0].x, xo[0].y, xo[1].x, xo[1].y}; *(f32x4*)(F.out + (size_t)row * D + c + 4) = (f32x4){xo[2].x, xo[2].y, xo[3].x, xo[3].y}; }
                else { u32x4 w; w.x = pk2(xo[0].x, xo[0].y); w.y = pk2(xo[1].x, xo[1].y); w.z = pk2(xo[2].x, xo[2].y); w.w = pk2(xo[3].x, xo[3].y); *(u32x4*)(X + (size_t)row * D + c) = w;
                    const f32x4 sa = *(const LAS f32x4*)(P_s + c), sb = *(const LAS f32x4*)(P_s + c + 4), ha = *(const LAS f32x4*)(P_h + c), hb = *(const LAS f32x4*)(P_h + c + 4);
                    const f32x2 y0 = xo[0] * (f32x2){sa.x, sa.y} + (f32x2){ha.x, ha.y}, y1 = xo[1] * (f32x2){sa.z, sa.w} + (f32x2){ha.z, ha.w}, y2 = xo[2] * (f32x2){sb.x, sb.y} + (f32x2){hb.x, hb.y}, y3 = xo[3] * (f32x2){sb.z, sb.w} + (f32x2){hb.z, hb.w};
                    u32x2 hw; hw.x = pk4_fp8(y0.x, y0.y, y1.x, y1.y); hw.y = pk4_fp8(y2.x, y2.y, y3.x, y3.y); *(u32x2*)(H8 + (size_t)row * D + c) = hw; } }
        }
#undef LNM_LOAD
    }
}
__device__ __forceinline__ void spatial_simple(Frame& F) {
    PH_IDS;
    LAS float* vt = (LAS float*)F.lds;
    LAS float* wt = (LAS float*)(F.lds + 65536);
    LAS float* st = (LAS float*)(F.lds + LDSX_OFF + 1024);
    const bf16* UV = WSP(bf16, WS_UV); bf16* GT = (bf16*)F.out; const float* vst = WSP(float, WS_VSTP);
    for (int ch = F.vcu; ch < M / 128; ch += F.G) {
        __syncthreads();
        if (tid < 128) { float s = 0.f, s2 = 0.f; const f32x4* pp = (const f32x4*)(vst + (size_t)(ch * 128 + tid) * 64);
#pragma unroll
            for (int i = 0; i < 16; ++i) { const f32x4 t = pp[i]; s += t.x; s2 += t.y; s += t.z; s2 += t.w; }
            const float mean = s * (1.0f / D); const float var = fmaxf(s2 * (1.0f / D) - mean * mean, 0.f);
            st[tid * 2] = mean; st[tid * 2 + 1] = 1.0f / sqrtf(var + LN_EPS); }
#pragma unroll 1
        for (int g = 0; g < 16; ++g) {
            __syncthreads();
            for (int idx = tid; idx < 16384; idx += 512) { const int q = idx >> 7, c = idx & 127, col = g * 128 + c;
                const float v = bf2f(UV[(size_t)(ch * 128 + q) * 4096 + 2048 + col]);
                vt[idx] = (v - st[q * 2]) * st[q * 2 + 1] * F.in[17][col] + F.in[18][col]; wt[q * 129 + c] = F.in[19][g * 16384 + idx]; }
            __syncthreads();
            const int p = tid & 127, cg = tid >> 7;
            float acc[32];
#pragma unroll
            for (int i = 0; i < 32; ++i) acc[i] = 0.f;
#pragma unroll 1
            for (int q = 0; q < 128; ++q) { const float w = wt[p * 129 + q];
#pragma unroll
                for (int i = 0; i < 32; i += 4) { const f32x4 v = *(const LAS f32x4*)(vt + q * 128 + cg * 32 + i); acc[i] += w * v.x; acc[i + 1] += w * v.y; acc[i + 2] += w * v.z; acc[i + 3] += w * v.w; } }
            const size_t row = (size_t)ch * 128 + p; const float bsv = F.in[20][g * 128 + p];
            const bf16* up = UV + row * 4096 + g * 128 + cg * 32; bf16* op = GT + row * D + g * 128 + cg * 32;
#pragma unroll
            for (int i = 0; i < 32; i += 4) { const f32x4 uu = ld_bf4(up + i); st_bf4(op + i, (f32x4){uu.x * (acc[i] + bsv), uu.y * (acc[i + 1] + bsv), uu.z * (acc[i + 2] + bsv), uu.w * (acc[i + 3] + bsv)}); }
        }
    }
}

__device__ __forceinline__ void spatial_fast(Frame& F) {
    using namespace att;
    PH_IDS; const int wid = wave, r32 = lane & 31, hi = lane >> 5;
    LAS char* lds = (LAS char*)F.lds;
    LAS bf16* ot = (LAS bf16*)(lds + 65536) + wid * (32 * 136);
    LAS float* st = (LAS float*)(lds + 135168);
    const bf16* UV = WSP(bf16, WS_UV); unsigned char* GT = (unsigned char*)F.out; const float* vst = WSP(float, WS_VSTP); const bf16* WSB = WSP(bf16, WS_WSB);
    const int q0 = tid >> 4, cc = tid & 15;
    const int gsw = wid >> 2, pbase = (wid & 3) * 32;
    const int vbase = (int)(unsigned)(uintptr_t)lds + v_rd_base(lane) + gsw * 2 * 16384;
    for (int ch = F.vcu; ch < M / 128; ch += F.G) {
        __syncthreads();
        if (tid < 128) { float s = 0.f, s2 = 0.f; const f32x4* pp = (const f32x4*)(vst + (size_t)(ch * 128 + tid) * 64);
#pragma unroll
            for (int i = 0; i < 16; ++i) { const f32x4 t = pp[i]; s += t.x; s2 += t.y; s += t.z; s2 += t.w; }
            const float mean = s * (1.0f / D); const float var = fmaxf(s2 * (1.0f / D) - mean * mean, 0.f);
            st[tid * 2] = mean; st[tid * 2 + 1] = 1.0f / sqrtf(var + LN_EPS); }
        __syncthreads();
        const char* vsrc = (const char*)(UV + (size_t)ch * 128 * 4096 + 2048); const unsigned voff = (unsigned)(q0 * 4096 + cc * 8) * 2u;
        u32x4 raw[2][4];
#define LOADV(it_) do { _Pragma("unroll") for (int gs = 0; gs < 2; ++gs) _Pragma("unroll") for (int j = 0; j < 4; ++j) \
            raw[gs][j] = *(const u32x4*)(vsrc + voff + (size_t)((2 * (it_) + gs) * 256 + j * 32 * 8192)); } while (0)
        LOADV(0);
#pragma unroll 1
        for (int it = 0; it < 8; ++it) {
#pragma unroll
            for (int gs = 0; gs < 2; ++gs) { const int col = (2 * it + gs) * 128 + cc * 8;
                const f32x4 ga = *(const f32x4*)(F.in[17] + col), gb = *(const f32x4*)(F.in[17] + col + 4), ba = *(const f32x4*)(F.in[18] + col), bb = *(const f32x4*)(F.in[18] + col + 4);
#pragma unroll
                for (int j = 0; j < 4; ++j) { const int q = q0 + 32 * j; const float mean = st[2 * q], rstd = st[2 * q + 1]; const u32x4 w = raw[gs][j]; u32x4 o;
                    o.x = pk2((bf_lo(w.x) - mean) * rstd * ga.x + ba.x, (bf_hi(w.x) - mean) * rstd * ga.y + ba.y); o.y = pk2((bf_lo(w.y) - mean) * rstd * ga.z + ba.z, (bf_hi(w.y) - mean) * rstd * ga.w + ba.w);
                    o.z = pk2((bf_lo(w.z) - mean) * rstd * gb.x + bb.x, (bf_hi(w.z) - mean) * rstd * gb.y + bb.y); o.w = pk2((bf_lo(w.w) - mean) * rstd * gb.z + bb.z, (bf_hi(w.w) - mean) * rstd * gb.w + bb.w);
                    *(LAS u32x4*)(lds + (gs * 2 + (q >> 6)) * 16384 + v_st(q & 63, cc * 8)) = o; } }
            __syncthreads();
            if (it + 1 < 8) LOADV(it + 1);
            const int g = 2 * it + gsw;
            bf16x8 wa[8];
#pragma unroll
            for (int ks = 0; ks < 8; ++ks) wa[ks] = *(const bf16x8*)(WSB + (size_t)(g * 128 + pbase + r32) * 128 + ks * 16 + hi * 8);
            f32x16 o[4] = {};
            pv_d0(o, vbase, wa[0], wa[1], wa[2], wa[3]); pv_d0(o, vbase + 16384, wa[4], wa[5], wa[6], wa[7]);
#pragma unroll
            for (int r = 0; r < 16; ++r) { const float bs = F.in[20][g * 128 + pbase + crow(r, hi)];
#pragma unroll
                for (int d0 = 0; d0 < 4; ++d0) ot[crow(r, hi) * 136 + d0 * 32 + r32] = (bf16)f2bf(o[d0][r] + bs); }
            asm volatile("s_waitcnt lgkmcnt(0)" ::: "memory");
            const size_t tok = (size_t)ch * 128 + pbase + (lane >> 4);
#pragma unroll
            for (int k = 0; k < 8; ++k) { const u32x4 sv = *(const LAS u32x4*)(ot + (k * 4 + (lane >> 4)) * 136 + (lane & 15) * 8);
                const u32x4 uu = *(const u32x4*)(UV + (tok + k * 4) * 4096 + g * 128 + (lane & 15) * 8); u32x2 w;
                w.x = pk4_fp8(bf_lo(uu.x) * bf_lo(sv.x), bf_hi(uu.x) * bf_hi(sv.x), bf_lo(uu.y) * bf_lo(sv.y), bf_hi(uu.y) * bf_hi(sv.y));
                w.y = pk4_fp8(bf_lo(uu.z) * bf_lo(sv.z), bf_hi(uu.z) * bf_hi(sv.z), bf_lo(uu.w) * bf_lo(sv.w), bf_hi(uu.w) * bf_hi(sv.w));
                *(u32x2*)(GT + (tok + k * 4) * D + g * 128 + (lane & 15) * 8) = w; }
            __syncthreads();
        }
#undef LOADV
    }
}

constexpr int NPH = 17;
struct Args { const float* in[27]; float* out; unsigned char* ws; int ph_lo, ph_hi; };
__global__ void __launch_bounds__(NWAVES * 64, 2) mk_fwd(Args args) {
    extern __shared__ __attribute__((aligned(16))) unsigned char lds_raw[];
    Frame F;
    F.lds = (LAS unsigned char*)lds_raw;
    F.MISC = (volatile LAS unsigned*)(F.lds + MISC_OFF);
    F.wave0 = __builtin_amdgcn_readfirstlane((int)threadIdx.x >> 6);
    F.G = gridDim.x; { const int bx = blockIdx.x; F.vcu = (F.G % 8 == 0) ? (bx % 8) * (F.G / 8) + bx / 8 : bx; }
#pragma unroll
    for (int i = 0; i < 27; ++i) F.in[i] = args.in[i];
    F.out = args.out; F.ws = args.ws; F.ctl = (unsigned*)(args.ws + WS_CTL);
    if (threadIdx.x < 64) ((LAS unsigned*)(F.lds + MISC_OFF))[threadIdx.x] = 0u;
    __syncthreads();
    XcdBarrier bar; bar.bar = F.ctl + CW_BAR; bar.x = 0; bar.st = nullptr;
    if (MK_N_LAUNCHES == 1) bar = xcd_barrier_post(F.ctl + CW_BAR, F.MISC + 8, threadIdx.x == 0);
    const int lo = args.ph_lo, hi = args.ph_hi;
#define IN(k) (lo <= (k) && (k) < hi)
#define SEAM(k) do { if (IN(k) && IN((k) + 1)) xcd_barrier(bar, F.wave0 == 0 && fresh_lane() == 0); } while (0)

#define RUN(k, ...) do { if (IN(k)) { constexpr bool dup_pass = false; (void)dup_pass; __VA_ARGS__ } SEAM(k); if (DUP_PHASE == (k) && IN(k)) { constexpr bool dup_pass = true; (void)dup_pass; __VA_ARGS__ xcd_barrier(bar, F.wave0 == 0 && fresh_lane() == 0); } } while (0)
    RUN(0, p0_prologue(F););
    RUN(1, p1_modulate(F););
    RUN(2,
        { LAS float* tabL = (LAS float*)(F.lds + LDSX_OFF); { const int t_ = F.wave0 * 64 + fresh_lane(); for (int i = t_; i < 4096; i += 512) tabL[i] = WSP(float, WS_TAB)[i]; } __syncthreads();
          const unsigned char* h8 = (const unsigned char*)F.out + (size_t)M * D * 2; const unsigned char* w8 = WSP(unsigned char, WS_WINE) + (size_t)3072 * D;
          { Gemm g{(const bf16*)h8, (const bf16*)WSP(unsigned char, WS_WINE), M, 6144, D}; pg8::StaticOrder S; S.init(M, 6144, F.G, (int)blockIdx.x);
            EpiInProj E{WSP(bf16, WS_PROJ), WSP(bf16, WS_Q), WSP(bf16, WS_KB), WSP(bf16, WS_VB), tabL, tabL + 2048, 0};
            GEMM_PHASE_F8(EpiInProj, pg8::StaticOrder, F.lds, g, S, E); }
          { Gemm g{(const bf16*)(h8 + (size_t)M * D), (const bf16*)(w8 + (size_t)1024 * D), MC, 2048, D}; pg8::StaticOrder S; S.init(MC, 2048, F.G, (int)blockIdx.x);
            EpiCtx E{WSP(bf16, WS_KB), WSP(bf16, WS_VB)};
            GEMM_PHASE_F8(EpiCtx, pg8::StaticOrder, F.lds, g, S, E); } }
        if (!dup_pass) { const int c = (int)blockIdx.x;
            if (F.G <= 32) convert_weights<1>(F, c * NWAVES + F.wave0, F.G * NWAVES, F.wave0, fresh_lane(), 0, CW_SPLIT1);
            else if (c >= 32) convert_weights<1>(F, (c - 32) * NWAVES + F.wave0, (F.G - 32) * NWAVES, F.wave0, fresh_lane(), 0, CW_SPLIT1); });
#if USE_FAST_ATTN
    RUN(3, conv_pass(F); attn_fast(F););
#else
    RUN(3, conv_pass(F); attn_simple(F););
    RUN(4, attn_finish(F););
#endif
    RUN(5, { Gemm g{(const bf16*)F.out, WSP(bf16, WS_WOUTE), M, D, D}; pg8::StaticOrder S; S.init(M, D, F.G, (int)blockIdx.x);
        EpiRes<true> E{F.in[0], nullptr, MODP(0, 0, 2), (bf16*)F.out + (size_t)M * D};
        GEMM_PHASE_F8(EpiRes<true>, pg8::StaticOrder, F.lds, g, S, E); });
    RUN(6, ln_route_pass<0>(F););
    RUN(7, { LAS int* tp; LAS int* cnt; const int TP = moe_tables<0>(F, tp, cnt);
        Gemm g{(const bf16*)WSP(unsigned char, WS_H8), (const bf16*)(WSP(unsigned char, WS_WGU)), M, 1024, D}; pg8::MoeOrder<true> S{tp, cnt, WSP(int2, WS_LIST), 4, TP * 4, F.G, (int)blockIdx.x, tp + 64};
        EpiGU E{WSP(unsigned char, WS_HID)}; GEMM_PHASE_F8(EpiGU, pg8::MoeOrder<true>, F.lds, g, S, E);
        if (!dup_pass) { const int rem = (TP * 4) % F.G; const int c = (int)blockIdx.x;
            if (rem == 0) convert_weights<1>(F, c * NWAVES + F.wave0, F.G * NWAVES, F.wave0, fresh_lane(), CW_SPLIT1, CW_N1);
            else if (c >= rem) convert_weights<1>(F, (c - rem) * NWAVES + F.wave0, (F.G - rem) * NWAVES, F.wave0, fresh_lane(), CW_SPLIT1, CW_N1); } });
    RUN(8, { LAS int* tp; LAS int* cnt; const int TP = moe_tables<0>(F, tp, cnt);
        Gemm g{(const bf16*)WSP(unsigned char, WS_HID), (const bf16*)(WSP(unsigned char, WS_WDN)), M, 2048, ED}; pg8::MoeOrder<false> S{tp, cnt, WSP(int2, WS_LIST), 8, TP * 8, F.G, (int)blockIdx.x, tp + 64};
        EpiDown E{WSP(int2, WS_LIST), WSP(bf16, WS_YB), (LAS u32x2*)(F.lds + LDSX_OFF + 20480)}; GEMM_PHASE_F8(EpiDown, pg8::MoeOrder<false>, F.lds, g, S, E); });
    RUN(9, ln_moe_pass<0>(F););
    RUN(10, { Gemm g{(const bf16*)WSP(unsigned char, WS_H8), WSP(bf16, WS_WINO), M, 4096, D}; pg8::StaticOrder S; S.init(M, 4096, F.G, (int)blockIdx.x);
        EpiGelu E{WSP(bf16, WS_UV), WSP(float, WS_VSTP)}; GEMM_PHASE_F8(EpiGelu, pg8::StaticOrder, F.lds, g, S, E); });
#if USE_FAST_SPATIAL
    RUN(11, spatial_fast(F););
#else
    RUN(11, spatial_simple(F););
#endif
    RUN(12, { Gemm g{(const bf16*)F.out, WSP(bf16, WS_WOUTO), M, D, D}; pg8::StaticOrder S; S.init(M, D, F.G, (int)blockIdx.x);
        EpiRes<false> E{nullptr, WSP(bf16, WS_X), MODP(1, 0, 2), (bf16*)F.out + (size_t)M * D};
        GEMM_PHASE_F8(EpiRes<false>, pg8::StaticOrder, F.lds, g, S, E); });
    RUN(13, ln_route_pass<1>(F););
    RUN(14, { LAS int* tp; LAS int* cnt; const int TP = moe_tables<1>(F, tp, cnt);
        Gemm g{(const bf16*)WSP(unsigned char, WS_H8), (const bf16*)(WSP(unsigned char, WS_WGU) + (size_t)16 * 1024 * D), M, 1024, D}; pg8::MoeOrder<true> S{tp, cnt, WSP(int2, WS_LIST), 4, TP * 4, F.G, (int)blockIdx.x, tp + 64};
        EpiGU E{WSP(unsigned char, WS_HID)}; GEMM_PHASE_F8(EpiGU, pg8::MoeOrder<true>, F.lds, g, S, E); });
    RUN(15, { LAS int* tp; LAS int* cnt; const int TP = moe_tables<1>(F, tp, cnt);
        Gemm g{(const bf16*)WSP(unsigned char, WS_HID), (const bf16*)(WSP(unsigned char, WS_WDN) + (size_t)16 * D * ED), M, 2048, ED}; pg8::MoeOrder<false> S{tp, cnt, WSP(int2, WS_LIST), 8, TP * 8, F.G, (int)blockIdx.x, tp + 64};
        EpiDown E{WSP(int2, WS_LIST), WSP(bf16, WS_YB), (LAS u32x2*)(F.lds + LDSX_OFF + 20480)}; GEMM_PHASE_F8(EpiDown, pg8::MoeOrder<false>, F.lds, g, S, E); });
    if (DUP_PHASE == 16) { ln_moe_pass<1>(F); xcd_barrier(bar, F.wave0 == 0 && fresh_lane() == 0); }
    if (IN(16)) { ln_moe_pass<1>(F); }
#undef RUN
#undef IN
#undef SEAM
}

extern "C" void kernel_launch(void* const* d_in, const int* in_sizes, int n_in, void* d_out, int out_size, void* d_ws, size_t ws_size, hipStream_t stream) {
    static int grid = 0;
    if (grid == 0) {
        if (n_in != 27 || in_sizes[0] != M * D || out_size != M * D || ws_size < WS_END) { fprintf(stderr, "kernel_launch: shape/workspace mismatch (n_in %d, ws %zu < %zu)\n", n_in, ws_size, (size_t)WS_END); grid = -1; return; }
        int dev = 0, cus = 0, per_cu = 0;
        if (hipGetDevice(&dev) != hipSuccess || hipDeviceGetAttribute(&cus, hipDeviceAttributeMultiprocessorCount, dev) != hipSuccess) { grid = -1; return; }
        if (hipFuncSetAttribute((const void*)mk_fwd, hipFuncAttributeMaxDynamicSharedMemorySize, LDS_BYTES) != hipSuccess) { fprintf(stderr, "kernel_launch: hipFuncSetAttribute failed\n"); grid = -1; return; }
        if (hipOccupancyMaxActiveBlocksPerMultiprocessor(&per_cu, (const void*)mk_fwd, NWAVES * 64, LDS_BYTES) != hipSuccess || per_cu < 1) fprintf(stderr, "kernel_launch: occupancy query reports %d\n", per_cu);
        (void)hipGetLastError();
        grid = cus;
    }
    if (grid < 0) return;
    if (hipMemsetAsync((char*)d_ws + WS_CTL, 0, CTL_ZERO_BYTES, stream) != hipSuccess) return;
    Args a{};
    for (int i = 0; i < 27; ++i) a.in[i] = (const float*)d_in[i];
    a.out = (float*)d_out; a.ws = (unsigned char*)d_ws;
    if (MK_N_LAUNCHES == 1) { a.ph_lo = 0; a.ph_hi = NPH; hipLaunchKernelGGL(mk_fwd, dim3(grid), dim3(NWAVES * 64), LDS_BYTES, stream, a); }
    else for (int p = 0; p < NPH; ++p) {
#if USE_FAST_ATTN
        if (p == 4) continue;
#endif
        a.ph_lo = p; a.ph_hi = p + 1; hipLaunchKernelGGL(mk_fwd, dim3(grid), dim3(NWAVES * 64), LDS_BYTES, stream, a); }
    const hipError_t le = hipPeekAtLastError();
    if (le != hipSuccess) fprintf(stderr, "kernel_launch: launch failed: %s\n", hipGetErrorName(le));
}
```

```cpp
#include <hip/hip_runtime.h>
#include <cstdio>
#include <cstdint>

#ifndef MK_N_LAUNCHES
#define MK_N_LAUNCHES 1
#endif
#ifndef DUP_PHASE
#define ATT_OVF_LIMIT __builtin_inff()
#define DUP_PHASE -1
#endif
#ifndef USE_FAST_GEMM
#define USE_FAST_GEMM 1
#endif
#ifndef USE_FAST_ATTN
#define USE_FAST_ATTN 1
#endif
#ifndef USE_FAST_SPATIAL
#define USE_FAST_SPATIAL 1
#endif

#define GAS __attribute__((address_space(1)))
#define LAS __attribute__((address_space(3)))
typedef unsigned short bf16;
typedef short bf16x8 __attribute__((ext_vector_type(8)));
typedef float f32x4 __attribute__((ext_vector_type(4)));
typedef float f32x2 __attribute__((ext_vector_type(2)));
typedef unsigned u32x4 __attribute__((ext_vector_type(4)));
typedef unsigned u32x2 __attribute__((ext_vector_type(2)));
typedef GAS unsigned gu32;

constexpr int D = 2048, BATCH = 4, SEQ = 8192, M = BATCH * SEQ, CTXL = 256, MC = BATCH * CTXL, KV = SEQ + CTXL;
constexpr int NE = 16, ED = 512, CAP = 32768;
constexpr float ALPHA = 1.41421356237309515f, LN_EPS = 1e-5f;
constexpr int NWAVES = 8;
constexpr float QSCALE = 0.125f * 1.4426950408889634f;

constexpr size_t MiB = 1u << 20;
constexpr size_t WS_CTL = 0, CTL_ZERO_BYTES = 64 * 1024;
constexpr size_t WS_MOD = 2 * MiB;
constexpr size_t WS_TAB = 3 * MiB;
constexpr size_t WS_WRT = 3 * MiB + 64 * 1024;
constexpr size_t WS_WSB = 3 * MiB + 256 * 1024;
constexpr size_t WS_WRT2 = 24 * MiB;
constexpr size_t WS_RC = 25 * MiB;
constexpr size_t WS_LIST = 4 * MiB;
constexpr size_t WS_WINE = 8 * MiB;
constexpr size_t WS_WOUTE = 32 * MiB;
constexpr size_t WS_WINO = 40 * MiB;
constexpr size_t WS_WOUTO = 56 * MiB;
constexpr size_t WS_WGU = 64 * MiB;
constexpr size_t WS_WDN = 192 * MiB;
constexpr size_t WS_A = 256 * MiB;
constexpr size_t WS_PROJ = WS_A;
constexpr size_t WS_Q = WS_A + 192 * MiB;
constexpr size_t WS_KB = WS_A + 256 * MiB;
constexpr size_t WS_VB = WS_A + 322 * MiB;
constexpr size_t WS_HID = WS_A;
constexpr size_t WS_H8 = WS_A + 324 * MiB;
constexpr size_t WS_YB = WS_A + 68 * MiB;
constexpr size_t WS_UV = WS_A;
constexpr size_t WS_VSTP = WS_A + 256 * MiB;
constexpr size_t WS_H = WS_A + 388 * MiB;
constexpr size_t WS_X = WS_H + 128 * MiB;
constexpr size_t WS_HC = WS_X + 128 * MiB;
constexpr size_t WS_END = WS_HC + 4 * MiB;
static_assert(WS_VB + (size_t)BATCH * KV * 1024 * 2 <= WS_H && WS_YB + (size_t)M * 2 * 2048 * 2 <= WS_H && WS_END <= 1024 * MiB, "ws map");
constexpr int CW_BAR = 4096;
constexpr int CW_CNT = 8192;
constexpr int CW_VST = 262144;
constexpr int RING_BYTES = 131072, LDSX_OFF = RING_BYTES, MISC_OFF = LDSX_OFF + 24576, LDS_BYTES = 163840;

#define RLX_AGENT __ATOMIC_RELAXED, __HIP_MEMORY_SCOPE_AGENT
#define LDS_WAIT() asm volatile("s_waitcnt lgkmcnt(0)" ::: "memory")
#define VM_WAIT() asm volatile("s_waitcnt vmcnt(0)" ::: "memory")
__device__ __forceinline__ unsigned f2bf(float f) { unsigned u = __builtin_bit_cast(unsigned, f); return (u + 0x7fffu + ((u >> 16) & 1u)) >> 16; }
__device__ __forceinline__ unsigned pk2(float lo, float hi) { unsigned r; asm("v_cvt_pk_bf16_f32 %0, %1, %2" : "=v"(r) : "v"(lo), "v"(hi)); return r; }
__device__ __forceinline__ float bf_lo(unsigned u) { return __uint_as_float(u << 16); }
__device__ __forceinline__ float bf_hi(unsigned u) { return __uint_as_float(u & 0xffff0000u); }
__device__ __forceinline__ float bf2f(bf16 h) { return __uint_as_float((unsigned)h << 16); }
__device__ __forceinline__ f32x4 ld_bf4(const bf16* p) { const u32x2 w = *(const u32x2*)p; return (f32x4){bf_lo(w.x), bf_hi(w.x), bf_lo(w.y), bf_hi(w.y)}; }
__device__ __forceinline__ void st_bf4(bf16* p, f32x4 v) { u32x2 w; w.x = pk2(v.x, v.y); w.y = pk2(v.z, v.w); *(u32x2*)p = w; }
__device__ __forceinline__ float wave_sum(float v) {
#pragma unroll
    for (int o = 1; o < 64; o <<= 1) v += __shfl_xor(v, o);
    return v;
}
__device__ __forceinline__ __amdgpu_buffer_rsrc_t make_rsrc(const void* p, int bytes) {
    const unsigned long long v = (unsigned long long)p; const unsigned lo = __builtin_amdgcn_readfirstlane((unsigned)v), hi = __builtin_amdgcn_readfirstlane((unsigned)(v >> 32));
    return __builtin_amdgcn_make_buffer_rsrc((void*)(((unsigned long long)hi << 32) | lo), 0, bytes, 0x00020000);
}
__device__ __forceinline__ bf16x8 bufld16(__amdgpu_buffer_rsrc_t r, unsigned voff, unsigned soff) { return __builtin_bit_cast(bf16x8, __builtin_amdgcn_raw_buffer_load_b128(r, (int)voff, (int)soff, 0)); }
__device__ __forceinline__ unsigned pk4_fp8(float a, float b, float c, float d) {
    a = __builtin_amdgcn_fmed3f(a, -448.f, 448.f); b = __builtin_amdgcn_fmed3f(b, -448.f, 448.f); c = __builtin_amdgcn_fmed3f(c, -448.f, 448.f); d = __builtin_amdgcn_fmed3f(d, -448.f, 448.f);
    int v = __builtin_amdgcn_cvt_pk_fp8_f32(a, b, 0, false); v = __builtin_amdgcn_cvt_pk_fp8_f32(c, d, v, true); return (unsigned)v; }
__device__ __forceinline__ void st_f8x8(unsigned char* p, f32x4 a, f32x4 b) { u32x2 w; w.x = pk4_fp8(a.x, a.y, a.z, a.w); w.y = pk4_fp8(b.x, b.y, b.z, b.w); *(u32x2*)p = w; }
constexpr float W8_SCALE = 32.0f;
__device__ __forceinline__ float silu_f(float x) { return x * __builtin_amdgcn_rcpf(1.0f + __builtin_amdgcn_exp2f(-1.4426950408889634f * x)); }
__device__ __forceinline__ float gelu_tanh_f(float x) {
    const float w = x * __builtin_fmaf(x * x, -0.1029432396f, -2.3022081981f); return x * __builtin_amdgcn_rcpf(1.0f + __builtin_amdgcn_exp2f(w)); }

#define XB_TMO      128
#define XB_XCNT(j)  (256  + 64 * (j))
#define XB_XSUB(j)  (1280 + 64 * (j))
#define XB_XGEN(j)  (2304 + 64 * (j))
#define XB_TOP      3328
#define XB_TOPGEN   3392
#define XCD_BAR_WORDS 3456
#define XB_SPIN_CAP (1u << 21)
__device__ __forceinline__ unsigned xb_ld(unsigned* p)              { return __hip_atomic_load(p, __ATOMIC_RELAXED, __HIP_MEMORY_SCOPE_AGENT); }
__device__ __forceinline__ unsigned xb_add(unsigned* p, unsigned v) { return __hip_atomic_fetch_add(p, v, __ATOMIC_RELAXED, __HIP_MEMORY_SCOPE_AGENT); }
__device__ __forceinline__ unsigned xb_xcc_id() { return (unsigned)__builtin_amdgcn_s_getreg((3 << 11) | 20) & 0xFu; }
#define XB_SPIN(cond, bar) do { unsigned _sp = 0; while (cond) { __builtin_amdgcn_s_sleep(1); \
    if ((++_sp & 255u) == 0u) { if (xb_ld(&(bar)[XB_TMO])) break; if (_sp > XB_SPIN_CAP) { atomicAdd(&(bar)[XB_TMO], 1u); break; } } } } while (0)
struct XcdBarrier { unsigned* bar; unsigned x; volatile LAS unsigned* st; };
__device__ __forceinline__ XcdBarrier xcd_barrier_post(unsigned* bar, volatile LAS unsigned* st, bool t0) {
    XcdBarrier b; b.bar = bar; b.x = xb_xcc_id(); b.st = st;
    if (t0) (void)xb_add(&bar[XB_XCNT(b.x)], 1u);
    return b;
}
__device__ __forceinline__ void xcd_barrier_complete(unsigned* bar, unsigned x, unsigned& nloc, unsigned& nx) {
    const unsigned G = gridDim.x * gridDim.y * gridDim.z;
    unsigned sum, cnt, mine, sp = 0u;
    for (;;) {
        sum = 0u; cnt = 0u; mine = 0u;
#pragma unroll
        for (unsigned j = 0; j < 16; ++j) { const unsigned c = xb_ld(&bar[XB_XCNT(j)]); sum += c; cnt += (c > 0u) ? 1u : 0u; mine = (j == x) ? c : mine; }
        if (sum == G) break;
        __builtin_amdgcn_s_sleep(1);
        if ((++sp & 255u) == 0u) { if (xb_ld(&bar[XB_TMO])) break; if (sp > XB_SPIN_CAP) { atomicAdd(&bar[XB_TMO], 1u); break; } }
    }
    nloc = mine > 0u ? mine : 1u; nx = cnt > 0u ? cnt : 1u;
}
__device__ __forceinline__ void xcd_barrier(const XcdBarrier& b, bool t0) {
    asm volatile("s_waitcnt vmcnt(0)" ::: "memory");
    __syncthreads();
    if (t0) {
        unsigned* bar = b.bar;
        __builtin_amdgcn_s_waitcnt(0);
        unsigned nloc = b.st[0], nx = b.st[1];
        if (nloc == 0u) { xcd_barrier_complete(bar, b.x, nloc, nx); b.st[0] = nloc; b.st[1] = nx; }
        const unsigned old = xb_add(&bar[XB_XSUB(b.x)], 1u);
        const unsigned gen = old / nloc;
        if (old + 1u == (gen + 1u) * nloc) {
            __builtin_amdgcn_fence(__ATOMIC_RELEASE, "agent");
            asm volatile("s_waitcnt vmcnt(0)" ::: "memory");
            const unsigned og = xb_add(&bar[XB_TOP], 1u);
            const unsigned tg = og / nx;
            if (og + 1u == (tg + 1u) * nx) xb_add(&bar[XB_TOPGEN], 1u);
            else XB_SPIN(xb_ld(&bar[XB_TOPGEN]) == tg, bar);
            __builtin_amdgcn_fence(__ATOMIC_ACQUIRE, "agent");
            xb_add(&bar[XB_XGEN(b.x)], 1u);
            asm volatile("s_waitcnt vmcnt(0)" ::: "memory");
        } else {
            XB_SPIN(xb_ld(&bar[XB_XGEN(b.x)]) == gen, bar);
            __builtin_amdgcn_fence(__ATOMIC_ACQUIRE, "agent");
            asm volatile("s_waitcnt vmcnt(0)" ::: "memory");
        }
    }
    __syncthreads();
}

namespace pg8 {
constexpr int BM = 256, BK = 64, HALF = 128, HTB = HALF * BK * 2, STAGE_BYTES = 8 * HTB, NXCD = 8, WGM = 8;
__host__ __device__ __forceinline__ int lds_byte(int r, int c) { const int st = (r >> 4) * 2 + (c >> 5), rr = r & 15, cc = c & 31, ob = rr * 64 + cc * 2; return st * 1024 + (ob ^ (((ob >> 9) & 1) << 5)); }
__host__ __device__ __forceinline__ void stage_rc(int b, int& R, int& C) { const int st = b / 1024, sb = b % 1024, swz = sb ^ (((sb >> 9) & 1) << 5); R = (st >> 1) * 16 + swz / 64; C = (st & 1) * 32 + (swz % 64) / 2; }
__host__ __device__ __forceinline__ int perm32(int rho) { const int n = rho >> 4, i = rho & 15; return 8 * (i >> 2) + 4 * n + (i & 3); }

struct Unit { int pm, pn, e, lbase, nvalid; };
struct Gemm { const bf16* A; const bf16* Bt; int M, N, K; };

struct StaticOrder {
    static constexpr bool GATHER = false;
    int nM, nN, nwg, G, c;
    __device__ void init(int M_, int N_, int G_, int c_) { nM = M_ / BM; nN = N_ / BM; nwg = nM * nN; G = G_; c = c_; }
    __device__ bool next(int i, Unit& u) const {
        const long L = (long)i * G + c; if (L >= nwg) return false;
        int wgid = (int)L; { const int q = nwg / NXCD, r = nwg % NXCD, xcd = wgid % NXCD, off = wgid / NXCD; wgid = (xcd < r ? xcd * (q + 1) : r * (q + 1) + (xcd - r) * q) + off; }
        const int nig = WGM * nN, gid = wgid / nig, fm = gid * WGM, gsz = (nM - fm) < WGM ? (nM - fm) : WGM;
        u.pm = fm + ((wgid % nig) % gsz); u.pn = (wgid % nig) / gsz; u.e = 0; u.lbase = 0; u.nvalid = 256; return true;
    }
    __device__ __forceinline__ int arow(const Unit& u, int r) const { return u.pm * BM + r; }
};
template <bool GATHER_> struct MoeOrder {
    static constexpr bool GATHER = GATHER_;
    const LAS int* tp; const LAS int* cnt; const int2* list; int NT, nwg, G, c; const LAS int* ord;
    __device__ bool next(int i, Unit& u) const {
        const long L = (long)i * G + c; if (L >= nwg) return false;
        int w = (int)L; { const int q = nwg / NXCD, r = nwg % NXCD, xcd = w % NXCD, off = w / NXCD; w = (xcd < r ? xcd * (q + 1) : r * (q + 1) + (xcd - r) * q) + off; }
        const int po = w / NT, pnl = w - po * NT, pmg = ord[po];
        typedef int i32x4 __attribute__((ext_vector_type(4)));
        const i32x4 t0 = *(const LAS i32x4*)tp, t1 = *(const LAS i32x4*)(tp + 4), t2 = *(const LAS i32x4*)(tp + 8), t3 = *(const LAS i32x4*)(tp + 12);
        const int e = (pmg >= t0.y) + (pmg >= t0.z) + (pmg >= t0.w) + (pmg >= t1.x) + (pmg >= t1.y) + (pmg >= t1.z) + (pmg >= t1.w)
                    + (pmg >= t2.x) + (pmg >= t2.y) + (pmg >= t2.z) + (pmg >= t2.w) + (pmg >= t3.x) + (pmg >= t3.y) + (pmg >= t3.z) + (pmg >= t3.w);
        static_assert(NE == 16, "MoeOrder::next reads tp[0..15]");
        const int tile = pmg - tp[e];
        u.pm = pmg; u.pn = e * NT + pnl; u.e = e; u.lbase = e * CAP + tile * 256; const int nv = cnt[e] - tile * 256; u.nvalid = nv < 256 ? nv : 256; return true;
    }
    __device__ __forceinline__ int arow(const Unit& u, int r) const { if (!GATHER_) return u.pm * BM + r; return r < u.nvalid ? (list[u.lbase + r].x >> 1) : 0; }
};

template <class Epi, class Sched>
__device__ __forceinline__ void gemm_simple(int wid, int lane, const Gemm g, const Sched& S, const Epi& E) {
    const int wr = wid >> 2, wc = wid & 3, fr = lane & 15, fq = lane >> 4;
    const int K = g.K;
    for (int ui = 0;; ++ui) {
        Unit u; if (!S.next(ui, u)) break;
        f32x4 acc[2][2][4][2];
#pragma unroll
        for (int a = 0; a < 2; ++a)
#pragma unroll
            for (int b = 0; b < 2; ++b)
#pragma unroll
                for (int m = 0; m < 4; ++m)
#pragma unroll
                    for (int n = 0; n < 2; ++n) acc[a][b][m][n] = (f32x4){0.f, 0.f, 0.f, 0.f};
        unsigned ap[2][4], bp[2][2];
#pragma unroll
        for (int a = 0; a < 2; ++a)
#pragma unroll
            for (int m = 0; m < 4; ++m) ap[a][m] = (unsigned)S.arow(u, a * HALF + wr * 64 + m * 16 + fr) * (unsigned)K + fq * 8;
#pragma unroll
        for (int b = 0; b < 2; ++b)
#pragma unroll
            for (int n = 0; n < 2; ++n) { const int rho = 16 * n + fr; bp[b][n] = (unsigned)(u.pn * BM + b * HALF + wc * 32 + (Epi::PERM ? perm32(rho) : rho)) * (unsigned)K + fq * 8; }
#pragma unroll 1
        for (int k = 0; k < K; k += 32) {
            bf16x8 Af[2][4], Bf[2][2];
#pragma unroll
            for (int a = 0; a < 2; ++a)
#pragma unroll
                for (int m = 0; m < 4; ++m) Af[a][m] = *(const bf16x8*)(g.A + ap[a][m] + k);
#pragma unroll
            for (int b = 0; b < 2; ++b)
#pragma unroll
                for (int n = 0; n < 2; ++n) Bf[b][n] = *(const bf16x8*)(g.Bt + bp[b][n] + k);
#pragma unroll
            for (int a = 0; a < 2; ++a)
#pragma unroll
                for (int b = 0; b < 2; ++b)
#pragma unroll
                    for (int m = 0; m < 4; ++m)
#pragma unroll
                        for (int n = 0; n < 2; ++n) acc[a][b][m][n] = __builtin_amdgcn_mfma_f32_16x16x32_bf16(Bf[b][n], Af[a][m], acc[a][b][m][n], 0, 0, 0);
        }
        E(acc, u, wr, wc, fr, fq);
    }
}

typedef int v8i32 __attribute__((ext_vector_type(8)));
typedef int v4i32 __attribute__((ext_vector_type(4)));
template <class Epi, class Sched, bool F8 = false>
__device__ __forceinline__ void gemm_phase(int wid, int lane, LAS unsigned char* lds, const Gemm g, const Sched& S, const Epi& E) {
    const int tid = wid * 64 + lane, wr = wid >> 2, wc = wid & 3, fr = lane & 15, fq = lane >> 4;
    const int K = F8 ? g.K / 2 : g.K  , nt = K / BK;
    unsigned voffA[2], voffB[2]; int Rr[2], Cc[2];
#pragma unroll
    for (int i = 0; i < 2; ++i) { int R, C; stage_rc(tid * 16 + i * 8192, R, C); const int Rb = Epi::PERM ? ((R & ~31) + perm32(R & 31)) : R;
        voffA[i] = (unsigned)(R * K + C) * 2u; voffB[i] = (unsigned)(Rb * K + C) * 2u; Rr[i] = R; Cc[i] = C; }
    const unsigned kstep = (unsigned)(BK * 2);
    const unsigned hstep = (unsigned)HALF * (unsigned)K * 2u;
    const unsigned tstep = 2 * hstep;
    const __amdgpu_buffer_rsrc_t rsA = make_rsrc(g.A, 0x7fffffff), rsB = make_rsrc(g.Bt, 0x7fffffff);
    const unsigned ldsw = (unsigned)wid * 1024u;
    const int aoff0 = lds_byte(wr * 64 + fr, F8 ? fq * 16 : fq * 8), aoff1 = F8 ? lds_byte(wr * 64 + fr, fq * 16 + 8) : aoff0 + 1024;
    const int boff0 = lds_byte(wc * 32 + fr, F8 ? fq * 16 : fq * 8), boff1 = F8 ? lds_byte(wc * 32 + fr, fq * 16 + 8) : boff0 + 1024;
#define PG8_SA(b, h) (((b) * 2 + (h)) * HTB)
#define PG8_SB(b, h) ((4 + (b) * 2 + (h)) * HTB)
#define PG8_STAGE(bufoff, soff, voff) do { _Pragma("unroll") for (int _i = 0; _i < 2; ++_i) \
        __builtin_amdgcn_raw_ptr_buffer_load_lds(rsB, (LAS void*)(lds + (bufoff) + ldsw + _i * 8192), 16, (int)(voff)[_i], (int)(soff), 0, 0); } while (0)
#define PG8_STAGE_A(bufoff, h, contig_off, kt_bytes, use_next) do { _Pragma("unroll") for (int _i = 0; _i < 2; ++_i) { \
        const unsigned vo_ = Sched::GATHER ? ((use_next) ? gN[h][_i] : gC[h][_i]) : voffA[_i]; const unsigned so_ = Sched::GATHER ? (unsigned)(kt_bytes) : (unsigned)(contig_off); \
        __builtin_amdgcn_raw_ptr_buffer_load_lds(rsA, (LAS void*)(lds + (bufoff) + ldsw + _i * 8192), 16, (int)vo_, (int)so_, 0, 0); } } while (0)
#define PG8_GOFF(u_, o_) do { _Pragma("unroll") for (int _h = 0; _h < 2; ++_h) _Pragma("unroll") for (int _i = 0; _i < 2; ++_i) \
        o_[_h][_i] = ((unsigned)S.arow(u_, _h * HALF + Rr[_i]) * (unsigned)K + (unsigned)Cc[_i]) * 2u; } while (0)
#define PG8_LDA(dst, b, h) do { _Pragma("unroll") for (int m = 0; m < 4; ++m) { dst[m][0] = *(const LAS bf16x8*)(lds + PG8_SA(b, h) + aoff0 + m * 2048); dst[m][1] = *(const LAS bf16x8*)(lds + PG8_SA(b, h) + aoff1 + m * 2048); } } while (0)
#define PG8_LDB(dst, b, h) do { _Pragma("unroll") for (int n = 0; n < 2; ++n) { dst[n][0] = *(const LAS bf16x8*)(lds + PG8_SB(b, h) + boff0 + n * 2048); dst[n][1] = *(const LAS bf16x8*)(lds + PG8_SB(b, h) + boff1 + n * 2048); } } while (0)
#define PG8_V8(x_) __builtin_shufflevector(__builtin_bit_cast(v4i32, (x_)[0]), __builtin_bit_cast(v4i32, (x_)[1]), 0, 1, 2, 3, 4, 5, 6, 7)
#define PG8_MMA(ai, bj, At, Bt) do { __builtin_amdgcn_s_setprio(1); _Pragma("unroll") for (int m = 0; m < 4; ++m) _Pragma("unroll") for (int n = 0; n < 2; ++n) { \
        if constexpr (F8) { const v8i32 b8_ = PG8_V8(Bt[n]), a8_ = PG8_V8(At[m]);   \
            asm volatile("v_mfma_scale_f32_16x16x128_f8f6f4 %0, %1, %2, %0, %3, %4 op_sel_hi:[0,0,0]" : "+v"(acc[ai][bj][m][n]) : "v"(b8_), "v"(a8_), "v"(sc_w), "v"(sc_a)); } \
        else { _Pragma("unroll") for (int k = 0; k < 2; ++k) acc[ai][bj][m][n] = __builtin_amdgcn_mfma_f32_16x16x32_bf16(Bt[n][k], At[m][k], acc[ai][bj][m][n], 0, 0, 0); } } \
        __builtin_amdgcn_s_setprio(0); } while (0)
#define PG8_MMA0(ai, bj, At, Bt) do { __builtin_amdgcn_s_setprio(1); _Pragma("unroll") for (int m = 0; m < 4; ++m) _Pragma("unroll") for (int n = 0; n < 2; ++n) { \
        const v8i32 b8_ = PG8_V8(Bt[n]), a8_ = PG8_V8(At[m]); \
        asm volatile("v_mfma_scale_f32_16x16x128_f8f6f4 %0, %1, %2, 0, %3, %4 op_sel_hi:[0,0,0]" : "=v"(acc[ai][bj][m][n]) : "v"(b8_), "v"(a8_), "v"(sc_w), "v"(sc_a)); } \
        __builtin_amdgcn_s_setprio(0); } while (0)
#define PG8_MMAF(ai, At) do { if (F8 && first) { PG8_MMA0(ai, 0, At, B0); PG8_MMA0(ai, 1, At, B1); } else { PG8_MMA(ai, 0, At, B0); PG8_MMA(ai, 1, At, B1); } } while (0)
#define PG8_WAIT_V(n) asm volatile("s_waitcnt vmcnt(" #n ")" ::: "memory")
#define PG8_WAIT_L(n) asm volatile("s_waitcnt lgkmcnt(" #n ")" ::: "memory")
#define PG8_BAR __builtin_amdgcn_s_barrier()
#define PG8_SCHED __builtin_amdgcn_sched_barrier(0)
    const int sc_w = 0x7a7a7a7a  , sc_a = 0x7f7f7f7f  ; (void)sc_w; (void)sc_a;
    Unit cur, nxt; int ui = 0; int relaxN = 0;
    if (!S.next(0, cur)) return;
    unsigned gC[2][2], gN[2][2];
    if constexpr (Sched::GATHER) { PG8_GOFF(cur, gC); }
    else {
#pragma unroll
        for (int h = 0; h < 2; ++h)
#pragma unroll
            for (int i = 0; i < 2; ++i) { gC[h][i] = 0u; gN[h][i] = 0u; } }
    f32x4 acc[2][2][4][2];
#pragma unroll
    for (int a = 0; a < 2; ++a)
#pragma unroll
        for (int b = 0; b < 2; ++b)
#pragma unroll
            for (int m = 0; m < 4; ++m)
#pragma unroll
                for (int n = 0; n < 2; ++n) acc[a][b][m][n] = (f32x4){0.f, 0.f, 0.f, 0.f};
    bf16x8 At[4][2], B0[2][2], B1[2][2];
    unsigned cA = Sched::GATHER ? 0u : (unsigned)cur.pm * tstep, cB = (unsigned)cur.pn * tstep;
    PG8_STAGE(PG8_SB(0, 0), cB, voffB); PG8_STAGE(PG8_SB(0, 1), cB + hstep, voffB); PG8_STAGE_A(PG8_SA(0, 0), 0, cA, 0, false); PG8_STAGE_A(PG8_SA(0, 1), 1, cA + hstep, 0, false);
    if (wr == 1) PG8_BAR;
    PG8_WAIT_V(2); PG8_BAR;
    PG8_STAGE(PG8_SB(1, 0), cB + kstep, voffB); PG8_STAGE_A(PG8_SA(1, 0), 0, cA + kstep, kstep, false); PG8_STAGE(PG8_SB(1, 1), cB + hstep + kstep, voffB);
    PG8_WAIT_V(6); PG8_BAR;
    for (;;) {
        const bool has_next = S.next(ui + 1, nxt);
        if constexpr (Sched::GATHER) { if (has_next) { PG8_GOFF(nxt, gN); } else {
#pragma unroll
            for (int h = 0; h < 2; ++h)
#pragma unroll
                for (int i = 0; i < 2; ++i) gN[h][i] = gC[h][i]; } }
        const unsigned nA = (has_next && !Sched::GATHER) ? (unsigned)nxt.pm * tstep : cA, nB = has_next ? (unsigned)nxt.pn * tstep : cB;
        for (int t = 0; t < nt; t += 2) {
            const bool last = (t == nt - 2);
            const unsigned a1 = cA + (unsigned)(t + 1) * kstep;
            const unsigned a2 = last ? nA : cA + (unsigned)(t + 2) * kstep, b2 = last ? nB : cB + (unsigned)(t + 2) * kstep;
            const unsigned a3 = a2 + kstep, b3 = b2 + kstep;
            const unsigned k1 = (unsigned)(t + 1) * kstep, k2 = last ? 0u : (unsigned)(t + 2) * kstep, k3 = k2 + kstep;
            const bool first = (t == 0), rlx = first && relaxN > 0, halfu = cur.nvalid <= 128;
#define PG8_WAIT_VR() do { if (rlx) { if (relaxN == 8) PG8_WAIT_V(16); else if (relaxN == 16) PG8_WAIT_V(24); else PG8_WAIT_V(8); } else PG8_WAIT_V(8); } while (0)
            PG8_LDB(B0, 0, 0); PG8_LDB(B1, 0, 1); PG8_SCHED; PG8_LDA(At, 0, 0); if (!(first && ui > 0)) PG8_STAGE_A(PG8_SA(1, 1), 1, a1 + hstep, k1, false);
            PG8_WAIT_VR(); PG8_WAIT_L(0); PG8_BAR; PG8_MMAF(0, At); PG8_BAR; PG8_SCHED;
            PG8_LDA(At, 0, 1); PG8_STAGE(PG8_SB(0, 0), b2, voffB); PG8_STAGE(PG8_SB(0, 1), b2 + hstep, voffB); PG8_STAGE_A(PG8_SA(0, 0), 0, a2, k2, last);
            PG8_WAIT_VR(); PG8_WAIT_L(0); PG8_BAR; if (!halfu) { PG8_MMAF(1, At); } PG8_BAR; PG8_SCHED;
            PG8_LDB(B0, 1, 0); PG8_LDB(B1, 1, 1); PG8_SCHED; PG8_LDA(At, 1, 0); PG8_STAGE_A(PG8_SA(0, 1), 1, a2 + hstep, k2, last);
            PG8_WAIT_VR(); PG8_WAIT_L(0); PG8_BAR; PG8_MMA(0, 0, At, B0); PG8_MMA(0, 1, At, B1); PG8_BAR; PG8_SCHED;
            PG8_LDA(At, 1, 1); PG8_STAGE(PG8_SB(1, 0), b3, voffB); PG8_STAGE(PG8_SB(1, 1), b3 + hstep, voffB); PG8_STAGE_A(PG8_SA(1, 0), 0, a3, k3, last);
            PG8_WAIT_V(8); PG8_WAIT_L(0); PG8_BAR; if (!halfu) { PG8_MMA(1, 0, At, B0); PG8_MMA(1, 1, At, B1); } PG8_BAR; PG8_SCHED;
            if (last && has_next) { PG8_STAGE_A(PG8_SA(1, 1), 1, a3 + hstep, k3, true); PG8_SCHED; }
#undef PG8_WAIT_VR
        }
        if (wr == 0) PG8_BAR;
        if constexpr (F8) asm volatile("s_nop 15\n\ts_nop 15" ::: "memory");
        E(acc, cur, wr, wc, fr, fq);
        relaxN = has_next ? E.stores_lb(cur) : 0;
        if (!has_next) break;
        if constexpr (!F8) {
#pragma unroll
        for (int a = 0; a < 2; ++a)
#pragma unroll
            for (int b = 0; b < 2; ++b)
#pragma unroll
                for (int m = 0; m < 4; ++m)
#pragma unroll
                    for (int n = 0; n < 2; ++n) acc[a][b][m][n] = (f32x4){0.f, 0.f, 0.f, 0.f};
        }
        cur = nxt; cA = nA; cB = nB; ++ui;
#pragma unroll
        for (int h = 0; h < 2; ++h)
#pragma unroll
            for (int i = 0; i < 2; ++i) gC[h][i] = gN[h][i];
        if (wr == 1) PG8_BAR;
    }
    PG8_WAIT_V(0);
    PG8_BAR;
#undef PG8_SA
#undef PG8_SB
#undef PG8_STAGE
#undef PG8_STAGE_A
#undef PG8_GOFF
#undef PG8_LDA
#undef PG8_LDB
#undef PG8_MMA
#undef PG8_MMA0
#undef PG8_MMAF
#undef PG8_V8
#undef PG8_WAIT_V
#undef PG8_WAIT_L
#undef PG8_BAR
#undef PG8_SCHED
}
}
using pg8::Unit; using pg8::Gemm; using pg8::HALF; using pg8::BM;

#if USE_FAST_GEMM
#define GEMM_PHASE(EpiT, SchedT, lds, g, S, E) pg8::gemm_phase<EpiT, SchedT>(F.wave0, fresh_lane(), lds, g, S, E)
#define GEMM_PHASE_F8(EpiT, SchedT, lds, g, S, E) pg8::gemm_phase<EpiT, SchedT, true>(F.wave0, fresh_lane(), lds, g, S, E)
#else
#define GEMM_PHASE(EpiT, SchedT, lds, g, S, E) pg8::gemm_simple<EpiT, SchedT>(F.wave0, fresh_lane(), g, S, E)
#endif

__device__ __forceinline__ void st_bf8(bf16* p, f32x4 a, f32x4 b) { u32x4 w; w.x = pk2(a.x, a.y); w.y = pk2(a.z, a.w); w.z = pk2(b.x, b.y); w.w = pk2(b.z, b.w); *(u32x4*)p = w; }
__device__ __forceinline__ float lane32_partner(float v, bool upper) {
    auto rr = __builtin_amdgcn_permlane32_swap(__float_as_uint(v), __float_as_uint(v), false, false); return __uint_as_float(upper ? rr[0] : rr[1]);
}
struct EpiInProj {
    static constexpr bool PERM = true, AFTER_DRAIN = false;
    bf16* PROJ; bf16* Q; bf16* KB; bf16* VB; const LAS float* tabc; const LAS float* tabs; int pn_off;
    __device__ __forceinline__ int stores_lb(const Unit& u) const { return (u.pn + pn_off) < 8 ? 8 : 16; }
    __device__ __forceinline__ void operator()(const f32x4 (&acc)[2][2][4][2], const Unit& u, int wr, int wc, int fr, int fq) const {
        const int pn = u.pn + pn_off;
        if (pn < 8) {
#pragma unroll
            for (int ai = 0; ai < 2; ++ai)
#pragma unroll
                for (int m = 0; m < 4; ++m) { const int row = u.pm * BM + ai * HALF + wr * 64 + m * 16 + fr;
                    st_bf8(PROJ + (size_t)row * 2048 + pn * 128 + wc * 32 + 8 * fq, acc[ai][0][m][0] * acc[ai][1][m][0], acc[ai][0][m][1] * acc[ai][1][m][1]); }
        } else if (pn < 12) {
#pragma unroll
            for (int ai = 0; ai < 2; ++ai)
#pragma unroll
                for (int m = 0; m < 4; ++m) { const int row = u.pm * BM + ai * HALF + wr * 64 + m * 16 + fr; bf16* rp = PROJ + (size_t)row * 2048 + 1024 + (pn - 8) * 256 + wc * 32 + 8 * fq;
#pragma unroll
                    for (int bj = 0; bj < 2; ++bj) st_bf8(rp + bj * HALF, acc[ai][bj][m][0], acc[ai][bj][m][1]); }
        } else if (pn < 20) {
            const bool isq = pn < 16; const int cb = (pn - (isq ? 12 : 16)) * 256 + wc * 32 + 8 * fq; const size_t kb_minus_q = (size_t)((unsigned char*)KB - (unsigned char*)Q); const int axis = wc & 1; const bool upper = fq >= 2; const int fo = 8 * (fq & 1);
#pragma unroll
            for (int ai = 0; ai < 2; ++ai)
#pragma unroll
                for (int m = 0; m < 4; ++m) { const int row = u.pm * BM + ai * HALF + wr * 64 + m * 16 + fr; const int t = row & (SEQ - 1), b = row >> 13;
                    const int pos = axis ? (t & 63) : (t >> 6);
                    f32x4 cs0 = *(const LAS f32x4*)(tabc + pos * 16 + fo), cs1 = *(const LAS f32x4*)(tabc + pos * 16 + fo + 4); f32x4 sn0 = *(const LAS f32x4*)(tabs + pos * 16 + fo), sn1 = *(const LAS f32x4*)(tabs + pos * 16 + fo + 4);
                    if (!upper) { sn0 = -sn0; sn1 = -sn1; }
                    unsigned char* rp = (unsigned char*)Q + (isq ? ((size_t)row * 1024 + cb) : (kb_minus_q + ((size_t)b * KV + CTXL + t) * 1024 + cb));
                    if (isq) { cs0 = cs0 * QSCALE; cs1 = cs1 * QSCALE; sn0 = sn0 * QSCALE; sn1 = sn1 * QSCALE; }
#pragma unroll
                    for (int bj = 0; bj < 2; ++bj) { const f32x4 a0 = acc[ai][bj][m][0], a1 = acc[ai][bj][m][1];
                        const f32x4 p0 = (f32x4){lane32_partner(a0.x, upper), lane32_partner(a0.y, upper), lane32_partner(a0.z, upper), lane32_partner(a0.w, upper)};
                        const f32x4 p1 = (f32x4){lane32_partner(a1.x, upper), lane32_partner(a1.y, upper), lane32_partner(a1.z, upper), lane32_partner(a1.w, upper)};
                        st_f8x8(rp + bj * HALF, a0 * cs0 + p0 * sn0, a1 * cs1 + p1 * sn1); } }
        } else {
            const int cb = (pn - 20) * 256 + wc * 32 + 8 * fq;
#pragma unroll
            for (int ai = 0; ai < 2; ++ai)
#pragma unroll
                for (int m = 0; m < 4; ++m) { const int row = u.pm * BM + ai * HALF + wr * 64 + m * 16 + fr; const int t = row & (SEQ - 1), b = row >> 13;
                    unsigned char* rp = (unsigned char*)VB + ((size_t)b * KV + CTXL + t) * 1024 + cb;
#pragma unroll
                    for (int bj = 0; bj < 2; ++bj) st_f8x8(rp + bj * HALF, acc[ai][bj][m][0], acc[ai][bj][m][1]); }
        }
    }
};
struct EpiCtx {
    static constexpr bool PERM = true, AFTER_DRAIN = false;
    bf16* KB; bf16* VB;
    __device__ __forceinline__ int stores_lb(const Unit&) const { return 16; }
    __device__ __forceinline__ void operator()(const f32x4 (&acc)[2][2][4][2], const Unit& u, int wr, int wc, int fr, int fq) const {
        const bool isk = u.pn < 4; const int cb = (u.pn & 3) * 256 + wc * 32 + 8 * fq;
#pragma unroll
        for (int ai = 0; ai < 2; ++ai)
#pragma unroll
            for (int m = 0; m < 4; ++m) { const int row = u.pm * BM + ai * HALF + wr * 64 + m * 16 + fr; const int t = row & (CTXL - 1), b = row >> 8;
                const size_t eo = ((size_t)b * KV + t) * 1024 + cb;
#pragma unroll
                for (int bj = 0; bj < 2; ++bj) st_f8x8((unsigned char*)(isk ? KB : VB) + eo + bj * HALF, acc[ai][bj][m][0], acc[ai][bj][m][1]); }
    }
};
template <bool RES_F32> struct EpiRes {
    static constexpr bool PERM = true, AFTER_DRAIN = false;
    const float* xf; const bf16* xb; const float* gate  ; bf16* R;
    __device__ __forceinline__ int stores_lb(const Unit&) const { return 16; }
    struct Raw { f32x4 f[2][2][2]; u32x4 h[2][2]; };
    __device__ __forceinline__ void load(Raw& r, const Unit& u, int st, int wr, int fr, int cb) const {
        const int ai = st >> 1, mp = (st & 1) * 2;
#pragma unroll
        for (int mm = 0; mm < 2; ++mm) { const size_t off = (size_t)(u.pm * BM + ai * HALF + wr * 64 + (mp + mm) * 16 + fr) * D + cb;
#pragma unroll
            for (int bj = 0; bj < 2; ++bj) {
                if (RES_F32) { r.f[mm][bj][0] = *(const f32x4*)(xf + off + bj * HALF); r.f[mm][bj][1] = *(const f32x4*)(xf + off + bj * HALF + 4); }
                else r.h[mm][bj] = *(const u32x4*)(xb + off + bj * HALF); } }
    }
    __device__ __forceinline__ void operator()(const f32x4 (&acc)[2][2][4][2], const Unit& u, int wr, int wc, int fr, int fq) const {
        const int cb = u.pn * BM + wc * 32 + 8 * fq; const int b = (u.pm * BM) >> 13;
        f32x4 gv[2][2];
#pragma unroll
        for (int bj = 0; bj < 2; ++bj)
#pragma unroll
            for (int n = 0; n < 2; ++n) gv[bj][n] = *(const f32x4*)(gate + (size_t)b * (6 * D) + cb + bj * HALF + 4 * n);
        Raw ra, rb2; load(ra, u, 0, wr, fr, cb);
#pragma unroll
        for (int st = 0; st < 4; ++st) {
            Raw& cur = (st & 1) ? rb2 : ra; Raw& nxt = (st & 1) ? ra : rb2;
            if (st < 3) load(nxt, u, st + 1, wr, fr, cb);
            const int ai = st >> 1, mp = (st & 1) * 2;
#pragma unroll
            for (int mm = 0; mm < 2; ++mm) { const size_t off = (size_t)(u.pm * BM + ai * HALF + wr * 64 + (mp + mm) * 16 + fr) * D + cb;
#pragma unroll
                for (int bj = 0; bj < 2; ++bj) { f32x4 r0, r1;
                    if (RES_F32) { r0 = cur.f[mm][bj][0]; r1 = cur.f[mm][bj][1]; }
                    else { const u32x4 w = cur.h[mm][bj]; r0 = (f32x4){bf_lo(w.x), bf_hi(w.x), bf_lo(w.y), bf_hi(w.y)}; r1 = (f32x4){bf_lo(w.z), bf_hi(w.z), bf_lo(w.w), bf_hi(w.w)}; }
                    st_bf8(R + off + bj * HALF, r0 * ALPHA + gv[bj][0] * acc[ai][bj][mp + mm][0], r1 * ALPHA + gv[bj][1] * acc[ai][bj][mp + mm][1]); } }
        }
    }
};
struct EpiGU {
    static constexpr bool PERM = true, AFTER_DRAIN = false;
    unsigned char* HID;
    __device__ __forceinline__ int stores_lb(const Unit&) const { return 8; }
    __device__ __forceinline__ void operator()(const f32x4 (&acc)[2][2][4][2], const Unit& u, int wr, int wc, int fr, int fq) const {
        const int cb = (u.pn & 3) * 128 + wc * 32 + 8 * fq;
#pragma unroll
        for (int ai = 0; ai < 2; ++ai)
#pragma unroll
            for (int m = 0; m < 4; ++m) { const int row = u.pm * BM + ai * HALF + wr * 64 + m * 16 + fr;
                const f32x4 g0 = acc[ai][0][m][0], g1 = acc[ai][0][m][1], u0 = acc[ai][1][m][0], u1 = acc[ai][1][m][1]; u32x2 w;
                w.x = pk4_fp8(silu_f(g0.x) * u0.x, silu_f(g0.y) * u0.y, silu_f(g0.z) * u0.z, silu_f(g0.w) * u0.w); w.y = pk4_fp8(silu_f(g1.x) * u1.x, silu_f(g1.y) * u1.y, silu_f(g1.z) * u1.z, silu_f(g1.w) * u1.w);
                *(u32x2*)(HID + (size_t)row * ED + cb) = w; }
    }
};
struct EpiDown {
    static constexpr bool PERM = true, AFTER_DRAIN = false;
    const int2* list; bf16* YB;
    __device__ __forceinline__ int stores_lb(const Unit& u) const { return u.nvalid == 256 ? 16 : 0; }
    __device__ __forceinline__ void operator()(const f32x4 (&acc)[2][2][4][2], const Unit& u, int wr, int wc, int fr, int fq) const {
        const int cb = (u.pn & 7) * 256 + wc * 32 + 8 * fq;
        int2 le[2][4];
#pragma unroll
        for (int ai = 0; ai < 2; ++ai)
#pragma unroll
            for (int m = 0; m < 4; ++m) { const int rl = ai * HALF + wr * 64 + m * 16 + fr; le[ai][m] = list[u.lbase + (rl < u.nvalid ? rl : 0)]; }
#pragma unroll
        for (int ai = 0; ai < 2; ++ai)
#pragma unroll
            for (int m = 0; m < 4; ++m) { const int rl = ai * HALF + wr * 64 + m * 16 + fr;
                if (rl < u.nvalid) { const float w = __int_as_float(le[ai][m].y); bf16* rp = YB + (size_t)le[ai][m].x * D + cb;
#pragma unroll
                    for (int bj = 0; bj < 2; ++bj) st_bf8(rp + bj * HALF, acc[ai][bj][m][0] * w, acc[ai][bj][m][1] * w); } }
    }
};
struct EpiGelu {
    static constexpr bool PERM = true, AFTER_DRAIN = false;
    bf16* UV; float* vst;
    __device__ __forceinline__ int stores_lb(const Unit&) const { return 16; }
    __device__ __forceinline__ void operator()(const f32x4 (&acc)[2][2][4][2], const Unit& u, int wr, int wc, int fr, int fq) const {
        const int cb = u.pn * BM + wc * 32 + 8 * fq; const bool isv = u.pn >= 8;
#pragma unroll
        for (int ai = 0; ai < 2; ++ai)
#pragma unroll
            for (int m = 0; m < 4; ++m) { const int row = u.pm * BM + ai * HALF + wr * 64 + m * 16 + fr; bf16* rp = UV + (size_t)row * 4096 + cb; float s = 0.f, s2 = 0.f;
#pragma unroll
                for (int bj = 0; bj < 2; ++bj) { f32x4 v[2];
#pragma unroll
                    for (int n = 0; n < 2; ++n) { const f32x4 a = acc[ai][bj][m][n]; v[n] = (f32x4){gelu_tanh_f(a.x), gelu_tanh_f(a.y), gelu_tanh_f(a.z), gelu_tanh_f(a.w)};
                        s += (v[n].x + v[n].y) + (v[n].z + v[n].w); s2 += (v[n].x * v[n].x + v[n].y * v[n].y) + (v[n].z * v[n].z + v[n].w * v[n].w); }
                    st_bf8(rp + bj * HALF, v[0], v[1]); }
                if (isv) { s += __shfl_xor(s, 16); s += __shfl_xor(s, 32); s2 += __shfl_xor(s2, 16); s2 += __shfl_xor(s2, 32);
                    if (fq == 0) *(f32x2*)(vst + (((size_t)row * 8 + (u.pn - 8)) * 4 + wc) * 2) = (f32x2){s, s2}; } }
    }
};

__device__ __forceinline__ int fresh_lane() { int l; asm volatile("v_mbcnt_lo_u32_b32 %0, -1, 0\n\tv_mbcnt_hi_u32_b32 %0, -1, %0" : "=v"(l)); return l; }
#define fresh_tid() (F.wave0 * 64 + fresh_lane())
#define PH_IDS const int lane = fresh_lane(), wave = F.wave0, tid = wave * 64 + lane; (void)tid; (void)lane; (void)wave
struct Frame {
    LAS unsigned char* lds; volatile LAS unsigned* MISC; unsigned* ctl;
    int vcu, G, wave0;
    const float* in[27]; float* out; unsigned char* ws;
};
#define WSP(T, off) ((T*)(F.ws + (off)))
#define MODP(l, r, i) (WSP(float, WS_MOD) + (((l) * 5 + (r)) * 6 + (i)) * D)

__device__ __forceinline__ void tr_item(const float* W, int N, bf16* WT, int Kd, int item, int mode, LAS float* scr, int lane) {
    const int nblk = N / 32, kb = item / nblk, nb = item - kb * nblk, k0 = 64 * kb, n0 = 32 * nb;
    int d0 = mode ? (((n0 >> 7) << 8) + (n0 & 127) + (mode == 2 ? 128 : 0)) : n0;
    if (mode == 3) { const int c = n0 & 1023; d0 = n0 >= 3072 ? n0 : n0 < 1024 ? (((c >> 7) << 8) + (c & 127)) : n0 < 2048 ? 2048 + c : (((c >> 7) << 8) + 128 + (c & 127)); }
#pragma unroll 8
    for (int i = 0; i < 32; ++i) { const int kk = 2 * i + (lane >> 5); scr[kk * 33 + (lane & 31)] = W[(size_t)(k0 + kk) * N + n0 + (lane & 31)]; }
    LDS_WAIT(); asm volatile("" ::: "memory");
    const int c = lane & 7;
#pragma unroll
    for (int j = 0; j < 4; ++j) { const int n = (lane >> 3) + 8 * j; const LAS float* s = scr + (8 * c) * 33 + n;
        u32x4 o; o.x = pk2(s[0 * 33], s[1 * 33]); o.y = pk2(s[2 * 33], s[3 * 33]); o.z = pk2(s[4 * 33], s[5 * 33]); o.w = pk2(s[6 * 33], s[7 * 33]);
        *(u32x4*)(WT + (size_t)(d0 + n) * Kd + k0 + 8 * c) = o; }
    LDS_WAIT(); asm volatile("" ::: "memory");
}
constexpr int CW_I_EXP = 512, CW_I_GU = 16 * CW_I_EXP, CW_I_SQ = 32 * 64;
struct TrDesc { const float* src; bf16* dst; int N, Kd; bool f8; };
template <int L> __device__ __forceinline__ TrDesc tr_desc(Frame& F, int it) {
    constexpr int I_IN = L == 0 ? 32 * 192 : 32 * 128;
    const float* W; bf16* WT; int N, Kd, mode, q; int r = it;
    bool f8 = false;
    if (r < CW_I_GU) { const int le = L * 16 + (r >> 9); q = r & 511; W = F.in[24] + (size_t)le * D * ED; N = ED; WT = (bf16*)(WSP(unsigned char, WS_WGU) + (size_t)le * 1024 * D); Kd = D; mode = 1; f8 = true; }
    else if (r < 2 * CW_I_GU) { r -= CW_I_GU; const int le = L * 16 + (r >> 9); q = r & 511; W = F.in[25] + (size_t)le * D * ED; N = ED; WT = (bf16*)(WSP(unsigned char, WS_WGU) + (size_t)le * 1024 * D); Kd = D; mode = 2; f8 = true; }
    else if (r < 2 * CW_I_GU + I_IN) { q = r - 2 * CW_I_GU; W = L == 0 ? F.in[8] : F.in[16]; N = L == 0 ? 6144 : 4096; WT = L == 0 ? WSP(bf16, WS_WINE) : WSP(bf16, WS_WINO); Kd = D; mode = L == 0 ? 3 : 0; f8 = L == 1; }
    else if (r < 2 * CW_I_GU + I_IN + CW_I_SQ) { q = r - 2 * CW_I_GU - I_IN; W = L == 0 ? F.in[15] : F.in[21]; N = D; WT = L == 0 ? WSP(bf16, WS_WOUTE) : WSP(bf16, WS_WOUTO); Kd = D; mode = 0; f8 = true; }
    else { r -= 2 * CW_I_GU + I_IN + CW_I_SQ; const int le = L * 16 + (r >> 9); q = r & 511; W = F.in[26] + (size_t)le * ED * D; N = D; WT = (bf16*)(WSP(unsigned char, WS_WDN) + (size_t)le * D * ED); Kd = ED; mode = 0; f8 = true; }
    const int nblk = N / 32, kb = q / nblk, nb = q - kb * nblk, k0 = 64 * kb, n0 = 32 * nb;
    int d0 = mode ? (((n0 >> 7) << 8) + (n0 & 127) + (mode == 2 ? 128 : 0)) : n0;
    if (mode == 3) { const int c = n0 & 1023; d0 = n0 >= 3072 ? n0 : n0 < 1024 ? (((c >> 7) << 8) + (c & 127)) : n0 < 2048 ? 2048 + c : (((c >> 7) << 8) + 128 + (c & 127)); }
    if (mode == 3) f8 = true;
    TrDesc d; d.src = W + (size_t)k0 * N + n0; d.dst = f8 ? (bf16*)((unsigned char*)WT + (size_t)d0 * Kd + k0) : WT + (size_t)d0 * Kd + k0; d.N = N; d.Kd = Kd; d.f8 = f8; return d;
}
template <int L> __device__ __forceinline__ void convert_weights(Frame& F, int gw, int NGW, int wave, int lane, int lo, int hi) {
    LAS float* scr = (LAS float*)(F.lds + wave * 16384);
    int it = lo + gw; if (it >= hi) return;
    float rg[32]; TrDesc cur = tr_desc<L>(F, it);
#pragma unroll
    for (int i = 0; i < 32; ++i) rg[i] = cur.src[(size_t)(2 * i + (lane >> 5)) * cur.N + (lane & 31)];
    for (;;) {
#pragma unroll
        for (int i = 0; i < 32; ++i) scr[(2 * i + (lane >> 5)) * 33 + (lane & 31)] = rg[i];
        LDS_WAIT(); asm volatile("" ::: "memory");
        const int nit = it + NGW; const bool more = nit < hi; TrDesc nx = cur;
        if (more) { nx = tr_desc<L>(F, nit);
#pragma unroll
            for (int i = 0; i < 32; ++i) rg[i] = nx.src[(size_t)(2 * i + (lane >> 5)) * nx.N + (lane & 31)]; }
        if (cur.f8) {
            const int c = lane & 3;
#pragma unroll
            for (int j = 0; j < 2; ++j) { const int n = (lane >> 2) + 16 * j; const LAS float* sp = scr + (16 * c) * 33 + n; u32x4 o;
                o.x = pk4_fp8(sp[0 * 33] * W8_SCALE, sp[1 * 33] * W8_SCALE, sp[2 * 33] * W8_SCALE, sp[3 * 33] * W8_SCALE); o.y = pk4_fp8(sp[4 * 33] * W8_SCALE, sp[5 * 33] * W8_SCALE, sp[6 * 33] * W8_SCALE, sp[7 * 33] * W8_SCALE);
                o.z = pk4_fp8(sp[8 * 33] * W8_SCALE, sp[9 * 33] * W8_SCALE, sp[10 * 33] * W8_SCALE, sp[11 * 33] * W8_SCALE); o.w = pk4_fp8(sp[12 * 33] * W8_SCALE, sp[13 * 33] * W8_SCALE, sp[14 * 33] * W8_SCALE, sp[15 * 33] * W8_SCALE);
                *(u32x4*)((unsigned char*)cur.dst + (size_t)n * cur.Kd + 16 * c) = o; }
        } else {
        const int c = lane & 7;
#pragma unroll
        for (int j = 0; j < 4; ++j) { const int n = (lane >> 3) + 8 * j; const LAS float* sp = scr + (8 * c) * 33 + n;
            u32x4 o; o.x = pk2(sp[0 * 33], sp[1 * 33]); o.y = pk2(sp[2 * 33], sp[3 * 33]); o.z = pk2(sp[4 * 33], sp[5 * 33]); o.w = pk2(sp[6 * 33], sp[7 * 33]);
            *(u32x4*)(cur.dst + (size_t)n * cur.Kd + 8 * c) = o; }
        }
        LDS_WAIT(); asm volatile("" ::: "memory");
        if (!more) break;
        it = nit; cur = nx;
    }
}
constexpr int CW_N0 = 3 * CW_I_GU + 32 * 192 + CW_I_SQ, CW_N1 = 3 * CW_I_GU + 32 * 128 + CW_I_SQ, CW_SPLIT1 = 2 * CW_I_GU;
__device__ __forceinline__ void p0_prologue(Frame& F) {
    PH_IDS;
    {
        LAS float* sl = (LAS float*)F.lds;
        LAS float* part = (LAS float*)(F.lds + 40960);
        for (int i = tid; i < 5 * D; i += 512) { const int r = i >> 11, k = i & (D - 1); const float v = r < 4 ? F.in[1][r * D + k] : F.in[3][k]; sl[i] = silu_f(v); }
        __syncthreads();
        const int kg = tid >> 3, cg = tid & 7;
        for (int it = F.vcu; it < 768; it += F.G) {
            const int l = it / 384, c0 = (it - l * 384) * 32;
            const float* wm = F.in[4] + (size_t)l * D * 12288 + c0 + 4 * cg;
            f32x4 a0 = {0, 0, 0, 0}, a1 = a0, a2 = a0, a3 = a0, a4 = a0;
#pragma unroll 8
            for (int i = 0; i < 32; ++i) { const int k = kg + 64 * i; const f32x4 w = *(const f32x4*)(wm + (size_t)k * 12288);
                a0 += w * sl[k]; a1 += w * sl[D + k]; a2 += w * sl[2 * D + k]; a3 += w * sl[3 * D + k]; a4 += w * sl[4 * D + k]; }
            LAS float* pp = part + kg * 160 + 4 * cg;
            *(LAS f32x4*)(pp) = a0; *(LAS f32x4*)(pp + 32) = a1; *(LAS f32x4*)(pp + 64) = a2; *(LAS f32x4*)(pp + 96) = a3; *(LAS f32x4*)(pp + 128) = a4;
            __syncthreads();
            if (tid < 160) { float s = 0.f;
#pragma unroll 8
                for (int g = 0; g < 64; ++g) s += part[g * 160 + tid];
                const int r = tid >> 5, cc = tid & 31;
                WSP(float, WS_MOD)[(size_t)(l * 5 + r) * 12288 + c0 + cc] = s + F.in[5][l * 12288 + c0 + cc]; }
            __syncthreads();
        }
    }
    {
        const int gid = F.vcu * 512 + tid;
        if (gid < 2048) { const int pos = gid >> 4, f = gid & 15;
            const float inv = exp2f(-(float)f * (13.287712379549449f / 16.0f)); const float ang = (float)pos * inv;
            const float k = rintf(ang * 0.15915494309189535f); float r = fmaf(-k, 6.2831854820251465f, ang); r = fmaf(-k, -1.7484555e-7f, r);
            WSP(float, WS_TAB)[gid] = __cosf(r); WSP(float, WS_TAB)[2048 + gid] = __sinf(r); }
        for (int i = gid; i < 16 * 128 * 128; i += F.G * 512) WSP(bf16, WS_WSB)[i] = (bf16)f2bf(F.in[19][i]);
    }
    convert_weights<0>(F, F.vcu * NWAVES + wave, F.G * NWAVES, wave, lane, 0, CW_N0);
}
__device__ __forceinline__ void p1_modulate(Frame& F) {
    PH_IDS;
    LAS float* P_s = (LAS float*)F.lds; LAS float* P_h = P_s + D;
    for (int rw = F.vcu * NWAVES + wave; rw < 128; rw += F.G * NWAVES) { const int Lr = rw >> 6, br = (rw >> 4) & 3, e = rw & 15; const float* sh = MODP(Lr, br, 3); const float* sc = MODP(Lr, br, 4);
        bf16* wh = WSP(bf16, WS_WRT2) + (size_t)((Lr * 4 + br) * 32 + e) * D; bf16* wl = wh + 16 * D; float cs = 0.f;
        for (int k = lane; k < D; k += 64) { const float w0 = F.in[22][k * 16 + e]; const float w = w0 * (1.0f + sc[k]); cs += sh[k] * w0; const unsigned hb = f2bf(w); wh[k] = (bf16)hb; wl[k] = (bf16)f2bf(w - __uint_as_float(hb << 16)); }
#pragma unroll
        for (int o = 1; o < 64; o <<= 1) cs += __shfl_xor(cs, o);
        if (lane == 0) WSP(float, WS_RC)[(Lr * 4 + br) * 16 + e] = cs; }
    for (int blk = F.vcu; blk < M / 128; blk += F.G) {
        const int rowb = blk * 128 + wave * 16, b = rowb >> 13;
        __syncthreads();
        for (int i = tid; i < D; i += 512) { P_s[i] = 1.0f + MODP(0, b, 1)[i]; P_h[i] = MODP(0, b, 0)[i]; }
        __syncthreads();
        f32x4 rx[8];
#define P1_LOAD(r_) do { _Pragma("unroll") for (int j = 0; j < 4; ++j) { const float* p_ = F.in[0] + (size_t)(r_) * D + 512 * j + 8 * lane; rx[2 * j] = *(const f32x4*)p_; rx[2 * j + 1] = *(const f32x4*)(p_ + 4); } } while (0)
        P1_LOAD(rowb);
#pragma unroll 1
        for (int rr = 0; rr < 16; ++rr) {
            const int row = rowb + rr; u32x2 w8[4];
#pragma unroll
            for (int j = 0; j < 4; ++j) { const int c = 512 * j + 8 * lane;
                const f32x4 sa = *(const LAS f32x4*)(P_s + c), sb = *(const LAS f32x4*)(P_s + c + 4), ha = *(const LAS f32x4*)(P_h + c), hb = *(const LAS f32x4*)(P_h + c + 4);
                const f32x4 y0 = rx[2 * j] * sa + ha, y1 = rx[2 * j + 1] * sb + hb;
                w8[j].x = pk4_fp8(y0.x, y0.y, y0.z, y0.w); w8[j].y = pk4_fp8(y1.x, y1.y, y1.z, y1.w); }
            if (rr < 15) P1_LOAD(row + 1);
#pragma unroll
            for (int j = 0; j < 4; ++j) *(u32x2*)((unsigned char*)F.out + (size_t)M * D * 2 + (size_t)row * D + 512 * j + 8 * lane) = w8[j];
        }
#undef P1_LOAD
    }
    { const int gw = F.vcu * NWAVES + wave, NGW = F.G * NWAVES; const float* sh = MODP(0, 4, 0); const float* sc = MODP(0, 4, 1);
      for (int row = gw; row < MC; row += NGW) { const float* src = F.in[2] + (size_t)row * D; unsigned char* dst = (unsigned char*)F.out + (size_t)M * D * 2 + (size_t)M * D + (size_t)row * D;
#pragma unroll
          for (int j = 0; j < 8; ++j) { const int c = 256 * j + 4 * lane; const f32x4 v = *(const f32x4*)(src + c), s = *(const f32x4*)(sc + c), t = *(const f32x4*)(sh + c); const f32x4 y = v * (1.0f + s) + t; *(unsigned*)(dst + c) = pk4_fp8(y.x, y.y, y.z, y.w); } } }
}
__device__ __forceinline__ void conv_z(const bf16* proj, size_t row, int ch, float (&z)[8]) {
    const u32x4 w = *(const u32x4*)(proj + row * 2048 + ch);
    z[0] = bf_lo(w.x); z[1] = bf_hi(w.x); z[2] = bf_lo(w.y); z[3] = bf_hi(w.y); z[4] = bf_lo(w.z); z[5] = bf_hi(w.z); z[6] = bf_lo(w.w); z[7] = bf_hi(w.w);
}
__device__ __forceinline__ void conv_pass(Frame& F) {
    PH_IDS; const int gw = F.vcu * NWAVES + wave, NGW = F.G * NWAVES;
    const bf16* proj = WSP(bf16, WS_PROJ); unsigned char* mix = (unsigned char*)F.out;
    for (int it = gw; it < 2048; it += NGW) {
        const int run = it >> 1, ch = (it & 1) * 512 + lane * 8; const int r0 = run * 32;
        float w0[8], w1[8], w2[8];
#pragma unroll
        for (int i = 0; i < 8; ++i) { w0[i] = F.in[9][ch + i]; w1[i] = F.in[9][1024 + ch + i]; w2[i] = F.in[9][2048 + ch + i]; }
        float zp[8], zc[8], zn[8];
        if ((r0 & (SEQ - 1)) == 0) {
#pragma unroll
            for (int i = 0; i < 8; ++i) zp[i] = 0.f;
        } else conv_z(proj, (size_t)r0 - 1, ch, zp);
        conv_z(proj, (size_t)r0, ch, zc);
#pragma unroll 2
        for (int t = 0; t < 32; ++t) { const size_t row = (size_t)r0 + t;
            if (((row + 1) & (SEQ - 1)) == 0) {
#pragma unroll
                for (int i = 0; i < 8; ++i) zn[i] = 0.f;
            } else conv_z(proj, row + 1, ch, zn);
            const u32x4 bg = *(const u32x4*)(proj + row * 2048 + 1024 + ch);
            float o[8];
#pragma unroll
            for (int i = 0; i < 8; ++i) o[i] = w0[i] * zp[i] + w1[i] * zc[i] + w2[i] * zn[i];
            u32x2 w; w.x = pk4_fp8(bf_lo(bg.x) * o[0], bf_hi(bg.x) * o[1], bf_lo(bg.y) * o[2], bf_hi(bg.y) * o[3]);
            w.y = pk4_fp8(bf_lo(bg.z) * o[4], bf_hi(bg.z) * o[5], bf_lo(bg.w) * o[6], bf_hi(bg.w) * o[7]);
            *(u32x2*)(mix + row * D + ch) = w;
#pragma unroll
            for (int i = 0; i < 8; ++i) { zp[i] = zc[i]; zc[i] = zn[i]; } }
    }
}
__device__ __forceinline__ float lam_value(Frame& F, int lane) {
    const float a = wave_sum(F.in[10][lane] * F.in[11][lane]), b = wave_sum(F.in[12][lane] * F.in[13][lane]);
    return __expf(a) - __expf(b) + 0.2f;
}
__device__ __forceinline__ void attn_simple(Frame& F) {
    PH_IDS; const int gw = F.vcu * NWAVES + wave, NGW = F.G * NWAVES;
    const float lam = lam_value(F, lane);
    const bf16* Q = WSP(bf16, WS_Q); const bf16* KBp = WSP(bf16, WS_KB); const bf16* VBp = WSP(bf16, WS_VB); float* TMP = WSP(float, WS_H);
    for (int it = gw; it < 8192; it += NGW) {
        const int qb = it & 127, vc = (it >> 7) & 1, h = (it >> 8) & 7, b = it >> 11;
        const size_t qrow = (size_t)b * SEQ + qb * 64 + lane;
        float* tmp = TMP + (qrow * 8 + h) * 128 + vc * 64;
#pragma unroll 1
        for (int m = 0; m < 2; ++m) {
            float q[64], acc[64];
#pragma unroll
            for (int c = 0; c < 8; ++c) { const u32x4 w = *(const u32x4*)(Q + qrow * 1024 + h * 128 + m * 64 + c * 8); const float sc = 1.0f;
                q[8 * c + 0] = bf_lo(w.x) * sc; q[8 * c + 1] = bf_hi(w.x) * sc; q[8 * c + 2] = bf_lo(w.y) * sc; q[8 * c + 3] = bf_hi(w.y) * sc;
                q[8 * c + 4] = bf_lo(w.z) * sc; q[8 * c + 5] = bf_hi(w.z) * sc; q[8 * c + 6] = bf_lo(w.w) * sc; q[8 * c + 7] = bf_hi(w.w) * sc; }
#pragma unroll
            for (int i = 0; i < 64; ++i) acc[i] = 0.f;
            float mx = -1e30f, l = 0.f;
            const bf16* kp = KBp + (size_t)b * KV * 1024 + h * 128 + m * 64; const bf16* vp = VBp + (size_t)b * KV * 1024 + h * 128 + vc * 64;
#pragma unroll 1
            for (int j = 0; j < KV; ++j) {
                float s = 0.f;
#pragma unroll
                for (int c = 0; c < 8; ++c) { const u32x4 w = *(const u32x4*)(kp + (size_t)j * 1024 + c * 8);
                    s += q[8 * c + 0] * bf_lo(w.x) + q[8 * c + 1] * bf_hi(w.x) + q[8 * c + 2] * bf_lo(w.y) + q[8 * c + 3] * bf_hi(w.y)
                       + q[8 * c + 4] * bf_lo(w.z) + q[8 * c + 5] * bf_hi(w.z) + q[8 * c + 6] * bf_lo(w.w) + q[8 * c + 7] * bf_hi(w.w); }
                const float mn = fmaxf(mx, s), sc = exp2f(mx - mn), p = exp2f(s - mn); l = l * sc + p; mx = mn;
#pragma unroll
                for (int c = 0; c < 8; ++c) { const u32x4 w = *(const u32x4*)(vp + (size_t)j * 1024 + c * 8);
                    acc[8 * c + 0] = acc[8 * c + 0] * sc + p * bf_lo(w.x); acc[8 * c + 1] = acc[8 * c + 1] * sc + p * bf_hi(w.x);
                    acc[8 * c + 2] = acc[8 * c + 2] * sc + p * bf_lo(w.y); acc[8 * c + 3] = acc[8 * c + 3] * sc + p * bf_hi(w.y);
                    acc[8 * c + 4] = acc[8 * c + 4] * sc + p * bf_lo(w.z); acc[8 * c + 5] = acc[8 * c + 5] * sc + p * bf_hi(w.z);
                    acc[8 * c + 6] = acc[8 * c + 6] * sc + p * bf_lo(w.w); acc[8 * c + 7] = acc[8 * c + 7] * sc + p * bf_hi(w.w); }
            }
            const float inv = 1.0f / l;
            if (m == 0) {
#pragma unroll
                for (int i = 0; i < 64; i += 4) *(f32x4*)(tmp + i) = (f32x4){acc[i] * inv, acc[i + 1] * inv, acc[i + 2] * inv, acc[i + 3] * inv};
            } else {
#pragma unroll
                for (int i = 0; i < 64; i += 4) { const f32x4 t0 = *(const f32x4*)(tmp + i);
                    *(f32x4*)(tmp + i) = (f32x4){t0.x - lam * acc[i] * inv, t0.y - lam * acc[i + 1] * inv, t0.z - lam * acc[i + 2] * inv, t0.w - lam * acc[i + 3] * inv}; }
            }
        }
    }
}
__device__ __forceinline__ void attn_finish(Frame& F) {
    PH_IDS; const int gw = F.vcu * NWAVES + wave, NGW = F.G * NWAVES;
    const float* TMP = WSP(float, WS_H); bf16* mix = (bf16*)F.out;
    for (int row = gw; row < M; row += NGW) {
        f32x4 v[4]; float ss = 0.f;
#pragma unroll
        for (int i = 0; i < 4; ++i) { v[i] = *(const f32x4*)(TMP + (size_t)row * 1024 + lane * 16 + 4 * i); ss += (v[i].x * v[i].x + v[i].y * v[i].y) + (v[i].z * v[i].z + v[i].w * v[i].w); }
        ss += __shfl_xor(ss, 1); ss += __shfl_xor(ss, 2); ss += __shfl_xor(ss, 4);
        const float rs = 0.8f / sqrtf(ss * (1.0f / 128.0f) + LN_EPS);
#pragma unroll
        for (int i = 0; i < 4; ++i) { const f32x4 g = *(const f32x4*)(F.in[14] + ((lane * 16 + 4 * i) & 127)); st_bf4(mix + (size_t)row * D + 1024 + lane * 16 + 4 * i, v[i] * g * rs); }
    }
}
namespace att {
using f32x16 = __attribute__((ext_vector_type(16))) float;
using s16x4 = __attribute__((ext_vector_type(4))) short;
constexpr int QBLK = 32, KVBLK = 64, SHM_V = 16384, SHM_K = 8192, L_K = 0, L_V = 4 * SHM_K, L_WS = L_V + 4 * SHM_V, L_OST = 0, OST_LD = 136;
constexpr float SCALE = 0.125f, THR = 8.f;
#define ATT_KSW(row, c) ((row) * 128 + ((((c) ^ ((row) >> 1)) & 7) << 4))
#define ATT_SBAR() __builtin_amdgcn_sched_barrier(0)
__device__ __forceinline__ int crow(int r, int hi) { return (r & 3) + 8 * (r >> 2) + 4 * hi; }
__device__ __forceinline__ unsigned cvtpk(float lo, float hi) { unsigned r; asm volatile("v_cvt_pk_bf16_f32 %0, %1, %2" : "=v"(r) : "v"(lo), "v"(hi)); return r; }
template <bool FIRST> __device__ __forceinline__ void partialSM(f32x16& p0, f32x16& p1, f32x16& negm, float& alpha) {
    constexpr float THR2 = 8.0f, PBIAS = 4.0f;
    float m0 = fmaxf(fmaxf(p0[0], p0[1]), p0[2]), m1 = fmaxf(fmaxf(p1[0], p1[1]), p1[2]);
#pragma unroll
    for (int r = 3; r < 15; r += 2) { m0 = fmaxf(fmaxf(m0, p0[r]), p0[r + 1]); m1 = fmaxf(fmaxf(m1, p1[r]), p1[r + 1]); }
    float pmax = fmaxf(fmaxf(m0, p0[15]), fmaxf(m1, p1[15]));
    { auto rr = __builtin_amdgcn_permlane32_swap(__float_as_uint(pmax), __float_as_uint(pmax), false, false);
      pmax = fmaxf(__uint_as_float(rr[0]), __uint_as_float(rr[1])); }
    if (!FIRST && __builtin_expect(__all(pmax <= THR2), 1)) { alpha = 1.f; }
    else { const float dl = FIRST ? pmax - PBIAS : fmaxf(pmax - PBIAS, 0.f); alpha = __builtin_amdgcn_exp2f(-dl);
#pragma unroll
        for (int r = 0; r < 16; ++r) { p0[r] -= dl; p1[r] -= dl; negm[r] -= dl; } }
#pragma unroll
    for (int r = 0; r < 16; ++r) p0[r] = __builtin_amdgcn_exp2f(p0[r]);
}
__device__ __forceinline__ void finishSM(f32x16& p0, f32x16& p1, float alpha, float& l_reg, bf16x8& pa0, bf16x8& pa1, bf16x8& pa2, bf16x8& pa3) {
#pragma unroll
    for (int r = 0; r < 16; ++r) p1[r] = __builtin_amdgcn_exp2f(p1[r]);
    float s0 = p0[0] + p0[1], s1 = p0[2] + p0[3], s2 = p1[0] + p1[1], s3 = p1[2] + p1[3];
#pragma unroll
    for (int r = 4; r < 16; r += 4) { s0 += p0[r]; s1 += p0[r + 1]; s2 += p0[r + 2]; s3 += p0[r + 3]; s0 += p1[r]; s1 += p1[r + 1]; s2 += p1[r + 2]; s3 += p1[r + 3]; }
    float ps = (s0 + s1) + (s2 + s3);
    { auto rr = __builtin_amdgcn_permlane32_swap(__float_as_uint(ps), __float_as_uint(ps), false, false); ps = __uint_as_float(rr[0]) + __uint_as_float(rr[1]); }
    l_reg = l_reg * alpha + ps;
#define ATT_PK4(P, BASE, OUT) do { unsigned a0 = cvtpk(P[BASE + 0], P[BASE + 1]), a1 = cvtpk(P[BASE + 2], P[BASE + 3]);   \
    unsigned b0 = cvtpk(P[BASE + 4], P[BASE + 5]), b1 = cvtpk(P[BASE + 6], P[BASE + 7]);                              \
    auto r0 = __builtin_amdgcn_permlane32_swap(a0, b0, false, false); auto r1 = __builtin_amdgcn_permlane32_swap(a1, b1, false, false); \
    u32x4 w = {r0[0], r1[0], r0[1], r1[1]}; OUT = __builtin_bit_cast(bf16x8, w); } while (0)
    ATT_PK4(p0, 0, pa0); ATT_PK4(p0, 8, pa1); ATT_PK4(p1, 0, pa2); ATT_PK4(p1, 8, pa3);
#undef ATT_PK4
}
#define ATT_K8(row, c) ((row) * 64 + ((((c) ^ ((row) >> 2)) & 3) << 4))
__device__ __forceinline__ void qkt(f32x16& p0, f32x16& p1, const LAS char* Ks, const pg8::v8i32& qf, const f32x16& negm, int r32, int hi) {
    const pg8::v4i32 a0 = *(const LAS pg8::v4i32*)(Ks + ATT_K8(r32, 2 * hi)), a1 = *(const LAS pg8::v4i32*)(Ks + ATT_K8(r32, 2 * hi + 1));
    const pg8::v4i32 b0 = *(const LAS pg8::v4i32*)(Ks + ATT_K8(32 + r32, 2 * hi)), b1 = *(const LAS pg8::v4i32*)(Ks + ATT_K8(32 + r32, 2 * hi + 1));
    p0 = __builtin_amdgcn_mfma_scale_f32_32x32x64_f8f6f4(__builtin_shufflevector(a0, a1, 0, 1, 2, 3, 4, 5, 6, 7), qf, negm, 0, 0, 0, 0x7f7f7f7f, 0, 0x7f7f7f7f);
    p1 = __builtin_amdgcn_mfma_scale_f32_32x32x64_f8f6f4(__builtin_shufflevector(b0, b1, 0, 1, 2, 3, 4, 5, 6, 7), qf, negm, 0, 0, 0, 0x7f7f7f7f, 0, 0x7f7f7f7f);
}
__device__ __forceinline__ int v_st(int k, int c) { const int kk = (k & ~0xC) | ((k & 4) << 1) | ((k & 8) >> 1); return ((kk >> 3) * 4 + (c >> 5)) * 512 + ((kk & 7) * 32 + (c & 31)) * 2; }
__device__ __forceinline__ int v_rd_base(int lane) { return ((lane & 3) << 3) | (((lane >> 2) & 3) << 6) | (((lane >> 4) & 1) << 5) | (((lane >> 5) & 1) << 8); }
constexpr int v_rd_off(int d0, int ks, int half) { return d0 * 512 + ks * 4096 + half * 2048; }
template <int OFF> __device__ __forceinline__ s16x4 tr_read(int vb) { s16x4 r; asm volatile("ds_read_b64_tr_b16 %0, %1 offset:%2" : "=&v"(r) : "v"(vb), "i"(OFF) : "memory"); return r; }
template <int D0> __device__ __forceinline__ void pv_one(f32x16& od, int vb, bf16x8 pa0, bf16x8 pa1, bf16x8 pa2, bf16x8 pa3) {
    const s16x4 l0 = tr_read<v_rd_off(D0, 0, 0)>(vb), h0 = tr_read<v_rd_off(D0, 0, 1)>(vb), l1 = tr_read<v_rd_off(D0, 1, 0)>(vb), h1 = tr_read<v_rd_off(D0, 1, 1)>(vb);
    const s16x4 l2 = tr_read<v_rd_off(D0, 2, 0)>(vb), h2 = tr_read<v_rd_off(D0, 2, 1)>(vb), l3 = tr_read<v_rd_off(D0, 3, 0)>(vb), h3 = tr_read<v_rd_off(D0, 3, 1)>(vb);
    asm volatile("s_waitcnt lgkmcnt(0)" ::: "memory"); ATT_SBAR();
#define ATT_PK(L, H) (bf16x8){L[0], L[1], L[2], L[3], H[0], H[1], H[2], H[3]}
    od = __builtin_amdgcn_mfma_f32_32x32x16_bf16(pa0, ATT_PK(l0, h0), od, 0, 0, 0);
    od = __builtin_amdgcn_mfma_f32_32x32x16_bf16(pa1, ATT_PK(l1, h1), od, 0, 0, 0);
    od = __builtin_amdgcn_mfma_f32_32x32x16_bf16(pa2, ATT_PK(l2, h2), od, 0, 0, 0);
    od = __builtin_amdgcn_mfma_f32_32x32x16_bf16(pa3, ATT_PK(l3, h3), od, 0, 0, 0);
#undef ATT_PK
}
__device__ __forceinline__ void pv_d0(f32x16* o, int vb, bf16x8 pa0, bf16x8 pa1, bf16x8 pa2, bf16x8 pa3) {
    pv_one<0>(o[0], vb, pa0, pa1, pa2, pa3); pv_one<1>(o[1], vb, pa0, pa1, pa2, pa3); pv_one<2>(o[2], vb, pa0, pa1, pa2, pa3); pv_one<3>(o[3], vb, pa0, pa1, pa2, pa3);
}
__device__ __forceinline__ void psum(f32x16& osum, bf16x8 pa0, bf16x8 pa1, bf16x8 pa2, bf16x8 pa3) {
    const bf16x8 ones = {0x3F80, 0x3F80, 0x3F80, 0x3F80, 0x3F80, 0x3F80, 0x3F80, 0x3F80};
    osum = __builtin_amdgcn_mfma_f32_32x32x16_bf16(pa0, ones, osum, 0, 0, 0); osum = __builtin_amdgcn_mfma_f32_32x32x16_bf16(pa1, ones, osum, 0, 0, 0);
    osum = __builtin_amdgcn_mfma_f32_32x32x16_bf16(pa2, ones, osum, 0, 0, 0); osum = __builtin_amdgcn_mfma_f32_32x32x16_bf16(pa3, ones, osum, 0, 0, 0);
}
struct VFrag { s16x4 l0, h0, l1, h1, l2, h2, l3, h3; };
__device__ __forceinline__ void pv_rd0(VFrag& f, int vb) {
    f.l0 = tr_read<v_rd_off(0, 0, 0)>(vb); f.h0 = tr_read<v_rd_off(0, 0, 1)>(vb); f.l1 = tr_read<v_rd_off(0, 1, 0)>(vb); f.h1 = tr_read<v_rd_off(0, 1, 1)>(vb);
    f.l2 = tr_read<v_rd_off(0, 2, 0)>(vb); f.h2 = tr_read<v_rd_off(0, 2, 1)>(vb); f.l3 = tr_read<v_rd_off(0, 3, 0)>(vb); f.h3 = tr_read<v_rd_off(0, 3, 1)>(vb);
}
__device__ __forceinline__ void pv_d0_pre(f32x16* o, int vb, const VFrag& f, bf16x8 pa0, bf16x8 pa1, bf16x8 pa2, bf16x8 pa3) {
    asm volatile("s_waitcnt lgkmcnt(0)" ::: "memory"); ATT_SBAR();
#define ATT_PK(L, H) (bf16x8){L[0], L[1], L[2], L[3], H[0], H[1], H[2], H[3]}
    o[0] = __builtin_amdgcn_mfma_f32_32x32x16_bf16(pa0, ATT_PK(f.l0, f.h0), o[0], 0, 0, 0);
    o[0] = __builtin_amdgcn_mfma_f32_32x32x16_bf16(pa1, ATT_PK(f.l1, f.h1), o[0], 0, 0, 0);
    o[0] = __builtin_amdgcn_mfma_f32_32x32x16_bf16(pa2, ATT_PK(f.l2, f.h2), o[0], 0, 0, 0);
    o[0] = __builtin_amdgcn_mfma_f32_32x32x16_bf16(pa3, ATT_PK(f.l3, f.h3), o[0], 0, 0, 0);
#undef ATT_PK
    pv_one<1>(o[1], vb, pa0, pa1, pa2, pa3); pv_one<2>(o[2], vb, pa0, pa1, pa2, pa3); pv_one<3>(o[3], vb, pa0, pa1, pa2, pa3);
}
__device__ __forceinline__ int v8_sw(int key) { return (((key >> 1) & 1) << 1) | (((key >> 3) & 1) << 2); }
__device__ __forceinline__ int v8_st(int key, int chunk) { return key * 128 + ((chunk ^ v8_sw(key)) << 4); }
__device__ __forceinline__ int v8_rd_base(int lane, int d0) { const int i = lane & 15, q = i >> 1, p = i & 1, g1 = (lane >> 4) & 1, hi = lane >> 5; const int key0 = (q & 3) + 8 * (q >> 2) + 4 * hi;
    return key0 * 128 + ((((2 * d0 + g1) ^ v8_sw(key0)) & 7) << 4) + 8 * p; }
template <int OFF> __device__ __forceinline__ u32x2 tr8_read(int vb) { u32x2 r; asm volatile("ds_read_b64_tr_b8 %0, %1 offset:%2" : "=&v"(r) : "v"(vb), "i"(OFF) : "memory"); return r; }
struct V8Frag { u32x2 r0, r1, r2, r3; };
__device__ __forceinline__ void pv8_rd(V8Frag& f, int vb) { f.r0 = tr8_read<0>(vb); f.r1 = tr8_read<2048>(vb); f.r2 = tr8_read<4096>(vb); f.r3 = tr8_read<6144>(vb); }
template <int SO> __device__ __forceinline__ void pv8_rds(V8Frag& f, int vb) { f.r0 = tr8_read<SO>(vb); f.r1 = tr8_read<SO + 2048>(vb); f.r2 = tr8_read<SO + 4096>(vb); f.r3 = tr8_read<SO + 6144>(vb); }
__device__ __forceinline__ void pv8_mm(f32x16& od, const V8Frag& f, const pg8::v8i32& pa, int sc1) {
    const pg8::v8i32 bf = {(int)f.r0.x, (int)f.r0.y, (int)f.r1.x, (int)f.r1.y, (int)f.r2.x, (int)f.r2.y, (int)f.r3.x, (int)f.r3.y};
    asm volatile("v_mfma_scale_f32_32x32x64_f8f6f4 %0, %1, %2, %0, %3, %3 op_sel_hi:[0,0,0]" : "+v"(od) : "v"(pa), "v"(bf), "v"(sc1));
}
__device__ __forceinline__ void pv8_one(f32x16& od, int vb, const pg8::v8i32& pa, int sc1) { V8Frag f; pv8_rd(f, vb); asm volatile("s_waitcnt lgkmcnt(0)" ::: "memory"); ATT_SBAR(); pv8_mm(od, f, pa, sc1); }
__device__ __forceinline__ void pv8_d0(f32x16* o, const int (&vb)[4], int so, const pg8::v8i32& pa, int sc1) {
    pv8_one(o[0], vb[0] + so, pa, sc1); pv8_one(o[1], vb[1] + so, pa, sc1); pv8_one(o[2], vb[2] + so, pa, sc1); pv8_one(o[3], vb[3] + so, pa, sc1); }
__device__ __forceinline__ void pv8_d0_pre(f32x16* o, const int (&vb)[4], int so, const V8Frag& f, const pg8::v8i32& pa, int sc1) {
    asm volatile("s_waitcnt lgkmcnt(0)" ::: "memory"); ATT_SBAR(); pv8_mm(o[0], f, pa, sc1);
    pv8_one(o[1], vb[1] + so, pa, sc1); pv8_one(o[2], vb[2] + so, pa, sc1); pv8_one(o[3], vb[3] + so, pa, sc1); }
__device__ __forceinline__ void finishSM8(f32x16& p0, f32x16& p1, pg8::v8i32& pa) {
#pragma unroll
    for (int r = 0; r < 16; ++r) p1[r] = __builtin_amdgcn_exp2f(p1[r]);
#define ATT_F8(P, B) __builtin_amdgcn_cvt_pk_fp8_f32(P[B + 2], P[B + 3], __builtin_amdgcn_cvt_pk_fp8_f32(P[B], P[B + 1], 0, false), true)
    pa = (pg8::v8i32){ATT_F8(p0, 0), ATT_F8(p0, 4), ATT_F8(p0, 8), ATT_F8(p0, 12), ATT_F8(p1, 0), ATT_F8(p1, 4), ATT_F8(p1, 8), ATT_F8(p1, 12)};
#undef ATT_F8
}
__device__ __forceinline__ void psum8(f32x4& lacc, const pg8::v8i32& mask, const pg8::v8i32& pa, int sc1) {
    asm volatile("v_mfma_scale_f32_16x16x128_f8f6f4 %0, %1, %2, %0, %3, %3 op_sel_hi:[0,0,0]" : "+v"(lacc) : "v"(mask), "v"(pa), "v"(sc1));
}
struct KFrag { pg8::v4i32 a0, a1, b0, b1; };
__device__ __forceinline__ void k_read(KFrag& k, const LAS char* Ks, int r32, int hi) {
    k.a0 = *(const LAS pg8::v4i32*)(Ks + ATT_K8(r32, 2 * hi)); k.a1 = *(const LAS pg8::v4i32*)(Ks + ATT_K8(r32, 2 * hi + 1));
    k.b0 = *(const LAS pg8::v4i32*)(Ks + ATT_K8(32 + r32, 2 * hi)); k.b1 = *(const LAS pg8::v4i32*)(Ks + ATT_K8(32 + r32, 2 * hi + 1)); }
__device__ __forceinline__ void qk_mm(f32x16& p0, f32x16& p1, const KFrag& k, const pg8::v8i32& qf, const f32x16& negm) {
    p0 = __builtin_amdgcn_mfma_scale_f32_32x32x64_f8f6f4(__builtin_shufflevector(k.a0, k.a1, 0, 1, 2, 3, 4, 5, 6, 7), qf, negm, 0, 0, 0, 0x7f7f7f7f, 0, 0x7f7f7f7f);
    p1 = __builtin_amdgcn_mfma_scale_f32_32x32x64_f8f6f4(__builtin_shufflevector(k.b0, k.b1, 0, 1, 2, 3, 4, 5, 6, 7), qf, negm, 0, 0, 0, 0x7f7f7f7f, 0, 0x7f7f7f7f); }
template <int LO, int N> __device__ __forceinline__ void exp_n(f32x16& p) {
#pragma unroll
    for (int r = LO; r < LO + N; ++r) p[r] = __builtin_amdgcn_exp2f(p[r]);
    asm volatile("" : "+v"(p)); }
__device__ __forceinline__ int cvt4_fp8(float a, float b, float c, float d) { int r;
    asm("v_cvt_pk_fp8_f32 %0, %1, %2\n\tv_cvt_pk_fp8_f32 %0, %3, %4 op_sel:[0,0,1]" : "=&v"(r) : "v"(a), "v"(b), "v"(c), "v"(d)); return r; }
__device__ __forceinline__ void cvt_pa(pg8::v8i32& pa, const f32x16& p0, const f32x16& p1) {
#define ATT_F8(P, B) cvt4_fp8(P[B], P[B + 1], P[B + 2], P[B + 3])
    pa = (pg8::v8i32){ATT_F8(p0, 0), ATT_F8(p0, 4), ATT_F8(p0, 8), ATT_F8(p0, 12), ATT_F8(p1, 0), ATT_F8(p1, 4), ATT_F8(p1, 8), ATT_F8(p1, 12)};
#undef ATT_F8
}
__device__ __forceinline__ void sm_decide(f32x16& p0, f32x16& p1, f32x16& negm, float& alpha) {
    constexpr float THR2 = 8.0f, PBIAS = 4.0f;
    float m0 = fmaxf(fmaxf(p0[0], p0[1]), p0[2]), m1 = fmaxf(fmaxf(p1[0], p1[1]), p1[2]);
#pragma unroll
    for (int r = 3; r < 15; r += 2) { m0 = fmaxf(fmaxf(m0, p0[r]), p0[r + 1]); m1 = fmaxf(fmaxf(m1, p1[r]), p1[r + 1]); }
    float pmax = fmaxf(fmaxf(m0, p0[15]), fmaxf(m1, p1[15]));
    { auto rr = __builtin_amdgcn_permlane32_swap(__float_as_uint(pmax), __float_as_uint(pmax), false, false);
      pmax = fmaxf(__uint_as_float(rr[0]), __uint_as_float(rr[1])); }
    if (__builtin_expect(__all(pmax <= THR2), 1)) { alpha = 1.f; }
    else { const float dl = fmaxf(pmax - PBIAS, 0.f); alpha = __builtin_amdgcn_exp2f(-dl);
#pragma unroll
        for (int r = 0; r < 16; ++r) { p0[r] -= dl; p1[r] -= dl; negm[r] -= dl; } }
}
__device__ __forceinline__ void psum8z(f32x4& ts, const pg8::v8i32& mask, const pg8::v8i32& pa, int sc1) {
    asm volatile("v_mfma_scale_f32_16x16x128_f8f6f4 %0, %1, %2, 0, %3, %3 op_sel_hi:[0,0,0]" : "=&v"(ts) : "v"(mask), "v"(pa), "v"(sc1));
}
__device__ __forceinline__ void sm_redo(f32x16& p0, f32x16& p1, f32x16& negm, float& alpha, float& dl) {
    constexpr float PBIAS = 4.0f;
    float m0 = fmaxf(fmaxf(p0[0], p0[1]), p0[2]), m1 = fmaxf(fmaxf(p1[0], p1[1]), p1[2]);
#pragma unroll
    for (int r = 3; r < 15; r += 2) { m0 = fmaxf(fmaxf(m0, p0[r]), p0[r + 1]); m1 = fmaxf(fmaxf(m1, p1[r]), p1[r + 1]); }
    float pmax = fmaxf(fmaxf(m0, p0[15]), fmaxf(m1, p1[15]));
    { auto rr = __builtin_amdgcn_permlane32_swap(__float_as_uint(pmax), __float_as_uint(pmax), false, false);
      pmax = fmaxf(__uint_as_float(rr[0]), __uint_as_float(rr[1])); }
    dl = fmaxf(pmax - PBIAS, 0.f); alpha = __builtin_amdgcn_exp2f(-dl);
#pragma unroll
    for (int r = 0; r < 16; ++r) { p0[r] -= dl; p1[r] -= dl; negm[r] -= dl; }
}
}
__device__ __forceinline__ void attn_fast(Frame& F) {
    using namespace att;
    PH_IDS; const int wid = wave, r32 = lane & 31, hi = lane >> 5;
    const float lam = __builtin_bit_cast(float, __builtin_amdgcn_readfirstlane(__builtin_bit_cast(int, lam_value(F, lane))));
    LAS char* lds = (LAS char*)F.lds; LAS char* V_lds = lds + L_V; LAS char* K_lds = lds + L_K;
    LAS float* wsf = (LAS float*)(lds + L_WS) + wid * 64; LAS float* li_l = wsf; LAS float* al_l = wsf + 32;
    const bf16* Qg = WSP(bf16, WS_Q); const bf16* KBp = WSP(bf16, WS_KB); const bf16* VBp = WSP(bf16, WS_VB); unsigned char* mix = (unsigned char*)F.out;
    const int vkey = tid >> 3, vst0 = v8_st(vkey, tid & 7);
    const int kr = (tid >> 2) & 63, kc = tid & 3, kst = ATT_K8(kr, kc);
    int vb8[4];
#pragma unroll
    for (int d0 = 0; d0 < 4; ++d0) vb8[d0] = (int)(unsigned)(uintptr_t)V_lds + v8_rd_base(lane, d0);
    const int sc1 = 0x7f7f7f7f;
    pg8::v8i32 lmask;
    { const int mk = (((lane >> 4) ^ lane) & 1) ? 0 : 0x38383838; int m0, m1, m2, m3, m4, m5, m6, m7;
      asm volatile("v_mov_b32 %0, %8\n\tv_mov_b32 %1, %8\n\tv_mov_b32 %2, %8\n\tv_mov_b32 %3, %8\n\tv_mov_b32 %4, %8\n\tv_mov_b32 %5, %8\n\tv_mov_b32 %6, %8\n\tv_mov_b32 %7, %8"
                   : "=&v"(m0), "=&v"(m1), "=&v"(m2), "=&v"(m3), "=&v"(m4), "=&v"(m5), "=&v"(m6), "=&v"(m7) : "v"(mk));
      lmask = (pg8::v8i32){m0, m1, m2, m3, m4, m5, m6, m7}; }
    const unsigned voffV0 = (unsigned)(vkey * 1024 + (tid & 7) * 16), voffK = (unsigned)(kr * 1024 + kc * 16);
    constexpr int NT = KV / KVBLK;
    const int bx = (int)blockIdx.x;
    for (int ui = 0;; ++ui) {
        int unit;
        if (F.G == 256) { if (ui >= 4) break; unit = (ui * 8 + (bx & 7)) * 32 + (bx >> 3); }
        else { unit = ui * F.G + bx; if (unit >= 1024) break; }
        const int bh = unit >> 5, qb = unit & 31, b = bh >> 3, h = bh & 7;
        const size_t row0 = (size_t)b * SEQ + qb * 256;
#pragma unroll 1
        for (int mp = 0; mp < 2; ++mp) {
            const unsigned char* Kh = (const unsigned char*)KBp + (size_t)b * KV * 1024 + h * 128 + mp * 64; const unsigned char* Vh = (const unsigned char*)VBp + (size_t)b * KV * 1024 + h * 128;
            const __amdgpu_buffer_rsrc_t rsK = make_rsrc(Kh, KV * 1024), rsV = make_rsrc(Vh, KV * 1024);
            f32x16 o[4] = {}; f32x16 negm = {}; float l0 = 0.f, l1 = 0.f; f32x4 ts;
            const __amdgpu_buffer_rsrc_t rsQ = make_rsrc((const unsigned char*)Qg + (row0 + wid * QBLK) * 1024 + h * 128 + mp * 64, 32 * 1024);
            const int lq = fresh_lane(); const unsigned qoff = (unsigned)((lq & 31) * 1024 + (lq >> 5) * 32);
            const pg8::v8i32 qr = __builtin_shufflevector(__builtin_bit_cast(pg8::v4i32, bufld16(rsQ, qoff, 0)), __builtin_bit_cast(pg8::v4i32, bufld16(rsQ, qoff + 16, 0)), 0, 1, 2, 3, 4, 5, 6, 7);
            struct { bf16x8 vs0, ks0; } sr_;
#define SLOAD(t_) do { const unsigned so_ = (unsigned)(t_) * (unsigned)(KVBLK * 1024); \
    sr_.vs0 = bufld16(rsV, voffV0, so_); if (wid < 4) sr_.ks0 = bufld16(rsK, voffK, so_); } while (0)
#define SWRITE(t_) do { const int sl_ = (t_) & 3; *(LAS bf16x8*)(V_lds + sl_ * SHM_V + vst0) = sr_.vs0; \
    if (wid < 4) *(LAS bf16x8*)(K_lds + sl_ * SHM_K + kst) = sr_.ks0; } while (0)
#define KSLOT(t_) (K_lds + ((t_) & 3) * SHM_K)
#define VSLOT(t_) (((t_) & 3) * SHM_V)
#define RESC(a) do { if (__any((a) < 1.f)) { if (hi == 0) al_l[r32] = (a); asm volatile("s_nop 15\n\ts_nop 15\n\ts_waitcnt lgkmcnt(0)" ::: "memory");   \
    _Pragma("unroll") for (int r = 0; r < 16; ++r) { const float f_ = al_l[crow(r, hi)]; _Pragma("unroll") for (int d = 0; d < 4; ++d) o[d][r] *= f_; } \
    l0 *= al_l[r32 & 15]; l1 *= al_l[16 + (r32 & 15)]; } } while (0)
            f32x16 pA0, pA1, pB0, pB1; float alA; pg8::v8i32 pa;
            __syncthreads();
            SLOAD(0); SWRITE(0); SLOAD(1); SWRITE(1);
            __syncthreads();
            if (wid >= 4) __syncthreads();
            SLOAD(2); qkt(pA0, pA1, KSLOT(0), qr, negm, r32, hi);
            __syncthreads();
            partialSM<true>(pA0, pA1, negm, alA); SWRITE(2);
            __syncthreads();
            V8Frag vf;
#define ATT_WAITL(n_) asm volatile("s_waitcnt lgkmcnt(" #n_ ")" ::: "memory")
#define OVF_CHECK(PY0, PY1, PX0, PX1, SLP_, HAVE_PX) do { \
    asm volatile("s_nop 7\n\ts_nop 3" ::: "memory");        \
    if (__builtin_expect(__any(!(ts[0] < ATT_OVF_LIMIT) || !(ts[1] < ATT_OVF_LIMIT)), 0)) { \
        KFrag kq_; k_read(kq_, K_lds + (SLP_) * SHM_K, r32, hi); qk_mm(PY0, PY1, kq_, qr, negm); \
        float al_, dl_; sm_redo(PY0, PY1, negm, al_, dl_); \
        if (HAVE_PX) { _Pragma("unroll") for (int r = 0; r < 16; ++r) { PX0[r] -= dl_; PX1[r] -= dl_; } } \
        exp_n<0, 16>(PY0); exp_n<0, 16>(PY1); cvt_pa(pa, PY0, PY1); psum8z(ts, lmask, pa, sc1); \
        RESC(al_); \
        asm volatile("s_nop 7\n\ts_nop 3" ::: "memory"); } \
    l0 += ts[0]; l1 += ts[1]; asm volatile("" :: "v"(ts));   } while (0)
#define SLOADT(t_) do { const unsigned so_ = (unsigned)(t_) * (unsigned)(KVBLK * 1024); sr_.vs0 = bufld16(rsV, voffV0, so_); if (wid < 4) sr_.ks0 = bufld16(rsK, voffK, so_); } while (0)
#define SWRITES(SL_) do { *(LAS bf16x8*)(V_lds + (SL_) * SHM_V + vst0) = sr_.vs0; if (wid < 4) *(LAS bf16x8*)(K_lds + (SL_) * SHM_K + kst) = sr_.ks0; } while (0)
#define SEG_A(PX0, PX1, PY0, PY1, t_, SL_, ld_) do { \
    if (ld_) SLOADT((t_) + 2); \
    ATT_SBAR(); KFrag kf_; k_read(kf_, K_lds + (SL_) * SHM_K, r32, hi); ATT_SBAR(); \
    exp_n<0, 16>(PY1); ATT_SBAR(); \
    qk_mm(PX0, PX1, kf_, qr, negm); ATT_SBAR(); \
    cvt_pa(pa, PY0, PY1); psum8z(ts, lmask, pa, sc1); ATT_SBAR(); \
    pv8_rds<(((SL_) + 3) & 3) * SHM_V>(vf, vb8[0]); \
    __syncthreads(); } while (0)
#define SEG_B(PX0, PX1, PY0, PY1, SL_, ld_) do { \
    V8Frag vg_; constexpr int so_ = (((SL_) + 3) & 3) * SHM_V; \
    pv8_rds<so_>(vg_, vb8[1]); ATT_SBAR(); \
    OVF_CHECK(PY0, PY1, PX0, PX1, ((SL_) + 3) & 3, true); ATT_SBAR(); \
    ATT_WAITL(4); ATT_SBAR(); pv8_mm(o[0], vf, pa, sc1); \
    pv8_rds<so_>(vf, vb8[2]); ATT_SBAR(); \
    exp_n<0, 8>(PX0); ATT_SBAR(); \
    ATT_WAITL(4); ATT_SBAR(); pv8_mm(o[1], vg_, pa, sc1); \
    pv8_rds<so_>(vg_, vb8[3]); ATT_SBAR(); \
    exp_n<8, 8>(PX0); ATT_SBAR(); \
    ATT_WAITL(4); ATT_SBAR(); pv8_mm(o[2], vf, pa, sc1); ATT_SBAR(); \
    ATT_WAITL(0); ATT_SBAR(); pv8_mm(o[3], vg_, pa, sc1); ATT_SBAR(); \
    if (ld_) SWRITES(((SL_) + 2) & 3); \
    __syncthreads(); } while (0)
            static_assert(NT % 4 == 0 && NT >= 8, "the tile loop is unrolled over the 4 ring slots");
            SEG_A(pB0, pB1, pA0, pA1, 1, 1, true); SEG_B(pB0, pB1, pA0, pA1, 1, true);
#pragma unroll 1
            for (int t = 2; t + 3 < NT; t += 4) {
                SEG_A(pA0, pA1, pB0, pB1, t, 2, true); SEG_B(pA0, pA1, pB0, pB1, 2, true);
                SEG_A(pB0, pB1, pA0, pA1, t + 1, 3, true); SEG_B(pB0, pB1, pA0, pA1, 3, true);
                SEG_A(pA0, pA1, pB0, pB1, t + 2, 0, true); SEG_B(pA0, pA1, pB0, pB1, 0, true);
                SEG_A(pB0, pB1, pA0, pA1, t + 3, 1, true); SEG_B(pB0, pB1, pA0, pA1, 1, true);
            }
            SEG_A(pA0, pA1, pB0, pB1, NT - 2, 2, false); SEG_B(pA0, pA1, pB0, pB1, 2, false);
            SEG_A(pB0, pB1, pA0, pA1, NT - 1, 3, false); SEG_B(pB0, pB1, pA0, pA1, 3, false);
#undef SEG_A
#undef SEG_B
            exp_n<0, 16>(pB1); cvt_pa(pa, pB0, pB1); psum8z(ts, lmask, pa, sc1); ATT_SBAR();
            OVF_CHECK(pB0, pB1, pB0, pB1, 3, false); ATT_SBAR();
            pv8_d0(o, vb8, VSLOT(NT - 1), pa, sc1);
#undef OVF_CHECK
            asm volatile("s_nop 15\n\ts_nop 15" ::: "memory");
            if (wid < 4) __syncthreads();
            __syncthreads();
#undef KSLOT
#undef VSLOT
#undef SLOAD
#undef SWRITE
#undef RESC
            const int lane2 = fresh_lane(), t2 = wid * 64 + lane2, r32b = lane2 & 31, hi2 = lane2 >> 5;
            if (hi2 == 0) li_l[r32b] = (lane2 & 16) ? l1 : l0; asm volatile("s_waitcnt lgkmcnt(0)" ::: "memory");
            float rli[16];
#pragma unroll
            for (int r = 0; r < 16; ++r) rli[r] = 1.0f / li_l[crow(r, hi2)];
            float* SCR = WSP(float, WS_H) + ((size_t)blockIdx.x * 512 + t2) * 64;
            if (mp == 0) {
#pragma unroll
                for (int d0 = 0; d0 < 4; ++d0)
#pragma unroll
                    for (int r = 0; r < 16; r += 4) *(f32x4*)(SCR + d0 * 16 + r) = (f32x4){o[d0][r] * rli[r], o[d0][r + 1] * rli[r + 1], o[d0][r + 2] * rli[r + 2], o[d0][r + 3] * rli[r + 3]};
            } else {
                LAS bf16* ot = (LAS bf16*)(lds + L_OST) + wid * (32 * OST_LD);
                float gsub[4];
#pragma unroll
                for (int d0 = 0; d0 < 4; ++d0) gsub[d0] = F.in[14][d0 * 32 + r32b];
#pragma unroll
                for (int r = 0; r < 16; ++r) { float a = 0.f;
#pragma unroll
                    for (int d0 = 0; d0 < 4; ++d0) { const float t = SCR[d0 * 16 + r] - lam * (o[d0][r] * rli[r]); o[d0][r] = t; a += t * t; }
#define SWZ_ADD(x_, k_) x_ += __builtin_bit_cast(float, __builtin_amdgcn_ds_swizzle(__builtin_bit_cast(int, x_), ((k_) << 10) | 0x1F))
                    SWZ_ADD(a, 1); SWZ_ADD(a, 2); SWZ_ADD(a, 4); SWZ_ADD(a, 8); SWZ_ADD(a, 16);
#undef SWZ_ADD
                    const float ssr = 0.8f / sqrtf(a * (1.0f / 128.0f) + LN_EPS);
#pragma unroll
                    for (int d0 = 0; d0 < 4; ++d0) ot[crow(r, hi2) * OST_LD + d0 * 32 + r32b] = (bf16)f2bf(o[d0][r] * ssr * gsub[d0]); }
                asm volatile("s_waitcnt lgkmcnt(0)" ::: "memory");
                unsigned char* Ow = mix + (row0 + wid * QBLK + (lane2 >> 4)) * D + 1024 + h * 128 + (lane2 & 15) * 8;
#pragma unroll
                for (int k = 0; k < 8; ++k) { const u32x4 w = *(const LAS u32x4*)(ot + (k * 4 + (lane2 >> 4)) * OST_LD + (lane2 & 15) * 8); u32x2 w8;
                    w8.x = pk4_fp8(bf_lo(w.x), bf_hi(w.x), bf_lo(w.y), bf_hi(w.y)); w8.y = pk4_fp8(bf_lo(w.z), bf_hi(w.z), bf_lo(w.w), bf_hi(w.w)); *(u32x2*)(Ow + (size_t)k * 4 * D) = w8; }
            }
        }
    }
}
template <int L> __device__ __forceinline__ void ln_route_pass(Frame& F) {
    PH_IDS;
    LAS float* P_g = (LAS float*)F.lds;
    LAS float* P_b = P_g + D;
    LAS float* P_s = P_b + D;
    LAS float* P_h = P_s + D;
    LAS int* lcnt = (LAS int*)(F.lds + LDSX_OFF + 1024);
    LAS int* lbase = lcnt + 16;
    LAS int* rec = lcnt + 32;
    LAS float* recw = (LAS float*)(lcnt + 32 + 256);
    LAS float* lgt = (LAS float*)(F.lds + LDSX_OFF + 8192);
    const bf16* R = (const bf16*)F.out + (size_t)M * D; bf16* X = WSP(bf16, WS_X); unsigned char* H8 = WSP(unsigned char, WS_H8);
    const float* lng = F.in[6] + (L * 2 + 0) * D; const float* lnb = F.in[7] + (L * 2 + 0) * D;
    unsigned* gcnt = F.ctl + CW_CNT + L * 16; int2* list = WSP(int2, WS_LIST);
    for (int blk = F.vcu; blk < M / 128; blk += F.G) {
        if (tid < 16) lcnt[tid] = 0;
        __syncthreads();
        const int rowb = blk * 128 + wave * 16, b = rowb >> 13;
        { const float* sh = MODP(L, b, 3); const float* sc = MODP(L, b, 4);
          for (int i = tid; i < D; i += 512) { P_g[i] = lng[i]; P_b[i] = lnb[i]; P_s[i] = 1.0f + sc[i]; P_h[i] = sh[i]; } }
        __syncthreads();
        u32x4 raw0[4], raw1[4];
#pragma unroll
        for (int j = 0; j < 4; ++j) { raw0[j] = *(const u32x4*)(R + (size_t)rowb * D + 512 * j + 8 * lane); raw1[j] = *(const u32x4*)(R + (size_t)(rowb + 1) * D + 512 * j + 8 * lane); }
#pragma unroll 1
        for (int pp = 0; pp < 8; ++pp) {
            const int row = rowb + 2 * pp;
            f32x2 v0[16], v1[16]; f32x2 s0 = {0.f, 0.f}, s1 = {0.f, 0.f};
#pragma unroll
            for (int j = 0; j < 4; ++j) {
                v0[4 * j + 0] = (f32x2){bf_lo(raw0[j].x), bf_hi(raw0[j].x)}; v0[4 * j + 1] = (f32x2){bf_lo(raw0[j].y), bf_hi(raw0[j].y)}; v0[4 * j + 2] = (f32x2){bf_lo(raw0[j].z), bf_hi(raw0[j].z)}; v0[4 * j + 3] = (f32x2){bf_lo(raw0[j].w), bf_hi(raw0[j].w)};
                v1[4 * j + 0] = (f32x2){bf_lo(raw1[j].x), bf_hi(raw1[j].x)}; v1[4 * j + 1] = (f32x2){bf_lo(raw1[j].y), bf_hi(raw1[j].y)}; v1[4 * j + 2] = (f32x2){bf_lo(raw1[j].z), bf_hi(raw1[j].z)}; v1[4 * j + 3] = (f32x2){bf_lo(raw1[j].w), bf_hi(raw1[j].w)}; }
#pragma unroll
            for (int i = 0; i < 16; ++i) { s0 += v0[i]; s1 += v1[i]; }
            if (pp < 7) {
#pragma unroll
                for (int j = 0; j < 4; ++j) { raw0[j] = *(const u32x4*)(R + (size_t)(row + 2) * D + 512 * j + 8 * lane); raw1[j] = *(const u32x4*)(R + (size_t)(row + 3) * D + 512 * j + 8 * lane); } }
            float t0 = s0.x + s0.y, t1 = s1.x + s1.y;
#pragma unroll
            for (int o = 1; o < 64; o <<= 1) { t0 += __shfl_xor(t0, o); t1 += __shfl_xor(t1, o); }
            const float mean0 = t0 * (1.0f / D), mean1 = t1 * (1.0f / D); f32x2 q0 = {0.f, 0.f}, q1 = {0.f, 0.f};
#pragma unroll
            for (int i = 0; i < 16; ++i) { v0[i] = v0[i] - mean0; v1[i] = v1[i] - mean1; q0 += v0[i] * v0[i]; q1 += v1[i] * v1[i]; }
            float u0 = q0.x + q0.y, u1 = q1.x + q1.y;
#pragma unroll
            for (int o = 1; o < 64; o <<= 1) { u0 += __shfl_xor(u0, o); u1 += __shfl_xor(u1, o); }
            const float rstd0 = 1.0f / sqrtf(u0 * (1.0f / D) + LN_EPS), rstd1 = 1.0f / sqrtf(u1 * (1.0f / D) + LN_EPS);
#pragma unroll
            for (int j = 0; j < 4; ++j) { const int c = 512 * j + 8 * lane; u32x4 xo0, xo1; u32x2 h80, h81;
#pragma unroll
                for (int h = 0; h < 2; ++h) { const f32x4 g = *(const LAS f32x4*)(P_g + c + 4 * h), bb = *(const LAS f32x4*)(P_b + c + 4 * h), scv = *(const LAS f32x4*)(P_s + c + 4 * h), shv = *(const LAS f32x4*)(P_h + c + 4 * h);
                    const f32x2 ga = {g.x, g.y}, gb = {g.z, g.w}, ba = {bb.x, bb.y}, bc = {bb.z, bb.w}, sa = {scv.x, scv.y}, sb = {scv.z, scv.w}, ha = {shv.x, shv.y}, hb = {shv.z, shv.w};
                    const f32x2 xa0 = v0[4 * j + 2 * h] * rstd0 * ga + ba, xb0 = v0[4 * j + 2 * h + 1] * rstd0 * gb + bc, xa1 = v1[4 * j + 2 * h] * rstd1 * ga + ba, xb1 = v1[4 * j + 2 * h + 1] * rstd1 * gb + bc;
                    const f32x2 ya0 = xa0 * sa + ha, yb0 = xb0 * sb + hb, ya1 = xa1 * sa + ha, yb1 = xb1 * sb + hb;
                    if (h == 0) { h80.x = pk4_fp8(ya0.x, ya0.y, yb0.x, yb0.y); h81.x = pk4_fp8(ya1.x, ya1.y, yb1.x, yb1.y); } else { h80.y = pk4_fp8(ya0.x, ya0.y, yb0.x, yb0.y); h81.y = pk4_fp8(ya1.x, ya1.y, yb1.x, yb1.y); }
                    if (h == 0) { xo0.x = pk2(xa0.x, xa0.y); xo0.y = pk2(xb0.x, xb0.y); xo1.x = pk2(xa1.x, xa1.y); xo1.y = pk2(xb1.x, xb1.y); }
                    else { xo0.z = pk2(xa0.x, xa0.y); xo0.w = pk2(xb0.x, xb0.y); xo1.z = pk2(xa1.x, xa1.y); xo1.w = pk2(xb1.x, xb1.y); } }
                *(u32x4*)(X + (size_t)row * D + c) = xo0; *(u32x4*)(X + (size_t)(row + 1) * D + c) = xo1;
                *(u32x2*)(H8 + (size_t)row * D + c) = h80; *(u32x2*)(H8 + (size_t)(row + 1) * D + c) = h81; }
        }
        VM_WAIT();
        {
            const int l2 = fresh_lane(), i16 = l2 & 15, kq = l2 >> 4;
            const bf16* hp = X + (size_t)(rowb + i16) * D + 8 * kq; const bf16* whp = WSP(bf16, WS_WRT2) + (size_t)((L * 4 + b) * 32 + i16) * D + 8 * kq; const bf16* wlp = whp + 16 * D;
            f32x4 lacc = {0.f, 0.f, 0.f, 0.f};
#pragma unroll 8
            for (int ks = 0; ks < 64; ++ks) { const bf16x8 af = *(const bf16x8*)(hp + 32 * ks); const bf16x8 bh = *(const bf16x8*)(whp + 32 * ks), bl = *(const bf16x8*)(wlp + 32 * ks);
                lacc = __builtin_amdgcn_mfma_f32_16x16x32_bf16(af, bh, lacc, 0, 0, 0); lacc = __builtin_amdgcn_mfma_f32_16x16x32_bf16(af, bl, lacc, 0, 0, 0); }
            LAS float* lp = lgt + (wave * 16 + 4 * kq) * 16 + i16; const float rc = WSP(float, WS_RC)[(L * 4 + b) * 16 + i16];
            lp[0] = lacc.x + rc; lp[16] = lacc.y + rc; lp[32] = lacc.z + rc; lp[48] = lacc.w + rc;
        }
        LDS_WAIT();
        if (lane < 16) {
            const int rl = wave * 16 + fresh_lane(); float sco[16], sel[16];
#pragma unroll
            for (int e4 = 0; e4 < 4; ++e4) { const f32x4 lg = *(const LAS f32x4*)(lgt + rl * 16 + 4 * e4);
                sco[4 * e4 + 0] = 1.0f / (1.0f + __expf(-lg.x)); sco[4 * e4 + 1] = 1.0f / (1.0f + __expf(-lg.y)); sco[4 * e4 + 2] = 1.0f / (1.0f + __expf(-lg.z)); sco[4 * e4 + 3] = 1.0f / (1.0f + __expf(-lg.w)); }
#pragma unroll
            for (int e = 0; e < 16; ++e) sel[e] = sco[e] + F.in[23][e];
            int bg = 0; float bgs = -1e30f;
#pragma unroll
            for (int g = 0; g < 4; ++g) { float m1 = -1e30f, m2 = -1e30f;
#pragma unroll
                for (int i = 0; i < 4; ++i) { const float x = sel[4 * g + i]; if (x > m1) { m2 = m1; m1 = x; } else if (x > m2) m2 = x; }
                const float gs = m1 + m2; if (gs > bgs) { bgs = gs; bg = g; } }
            float s4[4], c4[4];
#pragma unroll
            for (int i = 0; i < 4; ++i) { s4[i] = bg == 0 ? sel[i] : bg == 1 ? sel[4 + i] : bg == 2 ? sel[8 + i] : sel[12 + i]; c4[i] = bg == 0 ? sco[i] : bg == 1 ? sco[4 + i] : bg == 2 ? sco[8 + i] : sco[12 + i]; }
            int i1 = 0; float b1 = s4[0];
#pragma unroll
            for (int i = 1; i < 4; ++i) if (s4[i] > b1) { b1 = s4[i]; i1 = i; }
            int i2 = -1; float b2 = -1e30f;
#pragma unroll
            for (int i = 0; i < 4; ++i) if (i != i1 && s4[i] > b2) { b2 = s4[i]; i2 = i; }
            const float cw1 = i1 == 0 ? c4[0] : i1 == 1 ? c4[1] : i1 == 2 ? c4[2] : c4[3], cw2 = i2 == 0 ? c4[0] : i2 == 1 ? c4[1] : i2 == 2 ? c4[2] : c4[3];
            const float inv = 1.0f / (cw1 + cw2);
            const int e1 = bg * 4 + i1, e2 = bg * 4 + i2;
            const int r1 = atomicAdd((int*)(lcnt + e1), 1), r2 = atomicAdd((int*)(lcnt + e2), 1);
            rec[rl * 2] = e1 | (r1 << 8); rec[rl * 2 + 1] = e2 | (r2 << 8); recw[rl * 2] = cw1 * inv; recw[rl * 2 + 1] = cw2 * inv;
        }
        __syncthreads();
        if (tid < 16) lbase[tid] = (int)atomicAdd(gcnt + tid, (unsigned)lcnt[tid]);
        __syncthreads();
        if (tid < 256) { const int v = rec[tid], e = v & 255, rank = v >> 8; const int entry = (blk * 128 + (tid >> 1)) * 2 + (tid & 1);
            list[e * CAP + lbase[e] + rank] = make_int2(entry, __float_as_int(recw[tid])); }
        __syncthreads();
    }
}
template <int L> __device__ __forceinline__ int moe_tables(Frame& F, LAS int*& tp, LAS int*& cnt) {
    tp = (LAS int*)(F.lds + LDSX_OFF + 16384); cnt = tp + 32;
    LAS int* ord = tp + 64; LAS int* tpf = tp + 352  ; LAS int* pix = tp + 372  ;
    if (F.wave0 == 0 && fresh_lane() == 0) { int acc = 0, fa = 0, pa = 0;
        for (int e = 0; e < NE; ++e) { const int c = (int)__hip_atomic_load(F.ctl + CW_CNT + L * 16 + e, RLX_AGENT); cnt[e] = c; tp[e] = acc; acc += (c + 255) >> 8; tpf[e] = fa; fa += c >> 8; pix[e] = pa; pa += (c & 255) ? 1 : 0; }
        tp[NE] = acc; tpf[NE] = fa; }
    __syncthreads();
    { const int t_ = F.wave0 * 64 + fresh_lane();
      if (t_ < NE) { const int c = cnt[t_], full = c >> 8, base = tp[t_], fo = tpf[t_]; for (int k = 0; k < full; ++k) ord[fo + k] = base + k; if (c & 255) ord[tpf[NE] + pix[t_]] = base + full; } }
    __syncthreads();
    return tp[NE];
}
template <int L> __device__ __forceinline__ void ln_moe_pass(Frame& F) {
    PH_IDS;
    bf16* X = WSP(bf16, WS_X); unsigned char* H8 = WSP(unsigned char, WS_H8); const bf16* YB = WSP(bf16, WS_YB);
    LAS float* P_g2 = (LAS float*)F.lds; LAS float* P_g = P_g2 + D; LAS float* P_b = P_g + D; LAS float* P_s = P_b + D; LAS float* P_h = P_s + D;
    for (int blk = F.vcu; blk < M / 128; blk += F.G) {
        const int rowb = blk * 128 + wave * 16, b = rowb >> 13;
        __syncthreads();
        for (int i = tid; i < D; i += 512) { P_g2[i] = MODP(L, b, 5)[i]; P_g[i] = F.in[6][(L * 2 + 1) * D + i]; P_b[i] = F.in[7][(L * 2 + 1) * D + i];
            if (L == 0) { P_s[i] = 1.0f + MODP(1, b, 1)[i]; P_h[i] = MODP(1, b, 0)[i]; } }
        __syncthreads();
        u32x4 rx[4], ry0[4], ry1[4];
#define LNM_LOAD(r_) do { _Pragma("unroll") for (int j = 0; j < 4; ++j) { const int c = 512 * j + 8 * lane; rx[j] = *(const u32x4*)(X + (size_t)(r_) * D + c); \
            ry0[j] = *(const u32x4*)(YB + (size_t)(r_) * 2 * D + c); ry1[j] = *(const u32x4*)(YB + ((size_t)(r_) * 2 + 1) * D + c); } } while (0)
        LNM_LOAD(rowb);
#pragma unroll 1
        for (int rr = 0; rr < 16; ++rr) {
            const int row = rowb + rr;
            f32x2 v[16]; f32x2 s2 = {0.f, 0.f};
#pragma unroll
            for (int j = 0; j < 4; ++j) { const int c = 512 * j + 8 * lane;
                const f32x4 ga = *(const LAS f32x4*)(P_g2 + c), gb = *(const LAS f32x4*)(P_g2 + c + 4);
#define LNM_E(k_, W_, G0_, G1_) v[4 * j + k_] = (f32x2){bf_lo(rx[j].W_), bf_hi(rx[j].W_)} * ALPHA + (f32x2){G0_, G1_} * ((f32x2){bf_lo(ry0[j].W_), bf_hi(ry0[j].W_)} + (f32x2){bf_lo(ry1[j].W_), bf_hi(ry1[j].W_)})
                LNM_E(0, x, ga.x, ga.y); LNM_E(1, y, ga.z, ga.w); LNM_E(2, z, gb.x, gb.y); LNM_E(3, w, gb.z, gb.w);
#undef LNM_E
            }
#pragma unroll
            for (int i = 0; i < 16; ++i) s2 += v[i];
            if (rr < 15) LNM_LOAD(row + 1);
            float t = s2.x + s2.y;
#pragma unroll
            for (int o = 1; o < 64; o <<= 1) t += __shfl_xor(t, o);
            const float mean = t * (1.0f / D); f32x2 q2 = {0.f, 0.f};
#pragma unroll
            for (int i = 0; i < 16; ++i) { v[i] = v[i] - mean; q2 += v[i] * v[i]; }
            float u = q2.x + q2.y;
#pragma unroll
            for (int o = 1; o < 64; o <<= 1) u += __shfl_xor(u, o);
            const float rstd = 1.0f / sqrtf(u * (1.0f / D) + LN_EPS);
#pragma unroll
            for (int j = 0; j < 4; ++j) { const int c = 512 * j + 8 * lane; f32x2 xo[4];
#pragma unroll
                for (int h = 0; h < 2; ++h) { const f32x4 g = *(const LAS f32x4*)(P_g + c + 4 * h), bb = *(const LAS f32x4*)(P_b + c + 4 * h);
                    xo[2 * h] = v[4 * j + 2 * h] * rstd * (f32x2){g.x, g.y} + (f32x2){bb.x, bb.y}; xo[2 * h + 1] = v[4 * j + 2 * h + 1] * rstd * (f32x2){g.z, g.w} + (f32x2){bb.z, bb.w}; }
                if (L == 1) { *(f32x4*)(F.out + (size_t)row * D + c) = (f32x4){xo[0].x, xo[0].y, xo[1].x, xo[1].y}; *(f32x4*)(F.out + (size_t)row * D + c + 4) = (f32x4){xo[2].x, xo[2].y, xo[3].x, xo[3].y}; }
                else { u32x4 w; w.x = pk2(xo[0].x, xo[0].y); w.y = pk2(xo[1].x, xo[1].y); w.z = pk2(xo[2].x, xo[2].y); w.w = pk2(xo[3].x, xo[3].y); *(u32x4*)(X + (size_t)row * D + c) = w;
                    const f32x4 sa = *(const LAS f32x4*)(P_s + c), sb = *(const LAS f32x4*)(P_s + c + 4), ha = *(const LAS f32x4*)(P_h + c), hb = *(const LAS f32x4*)(P_h + c + 4);
                    const f32x2 y0 = xo[0] * (f32x2){sa.x, sa.y} + (f32x2){ha.x, ha.y}, y1 = xo[1] * (f32x2){sa.z, sa.w} + (f32x2){ha.z, ha.w}, y2 = xo[2] * (f32x2){sb.x, sb.y} + (f32x2){hb.x, hb.y}, y3 = xo[3] * (f32x2){sb.z, sb.w} + (f32x2){hb.z, hb.w};
                    u32x2 hw; hw.x = pk4_fp8(y0.x, y0.y, y1.x, y1.y); hw.y = pk4_fp8(y2.x, y2.y, y3.x, y3.y); *(u32x2*)(H8 + (size_t)row * D + c) = hw; } }
        }
#undef LNM_LOAD
    }
}
__device__ __forceinline__ void spatial_simple(Frame& F) {
    PH_IDS;
    LAS float* vt = (LAS float*)F.lds;
    LAS float* wt = (LAS float*)(F.lds + 65536);
    LAS float* st = (LAS float*)(F.lds + LDSX_OFF + 1024);
    const bf16* UV = WSP(bf16, WS_UV); bf16* GT = (bf16*)F.out; const float* vst = WSP(float, WS_VSTP);
    for (int ch = F.vcu; ch < M / 128; ch += F.G) {
        __syncthreads();
        if (tid < 128) { float s = 0.f, s2 = 0.f; const f32x4* pp = (const f32x4*)(vst + (size_t)(ch * 128 + tid) * 64);
#pragma unroll
            for (int i = 0; i < 16; ++i) { const f32x4 t = pp[i]; s += t.x; s2 += t.y; s += t.z; s2 += t.w; }
            const float mean = s * (1.0f / D); const float var = fmaxf(s2 * (1.0f / D) - mean * mean, 0.f);
            st[tid * 2] = mean; st[tid * 2 + 1] = 1.0f / sqrtf(var + LN_EPS); }
#pragma unroll 1
        for (int g = 0; g < 16; ++g) {
            __syncthreads();
            for (int idx = tid; idx < 16384; idx += 512) { const int q = idx >> 7, c = idx & 127, col = g * 128 + c;
                const float v = bf2f(UV[(size_t)(ch * 128 + q) * 4096 + 2048 + col]);
                vt[idx] = (v - st[q * 2]) * st[q * 2 + 1] * F.in[17][col] + F.in[18][col]; wt[q * 129 + c] = F.in[19][g * 16384 + idx]; }
            __syncthreads();
            const int p = tid & 127, cg = tid >> 7;
            float acc[32];
#pragma unroll
            for (int i = 0; i < 32; ++i) acc[i] = 0.f;
#pragma unroll 1
            for (int q = 0; q < 128; ++q) { const float w = wt[p * 129 + q];
#pragma unroll
                for (int i = 0; i < 32; i += 4) { const f32x4 v = *(const LAS f32x4*)(vt + q * 128 + cg * 32 + i); acc[i] += w * v.x; acc[i + 1] += w * v.y; acc[i + 2] += w * v.z; acc[i + 3] += w * v.w; } }
            const size_t row = (size_t)ch * 128 + p; const float bsv = F.in[20][g * 128 + p];
            const bf16* up = UV + row * 4096 + g * 128 + cg * 32; bf16* op = GT + row * D + g * 128 + cg * 32;
#pragma unroll
            for (int i = 0; i < 32; i += 4) { const f32x4 uu = ld_bf4(up + i); st_bf4(op + i, (f32x4){uu.x * (acc[i] + bsv), uu.y * (acc[i + 1] + bsv), uu.z * (acc[i + 2] + bsv), uu.w * (acc[i + 3] + bsv)}); }
        }
    }
}

__device__ __forceinline__ void spatial_fast(Frame& F) {
    using namespace att;
    PH_IDS; const int wid = wave, r32 = lane & 31, hi = lane >> 5;
    LAS char* lds = (LAS char*)F.lds;
    LAS bf16* ot = (LAS bf16*)(lds + 65536) + wid * (32 * 136);
    LAS float* st = (LAS float*)(lds + 135168);
    const bf16* UV = WSP(bf16, WS_UV); unsigned char* GT = (unsigned char*)F.out; const float* vst = WSP(float, WS_VSTP); const bf16* WSB = WSP(bf16, WS_WSB);
    const int q0 = tid >> 4, cc = tid & 15;
    const int gsw = wid >> 2, pbase = (wid & 3) * 32;
    const int vbase = (int)(unsigned)(uintptr_t)lds + v_rd_base(lane) + gsw * 2 * 16384;
    for (int ch = F.vcu; ch < M / 128; ch += F.G) {
        __syncthreads();
        if (tid < 128) { float s = 0.f, s2 = 0.f; const f32x4* pp = (const f32x4*)(vst + (size_t)(ch * 128 + tid) * 64);
#pragma unroll
            for (int i = 0; i < 16; ++i) { const f32x4 t = pp[i]; s += t.x; s2 += t.y; s += t.z; s2 += t.w; }
            const float mean = s * (1.0f / D); const float var = fmaxf(s2 * (1.0f / D) - mean * mean, 0.f);
            st[tid * 2] = mean; st[tid * 2 + 1] = 1.0f / sqrtf(var + LN_EPS); }
        __syncthreads();
        const char* vsrc = (const char*)(UV + (size_t)ch * 128 * 4096 + 2048); const unsigned voff = (unsigned)(q0 * 4096 + cc * 8) * 2u;
        u32x4 raw[2][4];
#define LOADV(it_) do { _Pragma("unroll") for (int gs = 0; gs < 2; ++gs) _Pragma("unroll") for (int j = 0; j < 4; ++j) \
            raw[gs][j] = *(const u32x4*)(vsrc + voff + (size_t)((2 * (it_) + gs) * 256 + j * 32 * 8192)); } while (0)
        LOADV(0);
#pragma unroll 1
        for (int it = 0; it < 8; ++it) {
#pragma unroll
            for (int gs = 0; gs < 2; ++gs) { const int col = (2 * it + gs) * 128 + cc * 8;
                const f32x4 ga = *(const f32x4*)(F.in[17] + col), gb = *(const f32x4*)(F.in[17] + col + 4), ba = *(const f32x4*)(F.in[18] + col), bb = *(const f32x4*)(F.in[18] + col + 4);
#pragma unroll
                for (int j = 0; j < 4; ++j) { const int q = q0 + 32 * j; const float mean = st[2 * q], rstd = st[2 * q + 1]; const u32x4 w = raw[gs][j]; u32x4 o;
                    o.x = pk2((bf_lo(w.x) - mean) * rstd * ga.x + ba.x, (bf_hi(w.x) - mean) * rstd * ga.y + ba.y); o.y = pk2((bf_lo(w.y) - mean) * rstd * ga.z + ba.z, (bf_hi(w.y) - mean) * rstd * ga.w + ba.w);
                    o.z = pk2((bf_lo(w.z) - mean) * rstd * gb.x + bb.x, (bf_hi(w.z) - mean) * rstd * gb.y + bb.y); o.w = pk2((bf_lo(w.w) - mean) * rstd * gb.z + bb.z, (bf_hi(w.w) - mean) * rstd * gb.w + bb.w);
                    *(LAS u32x4*)(lds + (gs * 2 + (q >> 6)) * 16384 + v_st(q & 63, cc * 8)) = o; } }
            __syncthreads();
            if (it + 1 < 8) LOADV(it + 1);
            const int g = 2 * it + gsw;
            bf16x8 wa[8];
#pragma unroll
            for (int ks = 0; ks < 8; ++ks) wa[ks] = *(const bf16x8*)(WSB + (size_t)(g * 128 + pbase + r32) * 128 + ks * 16 + hi * 8);
            f32x16 o[4] = {};
            pv_d0(o, vbase, wa[0], wa[1], wa[2], wa[3]); pv_d0(o, vbase + 16384, wa[4], wa[5], wa[6], wa[7]);
#pragma unroll
            for (int r = 0; r < 16; ++r) { const float bs = F.in[20][g * 128 + pbase + crow(r, hi)];
#pragma unroll
                for (int d0 = 0; d0 < 4; ++d0) ot[crow(r, hi) * 136 + d0 * 32 + r32] = (bf16)f2bf(o[d0][r] + bs); }
            asm volatile("s_waitcnt lgkmcnt(0)" ::: "memory");
            const size_t tok = (size_t)ch * 128 + pbase + (lane >> 4);
#pragma unroll
            for (int k = 0; k < 8; ++k) { const u32x4 sv = *(const LAS u32x4*)(ot + (k * 4 + (lane >> 4)) * 136 + (lane & 15) * 8);
                const u32x4 uu = *(const u32x4*)(UV + (tok + k * 4) * 4096 + g * 128 + (lane & 15) * 8); u32x2 w;
                w.x = pk4_fp8(bf_lo(uu.x) * bf_lo(sv.x), bf_hi(uu.x) * bf_hi(sv.x), bf_lo(uu.y) * bf_lo(sv.y), bf_hi(uu.y) * bf_hi(sv.y));
                w.y = pk4_fp8(bf_lo(uu.z) * bf_lo(sv.z), bf_hi(uu.z) * bf_hi(sv.z), bf_lo(uu.w) * bf_lo(sv.w), bf_hi(uu.w) * bf_hi(sv.w));
                *(u32x2*)(GT + (tok + k * 4) * D + g * 128 + (lane & 15) * 8) = w; }
            __syncthreads();
        }
#undef LOADV
    }
}

constexpr int NPH = 17;
struct Args { const float* in[27]; float* out; unsigned char* ws; int ph_lo, ph_hi; };
__global__ void __launch_bounds__(NWAVES * 64, 2) mk_fwd(Args args) {
    extern __shared__ __attribute__((aligned(16))) unsigned char lds_raw[];
    Frame F;
    F.lds = (LAS unsigned char*)lds_raw;
    F.MISC = (volatile LAS unsigned*)(F.lds + MISC_OFF);
    F.wave0 = __builtin_amdgcn_readfirstlane((int)threadIdx.x >> 6);
    F.G = gridDim.x; { const int bx = blockIdx.x; F.vcu = (F.G % 8 == 0) ? (bx % 8) * (F.G / 8) + bx / 8 : bx; }
#pragma unroll
    for (int i = 0; i < 27; ++i) F.in[i] = args.in[i];
    F.out = args.out; F.ws = args.ws; F.ctl = (unsigned*)(args.ws + WS_CTL);
    if (threadIdx.x < 64) ((LAS unsigned*)(F.lds + MISC_OFF))[threadIdx.x] = 0u;
    __syncthreads();
    XcdBarrier bar; bar.bar = F.ctl + CW_BAR; bar.x = 0; bar.st = nullptr;
    if (MK_N_LAUNCHES == 1) bar = xcd_barrier_post(F.ctl + CW_BAR, F.MISC + 8, threadIdx.x == 0);
    const int lo = args.ph_lo, hi = args.ph_hi;
#define IN(k) (lo <= (k) && (k) < hi)
#define SEAM(k) do { if (IN(k) && IN((k) + 1)) xcd_barrier(bar, F.wave0 == 0 && fresh_lane() == 0); } while (0)

#define RUN(k, ...) do { if (IN(k)) { constexpr bool dup_pass = false; (void)dup_pass; __VA_ARGS__ } SEAM(k); if (DUP_PHASE == (k) && IN(k)) { constexpr bool dup_pass = true; (void)dup_pass; __VA_ARGS__ xcd_barrier(bar, F.wave0 == 0 && fresh_lane() == 0); } } while (0)
    RUN(0, p0_prologue(F););
    RUN(1, p1_modulate(F););
    RUN(2,
        { LAS float* tabL = (LAS float*)(F.lds + LDSX_OFF); { const int t_ = F.wave0 * 64 + fresh_lane(); for (int i = t_; i < 4096; i += 512) tabL[i] = WSP(float, WS_TAB)[i]; } __syncthreads();
          const unsigned char* h8 = (const unsigned char*)F.out + (size_t)M * D * 2; const unsigned char* w8 = WSP(unsigned char, WS_WINE) + (size_t)3072 * D;
          { Gemm g{(const bf16*)h8, (const bf16*)WSP(unsigned char, WS_WINE), M, 6144, D}; pg8::StaticOrder S; S.init(M, 6144, F.G, (int)blockIdx.x);
            EpiInProj E{WSP(bf16, WS_PROJ), WSP(bf16, WS_Q), WSP(bf16, WS_KB), WSP(bf16, WS_VB), tabL, tabL + 2048, 0};
            GEMM_PHASE_F8(EpiInProj, pg8::StaticOrder, F.lds, g, S, E); }
          { Gemm g{(const bf16*)(h8 + (size_t)M * D), (const bf16*)(w8 + (size_t)1024 * D), MC, 2048, D}; pg8::StaticOrder S; S.init(MC, 2048, F.G, (int)blockIdx.x);
            EpiCtx E{WSP(bf16, WS_KB), WSP(bf16, WS_VB)};
            GEMM_PHASE_F8(EpiCtx, pg8::StaticOrder, F.lds, g, S, E); } }
        if (!dup_pass) { const int c = (int)blockIdx.x;
            if (F.G <= 32) convert_weights<1>(F, c * NWAVES + F.wave0, F.G * NWAVES, F.wave0, fresh_lane(), 0, CW_SPLIT1);
            else if (c >= 32) convert_weights<1>(F, (c - 32) * NWAVES + F.wave0, (F.G - 32) * NWAVES, F.wave0, fresh_lane(), 0, CW_SPLIT1); });
#if USE_FAST_ATTN
    RUN(3, conv_pass(F); attn_fast(F););
#else
    RUN(3, conv_pass(F); attn_simple(F););
    RUN(4, attn_finish(F););
#endif
    RUN(5, { Gemm g{(const bf16*)F.out, WSP(bf16, WS_WOUTE), M, D, D}; pg8::StaticOrder S; S.init(M, D, F.G, (int)blockIdx.x);
        EpiRes<true> E{F.in[0], nullptr, MODP(0, 0, 2), (bf16*)F.out + (size_t)M * D};
        GEMM_PHASE_F8(EpiRes<true>, pg8::StaticOrder, F.lds, g, S, E); });
    RUN(6, ln_route_pass<0>(F););
    RUN(7, { LAS int* tp; LAS int* cnt; const int TP = moe_tables<0>(F, tp, cnt);
        Gemm g{(const bf16*)WSP(unsigned char, WS_H8), (const bf16*)(WSP(unsigned char, WS_WGU)), M, 1024, D}; pg8::MoeOrder<true> S{tp, cnt, WSP(int2, WS_LIST), 4, TP * 4, F.G, (int)blockIdx.x, tp + 64};
        EpiGU E{WSP(unsigned char, WS_HID)}; GEMM_PHASE_F8(EpiGU, pg8::MoeOrder<true>, F.lds, g, S, E);
        if (!dup_pass) { const int rem = (TP * 4) % F.G; const int c = (int)blockIdx.x;
            if (rem == 0) convert_weights<1>(F, c * NWAVES + F.wave0, F.G * NWAVES, F.wave0, fresh_lane(), CW_SPLIT1, CW_N1);
            else if (c >= rem) convert_weights<1>(F, (c - rem) * NWAVES + F.wave0, (F.G - rem) * NWAVES, F.wave0, fresh_lane(), CW_SPLIT1, CW_N1); } });
    RUN(8, { LAS int* tp; LAS int* cnt; const int TP = moe_tables<0>(F, tp, cnt);
        Gemm g{(const bf16*)WSP(unsigned char, WS_HID), (const bf16*)(WSP(unsigned char, WS_WDN)), M, 2048, ED}; pg8::MoeOrder<false> S{tp, cnt, WSP(int2, WS_LIST), 8, TP * 8, F.G, (int)blockIdx.x, tp + 64};
        EpiDown E{WSP(int2, WS_LIST), WSP(bf16, WS_YB)}; GEMM_PHASE_F8(EpiDown, pg8::MoeOrder<false>, F.lds, g, S, E); });
    RUN(9, ln_moe_pass<0>(F););
    RUN(10, { Gemm g{(const bf16*)WSP(unsigned char, WS_H8), WSP(bf16, WS_WINO), M, 4096, D}; pg8::StaticOrder S; S.init(M, 4096, F.G, (int)blockIdx.x);
        EpiGelu E{WSP(bf16, WS_UV), WSP(float, WS_VSTP)}; GEMM_PHASE_F8(EpiGelu, pg8::StaticOrder, F.lds, g, S, E); });
#if USE_FAST_SPATIAL
    RUN(11, spatial_fast(F););
#else
    RUN(11, spatial_simple(F););
#endif
    RUN(12, { Gemm g{(const bf16*)F.out, WSP(bf16, WS_WOUTO), M, D, D}; pg8::StaticOrder S; S.init(M, D, F.G, (int)blockIdx.x);
        EpiRes<false> E{nullptr, WSP(bf16, WS_X), MODP(1, 0, 2), (bf16*)F.out + (size_t)M * D};
        GEMM_PHASE_F8(EpiRes<false>, pg8::StaticOrder, F.lds, g, S, E); });
    RUN(13, ln_route_pass<1>(F););
    RUN(14, { LAS int* tp; LAS int* cnt; const int TP = moe_tables<1>(F, tp, cnt);
        Gemm g{(const bf16*)WSP(unsigned char, WS_H8), (const bf16*)(WSP(unsigned char, WS_WGU) + (size_t)16 * 1024 * D), M, 1024, D}; pg8::MoeOrder<true> S{tp, cnt, WSP(int2, WS_LIST), 4, TP * 4, F.G, (int)blockIdx.x, tp + 64};
        EpiGU E{WSP(unsigned char, WS_HID)}; GEMM_PHASE_F8(EpiGU, pg8::MoeOrder<true>, F.lds, g, S, E); });
    RUN(15, { LAS int* tp; LAS int* cnt; const int TP = moe_tables<1>(F, tp, cnt);
        Gemm g{(const bf16*)WSP(unsigned char, WS_HID), (const bf16*)(WSP(unsigned char, WS_WDN) + (size_t)16 * D * ED), M, 2048, ED}; pg8::MoeOrder<false> S{tp, cnt, WSP(int2, WS_LIST), 8, TP * 8, F.G, (int)blockIdx.x, tp + 64};
        EpiDown E{WSP(int2, WS_LIST), WSP(bf16, WS_YB)}; GEMM_PHASE_F8(EpiDown, pg8::MoeOrder<false>, F.lds, g, S, E); });
    if (DUP_PHASE == 16) { ln_moe_pass<1>(F); xcd_barrier(bar, F.wave0 == 0 && fresh_lane() == 0); }
    if (IN(16)) { ln_moe_pass<1>(F); }
#undef RUN
#undef IN
#undef SEAM
}

extern "C" void kernel_launch(void* const* d_in, const int* in_sizes, int n_in, void* d_out, int out_size, void* d_ws, size_t ws_size, hipStream_t stream) {
    static int grid = 0;
    if (grid == 0) {
        if (n_in != 27 || in_sizes[0] != M * D || out_size != M * D || ws_size < WS_END) { fprintf(stderr, "kernel_launch: shape/workspace mismatch (n_in %d, ws %zu < %zu)\n", n_in, ws_size, (size_t)WS_END); grid = -1; return; }
        int dev = 0, cus = 0, per_cu = 0;
        if (hipGetDevice(&dev) != hipSuccess || hipDeviceGetAttribute(&cus, hipDeviceAttributeMultiprocessorCount, dev) != hipSuccess) { grid = -1; return; }
        if (hipFuncSetAttribute((const void*)mk_fwd, hipFuncAttributeMaxDynamicSharedMemorySize, LDS_BYTES) != hipSuccess) { fprintf(stderr, "kernel_launch: hipFuncSetAttribute failed\n"); grid = -1; return; }
        if (hipOccupancyMaxActiveBlocksPerMultiprocessor(&per_cu, (const void*)mk_fwd, NWAVES * 64, LDS_BYTES) != hipSuccess || per_cu < 1) fprintf(stderr, "kernel_launch: occupancy query reports %d\n", per_cu);
        (void)hipGetLastError();
        grid = cus;
    }
    if (grid < 0) return;
    if (hipMemsetAsync((char*)d_ws + WS_CTL, 0, CTL_ZERO_BYTES, stream) != hipSuccess) return;
    Args a{};
    for (int i = 0; i < 27; ++i) a.in[i] = (const float*)d_in[i];
    a.out = (float*)d_out; a.ws = (unsigned char*)d_ws;
    if (MK_N_LAUNCHES == 1) { a.ph_lo = 0; a.ph_hi = NPH; hipLaunchKernelGGL(mk_fwd, dim3(grid), dim3(NWAVES * 64), LDS_BYTES, stream, a); }
    else for (int p = 0; p < NPH; ++p) {
#if USE_FAST_ATTN
        if (p == 4) continue;
#endif
        a.ph_lo = p; a.ph_hi = p + 1; hipLaunchKernelGGL(mk_fwd, dim3(grid), dim3(NWAVES * 64), LDS_BYTES, stream, a); }
    const hipError_t le = hipPeekAtLastError();
    if (le != hipSuccess) fprintf(stderr, "kernel_launch: launch failed: %s\n", hipGetErrorName(le));
}
```

```cpp
#include <hip/hip_runtime.h>
#include <cstdio>
#include <cstdint>

#ifndef MK_N_LAUNCHES
#define MK_N_LAUNCHES 1
#endif
#ifndef DUP_PHASE
#define ATT_OVF_LIMIT __builtin_inff()
#define DUP_PHASE -1
#endif
#ifndef USE_FAST_GEMM
#define USE_FAST_GEMM 1
#endif
#ifndef USE_FAST_ATTN
#define USE_FAST_ATTN 1
#endif
#ifndef USE_FAST_SPATIAL
#define USE_FAST_SPATIAL 1
#endif

#define GAS __attribute__((address_space(1)))
#define LAS __attribute__((address_space(3)))
typedef unsigned short bf16;
typedef short bf16x8 __attribute__((ext_vector_type(8)));
typedef float f32x4 __attribute__((ext_vector_type(4)));
typedef float f32x2 __attribute__((ext_vector_type(2)));
typedef unsigned u32x4 __attribute__((ext_vector_type(4)));
typedef unsigned u32x2 __attribute__((ext_vector_type(2)));
typedef GAS unsigned gu32;

constexpr int D = 2048, BATCH = 4, SEQ = 8192, M = BATCH * SEQ, CTXL = 256, MC = BATCH * CTXL, KV = SEQ + CTXL;
constexpr int NE = 16, ED = 512, CAP = 32768, NL = 24;
constexpr float ALPHA = 1.41421356237309515f, LN_EPS = 1e-5f;
constexpr int NWAVES = 8;
constexpr float QSCALE = 0.125f * 1.4426950408889634f;

constexpr size_t MiB = 1u << 20;
constexpr size_t WS_CTL = 0, CTL_ZERO_BYTES = 64 * 1024;
constexpr size_t WS_MOD = 2 * MiB;
constexpr size_t WS_TAB = 3 * MiB;
constexpr size_t WS_WRT = 3 * MiB + 64 * 1024;
constexpr size_t WS_WSB = 3 * MiB + 256 * 1024;
constexpr size_t WS_WRT2 = 24 * MiB;
constexpr size_t WS_RC = 25 * MiB;
constexpr size_t WS_LIST = 4 * MiB;
constexpr size_t WS_WINE = 8 * MiB;
constexpr size_t WS_WOUTE = 32 * MiB;
constexpr size_t WS_WINO = 40 * MiB;
constexpr size_t WS_WOUTO = 56 * MiB;
constexpr size_t WS_WGU = 64 * MiB;
constexpr size_t WS_WDN = 192 * MiB;
constexpr size_t WS_A = 256 * MiB;
constexpr size_t WS_PROJ = WS_A;
constexpr size_t WS_Q = WS_A + 192 * MiB;
constexpr size_t WS_KB = WS_A + 256 * MiB;
constexpr size_t WS_VB = WS_A + 322 * MiB;
constexpr size_t WS_HID = WS_A;
constexpr size_t WS_H8 = WS_A + 324 * MiB;
constexpr size_t WS_YB = WS_A + 68 * MiB;
constexpr size_t WS_UV = WS_A;
constexpr size_t WS_VSTP = WS_A + 256 * MiB;
constexpr size_t WS_H = WS_A + 388 * MiB;
constexpr size_t WS_LIST2 = WS_H;
constexpr size_t WS_X = WS_H + 128 * MiB;
constexpr size_t WS_HC = WS_X + 128 * MiB;
constexpr size_t WS_END = WS_HC + 4 * MiB;
static_assert(WS_VB + (size_t)BATCH * KV * 1024 * 2 <= WS_H && WS_YB + (size_t)M * 2 * 2048 * 2 <= WS_H && WS_END <= 1024 * MiB, "ws map");
constexpr int CW_BAR = 4096;
constexpr int CW_CNT = 8192;
constexpr int CW_VST = 262144;
constexpr int RING_BYTES = 131072, LDSX_OFF = RING_BYTES, MISC_OFF = LDSX_OFF + 24576, LDS_BYTES = 163840;

#define RLX_AGENT __ATOMIC_RELAXED, __HIP_MEMORY_SCOPE_AGENT
#define LDS_WAIT() asm volatile("s_waitcnt lgkmcnt(0)" ::: "memory")
#define VM_WAIT() asm volatile("s_waitcnt vmcnt(0)" ::: "memory")
__device__ __forceinline__ unsigned f2bf(float f) { unsigned u = __builtin_bit_cast(unsigned, f); return (u + 0x7fffu + ((u >> 16) & 1u)) >> 16; }
__device__ __forceinline__ unsigned pk2(float lo, float hi) { unsigned r; asm("v_cvt_pk_bf16_f32 %0, %1, %2" : "=v"(r) : "v"(lo), "v"(hi)); return r; }
__device__ __forceinline__ float bf_lo(unsigned u) { return __uint_as_float(u << 16); }
__device__ __forceinline__ float bf_hi(unsigned u) { return __uint_as_float(u & 0xffff0000u); }
__device__ __forceinline__ float bf2f(bf16 h) { return __uint_as_float((unsigned)h << 16); }
__device__ __forceinline__ f32x4 ld_bf4(const bf16* p) { const u32x2 w = *(const u32x2*)p; return (f32x4){bf_lo(w.x), bf_hi(w.x), bf_lo(w.y), bf_hi(w.y)}; }
__device__ __forceinline__ void st_bf4(bf16* p, f32x4 v) { u32x2 w; w.x = pk2(v.x, v.y); w.y = pk2(v.z, v.w); *(u32x2*)p = w; }
__device__ __forceinline__ float wave_sum(float v) {
#pragma unroll
    for (int o = 1; o < 64; o <<= 1) v += __shfl_xor(v, o);
    return v;
}
__device__ __forceinline__ __amdgpu_buffer_rsrc_t make_rsrc(const void* p, int bytes) {
    const unsigned long long v = (unsigned long long)p; const unsigned lo = __builtin_amdgcn_readfirstlane((unsigned)v), hi = __builtin_amdgcn_readfirstlane((unsigned)(v >> 32));
    return __builtin_amdgcn_make_buffer_rsrc((void*)(((unsigned long long)hi << 32) | lo), 0, bytes, 0x00020000);
}
__device__ __forceinline__ bf16x8 bufld16(__amdgpu_buffer_rsrc_t r, unsigned voff, unsigned soff) { return __builtin_bit_cast(bf16x8, __builtin_amdgcn_raw_buffer_load_b128(r, (int)voff, (int)soff, 0)); }
__device__ __forceinline__ unsigned pk4_fp8(float a, float b, float c, float d) {
    a = __builtin_amdgcn_fmed3f(a, -448.f, 448.f); b = __builtin_amdgcn_fmed3f(b, -448.f, 448.f); c = __builtin_amdgcn_fmed3f(c, -448.f, 448.f); d = __builtin_amdgcn_fmed3f(d, -448.f, 448.f);
    int v = __builtin_amdgcn_cvt_pk_fp8_f32(a, b, 0, false); v = __builtin_amdgcn_cvt_pk_fp8_f32(c, d, v, true); return (unsigned)v; }
__device__ __forceinline__ void st_f8x8(unsigned char* p, f32x4 a, f32x4 b) { u32x2 w; w.x = pk4_fp8(a.x, a.y, a.z, a.w); w.y = pk4_fp8(b.x, b.y, b.z, b.w); *(u32x2*)p = w; }
constexpr float W8_SCALE = 32.0f;
__device__ __forceinline__ float silu_f(float x) { return x * __builtin_amdgcn_rcpf(1.0f + __builtin_amdgcn_exp2f(-1.4426950408889634f * x)); }
__device__ __forceinline__ float gelu_tanh_f(float x) {
    const float w = x * __builtin_fmaf(x * x, -0.1029432396f, -2.3022081981f); return x * __builtin_amdgcn_rcpf(1.0f + __builtin_amdgcn_exp2f(w)); }

#define XB_TMO      128
#define XB_XCNT(j)  (256  + 64 * (j))
#define XB_XSUB(j)  (1280 + 64 * (j))
#define XB_XGEN(j)  (2304 + 64 * (j))
#define XB_TOP      3328
#define XB_TOPGEN   3392
#define XCD_BAR_WORDS 3456
#define XB_SPIN_CAP (1u << 21)
__device__ __forceinline__ unsigned xb_ld(unsigned* p)              { return __hip_atomic_load(p, __ATOMIC_RELAXED, __HIP_MEMORY_SCOPE_AGENT); }
__device__ __forceinline__ unsigned xb_add(unsigned* p, unsigned v) { return __hip_atomic_fetch_add(p, v, __ATOMIC_RELAXED, __HIP_MEMORY_SCOPE_AGENT); }
__device__ __forceinline__ unsigned xb_xcc_id() { return (unsigned)__builtin_amdgcn_s_getreg((3 << 11) | 20) & 0xFu; }
#define XB_SPIN(cond, bar) do { unsigned _sp = 0; while (cond) { __builtin_amdgcn_s_sleep(1); \
    if ((++_sp & 255u) == 0u) { if (xb_ld(&(bar)[XB_TMO])) break; if (_sp > XB_SPIN_CAP) { atomicAdd(&(bar)[XB_TMO], 1u); break; } } } } while (0)
struct XcdBarrier { unsigned* bar; unsigned x; volatile LAS unsigned* st; };
__device__ __forceinline__ XcdBarrier xcd_barrier_post(unsigned* bar, volatile LAS unsigned* st, bool t0) {
    XcdBarrier b; b.bar = bar; b.x = xb_xcc_id(); b.st = st;
    if (t0) (void)xb_add(&bar[XB_XCNT(b.x)], 1u);
    return b;
}
__device__ __forceinline__ void xcd_barrier_complete(unsigned* bar, unsigned x, unsigned& nloc, unsigned& nx) {
    const unsigned G = gridDim.x * gridDim.y * gridDim.z;
    unsigned sum, cnt, mine, sp = 0u;
    for (;;) {
        sum = 0u; cnt = 0u; mine = 0u;
#pragma unroll
        for (unsigned j = 0; j < 16; ++j) { const unsigned c = xb_ld(&bar[XB_XCNT(j)]); sum += c; cnt += (c > 0u) ? 1u : 0u; mine = (j == x) ? c : mine; }
        if (sum == G) break;
        __builtin_amdgcn_s_sleep(1);
        if ((++sp & 255u) == 0u) { if (xb_ld(&bar[XB_TMO])) break; if (sp > XB_SPIN_CAP) { atomicAdd(&bar[XB_TMO], 1u); break; } }
    }
    nloc = mine > 0u ? mine : 1u; nx = cnt > 0u ? cnt : 1u;
}
__device__ __forceinline__ void xcd_barrier(const XcdBarrier& b, bool t0) {
    asm volatile("s_waitcnt vmcnt(0)" ::: "memory");
    __syncthreads();
    if (t0) {
        unsigned* bar = b.bar;
        __builtin_amdgcn_s_waitcnt(0);
        unsigned nloc = b.st[0], nx = b.st[1];
        if (nloc == 0u) { xcd_barrier_complete(bar, b.x, nloc, nx); b.st[0] = nloc; b.st[1] = nx; }
        const unsigned old = xb_add(&bar[XB_XSUB(b.x)], 1u);
        const unsigned gen = old / nloc;
        if (old + 1u == (gen + 1u) * nloc) {
            __builtin_amdgcn_fence(__ATOMIC_RELEASE, "agent");
            asm volatile("s_waitcnt vmcnt(0)" ::: "memory");
            const unsigned og = xb_add(&bar[XB_TOP], 1u);
            const unsigned tg = og / nx;
            if (og + 1u == (tg + 1u) * nx) xb_add(&bar[XB_TOPGEN], 1u);
            else XB_SPIN(xb_ld(&bar[XB_TOPGEN]) == tg, bar);
            __builtin_amdgcn_fence(__ATOMIC_ACQUIRE, "agent");
            xb_add(&bar[XB_XGEN(b.x)], 1u);
            asm volatile("s_waitcnt vmcnt(0)" ::: "memory");
        } else {
            XB_SPIN(xb_ld(&bar[XB_XGEN(b.x)]) == gen, bar);
            __builtin_amdgcn_fence(__ATOMIC_ACQUIRE, "agent");
            asm volatile("s_waitcnt vmcnt(0)" ::: "memory");
        }
    }
    __syncthreads();
}

namespace pg8 {
constexpr int BM = 256, BK = 64, HALF = 128, HTB = HALF * BK * 2, STAGE_BYTES = 8 * HTB, NXCD = 8, WGM = 8;
__host__ __device__ __forceinline__ int lds_byte(int r, int c) { const int st = (r >> 4) * 2 + (c >> 5), rr = r & 15, cc = c & 31, ob = rr * 64 + cc * 2; return st * 1024 + (ob ^ (((ob >> 9) & 1) << 5)); }
__host__ __device__ __forceinline__ void stage_rc(int b, int& R, int& C) { const int st = b / 1024, sb = b % 1024, swz = sb ^ (((sb >> 9) & 1) << 5); R = (st >> 1) * 16 + swz / 64; C = (st & 1) * 32 + (swz % 64) / 2; }
__host__ __device__ __forceinline__ int perm32(int rho) { const int n = rho >> 4, i = rho & 15; return 8 * (i >> 2) + 4 * n + (i & 3); }

struct Unit { int pm, pn, e, lbase, nvalid, pn2, sub; };
struct Gemm { const bf16* A; const bf16* Bt; int M, N, K; int KB = 0; };

struct StaticOrder {
    static constexpr bool GATHER = false;
    int nM, nN, nwg, G, c;
    __device__ void init(int M_, int N_, int G_, int c_) { nM = M_ / BM; nN = N_ / BM; nwg = nM * nN; G = G_; c = c_; }
    __device__ bool next(int i, Unit& u) const {
        const long L = (long)i * G + c; if (L >= nwg) return false;
        int wgid = (int)L; { const int q = nwg / NXCD, r = nwg % NXCD, xcd = wgid % NXCD, off = wgid / NXCD; wgid = (xcd < r ? xcd * (q + 1) : r * (q + 1) + (xcd - r) * q) + off; }
        const int nig = WGM * nN, gid = wgid / nig, fm = gid * WGM, gsz = (nM - fm) < WGM ? (nM - fm) : WGM;
        u.pm = fm + ((wgid % nig) % gsz); u.pn = (wgid % nig) / gsz; u.e = 0; u.lbase = 0; u.nvalid = 256; u.pn2 = u.pn; u.sub = 0; return true;
    }
    __device__ __forceinline__ int arow(const Unit& u, int r) const { return u.pm * BM + r; }
};
template <bool GATHER_> struct MoeOrder {
    static constexpr bool GATHER = GATHER_;
    const LAS int* tp; const LAS int* cnt; const int4* list; int NT, nwg, G, c; const LAS int* ord;
    __device__ bool next(int i, Unit& u) const {
        const long L = (long)i * G + c; if (L >= nwg) return false;
        int w = (int)L; { const int q = nwg / NXCD, r = nwg % NXCD, xcd = w % NXCD, off = w / NXCD; w = (xcd < r ? xcd * (q + 1) : r * (q + 1) + (xcd - r) * q) + off; }
        const int po = w / NT, pnl = w - po * NT, pmg = ord[po];
        typedef int i32x4 __attribute__((ext_vector_type(4)));
        const i32x4 t0 = *(const LAS i32x4*)tp, t1 = *(const LAS i32x4*)(tp + 4), t2 = *(const LAS i32x4*)(tp + 8), t3 = *(const LAS i32x4*)(tp + 12), t4 = *(const LAS i32x4*)(tp + 16), t5 = *(const LAS i32x4*)(tp + 20);
        const int e = (pmg >= t0.y) + (pmg >= t0.z) + (pmg >= t0.w) + (pmg >= t1.x) + (pmg >= t1.y) + (pmg >= t1.z) + (pmg >= t1.w)
                    + (pmg >= t2.x) + (pmg >= t2.y) + (pmg >= t2.z) + (pmg >= t2.w) + (pmg >= t3.x) + (pmg >= t3.y) + (pmg >= t3.z) + (pmg >= t3.w)
                    + (pmg >= t4.x) + (pmg >= t4.y) + (pmg >= t4.z) + (pmg >= t4.w) + (pmg >= t5.x) + (pmg >= t5.y) + (pmg >= t5.z) + (pmg >= t5.w);
        static_assert(NL == 24, "MoeOrder::next reads tp[0..23]");
        const int tile = pmg - tp[e];
        const int g4 = e / 6, p6 = e - 6 * g4, lo = p6 < 3 ? 0 : (p6 < 5 ? 1 : 2), hi = p6 < 3 ? p6 + 1 : (p6 < 5 ? p6 - 1 : 3), elo = 4 * g4 + lo, ehi = 4 * g4 + hi;
        u.pm = pmg; u.e = e; u.sub = pnl; u.lbase = e * CAP + tile * 256; const int nv = cnt[e] - tile * 256; u.nvalid = nv < 256 ? nv : 256;
        if (GATHER_) { u.pn = (pnl < 4 ? elo : ehi) * 4 + (pnl & 3); u.pn2 = u.pn; }
        else { u.pn = elo * NT + pnl; u.pn2 = ehi * NT + pnl; }
        return true;
    }
    __device__ __forceinline__ int arow(const Unit& u, int r) const { if (!GATHER_) return u.pm * BM + r; return r < u.nvalid ? list[u.lbase + r].x : 0; }
};

template <class Epi, class Sched>
__device__ __forceinline__ void gemm_simple(int wid, int lane, const Gemm g, const Sched& S, const Epi& E) {
    const int wr = wid >> 2, wc = wid & 3, fr = lane & 15, fq = lane >> 4;
    const int K = g.K;
    for (int ui = 0;; ++ui) {
        Unit u; if (!S.next(ui, u)) break;
        f32x4 acc[2][2][4][2];
#pragma unroll
        for (int a = 0; a < 2; ++a)
#pragma unroll
            for (int b = 0; b < 2; ++b)
#pragma unroll
                for (int m = 0; m < 4; ++m)
#pragma unroll
                    for (int n = 0; n < 2; ++n) acc[a][b][m][n] = (f32x4){0.f, 0.f, 0.f, 0.f};
        unsigned ap[2][4], bp[2][2];
#pragma unroll
        for (int a = 0; a < 2; ++a)
#pragma unroll
            for (int m = 0; m < 4; ++m) ap[a][m] = (unsigned)S.arow(u, a * HALF + wr * 64 + m * 16 + fr) * (unsigned)K + fq * 8;
#pragma unroll
        for (int b = 0; b < 2; ++b)
#pragma unroll
            for (int n = 0; n < 2; ++n) { const int rho = 16 * n + fr; bp[b][n] = (unsigned)(u.pn * BM + b * HALF + wc * 32 + (Epi::PERM ? perm32(rho) : rho)) * (unsigned)K + fq * 8; }
#pragma unroll 1
        for (int k = 0; k < K; k += 32) {
            bf16x8 Af[2][4], Bf[2][2];
#pragma unroll
            for (int a = 0; a < 2; ++a)
#pragma unroll
                for (int m = 0; m < 4; ++m) Af[a][m] = *(const bf16x8*)(g.A + ap[a][m] + k);
#pragma unroll
            for (int b = 0; b < 2; ++b)
#pragma unroll
                for (int n = 0; n < 2; ++n) Bf[b][n] = *(const bf16x8*)(g.Bt + bp[b][n] + k);
#pragma unroll
            for (int a = 0; a < 2; ++a)
#pragma unroll
                for (int b = 0; b < 2; ++b)
#pragma unroll
                    for (int m = 0; m < 4; ++m)
#pragma unroll
                        for (int n = 0; n < 2; ++n) acc[a][b][m][n] = __builtin_amdgcn_mfma_f32_16x16x32_bf16(Bf[b][n], Af[a][m], acc[a][b][m][n], 0, 0, 0);
        }
        E(acc, u, wr, wc, fr, fq);
    }
}

typedef int v8i32 __attribute__((ext_vector_type(8)));
typedef int v4i32 __attribute__((ext_vector_type(4)));
template <class Epi, class Sched, bool F8 = false>
__device__ __forceinline__ void gemm_phase(int wid, int lane, LAS unsigned char* lds, const Gemm g, const Sched& S, const Epi& E) {
    const int tid = wid * 64 + lane, wr = wid >> 2, wc = wid & 3, fr = lane & 15, fq = lane >> 4;
    const int K = F8 ? g.K / 2 : g.K  , nt = K / BK;
    const int KBr = g.KB ? (F8 ? g.KB / 2 : g.KB) : K  , ntB = KBr / BK;
    unsigned voffA[2], voffB[2]; int Rr[2], Cc[2];
#pragma unroll
    for (int i = 0; i < 2; ++i) { int R, C; stage_rc(tid * 16 + i * 8192, R, C); const int Rb = Epi::PERM ? ((R & ~31) + perm32(R & 31)) : R;
        voffA[i] = (unsigned)(R * K + C) * 2u; voffB[i] = (unsigned)(Rb * KBr + C) * 2u; Rr[i] = R; Cc[i] = C; }
    const unsigned kstep = (unsigned)(BK * 2);
    const unsigned hstep = (unsigned)HALF * (unsigned)K * 2u;
    const unsigned tstep = 2 * hstep;
    const unsigned hstepB = (unsigned)HALF * (unsigned)KBr * 2u, tstepB = 2 * hstepB;
    const __amdgpu_buffer_rsrc_t rsA = make_rsrc(g.A, 0x7fffffff), rsB = make_rsrc(g.Bt, 0x7fffffff);
    const unsigned ldsw = (unsigned)wid * 1024u;
    const int aoff0 = lds_byte(wr * 64 + fr, F8 ? fq * 16 : fq * 8), aoff1 = F8 ? lds_byte(wr * 64 + fr, fq * 16 + 8) : aoff0 + 1024;
    const int boff0 = lds_byte(wc * 32 + fr, F8 ? fq * 16 : fq * 8), boff1 = F8 ? lds_byte(wc * 32 + fr, fq * 16 + 8) : boff0 + 1024;
#define PG8_SA(b, h) (((b) * 2 + (h)) * HTB)
#define PG8_SB(b, h) ((4 + (b) * 2 + (h)) * HTB)
#define PG8_STAGE(bufoff, soff, voff) do { _Pragma("unroll") for (int _i = 0; _i < 2; ++_i) \
        __builtin_amdgcn_raw_ptr_buffer_load_lds(rsB, (LAS void*)(lds + (bufoff) + ldsw + _i * 8192), 16, (int)(voff)[_i], (int)(soff), 0, 0); } while (0)
#define PG8_STAGE_A(bufoff, h, contig_off, kt_bytes, use_next) do { _Pragma("unroll") for (int _i = 0; _i < 2; ++_i) { \
        const unsigned vo_ = Sched::GATHER ? ((use_next) ? gN[h][_i] : gC[h][_i]) : voffA[_i]; const unsigned so_ = Sched::GATHER ? (unsigned)(kt_bytes) : (unsigned)(contig_off); \
        __builtin_amdgcn_raw_ptr_buffer_load_lds(rsA, (LAS void*)(lds + (bufoff) + ldsw + _i * 8192), 16, (int)vo_, (int)so_, 0, 0); } } while (0)
#define PG8_GOFF(u_, o_) do { _Pragma("unroll") for (int _h = 0; _h < 2; ++_h) _Pragma("unroll") for (int _i = 0; _i < 2; ++_i) \
        o_[_h][_i] = ((unsigned)S.arow(u_, _h * HALF + Rr[_i]) * (unsigned)K + (unsigned)Cc[_i]) * 2u; } while (0)
#define PG8_LDA(dst, b, h) do { _Pragma("unroll") for (int m = 0; m < 4; ++m) { dst[m][0] = *(const LAS bf16x8*)(lds + PG8_SA(b, h) + aoff0 + m * 2048); dst[m][1] = *(const LAS bf16x8*)(lds + PG8_SA(b, h) + aoff1 + m * 2048); } } while (0)
#define PG8_LDB(dst, b, h) do { _Pragma("unroll") for (int n = 0; n < 2; ++n) { dst[n][0] = *(const LAS bf16x8*)(lds + PG8_SB(b, h) + boff0 + n * 2048); dst[n][1] = *(const LAS bf16x8*)(lds + PG8_SB(b, h) + boff1 + n * 2048); } } while (0)
#define PG8_V8(x_) __builtin_shufflevector(__builtin_bit_cast(v4i32, (x_)[0]), __builtin_bit_cast(v4i32, (x_)[1]), 0, 1, 2, 3, 4, 5, 6, 7)
#define PG8_MMA(ai, bj, At, Bt) do { __builtin_amdgcn_s_setprio(1); _Pragma("unroll") for (int m = 0; m < 4; ++m) _Pragma("unroll") for (int n = 0; n < 2; ++n) { \
        if constexpr (F8) { const v8i32 b8_ = PG8_V8(Bt[n]), a8_ = PG8_V8(At[m]);   \
            asm volatile("v_mfma_scale_f32_16x16x128_f8f6f4 %0, %1, %2, %0, %3, %4 op_sel_hi:[0,0,0]" : "+v"(acc[ai][bj][m][n]) : "v"(b8_), "v"(a8_), "v"(sc_w), "v"(sc_a)); } \
        else { _Pragma("unroll") for (int k = 0; k < 2; ++k) acc[ai][bj][m][n] = __builtin_amdgcn_mfma_f32_16x16x32_bf16(Bt[n][k], At[m][k], acc[ai][bj][m][n], 0, 0, 0); } } \
        __builtin_amdgcn_s_setprio(0); } while (0)
#define PG8_WAIT_V(n) asm volatile("s_waitcnt vmcnt(" #n ")" ::: "memory")
#define PG8_WAIT_L(n) asm volatile("s_waitcnt lgkmcnt(" #n ")" ::: "memory")
#define PG8_BAR __builtin_amdgcn_s_barrier()
#define PG8_SCHED __builtin_amdgcn_sched_barrier(0)
    const int sc_w = 0x7a7a7a7a  , sc_a = 0x7f7f7f7f  ; (void)sc_w; (void)sc_a;
    Unit cur, nxt; int ui = 0; int relaxN = 0;
    if (!S.next(0, cur)) return;
    unsigned gC[2][2], gN[2][2];
    if constexpr (Sched::GATHER) { PG8_GOFF(cur, gC); }
    else {
#pragma unroll
        for (int h = 0; h < 2; ++h)
#pragma unroll
            for (int i = 0; i < 2; ++i) { gC[h][i] = 0u; gN[h][i] = 0u; } }
    f32x4 acc[2][2][4][2];
#pragma unroll
    for (int a = 0; a < 2; ++a)
#pragma unroll
        for (int b = 0; b < 2; ++b)
#pragma unroll
            for (int m = 0; m < 4; ++m)
#pragma unroll
                for (int n = 0; n < 2; ++n) acc[a][b][m][n] = (f32x4){0.f, 0.f, 0.f, 0.f};
    bf16x8 At[4][2], B0[2][2], B1[2][2];
    unsigned cA = Sched::GATHER ? 0u : (unsigned)cur.pm * tstep, cB = (unsigned)cur.pn * tstepB, cB2 = (unsigned)cur.pn2 * tstepB - (unsigned)ntB * kstep;
    PG8_STAGE(PG8_SB(0, 0), cB, voffB); PG8_STAGE(PG8_SB(0, 1), cB + hstepB, voffB); PG8_STAGE_A(PG8_SA(0, 0), 0, cA, 0, false); PG8_STAGE_A(PG8_SA(0, 1), 1, cA + hstep, 0, false);
    if (wr == 1) PG8_BAR;
    PG8_WAIT_V(2); PG8_BAR;
    PG8_STAGE(PG8_SB(1, 0), cB + kstep, voffB); PG8_STAGE_A(PG8_SA(1, 0), 0, cA + kstep, kstep, false); PG8_STAGE(PG8_SB(1, 1), cB + hstepB + kstep, voffB);
    PG8_WAIT_V(6); PG8_BAR;
    for (;;) {
        const bool has_next = S.next(ui + 1, nxt);
        if constexpr (Sched::GATHER) { if (has_next) { PG8_GOFF(nxt, gN); } else {
#pragma unroll
            for (int h = 0; h < 2; ++h)
#pragma unroll
                for (int i = 0; i < 2; ++i) gN[h][i] = gC[h][i]; } }
        const unsigned nA = (has_next && !Sched::GATHER) ? (unsigned)nxt.pm * tstep : cA, nB = has_next ? (unsigned)nxt.pn * tstepB : cB, nB2 = has_next ? (unsigned)nxt.pn2 * tstepB - (unsigned)ntB * kstep : cB2;
        for (int t = 0; t < nt; t += 2) {
            const bool last = (t == nt - 2);
            const unsigned a1 = cA + (unsigned)(t + 1) * kstep;
            const unsigned a2 = last ? nA : cA + (unsigned)(t + 2) * kstep, b2 = last ? nB : ((t + 2) < ntB ? cB : cB2) + (unsigned)(t + 2) * kstep;
            const unsigned a3 = a2 + kstep, b3 = last ? nB + kstep : ((t + 3) < ntB ? cB : cB2) + (unsigned)(t + 3) * kstep;
            const unsigned k1 = (unsigned)(t + 1) * kstep, k2 = last ? 0u : (unsigned)(t + 2) * kstep, k3 = k2 + kstep;
            const bool first = (t == 0), rlx = first && relaxN > 0, halfu = cur.nvalid <= 128;
#define PG8_WAIT_VR() do { if (rlx) { if (relaxN == 8) PG8_WAIT_V(16); else if (relaxN == 16) PG8_WAIT_V(24); else PG8_WAIT_V(8); } else PG8_WAIT_V(8); } while (0)
            PG8_LDB(B0, 0, 0); PG8_LDB(B1, 0, 1); PG8_SCHED; PG8_LDA(At, 0, 0); if (!(first && ui > 0)) PG8_STAGE_A(PG8_SA(1, 1), 1, a1 + hstep, k1, false);
            PG8_WAIT_VR(); PG8_WAIT_L(0); PG8_BAR; PG8_MMA(0, 0, At, B0); PG8_MMA(0, 1, At, B1); PG8_BAR; PG8_SCHED;
            PG8_LDA(At, 0, 1); PG8_STAGE(PG8_SB(0, 0), b2, voffB); PG8_STAGE(PG8_SB(0, 1), b2 + hstepB, voffB); PG8_STAGE_A(PG8_SA(0, 0), 0, a2, k2, last);
            PG8_WAIT_VR(); PG8_WAIT_L(0); PG8_BAR; if (!halfu) { PG8_MMA(1, 0, At, B0); PG8_MMA(1, 1, At, B1); } PG8_BAR; PG8_SCHED;
            PG8_LDB(B0, 1, 0); PG8_LDB(B1, 1, 1); PG8_SCHED; PG8_LDA(At, 1, 0); PG8_STAGE_A(PG8_SA(0, 1), 1, a2 + hstep, k2, last);
            PG8_WAIT_VR(); PG8_WAIT_L(0); PG8_BAR; PG8_MMA(0, 0, At, B0); PG8_MMA(0, 1, At, B1); PG8_BAR; PG8_SCHED;
            PG8_LDA(At, 1, 1); PG8_STAGE(PG8_SB(1, 0), b3, voffB); PG8_STAGE(PG8_SB(1, 1), b3 + hstepB, voffB); PG8_STAGE_A(PG8_SA(1, 0), 0, a3, k3, last);
            PG8_WAIT_V(8); PG8_WAIT_L(0); PG8_BAR; if (!halfu) { PG8_MMA(1, 0, At, B0); PG8_MMA(1, 1, At, B1); } PG8_BAR; PG8_SCHED;
            if (last && has_next) { PG8_STAGE_A(PG8_SA(1, 1), 1, a3 + hstep, k3, true); PG8_SCHED; }
#undef PG8_WAIT_VR
        }
        if (wr == 0) PG8_BAR;
        if constexpr (F8) asm volatile("s_nop 15\n\ts_nop 15" ::: "memory");
        E(acc, cur, wr, wc, fr, fq);
        relaxN = has_next ? E.stores_lb(cur) : 0;
        if (!has_next) break;
#pragma unroll
        for (int a = 0; a < 2; ++a)
#pragma unroll
            for (int b = 0; b < 2; ++b)
#pragma unroll
                for (int m = 0; m < 4; ++m)
#pragma unroll
                    for (int n = 0; n < 2; ++n) acc[a][b][m][n] = (f32x4){0.f, 0.f, 0.f, 0.f};
        cur = nxt; cA = nA; cB = nB; cB2 = nB2; ++ui;
#pragma unroll
        for (int h = 0; h < 2; ++h)
#pragma unroll
            for (int i = 0; i < 2; ++i) gC[h][i] = gN[h][i];
        if (wr == 1) PG8_BAR;
    }
    PG8_WAIT_V(0);
    PG8_BAR;
#undef PG8_SA
#undef PG8_SB
#undef PG8_STAGE
#undef PG8_STAGE_A
#undef PG8_GOFF
#undef PG8_LDA
#undef PG8_LDB
#undef PG8_MMA
#undef PG8_V8
#undef PG8_WAIT_V
#undef PG8_WAIT_L
#undef PG8_BAR
#undef PG8_SCHED
}
}
using pg8::Unit; using pg8::Gemm; using pg8::HALF; using pg8::BM;

#if USE_FAST_GEMM
#define GEMM_PHASE(EpiT, SchedT, lds, g, S, E) pg8::gemm_phase<EpiT, SchedT>(F.wave0, fresh_lane(), lds, g, S, E)
#define GEMM_PHASE_F8(EpiT, SchedT, lds, g, S, E) pg8::gemm_phase<EpiT, SchedT, true>(F.wave0, fresh_lane(), lds, g, S, E)
#else
#define GEMM_PHASE(EpiT, SchedT, lds, g, S, E) pg8::gemm_simple<EpiT, SchedT>(F.wave0, fresh_lane(), g, S, E)
#endif

__device__ __forceinline__ void st_bf8(bf16* p, f32x4 a, f32x4 b) { u32x4 w; w.x = pk2(a.x, a.y); w.y = pk2(a.z, a.w); w.z = pk2(b.x, b.y); w.w = pk2(b.z, b.w); *(u32x4*)p = w; }
__device__ __forceinline__ float lane32_partner(float v, bool upper) {
    auto rr = __builtin_amdgcn_permlane32_swap(__float_as_uint(v), __float_as_uint(v), false, false); return __uint_as_float(upper ? rr[0] : rr[1]);
}
struct EpiInProj {
    static constexpr bool PERM = true, AFTER_DRAIN = false;
    bf16* PROJ; bf16* Q; bf16* KB; bf16* VB; const LAS float* tabc; const LAS float* tabs; int pn_off;
    __device__ __forceinline__ int stores_lb(const Unit& u) const { return (u.pn + pn_off) < 8 ? 8 : 16; }
    __device__ __forceinline__ void operator()(const f32x4 (&acc)[2][2][4][2], const Unit& u, int wr, int wc, int fr, int fq) const {
        const int pn = u.pn + pn_off;
        if (pn < 8) {
#pragma unroll
            for (int ai = 0; ai < 2; ++ai)
#pragma unroll
                for (int m = 0; m < 4; ++m) { const int row = u.pm * BM + ai * HALF + wr * 64 + m * 16 + fr;
                    st_bf8(PROJ + (size_t)row * 2048 + pn * 128 + wc * 32 + 8 * fq, acc[ai][0][m][0] * acc[ai][1][m][0], acc[ai][0][m][1] * acc[ai][1][m][1]); }
        } else if (pn < 12) {
#pragma unroll
            for (int ai = 0; ai < 2; ++ai)
#pragma unroll
                for (int m = 0; m < 4; ++m) { const int row = u.pm * BM + ai * HALF + wr * 64 + m * 16 + fr; bf16* rp = PROJ + (size_t)row * 2048 + 1024 + (pn - 8) * 256 + wc * 32 + 8 * fq;
#pragma unroll
                    for (int bj = 0; bj < 2; ++bj) st_bf8(rp + bj * HALF, acc[ai][bj][m][0], acc[ai][bj][m][1]); }
        } else if (pn < 20) {
            const bool isq = pn < 16; const int cb = (pn - (isq ? 12 : 16)) * 256 + wc * 32 + 8 * fq; const size_t kb_minus_q = (size_t)((unsigned char*)KB - (unsigned char*)Q); const int axis = wc & 1; const bool upper = fq >= 2; const int fo = 8 * (fq & 1);
#pragma unroll
            for (int ai = 0; ai < 2; ++ai)
#pragma unroll
                for (int m = 0; m < 4; ++m) { const int row = u.pm * BM + ai * HALF + wr * 64 + m * 16 + fr; const int t = row & (SEQ - 1), b = row >> 13;
                    const int pos = axis ? (t & 63) : (t >> 6);
                    f32x4 cs0 = *(const LAS f32x4*)(tabc + pos * 16 + fo), cs1 = *(const LAS f32x4*)(tabc + pos * 16 + fo + 4); f32x4 sn0 = *(const LAS f32x4*)(tabs + pos * 16 + fo), sn1 = *(const LAS f32x4*)(tabs + pos * 16 + fo + 4);
                    if (!upper) { sn0 = -sn0; sn1 = -sn1; }
                    unsigned char* rp = (unsigned char*)Q + (isq ? ((size_t)row * 1024 + cb) : (kb_minus_q + ((size_t)b * KV + CTXL + t) * 1024 + cb));
                    if (isq) { cs0 = cs0 * QSCALE; cs1 = cs1 * QSCALE; sn0 = sn0 * QSCALE; sn1 = sn1 * QSCALE; }
#pragma unroll
                    for (int bj = 0; bj < 2; ++bj) { const f32x4 a0 = acc[ai][bj][m][0], a1 = acc[ai][bj][m][1];
                        const f32x4 p0 = (f32x4){lane32_partner(a0.x, upper), lane32_partner(a0.y, upper), lane32_partner(a0.z, upper), lane32_partner(a0.w, upper)};
                        const f32x4 p1 = (f32x4){lane32_partner(a1.x, upper), lane32_partner(a1.y, upper), lane32_partner(a1.z, upper), lane32_partner(a1.w, upper)};
                        st_f8x8(rp + bj * HALF, a0 * cs0 + p0 * sn0, a1 * cs1 + p1 * sn1); } }
        } else {
            const int cb = (pn - 20) * 256 + wc * 32 + 8 * fq;
#pragma unroll
            for (int ai = 0; ai < 2; ++ai)
#pragma unroll
                for (int m = 0; m < 4; ++m) { const int row = u.pm * BM + ai * HALF + wr * 64 + m * 16 + fr; const int t = row & (SEQ - 1), b = row >> 13;
                    unsigned char* rp = (unsigned char*)VB + ((size_t)b * KV + CTXL + t) * 1024 + cb;
#pragma unroll
                    for (int bj = 0; bj < 2; ++bj) st_f8x8(rp + bj * HALF, acc[ai][bj][m][0], acc[ai][bj][m][1]); }
        }
    }
};
struct EpiCtx {
    static constexpr bool PERM = true, AFTER_DRAIN = false;
    bf16* KB; bf16* VB;
    __device__ __forceinline__ int stores_lb(const Unit&) const { return 16; }
    __device__ __forceinline__ void operator()(const f32x4 (&acc)[2][2][4][2], const Unit& u, int wr, int wc, int fr, int fq) const {
        const bool isk = u.pn < 4; const int cb = (u.pn & 3) * 256 + wc * 32 + 8 * fq;
#pragma unroll
        for (int ai = 0; ai < 2; ++ai)
#pragma unroll
            for (int m = 0; m < 4; ++m) { const int row = u.pm * BM + ai * HALF + wr * 64 + m * 16 + fr; const int t = row & (CTXL - 1), b = row >> 8;
                const size_t eo = ((size_t)b * KV + t) * 1024 + cb;
#pragma unroll
                for (int bj = 0; bj < 2; ++bj) st_f8x8((unsigned char*)(isk ? KB : VB) + eo + bj * HALF, acc[ai][bj][m][0], acc[ai][bj][m][1]); }
    }
};
template <bool RES_F32> struct EpiRes {
    static constexpr bool PERM = true, AFTER_DRAIN = false;
    const float* xf; const bf16* xb; const float* gate  ; bf16* R;
    __device__ __forceinline__ int stores_lb(const Unit&) const { return 16; }
    struct Raw { f32x4 f[2][2][2]; u32x4 h[2][2]; };
    __device__ __forceinline__ void load(Raw& r, const Unit& u, int st, int wr, int fr, int cb) const {
        const int ai = st >> 1, mp = (st & 1) * 2;
#pragma unroll
        for (int mm = 0; mm < 2; ++mm) { const size_t off = (size_t)(u.pm * BM + ai * HALF + wr * 64 + (mp + mm) * 16 + fr) * D + cb;
#pragma unroll
            for (int bj = 0; bj < 2; ++bj) {
                if (RES_F32) { r.f[mm][bj][0] = *(const f32x4*)(xf + off + bj * HALF); r.f[mm][bj][1] = *(const f32x4*)(xf + off + bj * HALF + 4); }
                else r.h[mm][bj] = *(const u32x4*)(xb + off + bj * HALF); } }
    }
    __device__ __forceinline__ void operator()(const f32x4 (&acc)[2][2][4][2], const Unit& u, int wr, int wc, int fr, int fq) const {
        const int cb = u.pn * BM + wc * 32 + 8 * fq; const int b = (u.pm * BM) >> 13;
        f32x4 gv[2][2];
#pragma unroll
        for (int bj = 0; bj < 2; ++bj)
#pragma unroll
            for (int n = 0; n < 2; ++n) gv[bj][n] = *(const f32x4*)(gate + (size_t)b * (6 * D) + cb + bj * HALF + 4 * n);
        Raw ra, rb2; load(ra, u, 0, wr, fr, cb);
#pragma unroll
        for (int st = 0; st < 4; ++st) {
            Raw& cur = (st & 1) ? rb2 : ra; Raw& nxt = (st & 1) ? ra : rb2;
            if (st < 3) load(nxt, u, st + 1, wr, fr, cb);
            const int ai = st >> 1, mp = (st & 1) * 2;
#pragma unroll
            for (int mm = 0; mm < 2; ++mm) { const size_t off = (size_t)(u.pm * BM + ai * HALF + wr * 64 + (mp + mm) * 16 + fr) * D + cb;
#pragma unroll
                for (int bj = 0; bj < 2; ++bj) { f32x4 r0, r1;
                    if (RES_F32) { r0 = cur.f[mm][bj][0]; r1 = cur.f[mm][bj][1]; }
                    else { const u32x4 w = cur.h[mm][bj]; r0 = (f32x4){bf_lo(w.x), bf_hi(w.x), bf_lo(w.y), bf_hi(w.y)}; r1 = (f32x4){bf_lo(w.z), bf_hi(w.z), bf_lo(w.w), bf_hi(w.w)}; }
                    st_bf8(R + off + bj * HALF, r0 * ALPHA + gv[bj][0] * acc[ai][bj][mp + mm][0], r1 * ALPHA + gv[bj][1] * acc[ai][bj][mp + mm][1]); } }
        }
    }
};
struct EpiGU {
    static constexpr bool PERM = true, AFTER_DRAIN = false;
    unsigned char* HID;
    const int4* list;
    __device__ __forceinline__ int stores_lb(const Unit&) const { return 8; }
    __device__ __forceinline__ void operator()(const f32x4 (&acc)[2][2][4][2], const Unit& u, int wr, int wc, int fr, int fq) const {
        const int cb = u.sub * 128 + wc * 32 + 8 * fq; const bool hiw = u.sub >= 4;
        float wgt[2][4];
#pragma unroll
        for (int ai = 0; ai < 2; ++ai)
#pragma unroll
            for (int m = 0; m < 4; ++m) { const int rl = ai * HALF + wr * 64 + m * 16 + fr; const int4 le = list[u.lbase + (rl < u.nvalid ? rl : 0)]; wgt[ai][m] = __int_as_float(hiw ? le.z : le.y); }
#pragma unroll
        for (int ai = 0; ai < 2; ++ai)
#pragma unroll
            for (int m = 0; m < 4; ++m) { const int row = u.pm * BM + ai * HALF + wr * 64 + m * 16 + fr; const float w_ = wgt[ai][m];
                const f32x4 g0 = acc[ai][0][m][0], g1 = acc[ai][0][m][1], u0 = acc[ai][1][m][0] * w_, u1 = acc[ai][1][m][1] * w_; u32x2 w;
                w.x = pk4_fp8(silu_f(g0.x) * u0.x, silu_f(g0.y) * u0.y, silu_f(g0.z) * u0.z, silu_f(g0.w) * u0.w); w.y = pk4_fp8(silu_f(g1.x) * u1.x, silu_f(g1.y) * u1.y, silu_f(g1.z) * u1.z, silu_f(g1.w) * u1.w);
                *(u32x2*)(HID + (size_t)row * (2 * ED) + cb) = w; }
    }
};
struct EpiDown {
    static constexpr bool PERM = true, AFTER_DRAIN = false;
    const int4* list; bf16* YB;
    __device__ __forceinline__ int stores_lb(const Unit& u) const { return u.nvalid == 256 ? 16 : 0; }
    __device__ __forceinline__ void operator()(const f32x4 (&acc)[2][2][4][2], const Unit& u, int wr, int wc, int fr, int fq) const {
        const int cb = u.sub * 256 + wc * 32 + 8 * fq;
        int tok[2][4];
#pragma unroll
        for (int ai = 0; ai < 2; ++ai)
#pragma unroll
            for (int m = 0; m < 4; ++m) { const int rl = ai * HALF + wr * 64 + m * 16 + fr; tok[ai][m] = list[u.lbase + (rl < u.nvalid ? rl : 0)].x; }
#pragma unroll
        for (int ai = 0; ai < 2; ++ai)
#pragma unroll
            for (int m = 0; m < 4; ++m) { const int rl = ai * HALF + wr * 64 + m * 16 + fr;
                if (rl < u.nvalid) { bf16* rp = YB + (size_t)tok[ai][m] * D + cb;
#pragma unroll
                    for (int bj = 0; bj < 2; ++bj) st_bf8(rp + bj * HALF, acc[ai][bj][m][0], acc[ai][bj][m][1]); } }
    }
};
struct EpiGelu {
    static constexpr bool PERM = true, AFTER_DRAIN = false;
    bf16* UV; float* vst;
    __device__ __forceinline__ int stores_lb(const Unit&) const { return 16; }
    __device__ __forceinline__ void operator()(const f32x4 (&acc)[2][2][4][2], const Unit& u, int wr, int wc, int fr, int fq) const {
        const int cb = u.pn * BM + wc * 32 + 8 * fq; const bool isv = u.pn >= 8;
#pragma unroll
        for (int ai = 0; ai < 2; ++ai)
#pragma unroll
            for (int m = 0; m < 4; ++m) { const int row = u.pm * BM + ai * HALF + wr * 64 + m * 16 + fr; bf16* rp = UV + (size_t)row * 4096 + cb; float s = 0.f, s2 = 0.f;
#pragma unroll
                for (int bj = 0; bj < 2; ++bj) { f32x4 v[2];
#pragma unroll
                    for (int n = 0; n < 2; ++n) { const f32x4 a = acc[ai][bj][m][n]; v[n] = (f32x4){gelu_tanh_f(a.x), gelu_tanh_f(a.y), gelu_tanh_f(a.z), gelu_tanh_f(a.w)};
                        s += (v[n].x + v[n].y) + (v[n].z + v[n].w); s2 += (v[n].x * v[n].x + v[n].y * v[n].y) + (v[n].z * v[n].z + v[n].w * v[n].w); }
                    st_bf8(rp + bj * HALF, v[0], v[1]); }
                if (isv) { s += __shfl_xor(s, 16); s += __shfl_xor(s, 32); s2 += __shfl_xor(s2, 16); s2 += __shfl_xor(s2, 32);
                    if (fq == 0) *(f32x2*)(vst + (((size_t)row * 8 + (u.pn - 8)) * 4 + wc) * 2) = (f32x2){s, s2}; } }
    }
};

__device__ __forceinline__ int fresh_lane() { int l; asm volatile("v_mbcnt_lo_u32_b32 %0, -1, 0\n\tv_mbcnt_hi_u32_b32 %0, -1, %0" : "=v"(l)); return l; }
#define fresh_tid() (F.wave0 * 64 + fresh_lane())
#define PH_IDS const int lane = fresh_lane(), wave = F.wave0, tid = wave * 64 + lane; (void)tid; (void)lane; (void)wave
struct Frame {
    LAS unsigned char* lds; volatile LAS unsigned* MISC; unsigned* ctl;
    int vcu, G, wave0;
    const float* in[27]; float* out; unsigned char* ws;
};
#define WSP(T, off) ((T*)(F.ws + (off)))
#define MODP(l, r, i) (WSP(float, WS_MOD) + (((l) * 5 + (r)) * 6 + (i)) * D)

__device__ __forceinline__ void tr_item(const float* W, int N, bf16* WT, int Kd, int item, int mode, LAS float* scr, int lane) {
    const int nblk = N / 32, kb = item / nblk, nb = item - kb * nblk, k0 = 64 * kb, n0 = 32 * nb;
    int d0 = mode ? (((n0 >> 7) << 8) + (n0 & 127) + (mode == 2 ? 128 : 0)) : n0;
    if (mode == 3) { const int c = n0 & 1023; d0 = n0 >= 3072 ? n0 : n0 < 1024 ? (((c >> 7) << 8) + (c & 127)) : n0 < 2048 ? 2048 + c : (((c >> 7) << 8) + 128 + (c & 127)); }
#pragma unroll 8
    for (int i = 0; i < 32; ++i) { const int kk = 2 * i + (lane >> 5); scr[kk * 33 + (lane & 31)] = W[(size_t)(k0 + kk) * N + n0 + (lane & 31)]; }
    LDS_WAIT(); asm volatile("" ::: "memory");
    const int c = lane & 7;
#pragma unroll
    for (int j = 0; j < 4; ++j) { const int n = (lane >> 3) + 8 * j; const LAS float* s = scr + (8 * c) * 33 + n;
        u32x4 o; o.x = pk2(s[0 * 33], s[1 * 33]); o.y = pk2(s[2 * 33], s[3 * 33]); o.z = pk2(s[4 * 33], s[5 * 33]); o.w = pk2(s[6 * 33], s[7 * 33]);
        *(u32x4*)(WT + (size_t)(d0 + n) * Kd + k0 + 8 * c) = o; }
    LDS_WAIT(); asm volatile("" ::: "memory");
}
constexpr int CW_I_EXP = 512, CW_I_GU = 16 * CW_I_EXP, CW_I_SQ = 32 * 64;
struct TrDesc { const float* src; bf16* dst; int N, Kd; bool f8; };
template <int L> __device__ __forceinline__ TrDesc tr_desc(Frame& F, int it) {
    constexpr int I_IN = L == 0 ? 32 * 192 : 32 * 128;
    const float* W; bf16* WT; int N, Kd, mode, q; int r = it;
    bool f8 = false;
    if (r < CW_I_GU) { const int le = L * 16 + (r >> 9); q = r & 511; W = F.in[24] + (size_t)le * D * ED; N = ED; WT = (bf16*)(WSP(unsigned char, WS_WGU) + (size_t)le * 1024 * D); Kd = D; mode = 1; f8 = true; }
    else if (r < 2 * CW_I_GU) { r -= CW_I_GU; const int le = L * 16 + (r >> 9); q = r & 511; W = F.in[25] + (size_t)le * D * ED; N = ED; WT = (bf16*)(WSP(unsigned char, WS_WGU) + (size_t)le * 1024 * D); Kd = D; mode = 2; f8 = true; }
    else if (r < 2 * CW_I_GU + I_IN) { q = r - 2 * CW_I_GU; W = L == 0 ? F.in[8] : F.in[16]; N = L == 0 ? 6144 : 4096; WT = L == 0 ? WSP(bf16, WS_WINE) : WSP(bf16, WS_WINO); Kd = D; mode = L == 0 ? 3 : 0; f8 = L == 1; }
    else if (r < 2 * CW_I_GU + I_IN + CW_I_SQ) { q = r - 2 * CW_I_GU - I_IN; W = L == 0 ? F.in[15] : F.in[21]; N = D; WT = L == 0 ? WSP(bf16, WS_WOUTE) : WSP(bf16, WS_WOUTO); Kd = D; mode = 0; f8 = true; }
    else { r -= 2 * CW_I_GU + I_IN + CW_I_SQ; const int le = L * 16 + (r >> 9); q = r & 511; W = F.in[26] + (size_t)le * ED * D; N = D; WT = (bf16*)(WSP(unsigned char, WS_WDN) + (size_t)le * D * ED); Kd = ED; mode = 0; f8 = true; }
    const int nblk = N / 32, kb = q / nblk, nb = q - kb * nblk, k0 = 64 * kb, n0 = 32 * nb;
    int d0 = mode ? (((n0 >> 7) << 8) + (n0 & 127) + (mode == 2 ? 128 : 0)) : n0;
    if (mode == 3) { const int c = n0 & 1023; d0 = n0 >= 3072 ? n0 : n0 < 1024 ? (((c >> 7) << 8) + (c & 127)) : n0 < 2048 ? 2048 + c : (((c >> 7) << 8) + 128 + (c & 127)); }
    if (mode == 3) f8 = true;
    TrDesc d; d.src = W + (size_t)k0 * N + n0; d.dst = f8 ? (bf16*)((unsigned char*)WT + (size_t)d0 * Kd + k0) : WT + (size_t)d0 * Kd + k0; d.N = N; d.Kd = Kd; d.f8 = f8; return d;
}
template <int L> __device__ __forceinline__ void convert_weights(Frame& F, int gw, int NGW, int wave, int lane, int lo, int hi) {
    LAS float* scr = (LAS float*)(F.lds + wave * 16384);
    int it = lo + gw; if (it >= hi) return;
    float rg[32]; TrDesc cur = tr_desc<L>(F, it);
#pragma unroll
    for (int i = 0; i < 32; ++i) rg[i] = cur.src[(size_t)(2 * i + (lane >> 5)) * cur.N + (lane & 31)];
    for (;;) {
#pragma unroll
        for (int i = 0; i < 32; ++i) scr[(2 * i + (lane >> 5)) * 33 + (lane & 31)] = rg[i];
        LDS_WAIT(); asm volatile("" ::: "memory");
        const int nit = it + NGW; const bool more = nit < hi; TrDesc nx = cur;
        if (more) { nx = tr_desc<L>(F, nit);
#pragma unroll
            for (int i = 0; i < 32; ++i) rg[i] = nx.src[(size_t)(2 * i + (lane >> 5)) * nx.N + (lane & 31)]; }
        if (cur.f8) {
            const int c = lane & 3;
#pragma unroll
            for (int j = 0; j < 2; ++j) { const int n = (lane >> 2) + 16 * j; const LAS float* sp = scr + (16 * c) * 33 + n; u32x4 o;
                o.x = pk4_fp8(sp[0 * 33] * W8_SCALE, sp[1 * 33] * W8_SCALE, sp[2 * 33] * W8_SCALE, sp[3 * 33] * W8_SCALE); o.y = pk4_fp8(sp[4 * 33] * W8_SCALE, sp[5 * 33] * W8_SCALE, sp[6 * 33] * W8_SCALE, sp[7 * 33] * W8_SCALE);
                o.z = pk4_fp8(sp[8 * 33] * W8_SCALE, sp[9 * 33] * W8_SCALE, sp[10 * 33] * W8_SCALE, sp[11 * 33] * W8_SCALE); o.w = pk4_fp8(sp[12 * 33] * W8_SCALE, sp[13 * 33] * W8_SCALE, sp[14 * 33] * W8_SCALE, sp[15 * 33] * W8_SCALE);
                *(u32x4*)((unsigned char*)cur.dst + (size_t)n * cur.Kd + 16 * c) = o; }
        } else {
        const int c = lane & 7;
#pragma unroll
        for (int j = 0; j < 4; ++j) { const int n = (lane >> 3) + 8 * j; const LAS float* sp = scr + (8 * c) * 33 + n;
            u32x4 o; o.x = pk2(sp[0 * 33], sp[1 * 33]); o.y = pk2(sp[2 * 33], sp[3 * 33]); o.z = pk2(sp[4 * 33], sp[5 * 33]); o.w = pk2(sp[6 * 33], sp[7 * 33]);
            *(u32x4*)(cur.dst + (size_t)n * cur.Kd + 8 * c) = o; }
        }
        LDS_WAIT(); asm volatile("" ::: "memory");
        if (!more) break;
        it = nit; cur = nx;
    }
}
constexpr int CW_N0 = 3 * CW_I_GU + 32 * 192 + CW_I_SQ, CW_N1 = 3 * CW_I_GU + 32 * 128 + CW_I_SQ, CW_SPLIT1 = 2 * CW_I_GU;
__device__ __forceinline__ void p0_prologue(Frame& F) {
    PH_IDS;
    {
        LAS float* sl = (LAS float*)F.lds;
        LAS float* part = (LAS float*)(F.lds + 40960);
        for (int i = tid; i < 5 * D; i += 512) { const int r = i >> 11, k = i & (D - 1); const float v = r < 4 ? F.in[1][r * D + k] : F.in[3][k]; sl[i] = silu_f(v); }
        __syncthreads();
        const int kg = tid >> 3, cg = tid & 7;
        for (int it = F.vcu; it < 768; it += F.G) {
            const int l = it / 384, c0 = (it - l * 384) * 32;
            const float* wm = F.in[4] + (size_t)l * D * 12288 + c0 + 4 * cg;
            f32x4 a0 = {0, 0, 0, 0}, a1 = a0, a2 = a0, a3 = a0, a4 = a0;
#pragma unroll 8
            for (int i = 0; i < 32; ++i) { const int k = kg + 64 * i; const f32x4 w = *(const f32x4*)(wm + (size_t)k * 12288);
                a0 += w * sl[k]; a1 += w * sl[D + k]; a2 += w * sl[2 * D + k]; a3 += w * sl[3 * D + k]; a4 += w * sl[4 * D + k]; }
            LAS float* pp = part + kg * 160 + 4 * cg;
            *(LAS f32x4*)(pp) = a0; *(LAS f32x4*)(pp + 32) = a1; *(LAS f32x4*)(pp + 64) = a2; *(LAS f32x4*)(pp + 96) = a3; *(LAS f32x4*)(pp + 128) = a4;
            __syncthreads();
            if (tid < 160) { float s = 0.f;
#pragma unroll 8
                for (int g = 0; g < 64; ++g) s += part[g * 160 + tid];
                const int r = tid >> 5, cc = tid & 31;
                WSP(float, WS_MOD)[(size_t)(l * 5 + r) * 12288 + c0 + cc] = s + F.in[5][l * 12288 + c0 + cc]; }
            __syncthreads();
        }
    }
    {
        const int gid = F.vcu * 512 + tid;
        if (gid < 2048) { const int pos = gid >> 4, f = gid & 15;
            const float inv = exp2f(-(float)f * (13.287712379549449f / 16.0f)); const float ang = (float)pos * inv;
            const float k = rintf(ang * 0.15915494309189535f); float r = fmaf(-k, 6.2831854820251465f, ang); r = fmaf(-k, -1.7484555e-7f, r);
            WSP(float, WS_TAB)[gid] = __cosf(r); WSP(float, WS_TAB)[2048 + gid] = __sinf(r); }
        for (int i = gid; i < 16 * 128 * 128; i += F.G * 512) WSP(bf16, WS_WSB)[i] = (bf16)f2bf(F.in[19][i]);
    }
    convert_weights<0>(F, F.vcu * NWAVES + wave, F.G * NWAVES, wave, lane, 0, CW_N0);
}
__device__ __forceinline__ void p1_modulate(Frame& F) {
    PH_IDS;
    LAS float* P_s = (LAS float*)F.lds; LAS float* P_h = P_s + D;
    for (int rw = F.vcu * NWAVES + wave; rw < 128; rw += F.G * NWAVES) { const int Lr = rw >> 6, br = (rw >> 4) & 3, e = rw & 15; const float* sh = MODP(Lr, br, 3); const float* sc = MODP(Lr, br, 4);
        bf16* wh = WSP(bf16, WS_WRT2) + (size_t)((Lr * 4 + br) * 32 + e) * D; bf16* wl = wh + 16 * D; float cs = 0.f;
        for (int k = lane; k < D; k += 64) { const float w0 = F.in[22][k * 16 + e]; const float w = w0 * (1.0f + sc[k]); cs += sh[k] * w0; const unsigned hb = f2bf(w); wh[k] = (bf16)hb; wl[k] = (bf16)f2bf(w - __uint_as_float(hb << 16)); }
#pragma unroll
        for (int o = 1; o < 64; o <<= 1) cs += __shfl_xor(cs, o);
        if (lane == 0) WSP(float, WS_RC)[(Lr * 4 + br) * 16 + e] = cs; }
    for (int blk = F.vcu; blk < M / 128; blk += F.G) {
        const int rowb = blk * 128 + wave * 16, b = rowb >> 13;
        __syncthreads();
        for (int i = tid; i < D; i += 512) { P_s[i] = 1.0f + MODP(0, b, 1)[i]; P_h[i] = MODP(0, b, 0)[i]; }
        __syncthreads();
        f32x4 rx[8];
#define P1_LOAD(r_) do { _Pragma("unroll") for (int j = 0; j < 4; ++j) { const float* p_ = F.in[0] + (size_t)(r_) * D + 512 * j + 8 * lane; rx[2 * j] = *(const f32x4*)p_; rx[2 * j + 1] = *(const f32x4*)(p_ + 4); } } while (0)
        P1_LOAD(rowb);
#pragma unroll 1
        for (int rr = 0; rr < 16; ++rr) {
            const int row = rowb + rr; u32x2 w8[4];
#pragma unroll
            for (int j = 0; j < 4; ++j) { const int c = 512 * j + 8 * lane;
                const f32x4 sa = *(const LAS f32x4*)(P_s + c), sb = *(const LAS f32x4*)(P_s + c + 4), ha = *(const LAS f32x4*)(P_h + c), hb = *(const LAS f32x4*)(P_h + c + 4);
                const f32x4 y0 = rx[2 * j] * sa + ha, y1 = rx[2 * j + 1] * sb + hb;
                w8[j].x = pk4_fp8(y0.x, y0.y, y0.z, y0.w); w8[j].y = pk4_fp8(y1.x, y1.y, y1.z, y1.w); }
            if (rr < 15) P1_LOAD(row + 1);
#pragma unroll
            for (int j = 0; j < 4; ++j) *(u32x2*)((unsigned char*)F.out + (size_t)M * D * 2 + (size_t)row * D + 512 * j + 8 * lane) = w8[j];
        }
#undef P1_LOAD
    }
    { const int gw = F.vcu * NWAVES + wave, NGW = F.G * NWAVES; const float* sh = MODP(0, 4, 0); const float* sc = MODP(0, 4, 1);
      for (int row = gw; row < MC; row += NGW) { const float* src = F.in[2] + (size_t)row * D; unsigned char* dst = (unsigned char*)F.out + (size_t)M * D * 2 + (size_t)M * D + (size_t)row * D;
#pragma unroll
          for (int j = 0; j < 8; ++j) { const int c = 256 * j + 4 * lane; const f32x4 v = *(const f32x4*)(src + c), s = *(const f32x4*)(sc + c), t = *(const f32x4*)(sh + c); const f32x4 y = v * (1.0f + s) + t; *(unsigned*)(dst + c) = pk4_fp8(y.x, y.y, y.z, y.w); } } }
}
__device__ __forceinline__ void conv_z(const bf16* proj, size_t row, int ch, float (&z)[8]) {
    const u32x4 w = *(const u32x4*)(proj + row * 2048 + ch);
    z[0] = bf_lo(w.x); z[1] = bf_hi(w.x); z[2] = bf_lo(w.y); z[3] = bf_hi(w.y); z[4] = bf_lo(w.z); z[5] = bf_hi(w.z); z[6] = bf_lo(w.w); z[7] = bf_hi(w.w);
}
__device__ __forceinline__ void conv_pass(Frame& F) {
    PH_IDS; const int gw = F.vcu * NWAVES + wave, NGW = F.G * NWAVES;
    const bf16* proj = WSP(bf16, WS_PROJ); unsigned char* mix = (unsigned char*)F.out;
    for (int it = gw; it < 2048; it += NGW) {
        const int run = it >> 1, ch = (it & 1) * 512 + lane * 8; const int r0 = run * 32;
        float w0[8], w1[8], w2[8];
#pragma unroll
        for (int i = 0; i < 8; ++i) { w0[i] = F.in[9][ch + i]; w1[i] = F.in[9][1024 + ch + i]; w2[i] = F.in[9][2048 + ch + i]; }
        float zp[8], zc[8], zn[8];
        if ((r0 & (SEQ - 1)) == 0) {
#pragma unroll
            for (int i = 0; i < 8; ++i) zp[i] = 0.f;
        } else conv_z(proj, (size_t)r0 - 1, ch, zp);
        conv_z(proj, (size_t)r0, ch, zc);
#pragma unroll 2
        for (int t = 0; t < 32; ++t) { const size_t row = (size_t)r0 + t;
            if (((row + 1) & (SEQ - 1)) == 0) {
#pragma unroll
                for (int i = 0; i < 8; ++i) zn[i] = 0.f;
            } else conv_z(proj, row + 1, ch, zn);
            const u32x4 bg = *(const u32x4*)(proj + row * 2048 + 1024 + ch);
            float o[8];
#pragma unroll
            for (int i = 0; i < 8; ++i) o[i] = w0[i] * zp[i] + w1[i] * zc[i] + w2[i] * zn[i];
            u32x2 w; w.x = pk4_fp8(bf_lo(bg.x) * o[0], bf_hi(bg.x) * o[1], bf_lo(bg.y) * o[2], bf_hi(bg.y) * o[3]);
            w.y = pk4_fp8(bf_lo(bg.z) * o[4], bf_hi(bg.z) * o[5], bf_lo(bg.w) * o[6], bf_hi(bg.w) * o[7]);
            *(u32x2*)(mix + row * D + ch) = w;
#pragma unroll
            for (int i = 0; i < 8; ++i) { zp[i] = zc[i]; zc[i] = zn[i]; } }
    }
}
__device__ __forceinline__ float lam_value(Frame& F, int lane) {
    const float a = wave_sum(F.in[10][lane] * F.in[11][lane]), b = wave_sum(F.in[12][lane] * F.in[13][lane]);
    return __expf(a) - __expf(b) + 0.2f;
}
__device__ __forceinline__ void attn_simple(Frame& F) {
    PH_IDS; const int gw = F.vcu * NWAVES + wave, NGW = F.G * NWAVES;
    const float lam = lam_value(F, lane);
    const bf16* Q = WSP(bf16, WS_Q); const bf16* KBp = WSP(bf16, WS_KB); const bf16* VBp = WSP(bf16, WS_VB); float* TMP = WSP(float, WS_H);
    for (int it = gw; it < 8192; it += NGW) {
        const int qb = it & 127, vc = (it >> 7) & 1, h = (it >> 8) & 7, b = it >> 11;
        const size_t qrow = (size_t)b * SEQ + qb * 64 + lane;
        float* tmp = TMP + (qrow * 8 + h) * 128 + vc * 64;
#pragma unroll 1
        for (int m = 0; m < 2; ++m) {
            float q[64], acc[64];
#pragma unroll
            for (int c = 0; c < 8; ++c) { const u32x4 w = *(const u32x4*)(Q + qrow * 1024 + h * 128 + m * 64 + c * 8); const float sc = 1.0f;
                q[8 * c + 0] = bf_lo(w.x) * sc; q[8 * c + 1] = bf_hi(w.x) * sc; q[8 * c + 2] = bf_lo(w.y) * sc; q[8 * c + 3] = bf_hi(w.y) * sc;
                q[8 * c + 4] = bf_lo(w.z) * sc; q[8 * c + 5] = bf_hi(w.z) * sc; q[8 * c + 6] = bf_lo(w.w) * sc; q[8 * c + 7] = bf_hi(w.w) * sc; }
#pragma unroll
            for (int i = 0; i < 64; ++i) acc[i] = 0.f;
            float mx = -1e30f, l = 0.f;
            const bf16* kp = KBp + (size_t)b * KV * 1024 + h * 128 + m * 64; const bf16* vp = VBp + (size_t)b * KV * 1024 + h * 128 + vc * 64;
#pragma unroll 1
            for (int j = 0; j < KV; ++j) {
                float s = 0.f;
#pragma unroll
                for (int c = 0; c < 8; ++c) { const u32x4 w = *(const u32x4*)(kp + (size_t)j * 1024 + c * 8);
                    s += q[8 * c + 0] * bf_lo(w.x) + q[8 * c + 1] * bf_hi(w.x) + q[8 * c + 2] * bf_lo(w.y) + q[8 * c + 3] * bf_hi(w.y)
                       + q[8 * c + 4] * bf_lo(w.z) + q[8 * c + 5] * bf_hi(w.z) + q[8 * c + 6] * bf_lo(w.w) + q[8 * c + 7] * bf_hi(w.w); }
                const float mn = fmaxf(mx, s), sc = exp2f(mx - mn), p = exp2f(s - mn); l = l * sc + p; mx = mn;
#pragma unroll
                for (int c = 0; c < 8; ++c) { const u32x4 w = *(const u32x4*)(vp + (size_t)j * 1024 + c * 8);
                    acc[8 * c + 0] = acc[8 * c + 0] * sc + p * bf_lo(w.x); acc[8 * c + 1] = acc[8 * c + 1] * sc + p * bf_hi(w.x);
                    acc[8 * c + 2] = acc[8 * c + 2] * sc + p * bf_lo(w.y); acc[8 * c + 3] = acc[8 * c + 3] * sc + p * bf_hi(w.y);
                    acc[8 * c + 4] = acc[8 * c + 4] * sc + p * bf_lo(w.z); acc[8 * c + 5] = acc[8 * c + 5] * sc + p * bf_hi(w.z);
                    acc[8 * c + 6] = acc[8 * c + 6] * sc + p * bf_lo(w.w); acc[8 * c + 7] = acc[8 * c + 7] * sc + p * bf_hi(w.w); }
            }
            const float inv = 1.0f / l;
            if (m == 0) {
#pragma unroll
                for (int i = 0; i < 64; i += 4) *(f32x4*)(tmp + i) = (f32x4){acc[i] * inv, acc[i + 1] * inv, acc[i + 2] * inv, acc[i + 3] * inv};
            } else {
#pragma unroll
                for (int i = 0; i < 64; i += 4) { const f32x4 t0 = *(const f32x4*)(tmp + i);
                    *(f32x4*)(tmp + i) = (f32x4){t0.x - lam * acc[i] * inv, t0.y - lam * acc[i + 1] * inv, t0.z - lam * acc[i + 2] * inv, t0.w - lam * acc[i + 3] * inv}; }
            }
        }
    }
}
__device__ __forceinline__ void attn_finish(Frame& F) {
    PH_IDS; const int gw = F.vcu * NWAVES + wave, NGW = F.G * NWAVES;
    const float* TMP = WSP(float, WS_H); bf16* mix = (bf16*)F.out;
    for (int row = gw; row < M; row += NGW) {
        f32x4 v[4]; float ss = 0.f;
#pragma unroll
        for (int i = 0; i < 4; ++i) { v[i] = *(const f32x4*)(TMP + (size_t)row * 1024 + lane * 16 + 4 * i); ss += (v[i].x * v[i].x + v[i].y * v[i].y) + (v[i].z * v[i].z + v[i].w * v[i].w); }
        ss += __shfl_xor(ss, 1); ss += __shfl_xor(ss, 2); ss += __shfl_xor(ss, 4);
        const float rs = 0.8f / sqrtf(ss * (1.0f / 128.0f) + LN_EPS);
#pragma unroll
        for (int i = 0; i < 4; ++i) { const f32x4 g = *(const f32x4*)(F.in[14] + ((lane * 16 + 4 * i) & 127)); st_bf4(mix + (size_t)row * D + 1024 + lane * 16 + 4 * i, v[i] * g * rs); }
    }
}
namespace att {
using f32x16 = __attribute__((ext_vector_type(16))) float;
using s16x4 = __attribute__((ext_vector_type(4))) short;
constexpr int QBLK = 32, KVBLK = 64, SHM_V = 16384, SHM_K = 8192, L_K = 0, L_V = 4 * SHM_K, L_WS = L_V + 4 * SHM_V, L_OST = 0, OST_LD = 136;
constexpr float SCALE = 0.125f, THR = 8.f;
#define ATT_KSW(row, c) ((row) * 128 + ((((c) ^ ((row) >> 1)) & 7) << 4))
#define ATT_SBAR() __builtin_amdgcn_sched_barrier(0)
__device__ __forceinline__ int crow(int r, int hi) { return (r & 3) + 8 * (r >> 2) + 4 * hi; }
__device__ __forceinline__ unsigned cvtpk(float lo, float hi) { unsigned r; asm volatile("v_cvt_pk_bf16_f32 %0, %1, %2" : "=v"(r) : "v"(lo), "v"(hi)); return r; }
template <bool FIRST> __device__ __forceinline__ void partialSM(f32x16& p0, f32x16& p1, f32x16& negm, float& alpha) {
    constexpr float THR2 = 8.0f, PBIAS = 4.0f;
    float m0 = fmaxf(fmaxf(p0[0], p0[1]), p0[2]), m1 = fmaxf(fmaxf(p1[0], p1[1]), p1[2]);
#pragma unroll
    for (int r = 3; r < 15; r += 2) { m0 = fmaxf(fmaxf(m0, p0[r]), p0[r + 1]); m1 = fmaxf(fmaxf(m1, p1[r]), p1[r + 1]); }
    float pmax = fmaxf(fmaxf(m0, p0[15]), fmaxf(m1, p1[15]));
    { auto rr = __builtin_amdgcn_permlane32_swap(__float_as_uint(pmax), __float_as_uint(pmax), false, false);
      pmax = fmaxf(__uint_as_float(rr[0]), __uint_as_float(rr[1])); }
    if (!FIRST && __builtin_expect(__all(pmax <= THR2), 1)) { alpha = 1.f; }
    else { const float dl = FIRST ? pmax - PBIAS : fmaxf(pmax - PBIAS, 0.f); alpha = __builtin_amdgcn_exp2f(-dl);
#pragma unroll
        for (int r = 0; r < 16; ++r) { p0[r] -= dl; p1[r] -= dl; negm[r] -= dl; } }
#pragma unroll
    for (int r = 0; r < 16; ++r) p0[r] = __builtin_amdgcn_exp2f(p0[r]);
}
__device__ __forceinline__ void finishSM(f32x16& p0, f32x16& p1, float alpha, float& l_reg, bf16x8& pa0, bf16x8& pa1, bf16x8& pa2, bf16x8& pa3) {
#pragma unroll
    for (int r = 0; r < 16; ++r) p1[r] = __builtin_amdgcn_exp2f(p1[r]);
    float s0 = p0[0] + p0[1], s1 = p0[2] + p0[3], s2 = p1[0] + p1[1], s3 = p1[2] + p1[3];
#pragma unroll
    for (int r = 4; r < 16; r += 4) { s0 += p0[r]; s1 += p0[r + 1]; s2 += p0[r + 2]; s3 += p0[r + 3]; s0 += p1[r]; s1 += p1[r + 1]; s2 += p1[r + 2]; s3 += p1[r + 3]; }
    float ps = (s0 + s1) + (s2 + s3);
    { auto rr = __builtin_amdgcn_permlane32_swap(__float_as_uint(ps), __float_as_uint(ps), false, false); ps = __uint_as_float(rr[0]) + __uint_as_float(rr[1]); }
    l_reg = l_reg * alpha + ps;
#define ATT_PK4(P, BASE, OUT) do { unsigned a0 = cvtpk(P[BASE + 0], P[BASE + 1]), a1 = cvtpk(P[BASE + 2], P[BASE + 3]);   \
    unsigned b0 = cvtpk(P[BASE + 4], P[BASE + 5]), b1 = cvtpk(P[BASE + 6], P[BASE + 7]);                              \
    auto r0 = __builtin_amdgcn_permlane32_swap(a0, b0, false, false); auto r1 = __builtin_amdgcn_permlane32_swap(a1, b1, false, false); \
    u32x4 w = {r0[0], r1[0], r0[1], r1[1]}; OUT = __builtin_bit_cast(bf16x8, w); } while (0)
    ATT_PK4(p0, 0, pa0); ATT_PK4(p0, 8, pa1); ATT_PK4(p1, 0, pa2); ATT_PK4(p1, 8, pa3);
#undef ATT_PK4
}
#define ATT_K8(row, c) ((row) * 64 + ((((c) ^ ((row) >> 2)) & 3) << 4))
__device__ __forceinline__ void qkt(f32x16& p0, f32x16& p1, const LAS char* Ks, const pg8::v8i32& qf, const f32x16& negm, int r32, int hi) {
    const pg8::v4i32 a0 = *(const LAS pg8::v4i32*)(Ks + ATT_K8(r32, 2 * hi)), a1 = *(const LAS pg8::v4i32*)(Ks + ATT_K8(r32, 2 * hi + 1));
    const pg8::v4i32 b0 = *(const LAS pg8::v4i32*)(Ks + ATT_K8(32 + r32, 2 * hi)), b1 = *(const LAS pg8::v4i32*)(Ks + ATT_K8(32 + r32, 2 * hi + 1));
    p0 = __builtin_amdgcn_mfma_scale_f32_32x32x64_f8f6f4(__builtin_shufflevector(a0, a1, 0, 1, 2, 3, 4, 5, 6, 7), qf, negm, 0, 0, 0, 0x7f7f7f7f, 0, 0x7f7f7f7f);
    p1 = __builtin_amdgcn_mfma_scale_f32_32x32x64_f8f6f4(__builtin_shufflevector(b0, b1, 0, 1, 2, 3, 4, 5, 6, 7), qf, negm, 0, 0, 0, 0x7f7f7f7f, 0, 0x7f7f7f7f);
}
__device__ __forceinline__ int v_st(int k, int c) { const int kk = (k & ~0xC) | ((k & 4) << 1) | ((k & 8) >> 1); return ((kk >> 3) * 4 + (c >> 5)) * 512 + ((kk & 7) * 32 + (c & 31)) * 2; }
__device__ __forceinline__ int v_rd_base(int lane) { return ((lane & 3) << 3) | (((lane >> 2) & 3) << 6) | (((lane >> 4) & 1) << 5) | (((lane >> 5) & 1) << 8); }
constexpr int v_rd_off(int d0, int ks, int half) { return d0 * 512 + ks * 4096 + half * 2048; }
template <int OFF> __device__ __forceinline__ s16x4 tr_read(int vb) { s16x4 r; asm volatile("ds_read_b64_tr_b16 %0, %1 offset:%2" : "=&v"(r) : "v"(vb), "i"(OFF) : "memory"); return r; }
template <int D0> __device__ __forceinline__ void pv_one(f32x16& od, int vb, bf16x8 pa0, bf16x8 pa1, bf16x8 pa2, bf16x8 pa3) {
    const s16x4 l0 = tr_read<v_rd_off(D0, 0, 0)>(vb), h0 = tr_read<v_rd_off(D0, 0, 1)>(vb), l1 = tr_read<v_rd_off(D0, 1, 0)>(vb), h1 = tr_read<v_rd_off(D0, 1, 1)>(vb);
    const s16x4 l2 = tr_read<v_rd_off(D0, 2, 0)>(vb), h2 = tr_read<v_rd_off(D0, 2, 1)>(vb), l3 = tr_read<v_rd_off(D0, 3, 0)>(vb), h3 = tr_read<v_rd_off(D0, 3, 1)>(vb);
    asm volatile("s_waitcnt lgkmcnt(0)" ::: "memory"); ATT_SBAR();
#define ATT_PK(L, H) (bf16x8){L[0], L[1], L[2], L[3], H[0], H[1], H[2], H[3]}
    od = __builtin_amdgcn_mfma_f32_32x32x16_bf16(pa0, ATT_PK(l0, h0), od, 0, 0, 0);
    od = __builtin_amdgcn_mfma_f32_32x32x16_bf16(pa1, ATT_PK(l1, h1), od, 0, 0, 0);
    od = __builtin_amdgcn_mfma_f32_32x32x16_bf16(pa2, ATT_PK(l2, h2), od, 0, 0, 0);
    od = __builtin_amdgcn_mfma_f32_32x32x16_bf16(pa3, ATT_PK(l3, h3), od, 0, 0, 0);
#undef ATT_PK
}
__device__ __forceinline__ void pv_d0(f32x16* o, int vb, bf16x8 pa0, bf16x8 pa1, bf16x8 pa2, bf16x8 pa3) {
    pv_one<0>(o[0], vb, pa0, pa1, pa2, pa3); pv_one<1>(o[1], vb, pa0, pa1, pa2, pa3); pv_one<2>(o[2], vb, pa0, pa1, pa2, pa3); pv_one<3>(o[3], vb, pa0, pa1, pa2, pa3);
}
__device__ __forceinline__ void psum(f32x16& osum, bf16x8 pa0, bf16x8 pa1, bf16x8 pa2, bf16x8 pa3) {
    const bf16x8 ones = {0x3F80, 0x3F80, 0x3F80, 0x3F80, 0x3F80, 0x3F80, 0x3F80, 0x3F80};
    osum = __builtin_amdgcn_mfma_f32_32x32x16_bf16(pa0, ones, osum, 0, 0, 0); osum = __builtin_amdgcn_mfma_f32_32x32x16_bf16(pa1, ones, osum, 0, 0, 0);
    osum = __builtin_amdgcn_mfma_f32_32x32x16_bf16(pa2, ones, osum, 0, 0, 0); osum = __builtin_amdgcn_mfma_f32_32x32x16_bf16(pa3, ones, osum, 0, 0, 0);
}
struct VFrag { s16x4 l0, h0, l1, h1, l2, h2, l3, h3; };
__device__ __forceinline__ void pv_rd0(VFrag& f, int vb) {
    f.l0 = tr_read<v_rd_off(0, 0, 0)>(vb); f.h0 = tr_read<v_rd_off(0, 0, 1)>(vb); f.l1 = tr_read<v_rd_off(0, 1, 0)>(vb); f.h1 = tr_read<v_rd_off(0, 1, 1)>(vb);
    f.l2 = tr_read<v_rd_off(0, 2, 0)>(vb); f.h2 = tr_read<v_rd_off(0, 2, 1)>(vb); f.l3 = tr_read<v_rd_off(0, 3, 0)>(vb); f.h3 = tr_read<v_rd_off(0, 3, 1)>(vb);
}
__device__ __forceinline__ void pv_d0_pre(f32x16* o, int vb, const VFrag& f, bf16x8 pa0, bf16x8 pa1, bf16x8 pa2, bf16x8 pa3) {
    asm volatile("s_waitcnt lgkmcnt(0)" ::: "memory"); ATT_SBAR();
#define ATT_PK(L, H) (bf16x8){L[0], L[1], L[2], L[3], H[0], H[1], H[2], H[3]}
    o[0] = __builtin_amdgcn_mfma_f32_32x32x16_bf16(pa0, ATT_PK(f.l0, f.h0), o[0], 0, 0, 0);
    o[0] = __builtin_amdgcn_mfma_f32_32x32x16_bf16(pa1, ATT_PK(f.l1, f.h1), o[0], 0, 0, 0);
    o[0] = __builtin_amdgcn_mfma_f32_32x32x16_bf16(pa2, ATT_PK(f.l2, f.h2), o[0], 0, 0, 0);
    o[0] = __builtin_amdgcn_mfma_f32_32x32x16_bf16(pa3, ATT_PK(f.l3, f.h3), o[0], 0, 0, 0);
#undef ATT_PK
    pv_one<1>(o[1], vb, pa0, pa1, pa2, pa3); pv_one<2>(o[2], vb, pa0, pa1, pa2, pa3); pv_one<3>(o[3], vb, pa0, pa1, pa2, pa3);
}
__device__ __forceinline__ int v8_sw(int key) { return (((key >> 1) & 1) << 1) | (((key >> 3) & 1) << 2); }
__device__ __forceinline__ int v8_st(int key, int chunk) { return key * 128 + ((chunk ^ v8_sw(key)) << 4); }
__device__ __forceinline__ int v8_rd_base(int lane, int d0) { const int i = lane & 15, q = i >> 1, p = i & 1, g1 = (lane >> 4) & 1, hi = lane >> 5; const int key0 = (q & 3) + 8 * (q >> 2) + 4 * hi;
    return key0 * 128 + ((((2 * d0 + g1) ^ v8_sw(key0)) & 7) << 4) + 8 * p; }
template <int OFF> __device__ __forceinline__ u32x2 tr8_read(int vb) { u32x2 r; asm volatile("ds_read_b64_tr_b8 %0, %1 offset:%2" : "=&v"(r) : "v"(vb), "i"(OFF) : "memory"); return r; }
struct V8Frag { u32x2 r0, r1, r2, r3; };
__device__ __forceinline__ void pv8_rd(V8Frag& f, int vb) { f.r0 = tr8_read<0>(vb); f.r1 = tr8_read<2048>(vb); f.r2 = tr8_read<4096>(vb); f.r3 = tr8_read<6144>(vb); }
template <int SO> __device__ __forceinline__ void pv8_rds(V8Frag& f, int vb) { f.r0 = tr8_read<SO>(vb); f.r1 = tr8_read<SO + 2048>(vb); f.r2 = tr8_read<SO + 4096>(vb); f.r3 = tr8_read<SO + 6144>(vb); }
__device__ __forceinline__ void pv8_mm(f32x16& od, const V8Frag& f, const pg8::v8i32& pa, int sc1) {
    const pg8::v8i32 bf = {(int)f.r0.x, (int)f.r0.y, (int)f.r1.x, (int)f.r1.y, (int)f.r2.x, (int)f.r2.y, (int)f.r3.x, (int)f.r3.y};
    asm volatile("v_mfma_scale_f32_32x32x64_f8f6f4 %0, %1, %2, %0, %3, %3 op_sel_hi:[0,0,0]" : "+v"(od) : "v"(pa), "v"(bf), "v"(sc1));
}
__device__ __forceinline__ void pv8_one(f32x16& od, int vb, const pg8::v8i32& pa, int sc1) { V8Frag f; pv8_rd(f, vb); asm volatile("s_waitcnt lgkmcnt(0)" ::: "memory"); ATT_SBAR(); pv8_mm(od, f, pa, sc1); }
__device__ __forceinline__ void pv8_d0(f32x16* o, const int (&vb)[4], int so, const pg8::v8i32& pa, int sc1) {
    pv8_one(o[0], vb[0] + so, pa, sc1); pv8_one(o[1], vb[1] + so, pa, sc1); pv8_one(o[2], vb[2] + so, pa, sc1); pv8_one(o[3], vb[3] + so, pa, sc1); }
__device__ __forceinline__ void pv8_d0_pre(f32x16* o, const int (&vb)[4], int so, const V8Frag& f, const pg8::v8i32& pa, int sc1) {
    asm volatile("s_waitcnt lgkmcnt(0)" ::: "memory"); ATT_SBAR(); pv8_mm(o[0], f, pa, sc1);
    pv8_one(o[1], vb[1] + so, pa, sc1); pv8_one(o[2], vb[2] + so, pa, sc1); pv8_one(o[3], vb[3] + so, pa, sc1); }
__device__ __forceinline__ void finishSM8(f32x16& p0, f32x16& p1, pg8::v8i32& pa) {
#pragma unroll
    for (int r = 0; r < 16; ++r) p1[r] = __builtin_amdgcn_exp2f(p1[r]);
#define ATT_F8(P, B) __builtin_amdgcn_cvt_pk_fp8_f32(P[B + 2], P[B + 3], __builtin_amdgcn_cvt_pk_fp8_f32(P[B], P[B + 1], 0, false), true)
    pa = (pg8::v8i32){ATT_F8(p0, 0), ATT_F8(p0, 4), ATT_F8(p0, 8), ATT_F8(p0, 12), ATT_F8(p1, 0), ATT_F8(p1, 4), ATT_F8(p1, 8), ATT_F8(p1, 12)};
#undef ATT_F8
}
__device__ __forceinline__ void psum8(f32x4& lacc, const pg8::v8i32& mask, const pg8::v8i32& pa, int sc1) {
    asm volatile("v_mfma_scale_f32_16x16x128_f8f6f4 %0, %1, %2, %0, %3, %3 op_sel_hi:[0,0,0]" : "+v"(lacc) : "v"(mask), "v"(pa), "v"(sc1));
}
struct KFrag { pg8::v4i32 a0, a1, b0, b1; };
__device__ __forceinline__ void k_read(KFrag& k, const LAS char* Ks, int r32, int hi) {
    k.a0 = *(const LAS pg8::v4i32*)(Ks + ATT_K8(r32, 2 * hi)); k.a1 = *(const LAS pg8::v4i32*)(Ks + ATT_K8(r32, 2 * hi + 1));
    k.b0 = *(const LAS pg8::v4i32*)(Ks + ATT_K8(32 + r32, 2 * hi)); k.b1 = *(const LAS pg8::v4i32*)(Ks + ATT_K8(32 + r32, 2 * hi + 1)); }
__device__ __forceinline__ void qk_mm(f32x16& p0, f32x16& p1, const KFrag& k, const pg8::v8i32& qf, const f32x16& negm) {
    p0 = __builtin_amdgcn_mfma_scale_f32_32x32x64_f8f6f4(__builtin_shufflevector(k.a0, k.a1, 0, 1, 2, 3, 4, 5, 6, 7), qf, negm, 0, 0, 0, 0x7f7f7f7f, 0, 0x7f7f7f7f);
    p1 = __builtin_amdgcn_mfma_scale_f32_32x32x64_f8f6f4(__builtin_shufflevector(k.b0, k.b1, 0, 1, 2, 3, 4, 5, 6, 7), qf, negm, 0, 0, 0, 0x7f7f7f7f, 0, 0x7f7f7f7f); }
template <int LO, int N> __device__ __forceinline__ void exp_n(f32x16& p) {
#pragma unroll
    for (int r = LO; r < LO + N; ++r) p[r] = __builtin_amdgcn_exp2f(p[r]);
    asm volatile("" : "+v"(p)); }
__device__ __forceinline__ int cvt4_fp8(float a, float b, float c, float d) { int r;
    asm("v_cvt_pk_fp8_f32 %0, %1, %2\n\tv_cvt_pk_fp8_f32 %0, %3, %4 op_sel:[0,0,1]" : "=&v"(r) : "v"(a), "v"(b), "v"(c), "v"(d)); return r; }
__device__ __forceinline__ void cvt_pa(pg8::v8i32& pa, const f32x16& p0, const f32x16& p1) {
#define ATT_F8(P, B) cvt4_fp8(P[B], P[B + 1], P[B + 2], P[B + 3])
    pa = (pg8::v8i32){ATT_F8(p0, 0), ATT_F8(p0, 4), ATT_F8(p0, 8), ATT_F8(p0, 12), ATT_F8(p1, 0), ATT_F8(p1, 4), ATT_F8(p1, 8), ATT_F8(p1, 12)};
#undef ATT_F8
}
__device__ __forceinline__ void sm_decide(f32x16& p0, f32x16& p1, f32x16& negm, float& alpha) {
    constexpr float THR2 = 8.0f, PBIAS = 4.0f;
    float m0 = fmaxf(fmaxf(p0[0], p0[1]), p0[2]), m1 = fmaxf(fmaxf(p1[0], p1[1]), p1[2]);
#pragma unroll
    for (int r = 3; r < 15; r += 2) { m0 = fmaxf(fmaxf(m0, p0[r]), p0[r + 1]); m1 = fmaxf(fmaxf(m1, p1[r]), p1[r + 1]); }
    float pmax = fmaxf(fmaxf(m0, p0[15]), fmaxf(m1, p1[15]));
    { auto rr = __builtin_amdgcn_permlane32_swap(__float_as_uint(pmax), __float_as_uint(pmax), false, false);
      pmax = fmaxf(__uint_as_float(rr[0]), __uint_as_float(rr[1])); }
    if (__builtin_expect(__all(pmax <= THR2), 1)) { alpha = 1.f; }
    else { const float dl = fmaxf(pmax - PBIAS, 0.f); alpha = __builtin_amdgcn_exp2f(-dl);
#pragma unroll
        for (int r = 0; r < 16; ++r) { p0[r] -= dl; p1[r] -= dl; negm[r] -= dl; } }
}
__device__ __forceinline__ void psum8z(f32x4& ts, const pg8::v8i32& mask, const pg8::v8i32& pa, int sc1) {
    asm volatile("v_mfma_scale_f32_16x16x128_f8f6f4 %0, %1, %2, 0, %3, %3 op_sel_hi:[0,0,0]" : "=&v"(ts) : "v"(mask), "v"(pa), "v"(sc1));
}
__device__ __forceinline__ void sm_redo(f32x16& p0, f32x16& p1, f32x16& negm, float& alpha, float& dl) {
    constexpr float PBIAS = 4.0f;
    float m0 = fmaxf(fmaxf(p0[0], p0[1]), p0[2]), m1 = fmaxf(fmaxf(p1[0], p1[1]), p1[2]);
#pragma unroll
    for (int r = 3; r < 15; r += 2) { m0 = fmaxf(fmaxf(m0, p0[r]), p0[r + 1]); m1 = fmaxf(fmaxf(m1, p1[r]), p1[r + 1]); }
    float pmax = fmaxf(fmaxf(m0, p0[15]), fmaxf(m1, p1[15]));
    { auto rr = __builtin_amdgcn_permlane32_swap(__float_as_uint(pmax), __float_as_uint(pmax), false, false);
      pmax = fmaxf(__uint_as_float(rr[0]), __uint_as_float(rr[1])); }
    dl = fmaxf(pmax - PBIAS, 0.f); alpha = __builtin_amdgcn_exp2f(-dl);
#pragma unroll
    for (int r = 0; r < 16; ++r) { p0[r] -= dl; p1[r] -= dl; negm[r] -= dl; }
}
}
__device__ __forceinline__ void attn_fast(Frame& F) {
    using namespace att;
    PH_IDS; const int wid = wave, r32 = lane & 31, hi = lane >> 5;
    const float lam = __builtin_bit_cast(float, __builtin_amdgcn_readfirstlane(__builtin_bit_cast(int, lam_value(F, lane))));
    LAS char* lds = (LAS char*)F.lds; LAS char* V_lds = lds + L_V; LAS char* K_lds = lds + L_K;
    LAS float* wsf = (LAS float*)(lds + L_WS) + wid * 64; LAS float* li_l = wsf; LAS float* al_l = wsf + 32;
    const bf16* Qg = WSP(bf16, WS_Q); const bf16* KBp = WSP(bf16, WS_KB); const bf16* VBp = WSP(bf16, WS_VB); unsigned char* mix = (unsigned char*)F.out;
    const int vkey = tid >> 3, vst0 = v8_st(vkey, tid & 7);
    const int kr = (tid >> 2) & 63, kc = tid & 3, kst = ATT_K8(kr, kc);
    int vb8[4];
#pragma unroll
    for (int d0 = 0; d0 < 4; ++d0) vb8[d0] = (int)(unsigned)(uintptr_t)V_lds + v8_rd_base(lane, d0);
    const int sc1 = 0x7f7f7f7f;
    pg8::v8i32 lmask;
    { const int mk = (((lane >> 4) ^ lane) & 1) ? 0 : 0x38383838; int m0, m1, m2, m3, m4, m5, m6, m7;
      asm volatile("v_mov_b32 %0, %8\n\tv_mov_b32 %1, %8\n\tv_mov_b32 %2, %8\n\tv_mov_b32 %3, %8\n\tv_mov_b32 %4, %8\n\tv_mov_b32 %5, %8\n\tv_mov_b32 %6, %8\n\tv_mov_b32 %7, %8"
                   : "=&v"(m0), "=&v"(m1), "=&v"(m2), "=&v"(m3), "=&v"(m4), "=&v"(m5), "=&v"(m6), "=&v"(m7) : "v"(mk));
      lmask = (pg8::v8i32){m0, m1, m2, m3, m4, m5, m6, m7}; }
    const unsigned voffV0 = (unsigned)(vkey * 1024 + (tid & 7) * 16), voffK = (unsigned)(kr * 1024 + kc * 16);
    constexpr int NT = KV / KVBLK;
    const int bx = (int)blockIdx.x;
    for (int ui = 0;; ++ui) {
        int unit;
        if (F.G == 256) { if (ui >= 4) break; unit = (ui * 8 + (bx & 7)) * 32 + (bx >> 3); }
        else { unit = ui * F.G + bx; if (unit >= 1024) break; }
        const int bh = unit >> 5, qb = unit & 31, b = bh >> 3, h = bh & 7;
        const size_t row0 = (size_t)b * SEQ + qb * 256;
#pragma unroll 1
        for (int mp = 0; mp < 2; ++mp) {
            const unsigned char* Kh = (const unsigned char*)KBp + (size_t)b * KV * 1024 + h * 128 + mp * 64; const unsigned char* Vh = (const unsigned char*)VBp + (size_t)b * KV * 1024 + h * 128;
            const __amdgpu_buffer_rsrc_t rsK = make_rsrc(Kh, KV * 1024), rsV = make_rsrc(Vh, KV * 1024);
            f32x16 o[4] = {}; f32x16 negm = {}; float l0 = 0.f, l1 = 0.f; f32x4 ts;
            const __amdgpu_buffer_rsrc_t rsQ = make_rsrc((const unsigned char*)Qg + (row0 + wid * QBLK) * 1024 + h * 128 + mp * 64, 32 * 1024);
            const int lq = fresh_lane(); const unsigned qoff = (unsigned)((lq & 31) * 1024 + (lq >> 5) * 32);
            const pg8::v8i32 qr = __builtin_shufflevector(__builtin_bit_cast(pg8::v4i32, bufld16(rsQ, qoff, 0)), __builtin_bit_cast(pg8::v4i32, bufld16(rsQ, qoff + 16, 0)), 0, 1, 2, 3, 4, 5, 6, 7);
            struct { bf16x8 vs0, ks0; } sr_;
#define SLOAD(t_) do { const unsigned so_ = (unsigned)(t_) * (unsigned)(KVBLK * 1024); \
    sr_.vs0 = bufld16(rsV, voffV0, so_); if (wid < 4) sr_.ks0 = bufld16(rsK, voffK, so_); } while (0)
#define SWRITE(t_) do { const int sl_ = (t_) & 3; *(LAS bf16x8*)(V_lds + sl_ * SHM_V + vst0) = sr_.vs0; \
    if (wid < 4) *(LAS bf16x8*)(K_lds + sl_ * SHM_K + kst) = sr_.ks0; } while (0)
#define KSLOT(t_) (K_lds + ((t_) & 3) * SHM_K)
#define VSLOT(t_) (((t_) & 3) * SHM_V)
#define RESC(a) do { if (__any((a) < 1.f)) { if (hi == 0) al_l[r32] = (a); asm volatile("s_nop 15\n\ts_nop 15\n\ts_waitcnt lgkmcnt(0)" ::: "memory");   \
    _Pragma("unroll") for (int r = 0; r < 16; ++r) { const float f_ = al_l[crow(r, hi)]; _Pragma("unroll") for (int d = 0; d < 4; ++d) o[d][r] *= f_; } \
    l0 *= al_l[r32 & 15]; l1 *= al_l[16 + (r32 & 15)]; } } while (0)
            f32x16 pA0, pA1, pB0, pB1; float alA; pg8::v8i32 pa;
            __syncthreads();
            SLOAD(0); SWRITE(0); SLOAD(1); SWRITE(1);
            __syncthreads();
            if (wid >= 4) __syncthreads();
            SLOAD(2); qkt(pA0, pA1, KSLOT(0), qr, negm, r32, hi);
            __syncthreads();
            partialSM<true>(pA0, pA1, negm, alA); SWRITE(2);
            __syncthreads();
            V8Frag vf;
#define ATT_WAITL(n_) asm volatile("s_waitcnt lgkmcnt(" #n_ ")" ::: "memory")
#define OVF_CHECK(PY0, PY1, PX0, PX1, SLP_, HAVE_PX) do { \
    asm volatile("s_nop 7\n\ts_nop 3" ::: "memory");        \
    if (__builtin_expect(__any(!(ts[0] < ATT_OVF_LIMIT) || !(ts[1] < ATT_OVF_LIMIT)), 0)) { \
        KFrag kq_; k_read(kq_, K_lds + (SLP_) * SHM_K, r32, hi); qk_mm(PY0, PY1, kq_, qr, negm); \
        float al_, dl_; sm_redo(PY0, PY1, negm, al_, dl_); \
        if (HAVE_PX) { _Pragma("unroll") for (int r = 0; r < 16; ++r) { PX0[r] -= dl_; PX1[r] -= dl_; } } \
        exp_n<0, 16>(PY0); exp_n<0, 16>(PY1); cvt_pa(pa, PY0, PY1); psum8z(ts, lmask, pa, sc1); \
        RESC(al_); \
        asm volatile("s_nop 7\n\ts_nop 3" ::: "memory"); } \
    l0 += ts[0]; l1 += ts[1]; asm volatile("" :: "v"(ts));   } while (0)
#define SLOADT(t_) do { const unsigned so_ = (unsigned)(t_) * (unsigned)(KVBLK * 1024); sr_.vs0 = bufld16(rsV, voffV0, so_); if (wid < 4) sr_.ks0 = bufld16(rsK, voffK, so_); } while (0)
#define SWRITES(SL_) do { *(LAS bf16x8*)(V_lds + (SL_) * SHM_V + vst0) = sr_.vs0; if (wid < 4) *(LAS bf16x8*)(K_lds + (SL_) * SHM_K + kst) = sr_.ks0; } while (0)
#define SEG_A(PX0, PX1, PY0, PY1, t_, SL_, ld_) do { \
    if (ld_) SLOADT((t_) + 2); \
    ATT_SBAR(); KFrag kf_; k_read(kf_, K_lds + (SL_) * SHM_K, r32, hi); ATT_SBAR(); \
    exp_n<0, 16>(PY1); ATT_SBAR(); \
    qk_mm(PX0, PX1, kf_, qr, negm); ATT_SBAR(); \
    cvt_pa(pa, PY0, PY1); psum8z(ts, lmask, pa, sc1); ATT_SBAR(); \
    pv8_rds<(((SL_) + 3) & 3) * SHM_V>(vf, vb8[0]); \
    __syncthreads(); } while (0)
#define SEG_B(PX0, PX1, PY0, PY1, SL_, ld_) do { \
    V8Frag vg_; constexpr int so_ = (((SL_) + 3) & 3) * SHM_V; \
    pv8_rds<so_>(vg_, vb8[1]); ATT_SBAR(); \
    OVF_CHECK(PY0, PY1, PX0, PX1, ((SL_) + 3) & 3, true); ATT_SBAR(); \
    ATT_WAITL(4); ATT_SBAR(); pv8_mm(o[0], vf, pa, sc1); \
    pv8_rds<so_>(vf, vb8[2]); ATT_SBAR(); \
    exp_n<0, 8>(PX0); ATT_SBAR(); \
    ATT_WAITL(4); ATT_SBAR(); pv8_mm(o[1], vg_, pa, sc1); \
    pv8_rds<so_>(vg_, vb8[3]); ATT_SBAR(); \
    exp_n<8, 8>(PX0); ATT_SBAR(); \
    ATT_WAITL(4); ATT_SBAR(); pv8_mm(o[2], vf, pa, sc1); ATT_SBAR(); \
    ATT_WAITL(0); ATT_SBAR(); pv8_mm(o[3], vg_, pa, sc1); ATT_SBAR(); \
    if (ld_) SWRITES(((SL_) + 2) & 3); \
    __syncthreads(); } while (0)
            static_assert(NT % 4 == 0 && NT >= 8, "the tile loop is unrolled over the 4 ring slots");
            SEG_A(pB0, pB1, pA0, pA1, 1, 1, true); SEG_B(pB0, pB1, pA0, pA1, 1, true);
#pragma unroll 1
            for (int t = 2; t + 3 < NT; t += 4) {
                SEG_A(pA0, pA1, pB0, pB1, t, 2, true); SEG_B(pA0, pA1, pB0, pB1, 2, true);
                SEG_A(pB0, pB1, pA0, pA1, t + 1, 3, true); SEG_B(pB0, pB1, pA0, pA1, 3, true);
                SEG_A(pA0, pA1, pB0, pB1, t + 2, 0, true); SEG_B(pA0, pA1, pB0, pB1, 0, true);
                SEG_A(pB0, pB1, pA0, pA1, t + 3, 1, true); SEG_B(pB0, pB1, pA0, pA1, 1, true);
            }
            SEG_A(pA0, pA1, pB0, pB1, NT - 2, 2, false); SEG_B(pA0, pA1, pB0, pB1, 2, false);
            SEG_A(pB0, pB1, pA0, pA1, NT - 1, 3, false); SEG_B(pB0, pB1, pA0, pA1, 3, false);
#undef SEG_A
#undef SEG_B
            exp_n<0, 16>(pB1); cvt_pa(pa, pB0, pB1); psum8z(ts, lmask, pa, sc1); ATT_SBAR();
            OVF_CHECK(pB0, pB1, pB0, pB1, 3, false); ATT_SBAR();
            pv8_d0(o, vb8, VSLOT(NT - 1), pa, sc1);
#undef OVF_CHECK
            asm volatile("s_nop 15\n\ts_nop 15" ::: "memory");
            if (wid < 4) __syncthreads();
            __syncthreads();
#undef KSLOT
#undef VSLOT
#undef SLOAD
#undef SWRITE
#undef RESC
            const int lane2 = fresh_lane(), t2 = wid * 64 + lane2, r32b = lane2 & 31, hi2 = lane2 >> 5;
            if (hi2 == 0) li_l[r32b] = (lane2 & 16) ? l1 : l0; asm volatile("s_waitcnt lgkmcnt(0)" ::: "memory");
            float rli[16];
#pragma unroll
            for (int r = 0; r < 16; ++r) rli[r] = 1.0f / li_l[crow(r, hi2)];
            float* SCR = WSP(float, WS_H) + ((size_t)blockIdx.x * 512 + t2) * 64;
            if (mp == 0) {
#pragma unroll
                for (int d0 = 0; d0 < 4; ++d0)
#pragma unroll
                    for (int r = 0; r < 16; r += 4) *(f32x4*)(SCR + d0 * 16 + r) = (f32x4){o[d0][r] * rli[r], o[d0][r + 1] * rli[r + 1], o[d0][r + 2] * rli[r + 2], o[d0][r + 3] * rli[r + 3]};
            } else {
                LAS bf16* ot = (LAS bf16*)(lds + L_OST) + wid * (32 * OST_LD);
                float gsub[4];
#pragma unroll
                for (int d0 = 0; d0 < 4; ++d0) gsub[d0] = F.in[14][d0 * 32 + r32b];
#pragma unroll
                for (int r = 0; r < 16; ++r) { float a = 0.f;
#pragma unroll
                    for (int d0 = 0; d0 < 4; ++d0) { const float t = SCR[d0 * 16 + r] - lam * (o[d0][r] * rli[r]); o[d0][r] = t; a += t * t; }
#define SWZ_ADD(x_, k_) x_ += __builtin_bit_cast(float, __builtin_amdgcn_ds_swizzle(__builtin_bit_cast(int, x_), ((k_) << 10) | 0x1F))
                    SWZ_ADD(a, 1); SWZ_ADD(a, 2); SWZ_ADD(a, 4); SWZ_ADD(a, 8); SWZ_ADD(a, 16);
#undef SWZ_ADD
                    const float ssr = 0.8f / sqrtf(a * (1.0f / 128.0f) + LN_EPS);
#pragma unroll
                    for (int d0 = 0; d0 < 4; ++d0) ot[crow(r, hi2) * OST_LD + d0 * 32 + r32b] = (bf16)f2bf(o[d0][r] * ssr * gsub[d0]); }
                asm volatile("s_waitcnt lgkmcnt(0)" ::: "memory");
                unsigned char* Ow = mix + (row0 + wid * QBLK + (lane2 >> 4)) * D + 1024 + h * 128 + (lane2 & 15) * 8;
#pragma unroll
                for (int k = 0; k < 8; ++k) { const u32x4 w = *(const LAS u32x4*)(ot + (k * 4 + (lane2 >> 4)) * OST_LD + (lane2 & 15) * 8); u32x2 w8;
                    w8.x = pk4_fp8(bf_lo(w.x), bf_hi(w.x), bf_lo(w.y), bf_hi(w.y)); w8.y = pk4_fp8(bf_lo(w.z), bf_hi(w.z), bf_lo(w.w), bf_hi(w.w)); *(u32x2*)(Ow + (size_t)k * 4 * D) = w8; }
            }
        }
    }
}
template <int L> __device__ __forceinline__ void ln_route_pass(Frame& F) {
    PH_IDS;
    LAS float* P_g = (LAS float*)F.lds;
    LAS float* P_b = P_g + D;
    LAS float* P_s = P_b + D;
    LAS float* P_h = P_s + D;
    LAS int* lcnt = (LAS int*)(F.lds + LDSX_OFF + 1024);
    LAS int* lbase = lcnt + 32;
    LAS int* rec = lcnt + 64;
    LAS float* recw = (LAS float*)(lcnt + 64 + 256);
    LAS float* lgt = (LAS float*)(F.lds + LDSX_OFF + 8192);
    const bf16* R = (const bf16*)F.out + (size_t)M * D; bf16* X = WSP(bf16, WS_X); unsigned char* H8 = WSP(unsigned char, WS_H8);
    const float* lng = F.in[6] + (L * 2 + 0) * D; const float* lnb = F.in[7] + (L * 2 + 0) * D;
    unsigned* gcnt = F.ctl + CW_CNT + L * 32; int4* list = WSP(int4, WS_LIST2);
    for (int blk = F.vcu; blk < M / 128; blk += F.G) {
        if (tid < 32) lcnt[tid] = 0;
        __syncthreads();
        const int rowb = blk * 128 + wave * 16, b = rowb >> 13;
        { const float* sh = MODP(L, b, 3); const float* sc = MODP(L, b, 4);
          for (int i = tid; i < D; i += 512) { P_g[i] = lng[i]; P_b[i] = lnb[i]; P_s[i] = 1.0f + sc[i]; P_h[i] = sh[i]; } }
        __syncthreads();
        u32x4 raw0[4], raw1[4];
#pragma unroll
        for (int j = 0; j < 4; ++j) { raw0[j] = *(const u32x4*)(R + (size_t)rowb * D + 512 * j + 8 * lane); raw1[j] = *(const u32x4*)(R + (size_t)(rowb + 1) * D + 512 * j + 8 * lane); }
#pragma unroll 1
        for (int pp = 0; pp < 8; ++pp) {
            const int row = rowb + 2 * pp;
            f32x2 v0[16], v1[16]; f32x2 s0 = {0.f, 0.f}, s1 = {0.f, 0.f};
#pragma unroll
            for (int j = 0; j < 4; ++j) {
                v0[4 * j + 0] = (f32x2){bf_lo(raw0[j].x), bf_hi(raw0[j].x)}; v0[4 * j + 1] = (f32x2){bf_lo(raw0[j].y), bf_hi(raw0[j].y)}; v0[4 * j + 2] = (f32x2){bf_lo(raw0[j].z), bf_hi(raw0[j].z)}; v0[4 * j + 3] = (f32x2){bf_lo(raw0[j].w), bf_hi(raw0[j].w)};
                v1[4 * j + 0] = (f32x2){bf_lo(raw1[j].x), bf_hi(raw1[j].x)}; v1[4 * j + 1] = (f32x2){bf_lo(raw1[j].y), bf_hi(raw1[j].y)}; v1[4 * j + 2] = (f32x2){bf_lo(raw1[j].z), bf_hi(raw1[j].z)}; v1[4 * j + 3] = (f32x2){bf_lo(raw1[j].w), bf_hi(raw1[j].w)}; }
#pragma unroll
            for (int i = 0; i < 16; ++i) { s0 += v0[i]; s1 += v1[i]; }
            if (pp < 7) {
#pragma unroll
                for (int j = 0; j < 4; ++j) { raw0[j] = *(const u32x4*)(R + (size_t)(row + 2) * D + 512 * j + 8 * lane); raw1[j] = *(const u32x4*)(R + (size_t)(row + 3) * D + 512 * j + 8 * lane); } }
            float t0 = s0.x + s0.y, t1 = s1.x + s1.y;
#pragma unroll
            for (int o = 1; o < 64; o <<= 1) { t0 += __shfl_xor(t0, o); t1 += __shfl_xor(t1, o); }
            const float mean0 = t0 * (1.0f / D), mean1 = t1 * (1.0f / D); f32x2 q0 = {0.f, 0.f}, q1 = {0.f, 0.f};
#pragma unroll
            for (int i = 0; i < 16; ++i) { v0[i] = v0[i] - mean0; v1[i] = v1[i] - mean1; q0 += v0[i] * v0[i]; q1 += v1[i] * v1[i]; }
            float u0 = q0.x + q0.y, u1 = q1.x + q1.y;
#pragma unroll
            for (int o = 1; o < 64; o <<= 1) { u0 += __shfl_xor(u0, o); u1 += __shfl_xor(u1, o); }
            const float rstd0 = 1.0f / sqrtf(u0 * (1.0f / D) + LN_EPS), rstd1 = 1.0f / sqrtf(u1 * (1.0f / D) + LN_EPS);
#pragma unroll
            for (int j = 0; j < 4; ++j) { const int c = 512 * j + 8 * lane; u32x4 xo0, xo1; u32x2 h80, h81;
#pragma unroll
                for (int h = 0; h < 2; ++h) { const f32x4 g = *(const LAS f32x4*)(P_g + c + 4 * h), bb = *(const LAS f32x4*)(P_b + c + 4 * h), scv = *(const LAS f32x4*)(P_s + c + 4 * h), shv = *(const LAS f32x4*)(P_h + c + 4 * h);
                    const f32x2 ga = {g.x, g.y}, gb = {g.z, g.w}, ba = {bb.x, bb.y}, bc = {bb.z, bb.w}, sa = {scv.x, scv.y}, sb = {scv.z, scv.w}, ha = {shv.x, shv.y}, hb = {shv.z, shv.w};
                    const f32x2 xa0 = v0[4 * j + 2 * h] * rstd0 * ga + ba, xb0 = v0[4 * j + 2 * h + 1] * rstd0 * gb + bc, xa1 = v1[4 * j + 2 * h] * rstd1 * ga + ba, xb1 = v1[4 * j + 2 * h + 1] * rstd1 * gb + bc;
                    const f32x2 ya0 = xa0 * sa + ha, yb0 = xb0 * sb + hb, ya1 = xa1 * sa + ha, yb1 = xb1 * sb + hb;
                    if (h == 0) { h80.x = pk4_fp8(ya0.x, ya0.y, yb0.x, yb0.y); h81.x = pk4_fp8(ya1.x, ya1.y, yb1.x, yb1.y); } else { h80.y = pk4_fp8(ya0.x, ya0.y, yb0.x, yb0.y); h81.y = pk4_fp8(ya1.x, ya1.y, yb1.x, yb1.y); }
                    if (h == 0) { xo0.x = pk2(xa0.x, xa0.y); xo0.y = pk2(xb0.x, xb0.y); xo1.x = pk2(xa1.x, xa1.y); xo1.y = pk2(xb1.x, xb1.y); }
                    else { xo0.z = pk2(xa0.x, xa0.y); xo0.w = pk2(xb0.x, xb0.y); xo1.z = pk2(xa1.x, xa1.y); xo1.w = pk2(xb1.x, xb1.y); } }
                *(u32x4*)(X + (size_t)row * D + c) = xo0; *(u32x4*)(X + (size_t)(row + 1) * D + c) = xo1;
                *(u32x2*)(H8 + (size_t)row * D + c) = h80; *(u32x2*)(H8 + (size_t)(row + 1) * D + c) = h81; }
        }
        VM_WAIT();
        {
            const int l2 = fresh_lane(), i16 = l2 & 15, kq = l2 >> 4;
            const bf16* hp = X + (size_t)(rowb + i16) * D + 8 * kq; const bf16* whp = WSP(bf16, WS_WRT2) + (size_t)((L * 4 + b) * 32 + i16) * D + 8 * kq; const bf16* wlp = whp + 16 * D;
            f32x4 lacc = {0.f, 0.f, 0.f, 0.f};
#pragma unroll 8
            for (int ks = 0; ks < 64; ++ks) { const bf16x8 af = *(const bf16x8*)(hp + 32 * ks); const bf16x8 bh = *(const bf16x8*)(whp + 32 * ks), bl = *(const bf16x8*)(wlp + 32 * ks);
                lacc = __builtin_amdgcn_mfma_f32_16x16x32_bf16(af, bh, lacc, 0, 0, 0); lacc = __builtin_amdgcn_mfma_f32_16x16x32_bf16(af, bl, lacc, 0, 0, 0); }
            LAS float* lp = lgt + (wave * 16 + 4 * kq) * 16 + i16; const float rc = WSP(float, WS_RC)[(L * 4 + b) * 16 + i16];
            lp[0] = lacc.x + rc; lp[16] = lacc.y + rc; lp[32] = lacc.z + rc; lp[48] = lacc.w + rc;
        }
        LDS_WAIT();
        if (lane < 16) {
            const int rl = wave * 16 + fresh_lane(); float sco[16], sel[16];
#pragma unroll
            for (int e4 = 0; e4 < 4; ++e4) { const f32x4 lg = *(const LAS f32x4*)(lgt + rl * 16 + 4 * e4);
                sco[4 * e4 + 0] = 1.0f / (1.0f + __expf(-lg.x)); sco[4 * e4 + 1] = 1.0f / (1.0f + __expf(-lg.y)); sco[4 * e4 + 2] = 1.0f / (1.0f + __expf(-lg.z)); sco[4 * e4 + 3] = 1.0f / (1.0f + __expf(-lg.w)); }
#pragma unroll
            for (int e = 0; e < 16; ++e) sel[e] = sco[e] + F.in[23][e];
            int bg = 0; float bgs = -1e30f;
#pragma unroll
            for (int g = 0; g < 4; ++g) { float m1 = -1e30f, m2 = -1e30f;
#pragma unroll
                for (int i = 0; i < 4; ++i) { const float x = sel[4 * g + i]; if (x > m1) { m2 = m1; m1 = x; } else if (x > m2) m2 = x; }
                const float gs = m1 + m2; if (gs > bgs) { bgs = gs; bg = g; } }
            float s4[4], c4[4];
#pragma unroll
            for (int i = 0; i < 4; ++i) { s4[i] = bg == 0 ? sel[i] : bg == 1 ? sel[4 + i] : bg == 2 ? sel[8 + i] : sel[12 + i]; c4[i] = bg == 0 ? sco[i] : bg == 1 ? sco[4 + i] : bg == 2 ? sco[8 + i] : sco[12 + i]; }
            int i1 = 0; float b1 = s4[0];
#pragma unroll
            for (int i = 1; i < 4; ++i) if (s4[i] > b1) { b1 = s4[i]; i1 = i; }
            int i2 = -1; float b2 = -1e30f;
#pragma unroll
            for (int i = 0; i < 4; ++i) if (i != i1 && s4[i] > b2) { b2 = s4[i]; i2 = i; }
            const float cw1 = i1 == 0 ? c4[0] : i1 == 1 ? c4[1] : i1 == 2 ? c4[2] : c4[3], cw2 = i2 == 0 ? c4[0] : i2 == 1 ? c4[1] : i2 == 2 ? c4[2] : c4[3];
            const float inv = 1.0f / (cw1 + cw2);
            const bool sw = i2 < i1; const int lo_i = sw ? i2 : i1, hi_i = sw ? i1 : i2;
            const int pid = bg * 6 + ((lo_i * (7 - lo_i)) >> 1) + hi_i - lo_i - 1;
            const int r1 = atomicAdd((int*)(lcnt + pid), 1);
            rec[rl] = pid | (r1 << 8); recw[rl * 2] = (sw ? cw2 : cw1) * inv; recw[rl * 2 + 1] = (sw ? cw1 : cw2) * inv;
        }
        __syncthreads();
        if (tid < NL) lbase[tid] = (int)atomicAdd(gcnt + tid, (unsigned)lcnt[tid]);
        __syncthreads();
        if (tid < 128) { const int v = rec[tid], e = v & 255, rank = v >> 8;
            list[e * CAP + lbase[e] + rank] = make_int4(blk * 128 + tid, __float_as_int(recw[tid * 2]), __float_as_int(recw[tid * 2 + 1]), 0); }
        __syncthreads();
    }
}
template <int L> __device__ __forceinline__ int moe_tables(Frame& F, LAS int*& tp, LAS int*& cnt) {
    tp = (LAS int*)(F.lds + LDSX_OFF + 16384); cnt = tp + 32;
    LAS int* ord = tp + 64; LAS int* tpf = tp + 352  ; LAS int* pix = tp + 384  ;
    if (F.wave0 == 0 && fresh_lane() == 0) { int acc = 0, fa = 0, pa = 0;
        for (int e = 0; e < NL; ++e) { const int c = (int)__hip_atomic_load(F.ctl + CW_CNT + L * 32 + e, RLX_AGENT); cnt[e] = c; tp[e] = acc; acc += (c + 255) >> 8; tpf[e] = fa; fa += c >> 8; pix[e] = pa; pa += (c & 255) ? 1 : 0; }
        tp[NL] = acc; tpf[NL] = fa; }
    __syncthreads();
    { const int t_ = F.wave0 * 64 + fresh_lane();
      if (t_ < NL) { const int c = cnt[t_], full = c >> 8, base = tp[t_], fo = tpf[t_]; for (int k = 0; k < full; ++k) ord[fo + k] = base + k; if (c & 255) ord[tpf[NL] + pix[t_]] = base + full; } }
    __syncthreads();
    return tp[NL];
}
template <int L> __device__ __forceinline__ void ln_moe_pass(Frame& F) {
    PH_IDS;
    bf16* X = WSP(bf16, WS_X); unsigned char* H8 = WSP(unsigned char, WS_H8); const bf16* YB = WSP(bf16, WS_YB);
    LAS float* P_g2 = (LAS float*)F.lds; LAS float* P_g = P_g2 + D; LAS float* P_b = P_g + D; LAS float* P_s = P_b + D; LAS float* P_h = P_s + D;
    for (int blk = F.vcu; blk < M / 128; blk += F.G) {
        const int rowb = blk * 128 + wave * 16, b = rowb >> 13;
        __syncthreads();
        for (int i = tid; i < D; i += 512) { P_g2[i] = MODP(L, b, 5)[i]; P_g[i] = F.in[6][(L * 2 + 1) * D + i]; P_b[i] = F.in[7][(L * 2 + 1) * D + i];
            if (L == 0) { P_s[i] = 1.0f + MODP(1, b, 1)[i]; P_h[i] = MODP(1, b, 0)[i]; } }
        __syncthreads();
        u32x4 rx[4], ry0[4];
#define LNM_LOAD(r_) do { _Pragma("unroll") for (int j = 0; j < 4; ++j) { const int c = 512 * j + 8 * lane; rx[j] = *(const u32x4*)(X + (size_t)(r_) * D + c); \
            ry0[j] = *(const u32x4*)(YB + (size_t)(r_) * D + c); } } while (0)
        LNM_LOAD(rowb);
#pragma unroll 1
        for (int rr = 0; rr < 16; ++rr) {
            const int row = rowb + rr;
            f32x2 v[16]; f32x2 s2 = {0.f, 0.f};
#pragma unroll
            for (int j = 0; j < 4; ++j) { const int c = 512 * j + 8 * lane;
                const f32x4 ga = *(const LAS f32x4*)(P_g2 + c), gb = *(const LAS f32x4*)(P_g2 + c + 4);
#define LNM_E(k_, W_, G0_, G1_) v[4 * j + k_] = (f32x2){bf_lo(rx[j].W_), bf_hi(rx[j].W_)} * ALPHA + (f32x2){G0_, G1_} * (f32x2){bf_lo(ry0[j].W_), bf_hi(ry0[j].W_)}
                LNM_E(0, x, ga.x, ga.y); LNM_E(1, y, ga.z, ga.w); LNM_E(2, z, gb.x, gb.y); LNM_E(3, w, gb.z, gb.w);
#undef LNM_E
            }
#pragma unroll
            for (int i = 0; i < 16; ++i) s2 += v[i];
            if (rr < 15) LNM_LOAD(row + 1);
            float t = s2.x + s2.y;
#pragma unroll
            for (int o = 1; o < 64; o <<= 1) t += __shfl_xor(t, o);
            const float mean = t * (1.0f / D); f32x2 q2 = {0.f, 0.f};
#pragma unroll
            for (int i = 0; i < 16; ++i) { v[i] = v[i] - mean; q2 += v[i] * v[i]; }
            float u = q2.x + q2.y;
#pragma unroll
            for (int o = 1; o < 64; o <<= 1) u += __shfl_xor(u, o);
            const float rstd = 1.0f / sqrtf(u * (1.0f / D) + LN_EPS);
#pragma unroll
            for (int j = 0; j < 4; ++j) { const int c = 512 * j + 8 * lane; f32x2 xo[4];
#pragma unroll
                for (int h = 0; h < 2; ++h) { const f32x4 g = *(const LAS f32x4*)(P_g + c + 4 * h), bb = *(const LAS f32x4*)(P_b + c + 4 * h);
                    xo[2 * h] = v[4 * j + 2 * h] * rstd * (f32x2){g.x, g.y} + (f32x2){bb.x, bb.y}; xo[2 * h + 1] = v[4 * j + 2 * h + 1] * rstd * (f32x2){g.z, g.w} + (f32x2){bb.z, bb.w}; }
                if (L == 1) { *(f32x4*)(F.out + (size_t)row * D + c) = (f32x4){xo[0].x, xo[0].y, xo[1].x, xo[1].y}; *(f32x4*)(F.out + (size_t)row * D + c + 4) = (f32x4){xo[2].x, xo[2].y, xo[3].x, xo[3].y}; }
                else { u32x4 w; w.x = pk2(xo[0].x, xo[0].y); w.y = pk2(xo[1].x, xo[1].y); w.z = pk2(xo[2].x, xo[2].y); w.w = pk2(xo[3].x, xo[3].y); *(u32x4*)(X + (size_t)row * D + c) = w;
                    const f32x4 sa = *(const LAS f32x4*)(P_s + c), sb = *(const LAS f32x4*)(P_s + c + 4), ha = *(const LAS f32x4*)(P_h + c), hb = *(const LAS f32x4*)(P_h + c + 4);
                    const f32x2 y0 = xo[0] * (f32x2){sa.x, sa.y} + (f32x2){ha.x, ha.y}, y1 = xo[1] * (f32x2){sa.z, sa.w} + (f32x2){ha.z, ha.w}, y2 = xo[2] * (f32x2){sb.x, sb.y} + (f32x2){hb.x, hb.y}, y3 = xo[3] * (f32x2){sb.z, sb.w} + (f32x2){hb.z, hb.w};
                    u32x2 hw; hw.x = pk4_fp8(y0.x, y0.y, y1.x, y1.y); hw.y = pk4_fp8(y2.x, y2.y, y3.x, y3.y); *(u32x2*)(H8 + (size_t)row * D + c) = hw; } }
        }
#undef LNM_LOAD
    }
}
__device__ __forceinline__ void spatial_simple(Frame& F) {
    PH_IDS;
    LAS float* vt = (LAS float*)F.lds;
    LAS float* wt = (LAS float*)(F.lds + 65536);
    LAS float* st = (LAS float*)(F.lds + LDSX_OFF + 1024);
    const bf16* UV = WSP(bf16, WS_UV); bf16* GT = (bf16*)F.out; const float* vst = WSP(float, WS_VSTP);
    for (int ch = F.vcu; ch < M / 128; ch += F.G) {
        __syncthreads();
        if (tid < 128) { float s = 0.f, s2 = 0.f; const f32x4* pp = (const f32x4*)(vst + (size_t)(ch * 128 + tid) * 64);
#pragma unroll
            for (int i = 0; i < 16; ++i) { const f32x4 t = pp[i]; s += t.x; s2 += t.y; s += t.z; s2 += t.w; }
            const float mean = s * (1.0f / D); const float var = fmaxf(s2 * (1.0f / D) - mean * mean, 0.f);
            st[tid * 2] = mean; st[tid * 2 + 1] = 1.0f / sqrtf(var + LN_EPS); }
#pragma unroll 1
        for (int g = 0; g < 16; ++g) {
            __syncthreads();
            for (int idx = tid; idx < 16384; idx += 512) { const int q = idx >> 7, c = idx & 127, col = g * 128 + c;
                const float v = bf2f(UV[(size_t)(ch * 128 + q) * 4096 + 2048 + col]);
                vt[idx] = (v - st[q * 2]) * st[q * 2 + 1] * F.in[17][col] + F.in[18][col]; wt[q * 129 + c] = F.in[19][g * 16384 + idx]; }
            __syncthreads();
            const int p = tid & 127, cg = tid >> 7;
            float acc[32];
#pragma unroll
            for (int i = 0; i < 32; ++i) acc[i] = 0.f;
#pragma unroll 1
            for (int q = 0; q < 128; ++q) { const float w = wt[p * 129 + q];
#pragma unroll
                for (int i = 0; i < 32; i += 4) { const f32x4 v = *(const LAS f32x4*)(vt + q * 128 + cg * 32 + i); acc[i] += w * v.x; acc[i + 1] += w * v.y; acc[i + 2] += w * v.z; acc[i + 3] += w * v.w; } }
            const size_t row = (size_t)ch * 128 + p; const float bsv = F.in[20][g * 128 + p];
            const bf16* up = UV + row * 4096 + g * 128 + cg * 32; bf16* op = GT + row * D + g * 128 + cg * 32;
#pragma unroll
            for (int i = 0; i < 32; i += 4) { const f32x4 uu = ld_bf4(up + i); st_bf4(op + i, (f32x4){uu.x * (acc[i] + bsv), uu.y * (acc[i + 1] + bsv), uu.z * (acc[i + 2] + bsv), uu.w * (acc[i + 3] + bsv)}); }
        }
    }
}

__device__ __forceinline__ void spatial_fast(Frame& F) {
    using namespace att;
    PH_IDS; const int wid = wave, r32 = lane & 31, hi = lane >> 5;
    LAS char* lds = (LAS char*)F.lds;
    LAS bf16* ot = (LAS bf16*)(lds + 65536) + wid * (32 * 136);
    LAS float* st = (LAS float*)(lds + 135168);
    const bf16* UV = WSP(bf16, WS_UV); unsigned char* GT = (unsigned char*)F.out; const float* vst = WSP(float, WS_VSTP); const bf16* WSB = WSP(bf16, WS_WSB);
    const int q0 = tid >> 4, cc = tid & 15;
    const int gsw = wid >> 2, pbase = (wid & 3) * 32;
    const int vbase = (int)(unsigned)(uintptr_t)lds + v_rd_base(lane) + gsw * 2 * 16384;
    for (int ch = F.vcu; ch < M / 128; ch += F.G) {
        __syncthreads();
        if (tid < 128) { float s = 0.f, s2 = 0.f; const f32x4* pp = (const f32x4*)(vst + (size_t)(ch * 128 + tid) * 64);
#pragma unroll
            for (int i = 0; i < 16; ++i) { const f32x4 t = pp[i]; s += t.x; s2 += t.y; s += t.z; s2 += t.w; }
            const float mean = s * (1.0f / D); const float var = fmaxf(s2 * (1.0f / D) - mean * mean, 0.f);
            st[tid * 2] = mean; st[tid * 2 + 1] = 1.0f / sqrtf(var + LN_EPS); }
        __syncthreads();
        const char* vsrc = (const char*)(UV + (size_t)ch * 128 * 4096 + 2048); const unsigned voff = (unsigned)(q0 * 4096 + cc * 8) * 2u;
        u32x4 raw[2][4];
#define LOADV(it_) do { _Pragma("unroll") for (int gs = 0; gs < 2; ++gs) _Pragma("unroll") for (int j = 0; j < 4; ++j) \
            raw[gs][j] = *(const u32x4*)(vsrc + voff + (size_t)((2 * (it_) + gs) * 256 + j * 32 * 8192)); } while (0)
        LOADV(0);
#pragma unroll 1
        for (int it = 0; it < 8; ++it) {
#pragma unroll
            for (int gs = 0; gs < 2; ++gs) { const int col = (2 * it + gs) * 128 + cc * 8;
                const f32x4 ga = *(const f32x4*)(F.in[17] + col), gb = *(const f32x4*)(F.in[17] + col + 4), ba = *(const f32x4*)(F.in[18] + col), bb = *(const f32x4*)(F.in[18] + col + 4);
#pragma unroll
                for (int j = 0; j < 4; ++j) { const int q = q0 + 32 * j; const float mean = st[2 * q], rstd = st[2 * q + 1]; const u32x4 w = raw[gs][j]; u32x4 o;
                    o.x = pk2((bf_lo(w.x) - mean) * rstd * ga.x + ba.x, (bf_hi(w.x) - mean) * rstd * ga.y + ba.y); o.y = pk2((bf_lo(w.y) - mean) * rstd * ga.z + ba.z, (bf_hi(w.y) - mean) * rstd * ga.w + ba.w);
                    o.z = pk2((bf_lo(w.z) - mean) * rstd * gb.x + bb.x, (bf_hi(w.z) - mean) * rstd * gb.y + bb.y); o.w = pk2((bf_lo(w.w) - mean) * rstd * gb.z + bb.z, (bf_hi(w.w) - mean) * rstd * gb.w + bb.w);
                    *(LAS u32x4*)(lds + (gs * 2 + (q >> 6)) * 16384 + v_st(q & 63, cc * 8)) = o; } }
            __syncthreads();
            if (it + 1 < 8) LOADV(it + 1);
            const int g = 2 * it + gsw;
            bf16x8 wa[8];
#pragma unroll
            for (int ks = 0; ks < 8; ++ks) wa[ks] = *(const bf16x8*)(WSB + (size_t)(g * 128 + pbase + r32) * 128 + ks * 16 + hi * 8);
            f32x16 o[4] = {};
            pv_d0(o, vbase, wa[0], wa[1], wa[2], wa[3]); pv_d0(o, vbase + 16384, wa[4], wa[5], wa[6], wa[7]);
#pragma unroll
            for (int r = 0; r < 16; ++r) { const float bs = F.in[20][g * 128 + pbase + crow(r, hi)];
#pragma unroll
                for (int d0 = 0; d0 < 4; ++d0) ot[crow(r, hi) * 136 + d0 * 32 + r32] = (bf16)f2bf(o[d0][r] + bs); }
            asm volatile("s_waitcnt lgkmcnt(0)" ::: "memory");
            const size_t tok = (size_t)ch * 128 + pbase + (lane >> 4);
#pragma unroll
            for (int k = 0; k < 8; ++k) { const u32x4 sv = *(const LAS u32x4*)(ot + (k * 4 + (lane >> 4)) * 136 + (lane & 15) * 8);
                const u32x4 uu = *(const u32x4*)(UV + (tok + k * 4) * 4096 + g * 128 + (lane & 15) * 8); u32x2 w;
                w.x = pk4_fp8(bf_lo(uu.x) * bf_lo(sv.x), bf_hi(uu.x) * bf_hi(sv.x), bf_lo(uu.y) * bf_lo(sv.y), bf_hi(uu.y) * bf_hi(sv.y));
                w.y = pk4_fp8(bf_lo(uu.z) * bf_lo(sv.z), bf_hi(uu.z) * bf_hi(sv.z), bf_lo(uu.w) * bf_lo(sv.w), bf_hi(uu.w) * bf_hi(sv.w));
                *(u32x2*)(GT + (tok + k * 4) * D + g * 128 + (lane & 15) * 8) = w; }
            __syncthreads();
        }
#undef LOADV
    }
}

constexpr int NPH = 17;
struct Args { const float* in[27]; float* out; unsigned char* ws; int ph_lo, ph_hi; };
__global__ void __launch_bounds__(NWAVES * 64, 2) mk_fwd(Args args) {
    extern __shared__ __attribute__((aligned(16))) unsigned char lds_raw[];
    Frame F;
    F.lds = (LAS unsigned char*)lds_raw;
    F.MISC = (volatile LAS unsigned*)(F.lds + MISC_OFF);
    F.wave0 = __builtin_amdgcn_readfirstlane((int)threadIdx.x >> 6);
    F.G = gridDim.x; { const int bx = blockIdx.x; F.vcu = (F.G % 8 == 0) ? (bx % 8) * (F.G / 8) + bx / 8 : bx; }
#pragma unroll
    for (int i = 0; i < 27; ++i) F.in[i] = args.in[i];
    F.out = args.out; F.ws = args.ws; F.ctl = (unsigned*)(args.ws + WS_CTL);
    if (threadIdx.x < 64) ((LAS unsigned*)(F.lds + MISC_OFF))[threadIdx.x] = 0u;
    __syncthreads();
    XcdBarrier bar; bar.bar = F.ctl + CW_BAR; bar.x = 0; bar.st = nullptr;
    if (MK_N_LAUNCHES == 1) bar = xcd_barrier_post(F.ctl + CW_BAR, F.MISC + 8, threadIdx.x == 0);
    const int lo = args.ph_lo, hi = args.ph_hi;
#define IN(k) (lo <= (k) && (k) < hi)
#define SEAM(k) do { if (IN(k) && IN((k) + 1)) xcd_barrier(bar, F.wave0 == 0 && fresh_lane() == 0); } while (0)

#define RUN(k, ...) do { if (IN(k)) { constexpr bool dup_pass = false; (void)dup_pass; __VA_ARGS__ } SEAM(k); if (DUP_PHASE == (k) && IN(k)) { constexpr bool dup_pass = true; (void)dup_pass; __VA_ARGS__ xcd_barrier(bar, F.wave0 == 0 && fresh_lane() == 0); } } while (0)
    RUN(0, p0_prologue(F););
    RUN(1, p1_modulate(F););
    RUN(2,
        { LAS float* tabL = (LAS float*)(F.lds + LDSX_OFF); { const int t_ = F.wave0 * 64 + fresh_lane(); for (int i = t_; i < 4096; i += 512) tabL[i] = WSP(float, WS_TAB)[i]; } __syncthreads();
          const unsigned char* h8 = (const unsigned char*)F.out + (size_t)M * D * 2; const unsigned char* w8 = WSP(unsigned char, WS_WINE) + (size_t)3072 * D;
          { Gemm g{(const bf16*)h8, (const bf16*)WSP(unsigned char, WS_WINE), M, 6144, D}; pg8::StaticOrder S; S.init(M, 6144, F.G, (int)blockIdx.x);
            EpiInProj E{WSP(bf16, WS_PROJ), WSP(bf16, WS_Q), WSP(bf16, WS_KB), WSP(bf16, WS_VB), tabL, tabL + 2048, 0};
            GEMM_PHASE_F8(EpiInProj, pg8::StaticOrder, F.lds, g, S, E); }
          { Gemm g{(const bf16*)(h8 + (size_t)M * D), (const bf16*)(w8 + (size_t)1024 * D), MC, 2048, D}; pg8::StaticOrder S; S.init(MC, 2048, F.G, (int)blockIdx.x);
            EpiCtx E{WSP(bf16, WS_KB), WSP(bf16, WS_VB)};
            GEMM_PHASE_F8(EpiCtx, pg8::StaticOrder, F.lds, g, S, E); } }
        if (!dup_pass) { const int c = (int)blockIdx.x;
            if (F.G <= 32) convert_weights<1>(F, c * NWAVES + F.wave0, F.G * NWAVES, F.wave0, fresh_lane(), 0, CW_SPLIT1);
            else if (c >= 32) convert_weights<1>(F, (c - 32) * NWAVES + F.wave0, (F.G - 32) * NWAVES, F.wave0, fresh_lane(), 0, CW_SPLIT1); });
#if USE_FAST_ATTN
    RUN(3, conv_pass(F); attn_fast(F););
#else
    RUN(3, conv_pass(F); attn_simple(F););
    RUN(4, attn_finish(F););
#endif
    RUN(5, { Gemm g{(const bf16*)F.out, WSP(bf16, WS_WOUTE), M, D, D}; pg8::StaticOrder S; S.init(M, D, F.G, (int)blockIdx.x);
        EpiRes<true> E{F.in[0], nullptr, MODP(0, 0, 2), (bf16*)F.out + (size_t)M * D};
        GEMM_PHASE_F8(EpiRes<true>, pg8::StaticOrder, F.lds, g, S, E); });
    RUN(6, ln_route_pass<0>(F););
    RUN(7, { LAS int* tp; LAS int* cnt; const int TP = moe_tables<0>(F, tp, cnt);
        Gemm g{(const bf16*)WSP(unsigned char, WS_H8), (const bf16*)(WSP(unsigned char, WS_WGU)), M, 1024, D}; pg8::MoeOrder<true> S{tp, cnt, WSP(int4, WS_LIST2), 8, TP * 8, F.G, (int)blockIdx.x, tp + 64};
        EpiGU E{WSP(unsigned char, WS_HID), WSP(int4, WS_LIST2)}; GEMM_PHASE_F8(EpiGU, pg8::MoeOrder<true>, F.lds, g, S, E);
        if (!dup_pass) { const int rem = (TP * 8) % F.G; const int c = (int)blockIdx.x;
            if (rem == 0) convert_weights<1>(F, c * NWAVES + F.wave0, F.G * NWAVES, F.wave0, fresh_lane(), CW_SPLIT1, CW_N1);
            else if (c >= rem) convert_weights<1>(F, (c - rem) * NWAVES + F.wave0, (F.G - rem) * NWAVES, F.wave0, fresh_lane(), CW_SPLIT1, CW_N1); } });
    RUN(8, { LAS int* tp; LAS int* cnt; const int TP = moe_tables<0>(F, tp, cnt);
        Gemm g{(const bf16*)WSP(unsigned char, WS_HID), (const bf16*)(WSP(unsigned char, WS_WDN)), M, 2048, 2 * ED, ED}; pg8::MoeOrder<false> S{tp, cnt, WSP(int4, WS_LIST2), 8, TP * 8, F.G, (int)blockIdx.x, tp + 64};
        EpiDown E{WSP(int4, WS_LIST2), WSP(bf16, WS_YB)}; GEMM_PHASE_F8(EpiDown, pg8::MoeOrder<false>, F.lds, g, S, E); });
    RUN(9, ln_moe_pass<0>(F););
    RUN(10, { Gemm g{(const bf16*)WSP(unsigned char, WS_H8), WSP(bf16, WS_WINO), M, 4096, D}; pg8::StaticOrder S; S.init(M, 4096, F.G, (int)blockIdx.x);
        EpiGelu E{WSP(bf16, WS_UV), WSP(float, WS_VSTP)}; GEMM_PHASE_F8(EpiGelu, pg8::StaticOrder, F.lds, g, S, E); });
#if USE_FAST_SPATIAL
    RUN(11, spatial_fast(F););
#else
    RUN(11, spatial_simple(F););
#endif
    RUN(12, { Gemm g{(const bf16*)F.out, WSP(bf16, WS_WOUTO), M, D, D}; pg8::StaticOrder S; S.init(M, D, F.G, (int)blockIdx.x);
        EpiRes<false> E{nullptr, WSP(bf16, WS_X), MODP(1, 0, 2), (bf16*)F.out + (size_t)M * D};
        GEMM_PHASE_F8(EpiRes<false>, pg8::StaticOrder, F.lds, g, S, E); });
    RUN(13, ln_route_pass<1>(F););
    RUN(14, { LAS int* tp; LAS int* cnt; const int TP = moe_tables<1>(F, tp, cnt);
        Gemm g{(const bf16*)WSP(unsigned char, WS_H8), (const bf16*)(WSP(unsigned char, WS_WGU) + (size_t)16 * 1024 * D), M, 1024, D}; pg8::MoeOrder<true> S{tp, cnt, WSP(int4, WS_LIST2), 8, TP * 8, F.G, (int)blockIdx.x, tp + 64};
        EpiGU E{WSP(unsigned char, WS_HID), WSP(int4, WS_LIST2)}; GEMM_PHASE_F8(EpiGU, pg8::MoeOrder<true>, F.lds, g, S, E); });
    RUN(15, { LAS int* tp; LAS int* cnt; const int TP = moe_tables<1>(F, tp, cnt);
        Gemm g{(const bf16*)WSP(unsigned char, WS_HID), (const bf16*)(WSP(unsigned char, WS_WDN) + (size_t)16 * D * ED), M, 2048, 2 * ED, ED}; pg8::MoeOrder<false> S{tp, cnt, WSP(int4, WS_LIST2), 8, TP * 8, F.G, (int)blockIdx.x, tp + 64};
        EpiDown E{WSP(int4, WS_LIST2), WSP(bf16, WS_YB)}; GEMM_PHASE_F8(EpiDown, pg8::MoeOrder<false>, F.lds, g, S, E); });
    if (DUP_PHASE == 16) { ln_moe_pass<1>(F); xcd_barrier(bar, F.wave0 == 0 && fresh_lane() == 0); }
    if (IN(16)) { ln_moe_pass<1>(F); }
#undef RUN
#undef IN
#undef SEAM
}

extern "C" void kernel_launch(void* const* d_in, const int* in_sizes, int n_in, void* d_out, int out_size, void* d_ws, size_t ws_size, hipStream_t stream) {
    static int grid = 0;
    if (grid == 0) {
        if (n_in != 27 || in_sizes[0] != M * D || out_size != M * D || ws_size < WS_END) { fprintf(stderr, "kernel_launch: shape/workspace mismatch (n_in %d, ws %zu < %zu)\n", n_in, ws_size, (size_t)WS_END); grid = -1; return; }
        int dev = 0, cus = 0, per_cu = 0;
        if (hipGetDevice(&dev) != hipSuccess || hipDeviceGetAttribute(&cus, hipDeviceAttributeMultiprocessorCount, dev) != hipSuccess) { grid = -1; return; }
        if (hipFuncSetAttribute((const void*)mk_fwd, hipFuncAttributeMaxDynamicSharedMemorySize, LDS_BYTES) != hipSuccess) { fprintf(stderr, "kernel_launch: hipFuncSetAttribute failed\n"); grid = -1; return; }
        if (hipOccupancyMaxActiveBlocksPerMultiprocessor(&per_cu, (const void*)mk_fwd, NWAVES * 64, LDS_BYTES) != hipSuccess || per_cu < 1) fprintf(stderr, "kernel_launch: occupancy query reports %d\n", per_cu);
        (void)hipGetLastError();
        grid = cus;
    }
    if (grid < 0) return;
    if (hipMemsetAsync((char*)d_ws + WS_CTL, 0, CTL_ZERO_BYTES, stream) != hipSuccess) return;
    Args a{};
    for (int i = 0; i < 27; ++i) a.in[i] = (const float*)d_in[i];
    a.out = (float*)d_out; a.ws = (unsigned char*)d_ws;
    if (MK_N_LAUNCHES == 1) { a.ph_lo = 0; a.ph_hi = NPH; hipLaunchKernelGGL(mk_fwd, dim3(grid), dim3(NWAVES * 64), LDS_BYTES, stream, a); }
    else for (int p = 0; p < NPH; ++p) {
#if USE_FAST_ATTN
        if (p == 4) continue;
#endif
        a.ph_lo = p; a.ph_hi = p + 1; hipLaunchKernelGGL(mk_fwd, dim3(grid), dim3(NWAVES * 64), LDS_BYTES, stream, a); }
    const hipError_t le = hipPeekAtLastError();
    if (le != hipSuccess) fprintf(stderr, "kernel_launch: launch failed: %s\n", hipGetErrorName(le));
}
```

```cpp
#include <hip/hip_runtime.h>
#include <cstdio>
#include <cstdint>

#ifndef MK_N_LAUNCHES
#define MK_N_LAUNCHES 1
#endif
#ifndef DUP_PHASE
#define ATT_OVF_LIMIT __builtin_inff()
#define DUP_PHASE -1
#endif
#ifndef USE_FAST_GEMM
#define USE_FAST_GEMM 1
#endif
#ifndef USE_FAST_ATTN
#define USE_FAST_ATTN 1
#endif
#ifndef USE_FAST_SPATIAL
#define USE_FAST_SPATIAL 1
#endif

#define GAS __attribute__((address_space(1)))
#define LAS __attribute__((address_space(3)))
typedef unsigned short bf16;
typedef short bf16x8 __attribute__((ext_vector_type(8)));
typedef float f32x4 __attribute__((ext_vector_type(4)));
typedef float f32x2 __attribute__((ext_vector_type(2)));
typedef unsigned u32x4 __attribute__((ext_vector_type(4)));
typedef unsigned u32x2 __attribute__((ext_vector_type(2)));
typedef GAS unsigned gu32;

constexpr int D = 2048, BATCH = 4, SEQ = 8192, M = BATCH * SEQ, CTXL = 256, MC = BATCH * CTXL, KV = SEQ + CTXL;
constexpr int NE = 16, ED = 512, CAP = 32768, NL = 24;
constexpr float ALPHA = 1.41421356237309515f, LN_EPS = 1e-5f;
constexpr int NWAVES = 8;
constexpr float QSCALE = 0.125f * 1.4426950408889634f;

constexpr size_t MiB = 1u << 20;
constexpr size_t WS_CTL = 0, CTL_ZERO_BYTES = 64 * 1024;
constexpr size_t WS_MOD = 2 * MiB;
constexpr size_t WS_TAB = 3 * MiB;
constexpr size_t WS_WRT = 3 * MiB + 64 * 1024;
constexpr size_t WS_WSB = 3 * MiB + 256 * 1024;
constexpr size_t WS_WRT2 = 24 * MiB;
constexpr size_t WS_RC = 25 * MiB;
constexpr size_t WS_STAT = 26 * MiB;
constexpr size_t WS_LIST = 4 * MiB;
constexpr size_t WS_WINE = 8 * MiB;
constexpr size_t WS_WOUTE = 32 * MiB;
constexpr size_t WS_WINO = 40 * MiB;
constexpr size_t WS_WOUTO = 56 * MiB;
constexpr size_t WS_WGU = 64 * MiB;
constexpr size_t WS_WDN = 192 * MiB;
constexpr size_t WS_A = 256 * MiB;
constexpr size_t WS_R1 = WS_A + 196 * MiB;
constexpr size_t WS_PROJ = WS_A;
constexpr size_t WS_Q = WS_A + 192 * MiB;
constexpr size_t WS_KB = WS_A + 256 * MiB;
constexpr size_t WS_VB = WS_A + 322 * MiB;
constexpr size_t WS_HID = WS_A;
constexpr size_t WS_H8 = WS_A + 324 * MiB;
constexpr size_t WS_YB = WS_A + 68 * MiB;
constexpr size_t WS_UV = WS_A;
constexpr size_t WS_VSTP = WS_A + 256 * MiB;
constexpr size_t WS_H = WS_A + 388 * MiB;
constexpr size_t WS_LIST2 = WS_H;
constexpr size_t WS_X = WS_H + 128 * MiB;
constexpr size_t WS_HC = WS_X + 128 * MiB;
constexpr size_t WS_END = WS_HC + 4 * MiB;
static_assert(WS_VB + (size_t)BATCH * KV * 1024 * 2 <= WS_H && WS_YB + (size_t)M * 2 * 2048 * 2 <= WS_H && WS_END <= 1024 * MiB, "ws map");
constexpr int CW_BAR = 4096;
constexpr int CW_CNT = 8192;
constexpr int CW_VST = 262144;
constexpr int RING_BYTES = 131072, LDSX_OFF = RING_BYTES, MISC_OFF = LDSX_OFF + 24576, LDS_BYTES = 163840;

#define RLX_AGENT __ATOMIC_RELAXED, __HIP_MEMORY_SCOPE_AGENT
#define LDS_WAIT() asm volatile("s_waitcnt lgkmcnt(0)" ::: "memory")
#define VM_WAIT() asm volatile("s_waitcnt vmcnt(0)" ::: "memory")
__device__ __forceinline__ unsigned f2bf(float f) { unsigned u = __builtin_bit_cast(unsigned, f); return (u + 0x7fffu + ((u >> 16) & 1u)) >> 16; }
__device__ __forceinline__ unsigned pk2(float lo, float hi) { unsigned r; asm("v_cvt_pk_bf16_f32 %0, %1, %2" : "=v"(r) : "v"(lo), "v"(hi)); return r; }
__device__ __forceinline__ float bf_lo(unsigned u) { return __uint_as_float(u << 16); }
__device__ __forceinline__ float bf_hi(unsigned u) { return __uint_as_float(u & 0xffff0000u); }
__device__ __forceinline__ float bf2f(bf16 h) { return __uint_as_float((unsigned)h << 16); }
__device__ __forceinline__ f32x4 ld_bf4(const bf16* p) { const u32x2 w = *(const u32x2*)p; return (f32x4){bf_lo(w.x), bf_hi(w.x), bf_lo(w.y), bf_hi(w.y)}; }
__device__ __forceinline__ void st_bf4(bf16* p, f32x4 v) { u32x2 w; w.x = pk2(v.x, v.y); w.y = pk2(v.z, v.w); *(u32x2*)p = w; }
__device__ __forceinline__ float wave_sum(float v) {
#pragma unroll
    for (int o = 1; o < 64; o <<= 1) v += __shfl_xor(v, o);
    return v;
}
__device__ __forceinline__ __amdgpu_buffer_rsrc_t make_rsrc(const void* p, int bytes) {
    const unsigned long long v = (unsigned long long)p; const unsigned lo = __builtin_amdgcn_readfirstlane((unsigned)v), hi = __builtin_amdgcn_readfirstlane((unsigned)(v >> 32));
    return __builtin_amdgcn_make_buffer_rsrc((void*)(((unsigned long long)hi << 32) | lo), 0, bytes, 0x00020000);
}
__device__ __forceinline__ bf16x8 bufld16(__amdgpu_buffer_rsrc_t r, unsigned voff, unsigned soff) { return __builtin_bit_cast(bf16x8, __builtin_amdgcn_raw_buffer_load_b128(r, (int)voff, (int)soff, 0)); }
__device__ __forceinline__ unsigned pk4_fp8(float a, float b, float c, float d) {
    a = __builtin_amdgcn_fmed3f(a, -448.f, 448.f); b = __builtin_amdgcn_fmed3f(b, -448.f, 448.f); c = __builtin_amdgcn_fmed3f(c, -448.f, 448.f); d = __builtin_amdgcn_fmed3f(d, -448.f, 448.f);
    int v = __builtin_amdgcn_cvt_pk_fp8_f32(a, b, 0, false); v = __builtin_amdgcn_cvt_pk_fp8_f32(c, d, v, true); return (unsigned)v; }
__device__ __forceinline__ void st_f8x8(unsigned char* p, f32x4 a, f32x4 b) { u32x2 w; w.x = pk4_fp8(a.x, a.y, a.z, a.w); w.y = pk4_fp8(b.x, b.y, b.z, b.w); *(u32x2*)p = w; }
constexpr float W8_SCALE = 32.0f;
__device__ __forceinline__ float silu_f(float x) { return x * __builtin_amdgcn_rcpf(1.0f + __builtin_amdgcn_exp2f(-1.4426950408889634f * x)); }
__device__ __forceinline__ float gelu_tanh_f(float x) {
    const float w = x * __builtin_fmaf(x * x, -0.1029432396f, -2.3022081981f); return x * __builtin_amdgcn_rcpf(1.0f + __builtin_amdgcn_exp2f(w)); }

#define XB_TMO      128
#define XB_XCNT(j)  (256  + 64 * (j))
#define XB_XSUB(j)  (1280 + 64 * (j))
#define XB_XGEN(j)  (2304 + 64 * (j))
#define XB_TOP      3328
#define XB_TOPGEN   3392
#define XCD_BAR_WORDS 3456
#define XB_SPIN_CAP (1u << 21)
__device__ __forceinline__ unsigned xb_ld(unsigned* p)              { return __hip_atomic_load(p, __ATOMIC_RELAXED, __HIP_MEMORY_SCOPE_AGENT); }
__device__ __forceinline__ unsigned xb_add(unsigned* p, unsigned v) { return __hip_atomic_fetch_add(p, v, __ATOMIC_RELAXED, __HIP_MEMORY_SCOPE_AGENT); }
__device__ __forceinline__ unsigned xb_xcc_id() { return (unsigned)__builtin_amdgcn_s_getreg((3 << 11) | 20) & 0xFu; }
#define XB_SPIN(cond, bar) do { unsigned _sp = 0; while (cond) { __builtin_amdgcn_s_sleep(1); \
    if ((++_sp & 255u) == 0u) { if (xb_ld(&(bar)[XB_TMO])) break; if (_sp > XB_SPIN_CAP) { atomicAdd(&(bar)[XB_TMO], 1u); break; } } } } while (0)
struct XcdBarrier { unsigned* bar; unsigned x; volatile LAS unsigned* st; };
__device__ __forceinline__ XcdBarrier xcd_barrier_post(unsigned* bar, volatile LAS unsigned* st, bool t0) {
    XcdBarrier b; b.bar = bar; b.x = xb_xcc_id(); b.st = st;
    if (t0) (void)xb_add(&bar[XB_XCNT(b.x)], 1u);
    return b;
}
__device__ __forceinline__ void xcd_barrier_complete(unsigned* bar, unsigned x, unsigned& nloc, unsigned& nx) {
    const unsigned G = gridDim.x * gridDim.y * gridDim.z;
    unsigned sum, cnt, mine, sp = 0u;
    for (;;) {
        sum = 0u; cnt = 0u; mine = 0u;
#pragma unroll
        for (unsigned j = 0; j < 16; ++j) { const unsigned c = xb_ld(&bar[XB_XCNT(j)]); sum += c; cnt += (c > 0u) ? 1u : 0u; mine = (j == x) ? c : mine; }
        if (sum == G) break;
        __builtin_amdgcn_s_sleep(1);
        if ((++sp & 255u) == 0u) { if (xb_ld(&bar[XB_TMO])) break; if (sp > XB_SPIN_CAP) { atomicAdd(&bar[XB_TMO], 1u); break; } }
    }
    nloc = mine > 0u ? mine : 1u; nx = cnt > 0u ? cnt : 1u;
}
__device__ __forceinline__ void xcd_barrier(const XcdBarrier& b, bool t0) {
    asm volatile("s_waitcnt vmcnt(0)" ::: "memory");
    __syncthreads();
    if (t0) {
        unsigned* bar = b.bar;
        __builtin_amdgcn_s_waitcnt(0);
        unsigned nloc = b.st[0], nx = b.st[1];
        if (nloc == 0u) { xcd_barrier_complete(bar, b.x, nloc, nx); b.st[0] = nloc; b.st[1] = nx; }
        const unsigned old = xb_add(&bar[XB_XSUB(b.x)], 1u);
        const unsigned gen = old / nloc;
        if (old + 1u == (gen + 1u) * nloc) {
            __builtin_amdgcn_fence(__ATOMIC_RELEASE, "agent");
            asm volatile("s_waitcnt vmcnt(0)" ::: "memory");
            const unsigned og = xb_add(&bar[XB_TOP], 1u);
            const unsigned tg = og / nx;
            if (og + 1u == (tg + 1u) * nx) xb_add(&bar[XB_TOPGEN], 1u);
            else XB_SPIN(xb_ld(&bar[XB_TOPGEN]) == tg, bar);
            __builtin_amdgcn_fence(__ATOMIC_ACQUIRE, "agent");
            xb_add(&bar[XB_XGEN(b.x)], 1u);
            asm volatile("s_waitcnt vmcnt(0)" ::: "memory");
        } else {
            XB_SPIN(xb_ld(&bar[XB_XGEN(b.x)]) == gen, bar);
            __builtin_amdgcn_fence(__ATOMIC_ACQUIRE, "agent");
            asm volatile("s_waitcnt vmcnt(0)" ::: "memory");
        }
    }
    __syncthreads();
}

namespace pg8 {
constexpr int BM = 256, BK = 64, HALF = 128, HTB = HALF * BK * 2, STAGE_BYTES = 8 * HTB, NXCD = 8, WGM = 8;
__host__ __device__ __forceinline__ int lds_byte(int r, int c) { const int st = (r >> 4) * 2 + (c >> 5), rr = r & 15, cc = c & 31, ob = rr * 64 + cc * 2; return st * 1024 + (ob ^ (((ob >> 9) & 1) << 5)); }
__host__ __device__ __forceinline__ void stage_rc(int b, int& R, int& C) { const int st = b / 1024, sb = b % 1024, swz = sb ^ (((sb >> 9) & 1) << 5); R = (st >> 1) * 16 + swz / 64; C = (st & 1) * 32 + (swz % 64) / 2; }
__host__ __device__ __forceinline__ int perm32(int rho) { const int n = rho >> 4, i = rho & 15; return 8 * (i >> 2) + 4 * n + (i & 3); }

struct Unit { int pm, pn, e, lbase, nvalid, pn2, sub; };
struct Gemm { const bf16* A; const bf16* Bt; int M, N, K; int KB = 0; };

struct StaticOrder {
    static constexpr bool GATHER = false;
    int nM, nN, nwg, G, c;
    __device__ void init(int M_, int N_, int G_, int c_) { nM = M_ / BM; nN = N_ / BM; nwg = nM * nN; G = G_; c = c_; }
    __device__ bool next(int i, Unit& u) const {
        const long L = (long)i * G + c; if (L >= nwg) return false;
        int wgid = (int)L; { const int q = nwg / NXCD, r = nwg % NXCD, xcd = wgid % NXCD, off = wgid / NXCD; wgid = (xcd < r ? xcd * (q + 1) : r * (q + 1) + (xcd - r) * q) + off; }
        const int nig = WGM * nN, gid = wgid / nig, fm = gid * WGM, gsz = (nM - fm) < WGM ? (nM - fm) : WGM;
        u.pm = fm + ((wgid % nig) % gsz); u.pn = (wgid % nig) / gsz; u.e = 0; u.lbase = 0; u.nvalid = 256; u.pn2 = u.pn; u.sub = 0; return true;
    }
    __device__ __forceinline__ int arow(const Unit& u, int r) const { return u.pm * BM + r; }
};
template <bool GATHER_> struct MoeOrder {
    static constexpr bool GATHER = GATHER_;
    const LAS int* tp; const LAS int* cnt; const int4* list; int NT, nwg, G, c; const LAS int* ord;
    __device__ bool next(int i, Unit& u) const {
        const long L = (long)i * G + c; if (L >= nwg) return false;
        int w = (int)L; { const int q = nwg / NXCD, r = nwg % NXCD, xcd = w % NXCD, off = w / NXCD; w = (xcd < r ? xcd * (q + 1) : r * (q + 1) + (xcd - r) * q) + off; }
        const int po = w / NT, pnl = w - po * NT, pmg = ord[po];
        typedef int i32x4 __attribute__((ext_vector_type(4)));
        const i32x4 t0 = *(const LAS i32x4*)tp, t1 = *(const LAS i32x4*)(tp + 4), t2 = *(const LAS i32x4*)(tp + 8), t3 = *(const LAS i32x4*)(tp + 12), t4 = *(const LAS i32x4*)(tp + 16), t5 = *(const LAS i32x4*)(tp + 20);
        const int e = (pmg >= t0.y) + (pmg >= t0.z) + (pmg >= t0.w) + (pmg >= t1.x) + (pmg >= t1.y) + (pmg >= t1.z) + (pmg >= t1.w)
                    + (pmg >= t2.x) + (pmg >= t2.y) + (pmg >= t2.z) + (pmg >= t2.w) + (pmg >= t3.x) + (pmg >= t3.y) + (pmg >= t3.z) + (pmg >= t3.w)
                    + (pmg >= t4.x) + (pmg >= t4.y) + (pmg >= t4.z) + (pmg >= t4.w) + (pmg >= t5.x) + (pmg >= t5.y) + (pmg >= t5.z) + (pmg >= t5.w);
        static_assert(NL == 24, "MoeOrder::next reads tp[0..23]");
        const int tile = pmg - tp[e];
        const int g4 = e / 6, p6 = e - 6 * g4, lo = p6 < 3 ? 0 : (p6 < 5 ? 1 : 2), hi = p6 < 3 ? p6 + 1 : (p6 < 5 ? p6 - 1 : 3), elo = 4 * g4 + lo, ehi = 4 * g4 + hi;
        u.pm = pmg; u.e = e; u.sub = pnl; u.lbase = e * CAP + tile * 256; const int nv = cnt[e] - tile * 256; u.nvalid = nv < 256 ? nv : 256;
        if (GATHER_) { u.pn = (pnl < 4 ? elo : ehi) * 4 + (pnl & 3); u.pn2 = u.pn; }
        else { u.pn = elo * NT + pnl; u.pn2 = ehi * NT + pnl; }
        return true;
    }
    __device__ __forceinline__ int arow(const Unit& u, int r) const { if (!GATHER_) return u.pm * BM + r; return r < u.nvalid ? list[u.lbase + r].x : 0; }
};

template <class Epi, class Sched>
__device__ __forceinline__ void gemm_simple(int wid, int lane, const Gemm g, const Sched& S, const Epi& E) {
    const int wr = wid >> 2, wc = wid & 3, fr = lane & 15, fq = lane >> 4;
    const int K = g.K;
    for (int ui = 0;; ++ui) {
        Unit u; if (!S.next(ui, u)) break;
        f32x4 acc[2][2][4][2];
#pragma unroll
        for (int a = 0; a < 2; ++a)
#pragma unroll
            for (int b = 0; b < 2; ++b)
#pragma unroll
                for (int m = 0; m < 4; ++m)
#pragma unroll
                    for (int n = 0; n < 2; ++n) acc[a][b][m][n] = (f32x4){0.f, 0.f, 0.f, 0.f};
        unsigned ap[2][4], bp[2][2];
#pragma unroll
        for (int a = 0; a < 2; ++a)
#pragma unroll
            for (int m = 0; m < 4; ++m) ap[a][m] = (unsigned)S.arow(u, a * HALF + wr * 64 + m * 16 + fr) * (unsigned)K + fq * 8;
#pragma unroll
        for (int b = 0; b < 2; ++b)
#pragma unroll
            for (int n = 0; n < 2; ++n) { const int rho = 16 * n + fr; bp[b][n] = (unsigned)(u.pn * BM + b * HALF + wc * 32 + (Epi::PERM ? perm32(rho) : rho)) * (unsigned)K + fq * 8; }
#pragma unroll 1
        for (int k = 0; k < K; k += 32) {
            bf16x8 Af[2][4], Bf[2][2];
#pragma unroll
            for (int a = 0; a < 2; ++a)
#pragma unroll
                for (int m = 0; m < 4; ++m) Af[a][m] = *(const bf16x8*)(g.A + ap[a][m] + k);
#pragma unroll
            for (int b = 0; b < 2; ++b)
#pragma unroll
                for (int n = 0; n < 2; ++n) Bf[b][n] = *(const bf16x8*)(g.Bt + bp[b][n] + k);
#pragma unroll
            for (int a = 0; a < 2; ++a)
#pragma unroll
                for (int b = 0; b < 2; ++b)
#pragma unroll
                    for (int m = 0; m < 4; ++m)
#pragma unroll
                        for (int n = 0; n < 2; ++n) acc[a][b][m][n] = __builtin_amdgcn_mfma_f32_16x16x32_bf16(Bf[b][n], Af[a][m], acc[a][b][m][n], 0, 0, 0);
        }
        E(acc, u, wr, wc, fr, fq);
    }
}

typedef int v8i32 __attribute__((ext_vector_type(8)));
typedef int v4i32 __attribute__((ext_vector_type(4)));
template <class Epi, class Sched, bool F8 = false>
__device__ __forceinline__ void gemm_phase(int wid, int lane, LAS unsigned char* lds, const Gemm g, const Sched& S, const Epi& E) {
    const int tid = wid * 64 + lane, wr = wid >> 2, wc = wid & 3, fr = lane & 15, fq = lane >> 4;
    const int K = F8 ? g.K / 2 : g.K  , nt = K / BK;
    const int KBr = g.KB ? (F8 ? g.KB / 2 : g.KB) : K  , ntB = KBr / BK;
    unsigned voffA[2], voffB[2]; int Rr[2], Cc[2];
#pragma unroll
    for (int i = 0; i < 2; ++i) { int R, C; stage_rc(tid * 16 + i * 8192, R, C); const int Rb = Epi::PERM ? ((R & ~31) + perm32(R & 31)) : R;
        voffA[i] = (unsigned)(R * K + C) * 2u; voffB[i] = (unsigned)(Rb * KBr + C) * 2u; Rr[i] = R; Cc[i] = C; }
    const unsigned kstep = (unsigned)(BK * 2);
    const unsigned hstep = (unsigned)HALF * (unsigned)K * 2u;
    const unsigned tstep = 2 * hstep;
    const unsigned hstepB = (unsigned)HALF * (unsigned)KBr * 2u, tstepB = 2 * hstepB;
    const __amdgpu_buffer_rsrc_t rsA = make_rsrc(g.A, 0x7fffffff), rsB = make_rsrc(g.Bt, 0x7fffffff);
    const unsigned ldsw = (unsigned)wid * 1024u;
    const int aoff0 = lds_byte(wr * 64 + fr, F8 ? fq * 16 : fq * 8), aoff1 = F8 ? lds_byte(wr * 64 + fr, fq * 16 + 8) : aoff0 + 1024;
    const int boff0 = lds_byte(wc * 32 + fr, F8 ? fq * 16 : fq * 8), boff1 = F8 ? lds_byte(wc * 32 + fr, fq * 16 + 8) : boff0 + 1024;
#define PG8_SA(b, h) (((b) * 2 + (h)) * HTB)
#define PG8_SB(b, h) ((4 + (b) * 2 + (h)) * HTB)
#define PG8_STAGE(bufoff, soff, voff) do { _Pragma("unroll") for (int _i = 0; _i < 2; ++_i) \
        __builtin_amdgcn_raw_ptr_buffer_load_lds(rsB, (LAS void*)(lds + (bufoff) + ldsw + _i * 8192), 16, (int)(voff)[_i], (int)(soff), 0, 0); } while (0)
#define PG8_STAGE_A(bufoff, h, contig_off, kt_bytes, use_next) do { _Pragma("unroll") for (int _i = 0; _i < 2; ++_i) { \
        const unsigned vo_ = Sched::GATHER ? ((use_next) ? gN[h][_i] : gC[h][_i]) : voffA[_i]; const unsigned so_ = Sched::GATHER ? (unsigned)(kt_bytes) : (unsigned)(contig_off); \
        __builtin_amdgcn_raw_ptr_buffer_load_lds(rsA, (LAS void*)(lds + (bufoff) + ldsw + _i * 8192), 16, (int)vo_, (int)so_, 0, 0); } } while (0)
#define PG8_GOFF(u_, o_) do { _Pragma("unroll") for (int _h = 0; _h < 2; ++_h) _Pragma("unroll") for (int _i = 0; _i < 2; ++_i) \
        o_[_h][_i] = ((unsigned)S.arow(u_, _h * HALF + Rr[_i]) * (unsigned)K + (unsigned)Cc[_i]) * 2u; } while (0)
#define PG8_LDA(dst, b, h) do { _Pragma("unroll") for (int m = 0; m < 4; ++m) { dst[m][0] = *(const LAS bf16x8*)(lds + PG8_SA(b, h) + aoff0 + m * 2048); dst[m][1] = *(const LAS bf16x8*)(lds + PG8_SA(b, h) + aoff1 + m * 2048); } } while (0)
#define PG8_LDB(dst, b, h) do { _Pragma("unroll") for (int n = 0; n < 2; ++n) { dst[n][0] = *(const LAS bf16x8*)(lds + PG8_SB(b, h) + boff0 + n * 2048); dst[n][1] = *(const LAS bf16x8*)(lds + PG8_SB(b, h) + boff1 + n * 2048); } } while (0)
#define PG8_V8(x_) __builtin_shufflevector(__builtin_bit_cast(v4i32, (x_)[0]), __builtin_bit_cast(v4i32, (x_)[1]), 0, 1, 2, 3, 4, 5, 6, 7)
#define PG8_MMA(ai, bj, At, Bt) do { __builtin_amdgcn_s_setprio(1); _Pragma("unroll") for (int m = 0; m < 4; ++m) _Pragma("unroll") for (int n = 0; n < 2; ++n) { \
        if constexpr (F8) { const v8i32 b8_ = PG8_V8(Bt[n]), a8_ = PG8_V8(At[m]);   \
            asm volatile("v_mfma_scale_f32_16x16x128_f8f6f4 %0, %1, %2, %0, %3, %4 op_sel_hi:[0,0,0]" : "+v"(acc[ai][bj][m][n]) : "v"(b8_), "v"(a8_), "v"(sc_w), "v"(sc_a)); } \
        else { _Pragma("unroll") for (int k = 0; k < 2; ++k) acc[ai][bj][m][n] = __builtin_amdgcn_mfma_f32_16x16x32_bf16(Bt[n][k], At[m][k], acc[ai][bj][m][n], 0, 0, 0); } } \
        __builtin_amdgcn_s_setprio(0); } while (0)
#define PG8_WAIT_V(n) asm volatile("s_waitcnt vmcnt(" #n ")" ::: "memory")
#define PG8_WAIT_L(n) asm volatile("s_waitcnt lgkmcnt(" #n ")" ::: "memory")
#define PG8_BAR __builtin_amdgcn_s_barrier()
#define PG8_SCHED __builtin_amdgcn_sched_barrier(0)
    const int sc_w = 0x7a7a7a7a  , sc_a = 0x7f7f7f7f  ; (void)sc_w; (void)sc_a;
    Unit cur, nxt; int ui = 0; int relaxN = 0;
    if (!S.next(0, cur)) return;
    unsigned gC[2][2], gN[2][2];
    if constexpr (Sched::GATHER) { PG8_GOFF(cur, gC); }
    else {
#pragma unroll
        for (int h = 0; h < 2; ++h)
#pragma unroll
            for (int i = 0; i < 2; ++i) { gC[h][i] = 0u; gN[h][i] = 0u; } }
    f32x4 acc[2][2][4][2];
#pragma unroll
    for (int a = 0; a < 2; ++a)
#pragma unroll
        for (int b = 0; b < 2; ++b)
#pragma unroll
            for (int m = 0; m < 4; ++m)
#pragma unroll
                for (int n = 0; n < 2; ++n) acc[a][b][m][n] = (f32x4){0.f, 0.f, 0.f, 0.f};
    bf16x8 At[4][2], B0[2][2], B1[2][2];
    unsigned cA = Sched::GATHER ? 0u : (unsigned)cur.pm * tstep, cB = (unsigned)cur.pn * tstepB, cB2 = (unsigned)cur.pn2 * tstepB - (unsigned)ntB * kstep;
    PG8_STAGE(PG8_SB(0, 0), cB, voffB); PG8_STAGE(PG8_SB(0, 1), cB + hstepB, voffB); PG8_STAGE_A(PG8_SA(0, 0), 0, cA, 0, false); PG8_STAGE_A(PG8_SA(0, 1), 1, cA + hstep, 0, false);
    if (wr == 1) PG8_BAR;
    PG8_WAIT_V(2); PG8_BAR;
    PG8_STAGE(PG8_SB(1, 0), cB + kstep, voffB); PG8_STAGE_A(PG8_SA(1, 0), 0, cA + kstep, kstep, false); PG8_STAGE(PG8_SB(1, 1), cB + hstepB + kstep, voffB);
    PG8_WAIT_V(6); PG8_BAR;
    for (;;) {
        const bool has_next = S.next(ui + 1, nxt);
        if constexpr (Sched::GATHER) { if (has_next) { PG8_GOFF(nxt, gN); } else {
#pragma unroll
            for (int h = 0; h < 2; ++h)
#pragma unroll
                for (int i = 0; i < 2; ++i) gN[h][i] = gC[h][i]; } }
        const unsigned nA = (has_next && !Sched::GATHER) ? (unsigned)nxt.pm * tstep : cA, nB = has_next ? (unsigned)nxt.pn * tstepB : cB, nB2 = has_next ? (unsigned)nxt.pn2 * tstepB - (unsigned)ntB * kstep : cB2;
        for (int t = 0; t < nt; t += 2) {
            const bool last = (t == nt - 2);
            const unsigned a1 = cA + (unsigned)(t + 1) * kstep;
            const unsigned a2 = last ? nA : cA + (unsigned)(t + 2) * kstep, b2 = last ? nB : ((t + 2) < ntB ? cB : cB2) + (unsigned)(t + 2) * kstep;
            const unsigned a3 = a2 + kstep, b3 = last ? nB + kstep : ((t + 3) < ntB ? cB : cB2) + (unsigned)(t + 3) * kstep;
            const unsigned k1 = (unsigned)(t + 1) * kstep, k2 = last ? 0u : (unsigned)(t + 2) * kstep, k3 = k2 + kstep;
            const bool first = (t == 0), rlx = first && relaxN > 0, halfu = cur.nvalid <= 128;
#define PG8_WAIT_VR() do { if (rlx) { if (relaxN == 8) PG8_WAIT_V(16); else if (relaxN == 16) PG8_WAIT_V(24); else PG8_WAIT_V(8); } else PG8_WAIT_V(8); } while (0)
            PG8_LDB(B0, 0, 0); PG8_LDB(B1, 0, 1); PG8_SCHED; PG8_LDA(At, 0, 0); if (!(first && ui > 0)) PG8_STAGE_A(PG8_SA(1, 1), 1, a1 + hstep, k1, false);
            PG8_WAIT_VR(); PG8_WAIT_L(0); PG8_BAR; PG8_MMA(0, 0, At, B0); PG8_MMA(0, 1, At, B1); PG8_BAR; PG8_SCHED;
            PG8_LDA(At, 0, 1); PG8_STAGE(PG8_SB(0, 0), b2, voffB); PG8_STAGE(PG8_SB(0, 1), b2 + hstepB, voffB); PG8_STAGE_A(PG8_SA(0, 0), 0, a2, k2, last);
            PG8_WAIT_VR(); PG8_WAIT_L(0); PG8_BAR; if (!halfu) { PG8_MMA(1, 0, At, B0); PG8_MMA(1, 1, At, B1); } PG8_BAR; PG8_SCHED;
            PG8_LDB(B0, 1, 0); PG8_LDB(B1, 1, 1); PG8_SCHED; PG8_LDA(At, 1, 0); PG8_STAGE_A(PG8_SA(0, 1), 1, a2 + hstep, k2, last);
            PG8_WAIT_VR(); PG8_WAIT_L(0); PG8_BAR; PG8_MMA(0, 0, At, B0); PG8_MMA(0, 1, At, B1); PG8_BAR; PG8_SCHED;
            PG8_LDA(At, 1, 1); PG8_STAGE(PG8_SB(1, 0), b3, voffB); PG8_STAGE(PG8_SB(1, 1), b3 + hstepB, voffB); PG8_STAGE_A(PG8_SA(1, 0), 0, a3, k3, last);
            PG8_WAIT_V(8); PG8_WAIT_L(0); PG8_BAR; if (!halfu) { PG8_MMA(1, 0, At, B0); PG8_MMA(1, 1, At, B1); } PG8_BAR; PG8_SCHED;
            if (last && has_next) { PG8_STAGE_A(PG8_SA(1, 1), 1, a3 + hstep, k3, true); PG8_SCHED; }
#undef PG8_WAIT_VR
        }
        if (wr == 0) PG8_BAR;
        if constexpr (F8) asm volatile("s_nop 15\n\ts_nop 15" ::: "memory");
        E(acc, cur, wr, wc, fr, fq);
        relaxN = has_next ? E.stores_lb(cur) : 0;
        if (!has_next) break;
#pragma unroll
        for (int a = 0; a < 2; ++a)
#pragma unroll
            for (int b = 0; b < 2; ++b)
#pragma unroll
                for (int m = 0; m < 4; ++m)
#pragma unroll
                    for (int n = 0; n < 2; ++n) acc[a][b][m][n] = (f32x4){0.f, 0.f, 0.f, 0.f};
        cur = nxt; cA = nA; cB = nB; cB2 = nB2; ++ui;
#pragma unroll
        for (int h = 0; h < 2; ++h)
#pragma unroll
            for (int i = 0; i < 2; ++i) gC[h][i] = gN[h][i];
        if (wr == 1) PG8_BAR;
    }
    PG8_WAIT_V(0);
    PG8_BAR;
#undef PG8_SA
#undef PG8_SB
#undef PG8_STAGE
#undef PG8_STAGE_A
#undef PG8_GOFF
#undef PG8_LDA
#undef PG8_LDB
#undef PG8_MMA
#undef PG8_V8
#undef PG8_WAIT_V
#undef PG8_WAIT_L
#undef PG8_BAR
#undef PG8_SCHED
}
}
using pg8::Unit; using pg8::Gemm; using pg8::HALF; using pg8::BM;

#if USE_FAST_GEMM
#define GEMM_PHASE(EpiT, SchedT, lds, g, S, E) pg8::gemm_phase<EpiT, SchedT>(F.wave0, fresh_lane(), lds, g, S, E)
#define GEMM_PHASE_F8(EpiT, SchedT, lds, g, S, E) pg8::gemm_phase<EpiT, SchedT, true>(F.wave0, fresh_lane(), lds, g, S, E)
#else
#define GEMM_PHASE(EpiT, SchedT, lds, g, S, E) pg8::gemm_simple<EpiT, SchedT>(F.wave0, fresh_lane(), g, S, E)
#endif

__device__ __forceinline__ void st_bf8(bf16* p, f32x4 a, f32x4 b) { u32x4 w; w.x = pk2(a.x, a.y); w.y = pk2(a.z, a.w); w.z = pk2(b.x, b.y); w.w = pk2(b.z, b.w); *(u32x4*)p = w; }
__device__ __forceinline__ float lane32_partner(float v, bool upper) {
    auto rr = __builtin_amdgcn_permlane32_swap(__float_as_uint(v), __float_as_uint(v), false, false); return __uint_as_float(upper ? rr[0] : rr[1]);
}
struct EpiInProj {
    static constexpr bool PERM = true, AFTER_DRAIN = false;
    bf16* PROJ; bf16* Q; bf16* KB; bf16* VB; const LAS float* tabc; const LAS float* tabs; int pn_off;
    __device__ __forceinline__ int stores_lb(const Unit& u) const { return (u.pn + pn_off) < 8 ? 8 : 16; }
    __device__ __forceinline__ void operator()(const f32x4 (&acc)[2][2][4][2], const Unit& u, int wr, int wc, int fr, int fq) const {
        const int pn = u.pn + pn_off;
        if (pn < 8) {
#pragma unroll
            for (int ai = 0; ai < 2; ++ai)
#pragma unroll
                for (int m = 0; m < 4; ++m) { const int row = u.pm * BM + ai * HALF + wr * 64 + m * 16 + fr;
                    st_bf8(PROJ + (size_t)row * 2048 + pn * 128 + wc * 32 + 8 * fq, acc[ai][0][m][0] * acc[ai][1][m][0], acc[ai][0][m][1] * acc[ai][1][m][1]); }
        } else if (pn < 12) {
#pragma unroll
            for (int ai = 0; ai < 2; ++ai)
#pragma unroll
                for (int m = 0; m < 4; ++m) { const int row = u.pm * BM + ai * HALF + wr * 64 + m * 16 + fr; bf16* rp = PROJ + (size_t)row * 2048 + 1024 + (pn - 8) * 256 + wc * 32 + 8 * fq;
#pragma unroll
                    for (int bj = 0; bj < 2; ++bj) st_bf8(rp + bj * HALF, acc[ai][bj][m][0], acc[ai][bj][m][1]); }
        } else if (pn < 20) {
            const bool isq = pn < 16; const int cb = (pn - (isq ? 12 : 16)) * 256 + wc * 32 + 8 * fq; const size_t kb_minus_q = (size_t)((unsigned char*)KB - (unsigned char*)Q); const int axis = wc & 1; const bool upper = fq >= 2; const int fo = 8 * (fq & 1);
#pragma unroll
            for (int ai = 0; ai < 2; ++ai)
#pragma unroll
                for (int m = 0; m < 4; ++m) { const int row = u.pm * BM + ai * HALF + wr * 64 + m * 16 + fr; const int t = row & (SEQ - 1), b = row >> 13;
                    const int pos = axis ? (t & 63) : (t >> 6);
                    f32x4 cs0 = *(const LAS f32x4*)(tabc + pos * 16 + fo), cs1 = *(const LAS f32x4*)(tabc + pos * 16 + fo + 4); f32x4 sn0 = *(const LAS f32x4*)(tabs + pos * 16 + fo), sn1 = *(const LAS f32x4*)(tabs + pos * 16 + fo + 4);
                    if (!upper) { sn0 = -sn0; sn1 = -sn1; }
                    unsigned char* rp = (unsigned char*)Q + (isq ? ((size_t)row * 1024 + cb) : (kb_minus_q + ((size_t)b * KV + CTXL + t) * 1024 + cb));
                    if (isq) { cs0 = cs0 * QSCALE; cs1 = cs1 * QSCALE; sn0 = sn0 * QSCALE; sn1 = sn1 * QSCALE; }
#pragma unroll
                    for (int bj = 0; bj < 2; ++bj) { const f32x4 a0 = acc[ai][bj][m][0], a1 = acc[ai][bj][m][1];
                        const f32x4 p0 = (f32x4){lane32_partner(a0.x, upper), lane32_partner(a0.y, upper), lane32_partner(a0.z, upper), lane32_partner(a0.w, upper)};
                        const f32x4 p1 = (f32x4){lane32_partner(a1.x, upper), lane32_partner(a1.y, upper), lane32_partner(a1.z, upper), lane32_partner(a1.w, upper)};
                        st_f8x8(rp + bj * HALF, a0 * cs0 + p0 * sn0, a1 * cs1 + p1 * sn1); } }
        } else {
            const int cb = (pn - 20) * 256 + wc * 32 + 8 * fq;
#pragma unroll
            for (int ai = 0; ai < 2; ++ai)
#pragma unroll
                for (int m = 0; m < 4; ++m) { const int row = u.pm * BM + ai * HALF + wr * 64 + m * 16 + fr; const int t = row & (SEQ - 1), b = row >> 13;
                    unsigned char* rp = (unsigned char*)VB + ((size_t)b * KV + CTXL + t) * 1024 + cb;
#pragma unroll
                    for (int bj = 0; bj < 2; ++bj) st_f8x8(rp + bj * HALF, acc[ai][bj][m][0], acc[ai][bj][m][1]); }
        }
    }
};
struct EpiCtx {
    static constexpr bool PERM = true, AFTER_DRAIN = false;
    bf16* KB; bf16* VB;
    __device__ __forceinline__ int stores_lb(const Unit&) const { return 16; }
    __device__ __forceinline__ void operator()(const f32x4 (&acc)[2][2][4][2], const Unit& u, int wr, int wc, int fr, int fq) const {
        const bool isk = u.pn < 4; const int cb = (u.pn & 3) * 256 + wc * 32 + 8 * fq;
#pragma unroll
        for (int ai = 0; ai < 2; ++ai)
#pragma unroll
            for (int m = 0; m < 4; ++m) { const int row = u.pm * BM + ai * HALF + wr * 64 + m * 16 + fr; const int t = row & (CTXL - 1), b = row >> 8;
                const size_t eo = ((size_t)b * KV + t) * 1024 + cb;
#pragma unroll
                for (int bj = 0; bj < 2; ++bj) st_f8x8((unsigned char*)(isk ? KB : VB) + eo + bj * HALF, acc[ai][bj][m][0], acc[ai][bj][m][1]); }
    }
};
template <bool RES_F32> struct EpiRes {
    static constexpr bool PERM = true, AFTER_DRAIN = false;
    const float* xf; const bf16* xb; const float* gate  ; bf16* R;
    __device__ __forceinline__ int stores_lb(const Unit&) const { return 16; }
    struct Raw { f32x4 f[2][2][2]; u32x4 h[2][2]; };
    __device__ __forceinline__ void load(Raw& r, const Unit& u, int st, int wr, int fr, int cb) const {
        const int ai = st >> 1, mp = (st & 1) * 2;
#pragma unroll
        for (int mm = 0; mm < 2; ++mm) { const size_t off = (size_t)(u.pm * BM + ai * HALF + wr * 64 + (mp + mm) * 16 + fr) * D + cb;
#pragma unroll
            for (int bj = 0; bj < 2; ++bj) {
                if (RES_F32) { r.f[mm][bj][0] = *(const f32x4*)(xf + off + bj * HALF); r.f[mm][bj][1] = *(const f32x4*)(xf + off + bj * HALF + 4); }
                else r.h[mm][bj] = *(const u32x4*)(xb + off + bj * HALF); } }
    }
    __device__ __forceinline__ void operator()(const f32x4 (&acc)[2][2][4][2], const Unit& u, int wr, int wc, int fr, int fq) const {
        const int cb = u.pn * BM + wc * 32 + 8 * fq; const int b = (u.pm * BM) >> 13;
        f32x4 gv[2][2];
#pragma unroll
        for (int bj = 0; bj < 2; ++bj)
#pragma unroll
            for (int n = 0; n < 2; ++n) gv[bj][n] = *(const f32x4*)(gate + (size_t)b * (6 * D) + cb + bj * HALF + 4 * n);
        Raw ra, rb2; load(ra, u, 0, wr, fr, cb);
#pragma unroll
        for (int st = 0; st < 4; ++st) {
            Raw& cur = (st & 1) ? rb2 : ra; Raw& nxt = (st & 1) ? ra : rb2;
            if (st < 3) load(nxt, u, st + 1, wr, fr, cb);
            const int ai = st >> 1, mp = (st & 1) * 2;
#pragma unroll
            for (int mm = 0; mm < 2; ++mm) { const size_t off = (size_t)(u.pm * BM + ai * HALF + wr * 64 + (mp + mm) * 16 + fr) * D + cb;
#pragma unroll
                for (int bj = 0; bj < 2; ++bj) { f32x4 r0, r1;
                    if (RES_F32) { r0 = cur.f[mm][bj][0]; r1 = cur.f[mm][bj][1]; }
                    else { const u32x4 w = cur.h[mm][bj]; r0 = (f32x4){bf_lo(w.x), bf_hi(w.x), bf_lo(w.y), bf_hi(w.y)}; r1 = (f32x4){bf_lo(w.z), bf_hi(w.z), bf_lo(w.w), bf_hi(w.w)}; }
                    st_bf8(R + off + bj * HALF, r0 * ALPHA + gv[bj][0] * acc[ai][bj][mp + mm][0], r1 * ALPHA + gv[bj][1] * acc[ai][bj][mp + mm][1]); } }
        }
    }
};
struct EpiGU {
    static constexpr bool PERM = true, AFTER_DRAIN = false;
    unsigned char* HID;
    const int4* list;
    __device__ __forceinline__ int stores_lb(const Unit&) const { return 8; }
    __device__ __forceinline__ void operator()(const f32x4 (&acc)[2][2][4][2], const Unit& u, int wr, int wc, int fr, int fq) const {
        const int cb = u.sub * 128 + wc * 32 + 8 * fq; const bool hiw = u.sub >= 4;
        float wgt[2][4];
#pragma unroll
        for (int ai = 0; ai < 2; ++ai)
#pragma unroll
            for (int m = 0; m < 4; ++m) { const int rl = ai * HALF + wr * 64 + m * 16 + fr; const int4 le = list[u.lbase + (rl < u.nvalid ? rl : 0)]; wgt[ai][m] = __int_as_float(hiw ? le.z : le.y); }
#pragma unroll
        for (int ai = 0; ai < 2; ++ai)
#pragma unroll
            for (int m = 0; m < 4; ++m) { const int row = u.pm * BM + ai * HALF + wr * 64 + m * 16 + fr; const float w_ = wgt[ai][m];
                const f32x4 g0 = acc[ai][0][m][0], g1 = acc[ai][0][m][1], u0 = acc[ai][1][m][0] * w_, u1 = acc[ai][1][m][1] * w_; u32x2 w;
                w.x = pk4_fp8(silu_f(g0.x) * u0.x, silu_f(g0.y) * u0.y, silu_f(g0.z) * u0.z, silu_f(g0.w) * u0.w); w.y = pk4_fp8(silu_f(g1.x) * u1.x, silu_f(g1.y) * u1.y, silu_f(g1.z) * u1.z, silu_f(g1.w) * u1.w);
                *(u32x2*)(HID + (size_t)row * (2 * ED) + cb) = w; }
    }
};
struct EpiDown {
    static constexpr bool PERM = true, AFTER_DRAIN = false;
    const int4* list; bf16* YB;
    __device__ __forceinline__ int stores_lb(const Unit& u) const { return u.nvalid == 256 ? 16 : 0; }
    __device__ __forceinline__ void operator()(const f32x4 (&acc)[2][2][4][2], const Unit& u, int wr, int wc, int fr, int fq) const {
        const int cb = u.sub * 256 + wc * 32 + 8 * fq;
        int tok[2][4];
#pragma unroll
        for (int ai = 0; ai < 2; ++ai)
#pragma unroll
            for (int m = 0; m < 4; ++m) { const int rl = ai * HALF + wr * 64 + m * 16 + fr; tok[ai][m] = list[u.lbase + (rl < u.nvalid ? rl : 0)].x; }
#pragma unroll
        for (int ai = 0; ai < 2; ++ai)
#pragma unroll
            for (int m = 0; m < 4; ++m) { const int rl = ai * HALF + wr * 64 + m * 16 + fr;
                if (rl < u.nvalid) { bf16* rp = YB + (size_t)tok[ai][m] * D + cb;
#pragma unroll
                    for (int bj = 0; bj < 2; ++bj) st_bf8(rp + bj * HALF, acc[ai][bj][m][0], acc[ai][bj][m][1]); } }
    }
};
struct EpiGelu {
    static constexpr bool PERM = true, AFTER_DRAIN = false;
    bf16* UV; float* vst;
    __device__ __forceinline__ int stores_lb(const Unit&) const { return 16; }
    __device__ __forceinline__ void operator()(const f32x4 (&acc)[2][2][4][2], const Unit& u, int wr, int wc, int fr, int fq) const {
        const int cb = u.pn * BM + wc * 32 + 8 * fq; const bool isv = u.pn >= 8;
#pragma unroll
        for (int ai = 0; ai < 2; ++ai)
#pragma unroll
            for (int m = 0; m < 4; ++m) { const int row = u.pm * BM + ai * HALF + wr * 64 + m * 16 + fr; bf16* rp = UV + (size_t)row * 4096 + cb; float s = 0.f, s2 = 0.f;
#pragma unroll
                for (int bj = 0; bj < 2; ++bj) { f32x4 v[2];
#pragma unroll
                    for (int n = 0; n < 2; ++n) { const f32x4 a = acc[ai][bj][m][n]; v[n] = (f32x4){gelu_tanh_f(a.x), gelu_tanh_f(a.y), gelu_tanh_f(a.z), gelu_tanh_f(a.w)};
                        s += (v[n].x + v[n].y) + (v[n].z + v[n].w); s2 += (v[n].x * v[n].x + v[n].y * v[n].y) + (v[n].z * v[n].z + v[n].w * v[n].w); }
                    st_bf8(rp + bj * HALF, v[0], v[1]); }
                if (isv) { s += __shfl_xor(s, 16); s += __shfl_xor(s, 32); s2 += __shfl_xor(s2, 16); s2 += __shfl_xor(s2, 32);
                    if (fq == 0) *(f32x2*)(vst + (((size_t)row * 8 + (u.pn - 8)) * 4 + wc) * 2) = (f32x2){s, s2}; } }
    }
};

__device__ __forceinline__ int fresh_lane() { int l; asm volatile("v_mbcnt_lo_u32_b32 %0, -1, 0\n\tv_mbcnt_hi_u32_b32 %0, -1, %0" : "=v"(l)); return l; }
#define fresh_tid() (F.wave0 * 64 + fresh_lane())
#define PH_IDS const int lane = fresh_lane(), wave = F.wave0, tid = wave * 64 + lane; (void)tid; (void)lane; (void)wave
struct Frame {
    LAS unsigned char* lds; volatile LAS unsigned* MISC; unsigned* ctl;
    int vcu, G, wave0;
    const float* in[27]; float* out; unsigned char* ws;
};
#define WSP(T, off) ((T*)(F.ws + (off)))
#define MODP(l, r, i) (WSP(float, WS_MOD) + (((l) * 5 + (r)) * 6 + (i)) * D)

__device__ __forceinline__ void tr_item(const float* W, int N, bf16* WT, int Kd, int item, int mode, LAS float* scr, int lane) {
    const int nblk = N / 32, kb = item / nblk, nb = item - kb * nblk, k0 = 64 * kb, n0 = 32 * nb;
    int d0 = mode ? (((n0 >> 7) << 8) + (n0 & 127) + (mode == 2 ? 128 : 0)) : n0;
    if (mode == 3) { const int c = n0 & 1023; d0 = n0 >= 3072 ? n0 : n0 < 1024 ? (((c >> 7) << 8) + (c & 127)) : n0 < 2048 ? 2048 + c : (((c >> 7) << 8) + 128 + (c & 127)); }
#pragma unroll 8
    for (int i = 0; i < 32; ++i) { const int kk = 2 * i + (lane >> 5); scr[kk * 33 + (lane & 31)] = W[(size_t)(k0 + kk) * N + n0 + (lane & 31)]; }
    LDS_WAIT(); asm volatile("" ::: "memory");
    const int c = lane & 7;
#pragma unroll
    for (int j = 0; j < 4; ++j) { const int n = (lane >> 3) + 8 * j; const LAS float* s = scr + (8 * c) * 33 + n;
        u32x4 o; o.x = pk2(s[0 * 33], s[1 * 33]); o.y = pk2(s[2 * 33], s[3 * 33]); o.z = pk2(s[4 * 33], s[5 * 33]); o.w = pk2(s[6 * 33], s[7 * 33]);
        *(u32x4*)(WT + (size_t)(d0 + n) * Kd + k0 + 8 * c) = o; }
    LDS_WAIT(); asm volatile("" ::: "memory");
}
constexpr int CW_I_EXP = 512, CW_I_GU = 16 * CW_I_EXP, CW_I_SQ = 32 * 64;
struct TrDesc { const float* src; bf16* dst; int N, Kd; bool f8; };
template <int L> __device__ __forceinline__ TrDesc tr_desc(Frame& F, int it) {
    constexpr int I_IN = L == 0 ? 32 * 192 : 32 * 128;
    const float* W; bf16* WT; int N, Kd, mode, q; int r = it;
    bool f8 = false;
    if (r < CW_I_GU) { const int le = L * 16 + (r >> 9); q = r & 511; W = F.in[24] + (size_t)le * D * ED; N = ED; WT = (bf16*)(WSP(unsigned char, WS_WGU) + (size_t)le * 1024 * D); Kd = D; mode = 1; f8 = true; }
    else if (r < 2 * CW_I_GU) { r -= CW_I_GU; const int le = L * 16 + (r >> 9); q = r & 511; W = F.in[25] + (size_t)le * D * ED; N = ED; WT = (bf16*)(WSP(unsigned char, WS_WGU) + (size_t)le * 1024 * D); Kd = D; mode = 2; f8 = true; }
    else if (r < 2 * CW_I_GU + I_IN) { q = r - 2 * CW_I_GU; W = L == 0 ? F.in[8] : F.in[16]; N = L == 0 ? 6144 : 4096; WT = L == 0 ? WSP(bf16, WS_WINE) : WSP(bf16, WS_WINO); Kd = D; mode = L == 0 ? 3 : 0; f8 = L == 1; }
    else if (r < 2 * CW_I_GU + I_IN + CW_I_SQ) { q = r - 2 * CW_I_GU - I_IN; W = L == 0 ? F.in[15] : F.in[21]; N = D; WT = L == 0 ? WSP(bf16, WS_WOUTE) : WSP(bf16, WS_WOUTO); Kd = D; mode = 0; f8 = true; }
    else { r -= 2 * CW_I_GU + I_IN + CW_I_SQ; const int le = L * 16 + (r >> 9); q = r & 511; W = F.in[26] + (size_t)le * ED * D; N = D; WT = (bf16*)(WSP(unsigned char, WS_WDN) + (size_t)le * D * ED); Kd = ED; mode = 0; f8 = true; }
    const int nblk = N / 32, kb = q / nblk, nb = q - kb * nblk, k0 = 64 * kb, n0 = 32 * nb;
    int d0 = mode ? (((n0 >> 7) << 8) + (n0 & 127) + (mode == 2 ? 128 : 0)) : n0;
    if (mode == 3) { const int c = n0 & 1023; d0 = n0 >= 3072 ? n0 : n0 < 1024 ? (((c >> 7) << 8) + (c & 127)) : n0 < 2048 ? 2048 + c : (((c >> 7) << 8) + 128 + (c & 127)); }
    if (mode == 3) f8 = true;
    TrDesc d; d.src = W + (size_t)k0 * N + n0; d.dst = f8 ? (bf16*)((unsigned char*)WT + (size_t)d0 * Kd + k0) : WT + (size_t)d0 * Kd + k0; d.N = N; d.Kd = Kd; d.f8 = f8; return d;
}
template <int L> __device__ __forceinline__ void convert_weights(Frame& F, int gw, int NGW, int wave, int lane, int lo, int hi) {
    LAS float* scr = (LAS float*)(F.lds + wave * 16384);
    int it = lo + gw; if (it >= hi) return;
    float rg[32]; TrDesc cur = tr_desc<L>(F, it);
#pragma unroll
    for (int i = 0; i < 32; ++i) rg[i] = cur.src[(size_t)(2 * i + (lane >> 5)) * cur.N + (lane & 31)];
    for (;;) {
#pragma unroll
        for (int i = 0; i < 32; ++i) scr[(2 * i + (lane >> 5)) * 33 + (lane & 31)] = rg[i];
        LDS_WAIT(); asm volatile("" ::: "memory");
        const int nit = it + NGW; const bool more = nit < hi; TrDesc nx = cur;
        if (more) { nx = tr_desc<L>(F, nit);
#pragma unroll
            for (int i = 0; i < 32; ++i) rg[i] = nx.src[(size_t)(2 * i + (lane >> 5)) * nx.N + (lane & 31)]; }
        if (cur.f8) {
            const int c = lane & 3;
#pragma unroll
            for (int j = 0; j < 2; ++j) { const int n = (lane >> 2) + 16 * j; const LAS float* sp = scr + (16 * c) * 33 + n; u32x4 o;
                o.x = pk4_fp8(sp[0 * 33] * W8_SCALE, sp[1 * 33] * W8_SCALE, sp[2 * 33] * W8_SCALE, sp[3 * 33] * W8_SCALE); o.y = pk4_fp8(sp[4 * 33] * W8_SCALE, sp[5 * 33] * W8_SCALE, sp[6 * 33] * W8_SCALE, sp[7 * 33] * W8_SCALE);
                o.z = pk4_fp8(sp[8 * 33] * W8_SCALE, sp[9 * 33] * W8_SCALE, sp[10 * 33] * W8_SCALE, sp[11 * 33] * W8_SCALE); o.w = pk4_fp8(sp[12 * 33] * W8_SCALE, sp[13 * 33] * W8_SCALE, sp[14 * 33] * W8_SCALE, sp[15 * 33] * W8_SCALE);
                *(u32x4*)((unsigned char*)cur.dst + (size_t)n * cur.Kd + 16 * c) = o; }
        } else {
        const int c = lane & 7;
#pragma unroll
        for (int j = 0; j < 4; ++j) { const int n = (lane >> 3) + 8 * j; const LAS float* sp = scr + (8 * c) * 33 + n;
            u32x4 o; o.x = pk2(sp[0 * 33], sp[1 * 33]); o.y = pk2(sp[2 * 33], sp[3 * 33]); o.z = pk2(sp[4 * 33], sp[5 * 33]); o.w = pk2(sp[6 * 33], sp[7 * 33]);
            *(u32x4*)(cur.dst + (size_t)n * cur.Kd + 8 * c) = o; }
        }
        LDS_WAIT(); asm volatile("" ::: "memory");
        if (!more) break;
        it = nit; cur = nx;
    }
}
constexpr int CW_N0 = 3 * CW_I_GU + 32 * 192 + CW_I_SQ, CW_N1 = 3 * CW_I_GU + 32 * 128 + CW_I_SQ, CW_SPLIT1 = 2 * CW_I_GU;
__device__ __forceinline__ void p0_prologue(Frame& F) {
    PH_IDS;
    {
        LAS float* sl = (LAS float*)F.lds;
        LAS float* part = (LAS float*)(F.lds + 40960);
        for (int i = tid; i < 5 * D; i += 512) { const int r = i >> 11, k = i & (D - 1); const float v = r < 4 ? F.in[1][r * D + k] : F.in[3][k]; sl[i] = silu_f(v); }
        __syncthreads();
        const int kg = tid >> 3, cg = tid & 7;
        for (int it = F.vcu; it < 768; it += F.G) {
            const int l = it / 384, c0 = (it - l * 384) * 32;
            const float* wm = F.in[4] + (size_t)l * D * 12288 + c0 + 4 * cg;
            f32x4 a0 = {0, 0, 0, 0}, a1 = a0, a2 = a0, a3 = a0, a4 = a0;
#pragma unroll 8
            for (int i = 0; i < 32; ++i) { const int k = kg + 64 * i; const f32x4 w = *(const f32x4*)(wm + (size_t)k * 12288);
                a0 += w * sl[k]; a1 += w * sl[D + k]; a2 += w * sl[2 * D + k]; a3 += w * sl[3 * D + k]; a4 += w * sl[4 * D + k]; }
            LAS float* pp = part + kg * 160 + 4 * cg;
            *(LAS f32x4*)(pp) = a0; *(LAS f32x4*)(pp + 32) = a1; *(LAS f32x4*)(pp + 64) = a2; *(LAS f32x4*)(pp + 96) = a3; *(LAS f32x4*)(pp + 128) = a4;
            __syncthreads();
            if (tid < 160) { float s = 0.f;
#pragma unroll 8
                for (int g = 0; g < 64; ++g) s += part[g * 160 + tid];
                const int r = tid >> 5, cc = tid & 31;
                WSP(float, WS_MOD)[(size_t)(l * 5 + r) * 12288 + c0 + cc] = s + F.in[5][l * 12288 + c0 + cc]; }
            __syncthreads();
        }
    }
    {
        const int gid = F.vcu * 512 + tid;
        if (gid < 2048) { const int pos = gid >> 4, f = gid & 15;
            const float inv = exp2f(-(float)f * (13.287712379549449f / 16.0f)); const float ang = (float)pos * inv;
            const float k = rintf(ang * 0.15915494309189535f); float r = fmaf(-k, 6.2831854820251465f, ang); r = fmaf(-k, -1.7484555e-7f, r);
            WSP(float, WS_TAB)[gid] = __cosf(r); WSP(float, WS_TAB)[2048 + gid] = __sinf(r); }
        for (int i = gid; i < 16 * 128 * 128; i += F.G * 512) WSP(bf16, WS_WSB)[i] = (bf16)f2bf(F.in[19][i]);
    }
    convert_weights<0>(F, F.vcu * NWAVES + wave, F.G * NWAVES, wave, lane, 0, CW_N0);
}
__device__ __forceinline__ void p1_modulate(Frame& F) {
    PH_IDS;
    LAS float* P_s = (LAS float*)F.lds; LAS float* P_h = P_s + D;
    for (int rw = F.vcu * NWAVES + wave; rw < 128; rw += F.G * NWAVES) { const int Lr = rw >> 6, br = (rw >> 4) & 3, e = rw & 15; const float* sh = MODP(Lr, br, 3); const float* sc = MODP(Lr, br, 4);
        const float* lg = F.in[6] + (Lr * 2 + 0) * D; const float* lb = F.in[7] + (Lr * 2 + 0) * D;
        bf16* wh = WSP(bf16, WS_WRT2) + (size_t)((Lr * 4 + br) * 32 + e) * D; bf16* wl = wh + 16 * D; float c1 = 0.f, c2 = 0.f;
        for (int k = lane; k < D; k += 64) { const float w0 = F.in[22][k * 16 + e], m1 = 1.0f + sc[k]; const float w = lg[k] * m1 * w0; c2 += (lb[k] * m1 + sh[k]) * w0;
            const unsigned hb = f2bf(w); const float whf = __uint_as_float(hb << 16); const unsigned lob = f2bf(w - whf); wh[k] = (bf16)hb; wl[k] = (bf16)lob; c1 += whf + __uint_as_float(lob << 16); }
#pragma unroll
        for (int o = 1; o < 64; o <<= 1) { c1 += __shfl_xor(c1, o); c2 += __shfl_xor(c2, o); }
        if (lane == 0) { WSP(float, WS_RC)[(Lr * 4 + br) * 32 + e] = c1; WSP(float, WS_RC)[(Lr * 4 + br) * 32 + 16 + e] = c2; } }
    for (int blk = F.vcu; blk < M / 128; blk += F.G) {
        const int rowb = blk * 128 + wave * 16, b = rowb >> 13;
        __syncthreads();
        for (int i = tid; i < D; i += 512) { P_s[i] = 1.0f + MODP(0, b, 1)[i]; P_h[i] = MODP(0, b, 0)[i]; }
        __syncthreads();
        f32x4 rx[8];
#define P1_LOAD(r_) do { _Pragma("unroll") for (int j = 0; j < 4; ++j) { const float* p_ = F.in[0] + (size_t)(r_) * D + 512 * j + 8 * lane; rx[2 * j] = *(const f32x4*)p_; rx[2 * j + 1] = *(const f32x4*)(p_ + 4); } } while (0)
        P1_LOAD(rowb);
#pragma unroll 1
        for (int rr = 0; rr < 16; ++rr) {
            const int row = rowb + rr; u32x2 w8[4];
#pragma unroll
            for (int j = 0; j < 4; ++j) { const int c = 512 * j + 8 * lane;
                const f32x4 sa = *(const LAS f32x4*)(P_s + c), sb = *(const LAS f32x4*)(P_s + c + 4), ha = *(const LAS f32x4*)(P_h + c), hb = *(const LAS f32x4*)(P_h + c + 4);
                const f32x4 y0 = rx[2 * j] * sa + ha, y1 = rx[2 * j + 1] * sb + hb;
                w8[j].x = pk4_fp8(y0.x, y0.y, y0.z, y0.w); w8[j].y = pk4_fp8(y1.x, y1.y, y1.z, y1.w); }
            if (rr < 15) P1_LOAD(row + 1);
#pragma unroll
            for (int j = 0; j < 4; ++j) *(u32x2*)((unsigned char*)F.out + (size_t)M * D * 2 + (size_t)row * D + 512 * j + 8 * lane) = w8[j];
        }
#undef P1_LOAD
    }
    { const int gw = F.vcu * NWAVES + wave, NGW = F.G * NWAVES; const float* sh = MODP(0, 4, 0); const float* sc = MODP(0, 4, 1);
      for (int row = gw; row < MC; row += NGW) { const float* src = F.in[2] + (size_t)row * D; unsigned char* dst = (unsigned char*)F.out + (size_t)M * D * 2 + (size_t)M * D + (size_t)row * D;
#pragma unroll
          for (int j = 0; j < 8; ++j) { const int c = 256 * j + 4 * lane; const f32x4 v = *(const f32x4*)(src + c), s = *(const f32x4*)(sc + c), t = *(const f32x4*)(sh + c); const f32x4 y = v * (1.0f + s) + t; *(unsigned*)(dst + c) = pk4_fp8(y.x, y.y, y.z, y.w); } } }
}
__device__ __forceinline__ void conv_z(const bf16* proj, size_t row, int ch, float (&z)[8]) {
    const u32x4 w = *(const u32x4*)(proj + row * 2048 + ch);
    z[0] = bf_lo(w.x); z[1] = bf_hi(w.x); z[2] = bf_lo(w.y); z[3] = bf_hi(w.y); z[4] = bf_lo(w.z); z[5] = bf_hi(w.z); z[6] = bf_lo(w.w); z[7] = bf_hi(w.w);
}
__device__ __forceinline__ void conv_pass(Frame& F) {
    PH_IDS; const int gw = F.vcu * NWAVES + wave, NGW = F.G * NWAVES;
    const bf16* proj = WSP(bf16, WS_PROJ); unsigned char* mix = (unsigned char*)F.out;
    for (int it = gw; it < 2048; it += NGW) {
        const int run = it >> 1, ch = (it & 1) * 512 + lane * 8; const int r0 = run * 32;
        float w0[8], w1[8], w2[8];
#pragma unroll
        for (int i = 0; i < 8; ++i) { w0[i] = F.in[9][ch + i]; w1[i] = F.in[9][1024 + ch + i]; w2[i] = F.in[9][2048 + ch + i]; }
        float zp[8], zc[8], zn[8];
        if ((r0 & (SEQ - 1)) == 0) {
#pragma unroll
            for (int i = 0; i < 8; ++i) zp[i] = 0.f;
        } else conv_z(proj, (size_t)r0 - 1, ch, zp);
        conv_z(proj, (size_t)r0, ch, zc);
#pragma unroll 2
        for (int t = 0; t < 32; ++t) { const size_t row = (size_t)r0 + t;
            if (((row + 1) & (SEQ - 1)) == 0) {
#pragma unroll
                for (int i = 0; i < 8; ++i) zn[i] = 0.f;
            } else conv_z(proj, row + 1, ch, zn);
            const u32x4 bg = *(const u32x4*)(proj + row * 2048 + 1024 + ch);
            float o[8];
#pragma unroll
            for (int i = 0; i < 8; ++i) o[i] = w0[i] * zp[i] + w1[i] * zc[i] + w2[i] * zn[i];
            u32x2 w; w.x = pk4_fp8(bf_lo(bg.x) * o[0], bf_hi(bg.x) * o[1], bf_lo(bg.y) * o[2], bf_hi(bg.y) * o[3]);
            w.y = pk4_fp8(bf_lo(bg.z) * o[4], bf_hi(bg.z) * o[5], bf_lo(bg.w) * o[6], bf_hi(bg.w) * o[7]);
            *(u32x2*)(mix + row * D + ch) = w;
#pragma unroll
            for (int i = 0; i < 8; ++i) { zp[i] = zc[i]; zc[i] = zn[i]; } }
    }
}
__device__ __forceinline__ float lam_value(Frame& F, int lane) {
    const float a = wave_sum(F.in[10][lane] * F.in[11][lane]), b = wave_sum(F.in[12][lane] * F.in[13][lane]);
    return __expf(a) - __expf(b) + 0.2f;
}
__device__ __forceinline__ void attn_simple(Frame& F) {
    PH_IDS; const int gw = F.vcu * NWAVES + wave, NGW = F.G * NWAVES;
    const float lam = lam_value(F, lane);
    const bf16* Q = WSP(bf16, WS_Q); const bf16* KBp = WSP(bf16, WS_KB); const bf16* VBp = WSP(bf16, WS_VB); float* TMP = WSP(float, WS_H);
    for (int it = gw; it < 8192; it += NGW) {
        const int qb = it & 127, vc = (it >> 7) & 1, h = (it >> 8) & 7, b = it >> 11;
        const size_t qrow = (size_t)b * SEQ + qb * 64 + lane;
        float* tmp = TMP + (qrow * 8 + h) * 128 + vc * 64;
#pragma unroll 1
        for (int m = 0; m < 2; ++m) {
            float q[64], acc[64];
#pragma unroll
            for (int c = 0; c < 8; ++c) { const u32x4 w = *(const u32x4*)(Q + qrow * 1024 + h * 128 + m * 64 + c * 8); const float sc = 1.0f;
                q[8 * c + 0] = bf_lo(w.x) * sc; q[8 * c + 1] = bf_hi(w.x) * sc; q[8 * c + 2] = bf_lo(w.y) * sc; q[8 * c + 3] = bf_hi(w.y) * sc;
                q[8 * c + 4] = bf_lo(w.z) * sc; q[8 * c + 5] = bf_hi(w.z) * sc; q[8 * c + 6] = bf_lo(w.w) * sc; q[8 * c + 7] = bf_hi(w.w) * sc; }
#pragma unroll
            for (int i = 0; i < 64; ++i) acc[i] = 0.f;
            float mx = -1e30f, l = 0.f;
            const bf16* kp = KBp + (size_t)b * KV * 1024 + h * 128 + m * 64; const bf16* vp = VBp + (size_t)b * KV * 1024 + h * 128 + vc * 64;
#pragma unroll 1
            for (int j = 0; j < KV; ++j) {
                float s = 0.f;
#pragma unroll
                for (int c = 0; c < 8; ++c) { const u32x4 w = *(const u32x4*)(kp + (size_t)j * 1024 + c * 8);
                    s += q[8 * c + 0] * bf_lo(w.x) + q[8 * c + 1] * bf_hi(w.x) + q[8 * c + 2] * bf_lo(w.y) + q[8 * c + 3] * bf_hi(w.y)
                       + q[8 * c + 4] * bf_lo(w.z) + q[8 * c + 5] * bf_hi(w.z) + q[8 * c + 6] * bf_lo(w.w) + q[8 * c + 7] * bf_hi(w.w); }
                const float mn = fmaxf(mx, s), sc = exp2f(mx - mn), p = exp2f(s - mn); l = l * sc + p; mx = mn;
#pragma unroll
                for (int c = 0; c < 8; ++c) { const u32x4 w = *(const u32x4*)(vp + (size_t)j * 1024 + c * 8);
                    acc[8 * c + 0] = acc[8 * c + 0] * sc + p * bf_lo(w.x); acc[8 * c + 1] = acc[8 * c + 1] * sc + p * bf_hi(w.x);
                    acc[8 * c + 2] = acc[8 * c + 2] * sc + p * bf_lo(w.y); acc[8 * c + 3] = acc[8 * c + 3] * sc + p * bf_hi(w.y);
                    acc[8 * c + 4] = acc[8 * c + 4] * sc + p * bf_lo(w.z); acc[8 * c + 5] = acc[8 * c + 5] * sc + p * bf_hi(w.z);
                    acc[8 * c + 6] = acc[8 * c + 6] * sc + p * bf_lo(w.w); acc[8 * c + 7] = acc[8 * c + 7] * sc + p * bf_hi(w.w); }
            }
            const float inv = 1.0f / l;
            if (m == 0) {
#pragma unroll
                for (int i = 0; i < 64; i += 4) *(f32x4*)(tmp + i) = (f32x4){acc[i] * inv, acc[i + 1] * inv, acc[i + 2] * inv, acc[i + 3] * inv};
            } else {
#pragma unroll
                for (int i = 0; i < 64; i += 4) { const f32x4 t0 = *(const f32x4*)(tmp + i);
                    *(f32x4*)(tmp + i) = (f32x4){t0.x - lam * acc[i] * inv, t0.y - lam * acc[i + 1] * inv, t0.z - lam * acc[i + 2] * inv, t0.w - lam * acc[i + 3] * inv}; }
            }
        }
    }
}
__device__ __forceinline__ void attn_finish(Frame& F) {
    PH_IDS; const int gw = F.vcu * NWAVES + wave, NGW = F.G * NWAVES;
    const float* TMP = WSP(float, WS_H); bf16* mix = (bf16*)F.out;
    for (int row = gw; row < M; row += NGW) {
        f32x4 v[4]; float ss = 0.f;
#pragma unroll
        for (int i = 0; i < 4; ++i) { v[i] = *(const f32x4*)(TMP + (size_t)row * 1024 + lane * 16 + 4 * i); ss += (v[i].x * v[i].x + v[i].y * v[i].y) + (v[i].z * v[i].z + v[i].w * v[i].w); }
        ss += __shfl_xor(ss, 1); ss += __shfl_xor(ss, 2); ss += __shfl_xor(ss, 4);
        const float rs = 0.8f / sqrtf(ss * (1.0f / 128.0f) + LN_EPS);
#pragma unroll
        for (int i = 0; i < 4; ++i) { const f32x4 g = *(const f32x4*)(F.in[14] + ((lane * 16 + 4 * i) & 127)); st_bf4(mix + (size_t)row * D + 1024 + lane * 16 + 4 * i, v[i] * g * rs); }
    }
}
namespace att {
using f32x16 = __attribute__((ext_vector_type(16))) float;
using s16x4 = __attribute__((ext_vector_type(4))) short;
constexpr int QBLK = 32, KVBLK = 64, SHM_V = 16384, SHM_K = 8192, L_K = 0, L_V = 4 * SHM_K, L_WS = L_V + 4 * SHM_V, L_OST = 0, OST_LD = 136;
constexpr float SCALE = 0.125f, THR = 8.f;
#define ATT_KSW(row, c) ((row) * 128 + ((((c) ^ ((row) >> 1)) & 7) << 4))
#define ATT_SBAR() __builtin_amdgcn_sched_barrier(0)
__device__ __forceinline__ int crow(int r, int hi) { return (r & 3) + 8 * (r >> 2) + 4 * hi; }
__device__ __forceinline__ unsigned cvtpk(float lo, float hi) { unsigned r; asm volatile("v_cvt_pk_bf16_f32 %0, %1, %2" : "=v"(r) : "v"(lo), "v"(hi)); return r; }
template <bool FIRST> __device__ __forceinline__ void partialSM(f32x16& p0, f32x16& p1, f32x16& negm, float& alpha) {
    constexpr float THR2 = 8.0f, PBIAS = 4.0f;
    float m0 = fmaxf(fmaxf(p0[0], p0[1]), p0[2]), m1 = fmaxf(fmaxf(p1[0], p1[1]), p1[2]);
#pragma unroll
    for (int r = 3; r < 15; r += 2) { m0 = fmaxf(fmaxf(m0, p0[r]), p0[r + 1]); m1 = fmaxf(fmaxf(m1, p1[r]), p1[r + 1]); }
    float pmax = fmaxf(fmaxf(m0, p0[15]), fmaxf(m1, p1[15]));
    { auto rr = __builtin_amdgcn_permlane32_swap(__float_as_uint(pmax), __float_as_uint(pmax), false, false);
      pmax = fmaxf(__uint_as_float(rr[0]), __uint_as_float(rr[1])); }
    if (!FIRST && __builtin_expect(__all(pmax <= THR2), 1)) { alpha = 1.f; }
    else { const float dl = FIRST ? pmax - PBIAS : fmaxf(pmax - PBIAS, 0.f); alpha = __builtin_amdgcn_exp2f(-dl);
#pragma unroll
        for (int r = 0; r < 16; ++r) { p0[r] -= dl; p1[r] -= dl; negm[r] -= dl; } }
#pragma unroll
    for (int r = 0; r < 16; ++r) p0[r] = __builtin_amdgcn_exp2f(p0[r]);
}
__device__ __forceinline__ void finishSM(f32x16& p0, f32x16& p1, float alpha, float& l_reg, bf16x8& pa0, bf16x8& pa1, bf16x8& pa2, bf16x8& pa3) {
#pragma unroll
    for (int r = 0; r < 16; ++r) p1[r] = __builtin_amdgcn_exp2f(p1[r]);
    float s0 = p0[0] + p0[1], s1 = p0[2] + p0[3], s2 = p1[0] + p1[1], s3 = p1[2] + p1[3];
#pragma unroll
    for (int r = 4; r < 16; r += 4) { s0 += p0[r]; s1 += p0[r + 1]; s2 += p0[r + 2]; s3 += p0[r + 3]; s0 += p1[r]; s1 += p1[r + 1]; s2 += p1[r + 2]; s3 += p1[r + 3]; }
    float ps = (s0 + s1) + (s2 + s3);
    { auto rr = __builtin_amdgcn_permlane32_swap(__float_as_uint(ps), __float_as_uint(ps), false, false); ps = __uint_as_float(rr[0]) + __uint_as_float(rr[1]); }
    l_reg = l_reg * alpha + ps;
#define ATT_PK4(P, BASE, OUT) do { unsigned a0 = cvtpk(P[BASE + 0], P[BASE + 1]), a1 = cvtpk(P[BASE + 2], P[BASE + 3]);   \
    unsigned b0 = cvtpk(P[BASE + 4], P[BASE + 5]), b1 = cvtpk(P[BASE + 6], P[BASE + 7]);                              \
    auto r0 = __builtin_amdgcn_permlane32_swap(a0, b0, false, false); auto r1 = __builtin_amdgcn_permlane32_swap(a1, b1, false, false); \
    u32x4 w = {r0[0], r1[0], r0[1], r1[1]}; OUT = __builtin_bit_cast(bf16x8, w); } while (0)
    ATT_PK4(p0, 0, pa0); ATT_PK4(p0, 8, pa1); ATT_PK4(p1, 0, pa2); ATT_PK4(p1, 8, pa3);
#undef ATT_PK4
}
#define ATT_K8(row, c) ((row) * 64 + ((((c) ^ ((row) >> 2)) & 3) << 4))
__device__ __forceinline__ void qkt(f32x16& p0, f32x16& p1, const LAS char* Ks, const pg8::v8i32& qf, const f32x16& negm, int r32, int hi) {
    const pg8::v4i32 a0 = *(const LAS pg8::v4i32*)(Ks + ATT_K8(r32, 2 * hi)), a1 = *(const LAS pg8::v4i32*)(Ks + ATT_K8(r32, 2 * hi + 1));
    const pg8::v4i32 b0 = *(const LAS pg8::v4i32*)(Ks + ATT_K8(32 + r32, 2 * hi)), b1 = *(const LAS pg8::v4i32*)(Ks + ATT_K8(32 + r32, 2 * hi + 1));
    p0 = __builtin_amdgcn_mfma_scale_f32_32x32x64_f8f6f4(__builtin_shufflevector(a0, a1, 0, 1, 2, 3, 4, 5, 6, 7), qf, negm, 0, 0, 0, 0x7f7f7f7f, 0, 0x7f7f7f7f);
    p1 = __builtin_amdgcn_mfma_scale_f32_32x32x64_f8f6f4(__builtin_shufflevector(b0, b1, 0, 1, 2, 3, 4, 5, 6, 7), qf, negm, 0, 0, 0, 0x7f7f7f7f, 0, 0x7f7f7f7f);
}
__device__ __forceinline__ int v_st(int k, int c) { const int kk = (k & ~0xC) | ((k & 4) << 1) | ((k & 8) >> 1); return ((kk >> 3) * 4 + (c >> 5)) * 512 + ((kk & 7) * 32 + (c & 31)) * 2; }
__device__ __forceinline__ int v_rd_base(int lane) { return ((lane & 3) << 3) | (((lane >> 2) & 3) << 6) | (((lane >> 4) & 1) << 5) | (((lane >> 5) & 1) << 8); }
constexpr int v_rd_off(int d0, int ks, int half) { return d0 * 512 + ks * 4096 + half * 2048; }
template <int OFF> __device__ __forceinline__ s16x4 tr_read(int vb) { s16x4 r; asm volatile("ds_read_b64_tr_b16 %0, %1 offset:%2" : "=&v"(r) : "v"(vb), "i"(OFF) : "memory"); return r; }
template <int D0> __device__ __forceinline__ void pv_one(f32x16& od, int vb, bf16x8 pa0, bf16x8 pa1, bf16x8 pa2, bf16x8 pa3) {
    const s16x4 l0 = tr_read<v_rd_off(D0, 0, 0)>(vb), h0 = tr_read<v_rd_off(D0, 0, 1)>(vb), l1 = tr_read<v_rd_off(D0, 1, 0)>(vb), h1 = tr_read<v_rd_off(D0, 1, 1)>(vb);
    const s16x4 l2 = tr_read<v_rd_off(D0, 2, 0)>(vb), h2 = tr_read<v_rd_off(D0, 2, 1)>(vb), l3 = tr_read<v_rd_off(D0, 3, 0)>(vb), h3 = tr_read<v_rd_off(D0, 3, 1)>(vb);
    asm volatile("s_waitcnt lgkmcnt(0)" ::: "memory"); ATT_SBAR();
#define ATT_PK(L, H) (bf16x8){L[0], L[1], L[2], L[3], H[0], H[1], H[2], H[3]}
    od = __builtin_amdgcn_mfma_f32_32x32x16_bf16(pa0, ATT_PK(l0, h0), od, 0, 0, 0);
    od = __builtin_amdgcn_mfma_f32_32x32x16_bf16(pa1, ATT_PK(l1, h1), od, 0, 0, 0);
    od = __builtin_amdgcn_mfma_f32_32x32x16_bf16(pa2, ATT_PK(l2, h2), od, 0, 0, 0);
    od = __builtin_amdgcn_mfma_f32_32x32x16_bf16(pa3, ATT_PK(l3, h3), od, 0, 0, 0);
#undef ATT_PK
}
__device__ __forceinline__ void pv_d0(f32x16* o, int vb, bf16x8 pa0, bf16x8 pa1, bf16x8 pa2, bf16x8 pa3) {
    pv_one<0>(o[0], vb, pa0, pa1, pa2, pa3); pv_one<1>(o[1], vb, pa0, pa1, pa2, pa3); pv_one<2>(o[2], vb, pa0, pa1, pa2, pa3); pv_one<3>(o[3], vb, pa0, pa1, pa2, pa3);
}
__device__ __forceinline__ void psum(f32x16& osum, bf16x8 pa0, bf16x8 pa1, bf16x8 pa2, bf16x8 pa3) {
    const bf16x8 ones = {0x3F80, 0x3F80, 0x3F80, 0x3F80, 0x3F80, 0x3F80, 0x3F80, 0x3F80};
    osum = __builtin_amdgcn_mfma_f32_32x32x16_bf16(pa0, ones, osum, 0, 0, 0); osum = __builtin_amdgcn_mfma_f32_32x32x16_bf16(pa1, ones, osum, 0, 0, 0);
    osum = __builtin_amdgcn_mfma_f32_32x32x16_bf16(pa2, ones, osum, 0, 0, 0); osum = __builtin_amdgcn_mfma_f32_32x32x16_bf16(pa3, ones, osum, 0, 0, 0);
}
struct VFrag { s16x4 l0, h0, l1, h1, l2, h2, l3, h3; };
__device__ __forceinline__ void pv_rd0(VFrag& f, int vb) {
    f.l0 = tr_read<v_rd_off(0, 0, 0)>(vb); f.h0 = tr_read<v_rd_off(0, 0, 1)>(vb); f.l1 = tr_read<v_rd_off(0, 1, 0)>(vb); f.h1 = tr_read<v_rd_off(0, 1, 1)>(vb);
    f.l2 = tr_read<v_rd_off(0, 2, 0)>(vb); f.h2 = tr_read<v_rd_off(0, 2, 1)>(vb); f.l3 = tr_read<v_rd_off(0, 3, 0)>(vb); f.h3 = tr_read<v_rd_off(0, 3, 1)>(vb);
}
__device__ __forceinline__ void pv_d0_pre(f32x16* o, int vb, const VFrag& f, bf16x8 pa0, bf16x8 pa1, bf16x8 pa2, bf16x8 pa3) {
    asm volatile("s_waitcnt lgkmcnt(0)" ::: "memory"); ATT_SBAR();
#define ATT_PK(L, H) (bf16x8){L[0], L[1], L[2], L[3], H[0], H[1], H[2], H[3]}
    o[0] = __builtin_amdgcn_mfma_f32_32x32x16_bf16(pa0, ATT_PK(f.l0, f.h0), o[0], 0, 0, 0);
    o[0] = __builtin_amdgcn_mfma_f32_32x32x16_bf16(pa1, ATT_PK(f.l1, f.h1), o[0], 0, 0, 0);
    o[0] = __builtin_amdgcn_mfma_f32_32x32x16_bf16(pa2, ATT_PK(f.l2, f.h2), o[0], 0, 0, 0);
    o[0] = __builtin_amdgcn_mfma_f32_32x32x16_bf16(pa3, ATT_PK(f.l3, f.h3), o[0], 0, 0, 0);
#undef ATT_PK
    pv_one<1>(o[1], vb, pa0, pa1, pa2, pa3); pv_one<2>(o[2], vb, pa0, pa1, pa2, pa3); pv_one<3>(o[3], vb, pa0, pa1, pa2, pa3);
}
__device__ __forceinline__ int v8_sw(int key) { return (((key >> 1) & 1) << 1) | (((key >> 3) & 1) << 2); }
__device__ __forceinline__ int v8_st(int key, int chunk) { return key * 128 + ((chunk ^ v8_sw(key)) << 4); }
__device__ __forceinline__ int v8_rd_base(int lane, int d0) { const int i = lane & 15, q = i >> 1, p = i & 1, g1 = (lane >> 4) & 1, hi = lane >> 5; const int key0 = (q & 3) + 8 * (q >> 2) + 4 * hi;
    return key0 * 128 + ((((2 * d0 + g1) ^ v8_sw(key0)) & 7) << 4) + 8 * p; }
template <int OFF> __device__ __forceinline__ u32x2 tr8_read(int vb) { u32x2 r; asm volatile("ds_read_b64_tr_b8 %0, %1 offset:%2" : "=&v"(r) : "v"(vb), "i"(OFF) : "memory"); return r; }
struct V8Frag { u32x2 r0, r1, r2, r3; };
__device__ __forceinline__ void pv8_rd(V8Frag& f, int vb) { f.r0 = tr8_read<0>(vb); f.r1 = tr8_read<2048>(vb); f.r2 = tr8_read<4096>(vb); f.r3 = tr8_read<6144>(vb); }
template <int SO> __device__ __forceinline__ void pv8_rds(V8Frag& f, int vb) { f.r0 = tr8_read<SO>(vb); f.r1 = tr8_read<SO + 2048>(vb); f.r2 = tr8_read<SO + 4096>(vb); f.r3 = tr8_read<SO + 6144>(vb); }
__device__ __forceinline__ void pv8_mm(f32x16& od, const V8Frag& f, const pg8::v8i32& pa, int sc1) {
    const pg8::v8i32 bf = {(int)f.r0.x, (int)f.r0.y, (int)f.r1.x, (int)f.r1.y, (int)f.r2.x, (int)f.r2.y, (int)f.r3.x, (int)f.r3.y};
    asm volatile("v_mfma_scale_f32_32x32x64_f8f6f4 %0, %1, %2, %0, %3, %3 op_sel_hi:[0,0,0]" : "+v"(od) : "v"(pa), "v"(bf), "v"(sc1));
}
__device__ __forceinline__ void pv8_one(f32x16& od, int vb, const pg8::v8i32& pa, int sc1) { V8Frag f; pv8_rd(f, vb); asm volatile("s_waitcnt lgkmcnt(0)" ::: "memory"); ATT_SBAR(); pv8_mm(od, f, pa, sc1); }
__device__ __forceinline__ void pv8_d0(f32x16* o, const int (&vb)[4], int so, const pg8::v8i32& pa, int sc1) {
    pv8_one(o[0], vb[0] + so, pa, sc1); pv8_one(o[1], vb[1] + so, pa, sc1); pv8_one(o[2], vb[2] + so, pa, sc1); pv8_one(o[3], vb[3] + so, pa, sc1); }
__device__ __forceinline__ void pv8_d0_pre(f32x16* o, const int (&vb)[4], int so, const V8Frag& f, const pg8::v8i32& pa, int sc1) {
    asm volatile("s_waitcnt lgkmcnt(0)" ::: "memory"); ATT_SBAR(); pv8_mm(o[0], f, pa, sc1);
    pv8_one(o[1], vb[1] + so, pa, sc1); pv8_one(o[2], vb[2] + so, pa, sc1); pv8_one(o[3], vb[3] + so, pa, sc1); }
__device__ __forceinline__ void finishSM8(f32x16& p0, f32x16& p1, pg8::v8i32& pa) {
#pragma unroll
    for (int r = 0; r < 16; ++r) p1[r] = __builtin_amdgcn_exp2f(p1[r]);
#define ATT_F8(P, B) __builtin_amdgcn_cvt_pk_fp8_f32(P[B + 2], P[B + 3], __builtin_amdgcn_cvt_pk_fp8_f32(P[B], P[B + 1], 0, false), true)
    pa = (pg8::v8i32){ATT_F8(p0, 0), ATT_F8(p0, 4), ATT_F8(p0, 8), ATT_F8(p0, 12), ATT_F8(p1, 0), ATT_F8(p1, 4), ATT_F8(p1, 8), ATT_F8(p1, 12)};
#undef ATT_F8
}
__device__ __forceinline__ void psum8(f32x4& lacc, const pg8::v8i32& mask, const pg8::v8i32& pa, int sc1) {
    asm volatile("v_mfma_scale_f32_16x16x128_f8f6f4 %0, %1, %2, %0, %3, %3 op_sel_hi:[0,0,0]" : "+v"(lacc) : "v"(mask), "v"(pa), "v"(sc1));
}
struct KFrag { pg8::v4i32 a0, a1, b0, b1; };
__device__ __forceinline__ void k_read(KFrag& k, const LAS char* Ks, int r32, int hi) {
    k.a0 = *(const LAS pg8::v4i32*)(Ks + ATT_K8(r32, 2 * hi)); k.a1 = *(const LAS pg8::v4i32*)(Ks + ATT_K8(r32, 2 * hi + 1));
    k.b0 = *(const LAS pg8::v4i32*)(Ks + ATT_K8(32 + r32, 2 * hi)); k.b1 = *(const LAS pg8::v4i32*)(Ks + ATT_K8(32 + r32, 2 * hi + 1)); }
__device__ __forceinline__ void qk_mm(f32x16& p0, f32x16& p1, const KFrag& k, const pg8::v8i32& qf, const f32x16& negm) {
    p0 = __builtin_amdgcn_mfma_scale_f32_32x32x64_f8f6f4(__builtin_shufflevector(k.a0, k.a1, 0, 1, 2, 3, 4, 5, 6, 7), qf, negm, 0, 0, 0, 0x7f7f7f7f, 0, 0x7f7f7f7f);
    p1 = __builtin_amdgcn_mfma_scale_f32_32x32x64_f8f6f4(__builtin_shufflevector(k.b0, k.b1, 0, 1, 2, 3, 4, 5, 6, 7), qf, negm, 0, 0, 0, 0x7f7f7f7f, 0, 0x7f7f7f7f); }
template <int LO, int N> __device__ __forceinline__ void exp_n(f32x16& p) {
#pragma unroll
    for (int r = LO; r < LO + N; ++r) p[r] = __builtin_amdgcn_exp2f(p[r]);
    asm volatile("" : "+v"(p)); }
__device__ __forceinline__ int cvt4_fp8(float a, float b, float c, float d) { int r;
    asm("v_cvt_pk_fp8_f32 %0, %1, %2\n\tv_cvt_pk_fp8_f32 %0, %3, %4 op_sel:[0,0,1]" : "=&v"(r) : "v"(a), "v"(b), "v"(c), "v"(d)); return r; }
__device__ __forceinline__ void cvt_pa(pg8::v8i32& pa, const f32x16& p0, const f32x16& p1) {
#define ATT_F8(P, B) cvt4_fp8(P[B], P[B + 1], P[B + 2], P[B + 3])
    pa = (pg8::v8i32){ATT_F8(p0, 0), ATT_F8(p0, 4), ATT_F8(p0, 8), ATT_F8(p0, 12), ATT_F8(p1, 0), ATT_F8(p1, 4), ATT_F8(p1, 8), ATT_F8(p1, 12)};
#undef ATT_F8
}
__device__ __forceinline__ void sm_decide(f32x16& p0, f32x16& p1, f32x16& negm, float& alpha) {
    constexpr float THR2 = 8.0f, PBIAS = 4.0f;
    float m0 = fmaxf(fmaxf(p0[0], p0[1]), p0[2]), m1 = fmaxf(fmaxf(p1[0], p1[1]), p1[2]);
#pragma unroll
    for (int r = 3; r < 15; r += 2) { m0 = fmaxf(fmaxf(m0, p0[r]), p0[r + 1]); m1 = fmaxf(fmaxf(m1, p1[r]), p1[r + 1]); }
    float pmax = fmaxf(fmaxf(m0, p0[15]), fmaxf(m1, p1[15]));
    { auto rr = __builtin_amdgcn_permlane32_swap(__float_as_uint(pmax), __float_as_uint(pmax), false, false);
      pmax = fmaxf(__uint_as_float(rr[0]), __uint_as_float(rr[1])); }
    if (__builtin_expect(__all(pmax <= THR2), 1)) { alpha = 1.f; }
    else { const float dl = fmaxf(pmax - PBIAS, 0.f); alpha = __builtin_amdgcn_exp2f(-dl);
#pragma unroll
        for (int r = 0; r < 16; ++r) { p0[r] -= dl; p1[r] -= dl; negm[r] -= dl; } }
}
__device__ __forceinline__ void psum8z(f32x4& ts, const pg8::v8i32& mask, const pg8::v8i32& pa, int sc1) {
    asm volatile("v_mfma_scale_f32_16x16x128_f8f6f4 %0, %1, %2, 0, %3, %3 op_sel_hi:[0,0,0]" : "=&v"(ts) : "v"(mask), "v"(pa), "v"(sc1));
}
__device__ __forceinline__ void sm_redo(f32x16& p0, f32x16& p1, f32x16& negm, float& alpha, float& dl) {
    constexpr float PBIAS = 4.0f;
    float m0 = fmaxf(fmaxf(p0[0], p0[1]), p0[2]), m1 = fmaxf(fmaxf(p1[0], p1[1]), p1[2]);
#pragma unroll
    for (int r = 3; r < 15; r += 2) { m0 = fmaxf(fmaxf(m0, p0[r]), p0[r + 1]); m1 = fmaxf(fmaxf(m1, p1[r]), p1[r + 1]); }
    float pmax = fmaxf(fmaxf(m0, p0[15]), fmaxf(m1, p1[15]));
    { auto rr = __builtin_amdgcn_permlane32_swap(__float_as_uint(pmax), __float_as_uint(pmax), false, false);
      pmax = fmaxf(__uint_as_float(rr[0]), __uint_as_float(rr[1])); }
    dl = fmaxf(pmax - PBIAS, 0.f); alpha = __builtin_amdgcn_exp2f(-dl);
#pragma unroll
    for (int r = 0; r < 16; ++r) { p0[r] -= dl; p1[r] -= dl; negm[r] -= dl; }
}
}
__device__ __forceinline__ void attn_fast(Frame& F) {
    using namespace att;
    PH_IDS; const int wid = wave, r32 = lane & 31, hi = lane >> 5;
    const float lam = __builtin_bit_cast(float, __builtin_amdgcn_readfirstlane(__builtin_bit_cast(int, lam_value(F, lane))));
    LAS char* lds = (LAS char*)F.lds; LAS char* V_lds = lds + L_V; LAS char* K_lds = lds + L_K;
    LAS float* wsf = (LAS float*)(lds + L_WS) + wid * 64; LAS float* li_l = wsf; LAS float* al_l = wsf + 32;
    const bf16* Qg = WSP(bf16, WS_Q); const bf16* KBp = WSP(bf16, WS_KB); const bf16* VBp = WSP(bf16, WS_VB); unsigned char* mix = (unsigned char*)F.out;
    const int vkey = tid >> 3, vst0 = v8_st(vkey, tid & 7);
    const int kr = (tid >> 2) & 63, kc = tid & 3, kst = ATT_K8(kr, kc);
    int vb8[4];
#pragma unroll
    for (int d0 = 0; d0 < 4; ++d0) vb8[d0] = (int)(unsigned)(uintptr_t)V_lds + v8_rd_base(lane, d0);
    const int sc1 = 0x7f7f7f7f;
    pg8::v8i32 lmask;
    { const int mk = (((lane >> 4) ^ lane) & 1) ? 0 : 0x38383838; int m0, m1, m2, m3, m4, m5, m6, m7;
      asm volatile("v_mov_b32 %0, %8\n\tv_mov_b32 %1, %8\n\tv_mov_b32 %2, %8\n\tv_mov_b32 %3, %8\n\tv_mov_b32 %4, %8\n\tv_mov_b32 %5, %8\n\tv_mov_b32 %6, %8\n\tv_mov_b32 %7, %8"
                   : "=&v"(m0), "=&v"(m1), "=&v"(m2), "=&v"(m3), "=&v"(m4), "=&v"(m5), "=&v"(m6), "=&v"(m7) : "v"(mk));
      lmask = (pg8::v8i32){m0, m1, m2, m3, m4, m5, m6, m7}; }
    const unsigned voffV0 = (unsigned)(vkey * 1024 + (tid & 7) * 16), voffK = (unsigned)(kr * 1024 + kc * 16);
    constexpr int NT = KV / KVBLK;
    const int bx = (int)blockIdx.x;
    for (int ui = 0;; ++ui) {
        int unit;
        if (F.G == 256) { if (ui >= 4) break; unit = (ui * 8 + (bx & 7)) * 32 + (bx >> 3); }
        else { unit = ui * F.G + bx; if (unit >= 1024) break; }
        const int bh = unit >> 5, qb = unit & 31, b = bh >> 3, h = bh & 7;
        const size_t row0 = (size_t)b * SEQ + qb * 256;
#pragma unroll 1
        for (int mp = 0; mp < 2; ++mp) {
            const unsigned char* Kh = (const unsigned char*)KBp + (size_t)b * KV * 1024 + h * 128 + mp * 64; const unsigned char* Vh = (const unsigned char*)VBp + (size_t)b * KV * 1024 + h * 128;
            const __amdgpu_buffer_rsrc_t rsK = make_rsrc(Kh, KV * 1024), rsV = make_rsrc(Vh, KV * 1024);
            f32x16 o[4] = {}; f32x16 negm = {}; float l0 = 0.f, l1 = 0.f; f32x4 ts;
            const __amdgpu_buffer_rsrc_t rsQ = make_rsrc((const unsigned char*)Qg + (row0 + wid * QBLK) * 1024 + h * 128 + mp * 64, 32 * 1024);
            const int lq = fresh_lane(); const unsigned qoff = (unsigned)((lq & 31) * 1024 + (lq >> 5) * 32);
            const pg8::v8i32 qr = __builtin_shufflevector(__builtin_bit_cast(pg8::v4i32, bufld16(rsQ, qoff, 0)), __builtin_bit_cast(pg8::v4i32, bufld16(rsQ, qoff + 16, 0)), 0, 1, 2, 3, 4, 5, 6, 7);
            struct { bf16x8 vs0, ks0; } sr_;
#define SLOAD(t_) do { const unsigned so_ = (unsigned)(t_) * (unsigned)(KVBLK * 1024); \
    sr_.vs0 = bufld16(rsV, voffV0, so_); if (wid < 4) sr_.ks0 = bufld16(rsK, voffK, so_); } while (0)
#define SWRITE(t_) do { const int sl_ = (t_) & 3; *(LAS bf16x8*)(V_lds + sl_ * SHM_V + vst0) = sr_.vs0; \
    if (wid < 4) *(LAS bf16x8*)(K_lds + sl_ * SHM_K + kst) = sr_.ks0; } while (0)
#define KSLOT(t_) (K_lds + ((t_) & 3) * SHM_K)
#define VSLOT(t_) (((t_) & 3) * SHM_V)
#define RESC(a) do { if (__any((a) < 1.f)) { if (hi == 0) al_l[r32] = (a); asm volatile("s_nop 15\n\ts_nop 15\n\ts_waitcnt lgkmcnt(0)" ::: "memory");   \
    _Pragma("unroll") for (int r = 0; r < 16; ++r) { const float f_ = al_l[crow(r, hi)]; _Pragma("unroll") for (int d = 0; d < 4; ++d) o[d][r] *= f_; } \
    l0 *= al_l[r32 & 15]; l1 *= al_l[16 + (r32 & 15)]; } } while (0)
            f32x16 pA0, pA1, pB0, pB1; float alA; pg8::v8i32 pa;
            __syncthreads();
            SLOAD(0); SWRITE(0); SLOAD(1); SWRITE(1);
            __syncthreads();
            if (wid >= 4) __syncthreads();
            SLOAD(2); qkt(pA0, pA1, KSLOT(0), qr, negm, r32, hi);
            __syncthreads();
            partialSM<true>(pA0, pA1, negm, alA); SWRITE(2);
            __syncthreads();
            V8Frag vf;
#define ATT_WAITL(n_) asm volatile("s_waitcnt lgkmcnt(" #n_ ")" ::: "memory")
#define OVF_CHECK(PY0, PY1, PX0, PX1, SLP_, HAVE_PX) do { \
    asm volatile("s_nop 7\n\ts_nop 3" ::: "memory");        \
    if (__builtin_expect(__any(!(ts[0] < ATT_OVF_LIMIT) || !(ts[1] < ATT_OVF_LIMIT)), 0)) { \
        KFrag kq_; k_read(kq_, K_lds + (SLP_) * SHM_K, r32, hi); qk_mm(PY0, PY1, kq_, qr, negm); \
        float al_, dl_; sm_redo(PY0, PY1, negm, al_, dl_); \
        if (HAVE_PX) { _Pragma("unroll") for (int r = 0; r < 16; ++r) { PX0[r] -= dl_; PX1[r] -= dl_; } } \
        exp_n<0, 16>(PY0); exp_n<0, 16>(PY1); cvt_pa(pa, PY0, PY1); psum8z(ts, lmask, pa, sc1); \
        RESC(al_); \
        asm volatile("s_nop 7\n\ts_nop 3" ::: "memory"); } \
    l0 += ts[0]; l1 += ts[1]; asm volatile("" :: "v"(ts));   } while (0)
#define SLOADT(t_) do { const unsigned so_ = (unsigned)(t_) * (unsigned)(KVBLK * 1024); sr_.vs0 = bufld16(rsV, voffV0, so_); if (wid < 4) sr_.ks0 = bufld16(rsK, voffK, so_); } while (0)
#define SWRITES(SL_) do { *(LAS bf16x8*)(V_lds + (SL_) * SHM_V + vst0) = sr_.vs0; if (wid < 4) *(LAS bf16x8*)(K_lds + (SL_) * SHM_K + kst) = sr_.ks0; } while (0)
#define SEG_A(PX0, PX1, PY0, PY1, t_, SL_, ld_) do { \
    if (ld_) SLOADT((t_) + 2); \
    ATT_SBAR(); KFrag kf_; k_read(kf_, K_lds + (SL_) * SHM_K, r32, hi); ATT_SBAR(); \
    exp_n<0, 16>(PY1); ATT_SBAR(); \
    qk_mm(PX0, PX1, kf_, qr, negm); ATT_SBAR(); \
    cvt_pa(pa, PY0, PY1); psum8z(ts, lmask, pa, sc1); ATT_SBAR(); \
    pv8_rds<(((SL_) + 3) & 3) * SHM_V>(vf, vb8[0]); \
    __syncthreads(); } while (0)
#define SEG_B(PX0, PX1, PY0, PY1, SL_, ld_) do { \
    V8Frag vg_; constexpr int so_ = (((SL_) + 3) & 3) * SHM_V; \
    pv8_rds<so_>(vg_, vb8[1]); ATT_SBAR(); \
    OVF_CHECK(PY0, PY1, PX0, PX1, ((SL_) + 3) & 3, true); ATT_SBAR(); \
    ATT_WAITL(4); ATT_SBAR(); pv8_mm(o[0], vf, pa, sc1); \
    pv8_rds<so_>(vf, vb8[2]); ATT_SBAR(); \
    exp_n<0, 8>(PX0); ATT_SBAR(); \
    ATT_WAITL(4); ATT_SBAR(); pv8_mm(o[1], vg_, pa, sc1); \
    pv8_rds<so_>(vg_, vb8[3]); ATT_SBAR(); \
    exp_n<8, 8>(PX0); ATT_SBAR(); \
    ATT_WAITL(4); ATT_SBAR(); pv8_mm(o[2], vf, pa, sc1); ATT_SBAR(); \
    ATT_WAITL(0); ATT_SBAR(); pv8_mm(o[3], vg_, pa, sc1); ATT_SBAR(); \
    if (ld_) SWRITES(((SL_) + 2) & 3); \
    __syncthreads(); } while (0)
            static_assert(NT % 4 == 0 && NT >= 8, "the tile loop is unrolled over the 4 ring slots");
            SEG_A(pB0, pB1, pA0, pA1, 1, 1, true); SEG_B(pB0, pB1, pA0, pA1, 1, true);
#pragma unroll 1
            for (int t = 2; t + 3 < NT; t += 4) {
                SEG_A(pA0, pA1, pB0, pB1, t, 2, true); SEG_B(pA0, pA1, pB0, pB1, 2, true);
                SEG_A(pB0, pB1, pA0, pA1, t + 1, 3, true); SEG_B(pB0, pB1, pA0, pA1, 3, true);
                SEG_A(pA0, pA1, pB0, pB1, t + 2, 0, true); SEG_B(pA0, pA1, pB0, pB1, 0, true);
                SEG_A(pB0, pB1, pA0, pA1, t + 3, 1, true); SEG_B(pB0, pB1, pA0, pA1, 1, true);
            }
            SEG_A(pA0, pA1, pB0, pB1, NT - 2, 2, false); SEG_B(pA0, pA1, pB0, pB1, 2, false);
            SEG_A(pB0, pB1, pA0, pA1, NT - 1, 3, false); SEG_B(pB0, pB1, pA0, pA1, 3, false);
#undef SEG_A
#undef SEG_B
            exp_n<0, 16>(pB1); cvt_pa(pa, pB0, pB1); psum8z(ts, lmask, pa, sc1); ATT_SBAR();
            OVF_CHECK(pB0, pB1, pB0, pB1, 3, false); ATT_SBAR();
            pv8_d0(o, vb8, VSLOT(NT - 1), pa, sc1);
#undef OVF_CHECK
            asm volatile("s_nop 15\n\ts_nop 15" ::: "memory");
            if (wid < 4) __syncthreads();
            __syncthreads();
#undef KSLOT
#undef VSLOT
#undef SLOAD
#undef SWRITE
#undef RESC
            const int lane2 = fresh_lane(), t2 = wid * 64 + lane2, r32b = lane2 & 31, hi2 = lane2 >> 5;
            if (hi2 == 0) li_l[r32b] = (lane2 & 16) ? l1 : l0; asm volatile("s_waitcnt lgkmcnt(0)" ::: "memory");
            float rli[16];
#pragma unroll
            for (int r = 0; r < 16; ++r) rli[r] = 1.0f / li_l[crow(r, hi2)];
            float* SCR = WSP(float, WS_H) + ((size_t)blockIdx.x * 512 + t2) * 64;
            if (mp == 0) {
#pragma unroll
                for (int d0 = 0; d0 < 4; ++d0)
#pragma unroll
                    for (int r = 0; r < 16; r += 4) *(f32x4*)(SCR + d0 * 16 + r) = (f32x4){o[d0][r] * rli[r], o[d0][r + 1] * rli[r + 1], o[d0][r + 2] * rli[r + 2], o[d0][r + 3] * rli[r + 3]};
            } else {
                LAS bf16* ot = (LAS bf16*)(lds + L_OST) + wid * (32 * OST_LD);
                float gsub[4];
#pragma unroll
                for (int d0 = 0; d0 < 4; ++d0) gsub[d0] = F.in[14][d0 * 32 + r32b];
#pragma unroll
                for (int r = 0; r < 16; ++r) { float a = 0.f;
#pragma unroll
                    for (int d0 = 0; d0 < 4; ++d0) { const float t = SCR[d0 * 16 + r] - lam * (o[d0][r] * rli[r]); o[d0][r] = t; a += t * t; }
#define SWZ_ADD(x_, k_) x_ += __builtin_bit_cast(float, __builtin_amdgcn_ds_swizzle(__builtin_bit_cast(int, x_), ((k_) << 10) | 0x1F))
                    SWZ_ADD(a, 1); SWZ_ADD(a, 2); SWZ_ADD(a, 4); SWZ_ADD(a, 8); SWZ_ADD(a, 16);
#undef SWZ_ADD
                    const float ssr = 0.8f / sqrtf(a * (1.0f / 128.0f) + LN_EPS);
#pragma unroll
                    for (int d0 = 0; d0 < 4; ++d0) ot[crow(r, hi2) * OST_LD + d0 * 32 + r32b] = (bf16)f2bf(o[d0][r] * ssr * gsub[d0]); }
                asm volatile("s_waitcnt lgkmcnt(0)" ::: "memory");
                unsigned char* Ow = mix + (row0 + wid * QBLK + (lane2 >> 4)) * D + 1024 + h * 128 + (lane2 & 15) * 8;
#pragma unroll
                for (int k = 0; k < 8; ++k) { const u32x4 w = *(const LAS u32x4*)(ot + (k * 4 + (lane2 >> 4)) * OST_LD + (lane2 & 15) * 8); u32x2 w8;
                    w8.x = pk4_fp8(bf_lo(w.x), bf_hi(w.x), bf_lo(w.y), bf_hi(w.y)); w8.y = pk4_fp8(bf_lo(w.z), bf_hi(w.z), bf_lo(w.w), bf_hi(w.w)); *(u32x2*)(Ow + (size_t)k * 4 * D) = w8; }
            }
        }
    }
}
template <int L> __device__ __forceinline__ void ln_route_pass(Frame& F) {
    PH_IDS;
    LAS float* P_g = (LAS float*)F.lds;
    LAS float* P_b = P_g + D;
    LAS float* P_s = P_b + D;
    LAS float* P_h = P_s + D;
    LAS int* lcnt = (LAS int*)(F.lds + LDSX_OFF + 1024);
    LAS int* lbase = lcnt + 32;
    LAS int* rec = lcnt + 64;
    LAS float* recw = (LAS float*)(lcnt + 64 + 256);
    LAS float* lgt = (LAS float*)(F.lds + LDSX_OFF + 8192);
    LAS float* rst = (LAS float*)(lcnt + 64 + 256 + 256);
    const bf16* R = L == 0 ? (const bf16*)F.out + (size_t)M * D : WSP(bf16, WS_R1); unsigned char* H8 = WSP(unsigned char, WS_H8); float* stat = WSP(float, WS_STAT);
    const float* lng = F.in[6] + (L * 2 + 0) * D; const float* lnb = F.in[7] + (L * 2 + 0) * D;
    unsigned* gcnt = F.ctl + CW_CNT + L * 32; int4* list = WSP(int4, WS_LIST2);
    for (int blk = F.vcu; blk < M / 128; blk += F.G) {
        if (tid < 32) lcnt[tid] = 0;
        __syncthreads();
        const int rowb = blk * 128 + wave * 16, b = rowb >> 13;
        { const float* sh = MODP(L, b, 3); const float* sc = MODP(L, b, 4);
          for (int i = tid; i < D; i += 512) { P_g[i] = lng[i]; P_b[i] = lnb[i]; P_s[i] = 1.0f + sc[i]; P_h[i] = sh[i]; } }
        __syncthreads();
        u32x4 raw0[4], raw1[4];
#pragma unroll
        for (int j = 0; j < 4; ++j) { raw0[j] = *(const u32x4*)(R + (size_t)rowb * D + 512 * j + 8 * lane); raw1[j] = *(const u32x4*)(R + (size_t)(rowb + 1) * D + 512 * j + 8 * lane); }
#pragma unroll 1
        for (int pp = 0; pp < 8; ++pp) {
            const int row = rowb + 2 * pp;
            f32x2 v0[16], v1[16]; f32x2 s0 = {0.f, 0.f}, s1 = {0.f, 0.f};
#pragma unroll
            for (int j = 0; j < 4; ++j) {
                v0[4 * j + 0] = (f32x2){bf_lo(raw0[j].x), bf_hi(raw0[j].x)}; v0[4 * j + 1] = (f32x2){bf_lo(raw0[j].y), bf_hi(raw0[j].y)}; v0[4 * j + 2] = (f32x2){bf_lo(raw0[j].z), bf_hi(raw0[j].z)}; v0[4 * j + 3] = (f32x2){bf_lo(raw0[j].w), bf_hi(raw0[j].w)};
                v1[4 * j + 0] = (f32x2){bf_lo(raw1[j].x), bf_hi(raw1[j].x)}; v1[4 * j + 1] = (f32x2){bf_lo(raw1[j].y), bf_hi(raw1[j].y)}; v1[4 * j + 2] = (f32x2){bf_lo(raw1[j].z), bf_hi(raw1[j].z)}; v1[4 * j + 3] = (f32x2){bf_lo(raw1[j].w), bf_hi(raw1[j].w)}; }
#pragma unroll
            for (int i = 0; i < 16; ++i) { s0 += v0[i]; s1 += v1[i]; }
            if (pp < 7) {
#pragma unroll
                for (int j = 0; j < 4; ++j) { raw0[j] = *(const u32x4*)(R + (size_t)(row + 2) * D + 512 * j + 8 * lane); raw1[j] = *(const u32x4*)(R + (size_t)(row + 3) * D + 512 * j + 8 * lane); } }
            float t0 = s0.x + s0.y, t1 = s1.x + s1.y;
#pragma unroll
            for (int o = 1; o < 64; o <<= 1) { t0 += __shfl_xor(t0, o); t1 += __shfl_xor(t1, o); }
            const float mean0 = t0 * (1.0f / D), mean1 = t1 * (1.0f / D); f32x2 q0 = {0.f, 0.f}, q1 = {0.f, 0.f};
#pragma unroll
            for (int i = 0; i < 16; ++i) { v0[i] = v0[i] - mean0; v1[i] = v1[i] - mean1; q0 += v0[i] * v0[i]; q1 += v1[i] * v1[i]; }
            float u0 = q0.x + q0.y, u1 = q1.x + q1.y;
#pragma unroll
            for (int o = 1; o < 64; o <<= 1) { u0 += __shfl_xor(u0, o); u1 += __shfl_xor(u1, o); }
            const float rstd0 = 1.0f / sqrtf(u0 * (1.0f / D) + LN_EPS), rstd1 = 1.0f / sqrtf(u1 * (1.0f / D) + LN_EPS);
            if (lane == 0) { *(LAS f32x4*)(rst + (wave * 16 + 2 * pp) * 2) = (f32x4){mean0, rstd0, mean1, rstd1}; *(f32x4*)(stat + (size_t)row * 2) = (f32x4){mean0, rstd0, mean1, rstd1}; }
#pragma unroll
            for (int j = 0; j < 4; ++j) { const int c = 512 * j + 8 * lane; u32x2 h80, h81;
#pragma unroll
                for (int h = 0; h < 2; ++h) { const f32x4 g = *(const LAS f32x4*)(P_g + c + 4 * h), bb = *(const LAS f32x4*)(P_b + c + 4 * h), scv = *(const LAS f32x4*)(P_s + c + 4 * h), shv = *(const LAS f32x4*)(P_h + c + 4 * h);
                    const f32x2 ga = {g.x, g.y}, gb = {g.z, g.w}, ba = {bb.x, bb.y}, bc = {bb.z, bb.w}, sa = {scv.x, scv.y}, sb = {scv.z, scv.w}, ha = {shv.x, shv.y}, hb = {shv.z, shv.w};
                    const f32x2 xa0 = v0[4 * j + 2 * h] * rstd0 * ga + ba, xb0 = v0[4 * j + 2 * h + 1] * rstd0 * gb + bc, xa1 = v1[4 * j + 2 * h] * rstd1 * ga + ba, xb1 = v1[4 * j + 2 * h + 1] * rstd1 * gb + bc;
                    const f32x2 ya0 = xa0 * sa + ha, yb0 = xb0 * sb + hb, ya1 = xa1 * sa + ha, yb1 = xb1 * sb + hb;
                    if (h == 0) { h80.x = pk4_fp8(ya0.x, ya0.y, yb0.x, yb0.y); h81.x = pk4_fp8(ya1.x, ya1.y, yb1.x, yb1.y); } else { h80.y = pk4_fp8(ya0.x, ya0.y, yb0.x, yb0.y); h81.y = pk4_fp8(ya1.x, ya1.y, yb1.x, yb1.y); }
                }
                *(u32x2*)(H8 + (size_t)row * D + c) = h80; *(u32x2*)(H8 + (size_t)(row + 1) * D + c) = h81; }
        }
        {
            const int l2 = fresh_lane(), i16 = l2 & 15, kq = l2 >> 4;
            const bf16* hp = R + (size_t)(rowb + i16) * D + 8 * kq; const bf16* whp = WSP(bf16, WS_WRT2) + (size_t)((L * 4 + b) * 32 + i16) * D + 8 * kq; const bf16* wlp = whp + 16 * D;
            f32x4 lacc = {0.f, 0.f, 0.f, 0.f};
#pragma unroll 8
            for (int ks = 0; ks < 64; ++ks) { const bf16x8 af = *(const bf16x8*)(hp + 32 * ks); const bf16x8 bh = *(const bf16x8*)(whp + 32 * ks), bl = *(const bf16x8*)(wlp + 32 * ks);
                lacc = __builtin_amdgcn_mfma_f32_16x16x32_bf16(af, bh, lacc, 0, 0, 0); lacc = __builtin_amdgcn_mfma_f32_16x16x32_bf16(af, bl, lacc, 0, 0, 0); }
            LAS float* lp = lgt + (wave * 16 + 4 * kq) * 16 + i16; const float c1 = WSP(float, WS_RC)[(L * 4 + b) * 32 + i16], c2 = WSP(float, WS_RC)[(L * 4 + b) * 32 + 16 + i16];
            const LAS float* rs = rst + (wave * 16 + 4 * kq) * 2;
            const f32x4 s01 = *(const LAS f32x4*)rs, s23 = *(const LAS f32x4*)(rs + 4);
            lp[0] = s01.y * (lacc.x - s01.x * c1) + c2; lp[16] = s01.w * (lacc.y - s01.z * c1) + c2; lp[32] = s23.y * (lacc.z - s23.x * c1) + c2; lp[48] = s23.w * (lacc.w - s23.z * c1) + c2;
        }
        LDS_WAIT();
        if (lane < 16) {
            const int rl = wave * 16 + fresh_lane(); float sco[16], sel[16];
#pragma unroll
            for (int e4 = 0; e4 < 4; ++e4) { const f32x4 lg = *(const LAS f32x4*)(lgt + rl * 16 + 4 * e4);
                sco[4 * e4 + 0] = 1.0f / (1.0f + __expf(-lg.x)); sco[4 * e4 + 1] = 1.0f / (1.0f + __expf(-lg.y)); sco[4 * e4 + 2] = 1.0f / (1.0f + __expf(-lg.z)); sco[4 * e4 + 3] = 1.0f / (1.0f + __expf(-lg.w)); }
#pragma unroll
            for (int e = 0; e < 16; ++e) sel[e] = sco[e] + F.in[23][e];
            int bg = 0; float bgs = -1e30f;
#pragma unroll
            for (int g = 0; g < 4; ++g) { float m1 = -1e30f, m2 = -1e30f;
#pragma unroll
                for (int i = 0; i < 4; ++i) { const float x = sel[4 * g + i]; if (x > m1) { m2 = m1; m1 = x; } else if (x > m2) m2 = x; }
                const float gs = m1 + m2; if (gs > bgs) { bgs = gs; bg = g; } }
            float s4[4], c4[4];
#pragma unroll
            for (int i = 0; i < 4; ++i) { s4[i] = bg == 0 ? sel[i] : bg == 1 ? sel[4 + i] : bg == 2 ? sel[8 + i] : sel[12 + i]; c4[i] = bg == 0 ? sco[i] : bg == 1 ? sco[4 + i] : bg == 2 ? sco[8 + i] : sco[12 + i]; }
            int i1 = 0; float b1 = s4[0];
#pragma unroll
            for (int i = 1; i < 4; ++i) if (s4[i] > b1) { b1 = s4[i]; i1 = i; }
            int i2 = -1; float b2 = -1e30f;
#pragma unroll
            for (int i = 0; i < 4; ++i) if (i != i1 && s4[i] > b2) { b2 = s4[i]; i2 = i; }
            const float cw1 = i1 == 0 ? c4[0] : i1 == 1 ? c4[1] : i1 == 2 ? c4[2] : c4[3], cw2 = i2 == 0 ? c4[0] : i2 == 1 ? c4[1] : i2 == 2 ? c4[2] : c4[3];
            const float inv = 1.0f / (cw1 + cw2);
            const bool sw = i2 < i1; const int lo_i = sw ? i2 : i1, hi_i = sw ? i1 : i2;
            const int pid = bg * 6 + ((lo_i * (7 - lo_i)) >> 1) + hi_i - lo_i - 1;
            const int r1 = atomicAdd((int*)(lcnt + pid), 1);
            rec[rl] = pid | (r1 << 8); recw[rl * 2] = (sw ? cw2 : cw1) * inv; recw[rl * 2 + 1] = (sw ? cw1 : cw2) * inv;
        }
        __syncthreads();
        if (tid < NL) lbase[tid] = (int)atomicAdd(gcnt + tid, (unsigned)lcnt[tid]);
        __syncthreads();
        if (tid < 128) { const int v = rec[tid], e = v & 255, rank = v >> 8;
            list[e * CAP + lbase[e] + rank] = make_int4(blk * 128 + tid, __float_as_int(recw[tid * 2]), __float_as_int(recw[tid * 2 + 1]), 0); }
        __syncthreads();
    }
}
template <int L> __device__ __forceinline__ int moe_tables(Frame& F, LAS int*& tp, LAS int*& cnt) {
    tp = (LAS int*)(F.lds + LDSX_OFF + 16384); cnt = tp + 32;
    LAS int* ord = tp + 64; LAS int* tpf = tp + 352  ; LAS int* pix = tp + 384  ;
    if (F.wave0 == 0 && fresh_lane() == 0) { int acc = 0, fa = 0, pa = 0;
        for (int e = 0; e < NL; ++e) { const int c = (int)__hip_atomic_load(F.ctl + CW_CNT + L * 32 + e, RLX_AGENT); cnt[e] = c; tp[e] = acc; acc += (c + 255) >> 8; tpf[e] = fa; fa += c >> 8; pix[e] = pa; pa += (c & 255) ? 1 : 0; }
        tp[NL] = acc; tpf[NL] = fa; }
    __syncthreads();
    { const int t_ = F.wave0 * 64 + fresh_lane();
      if (t_ < NL) { const int c = cnt[t_], full = c >> 8, base = tp[t_], fo = tpf[t_]; for (int k = 0; k < full; ++k) ord[fo + k] = base + k; if (c & 255) ord[tpf[NL] + pix[t_]] = base + full; } }
    __syncthreads();
    return tp[NL];
}
template <int L> __device__ __forceinline__ void ln_moe_pass(Frame& F) {
    PH_IDS;
    bf16* X = WSP(bf16, WS_X); unsigned char* H8 = WSP(unsigned char, WS_H8); const bf16* YB = WSP(bf16, WS_YB);
    const bf16* R = L == 0 ? (const bf16*)F.out + (size_t)M * D : WSP(bf16, WS_R1); const float* stat = WSP(float, WS_STAT);
    LAS float* P_g2 = (LAS float*)F.lds; LAS float* P_g = P_g2 + D; LAS float* P_b = P_g + D; LAS float* P_s = P_b + D; LAS float* P_h = P_s + D; LAS float* P_g1 = P_h + D; LAS float* P_b1 = P_g1 + D;
    for (int blk = F.vcu; blk < M / 128; blk += F.G) {
        const int rowb = blk * 128 + wave * 16, b = rowb >> 13;
        __syncthreads();
        for (int i = tid; i < D; i += 512) { P_g2[i] = MODP(L, b, 5)[i]; P_g[i] = F.in[6][(L * 2 + 1) * D + i]; P_b[i] = F.in[7][(L * 2 + 1) * D + i]; P_g1[i] = F.in[6][(L * 2 + 0) * D + i]; P_b1[i] = F.in[7][(L * 2 + 0) * D + i];
            if (L == 0) { P_s[i] = 1.0f + MODP(1, b, 1)[i]; P_h[i] = MODP(1, b, 0)[i]; } }
        __syncthreads();
        u32x4 rx[4], ry0[4]; f32x2 rstt;
#define LNM_LOAD(r_) do { _Pragma("unroll") for (int j = 0; j < 4; ++j) { const int c = 512 * j + 8 * lane; rx[j] = *(const u32x4*)(R + (size_t)(r_) * D + c); \
            ry0[j] = *(const u32x4*)(YB + (size_t)(r_) * D + c); } rstt = *(const f32x2*)(stat + (size_t)(r_) * 2); } while (0)
        LNM_LOAD(rowb);
#pragma unroll 1
        for (int rr = 0; rr < 16; ++rr) {
            const int row = rowb + rr;
            f32x2 v[16]; f32x2 s2 = {0.f, 0.f}; const float ra = rstt.y, rc = -rstt.x * rstt.y;
#pragma unroll
            for (int j = 0; j < 4; ++j) { const int c = 512 * j + 8 * lane;
                const f32x4 ga = *(const LAS f32x4*)(P_g2 + c), gb = *(const LAS f32x4*)(P_g2 + c + 4), g1a = *(const LAS f32x4*)(P_g1 + c), g1b = *(const LAS f32x4*)(P_g1 + c + 4), b1a = *(const LAS f32x4*)(P_b1 + c), b1b = *(const LAS f32x4*)(P_b1 + c + 4);
#define LNM_E(k_, W_, G0_, G1_, A0_, A1_, B0_, B1_) v[4 * j + k_] = (((f32x2){bf_lo(rx[j].W_), bf_hi(rx[j].W_)} * ra + rc) * (f32x2){A0_, A1_} + (f32x2){B0_, B1_}) * ALPHA + (f32x2){G0_, G1_} * (f32x2){bf_lo(ry0[j].W_), bf_hi(ry0[j].W_)}
                LNM_E(0, x, ga.x, ga.y, g1a.x, g1a.y, b1a.x, b1a.y); LNM_E(1, y, ga.z, ga.w, g1a.z, g1a.w, b1a.z, b1a.w); LNM_E(2, z, gb.x, gb.y, g1b.x, g1b.y, b1b.x, b1b.y); LNM_E(3, w, gb.z, gb.w, g1b.z, g1b.w, b1b.z, b1b.w);
#undef LNM_E
            }
#pragma unroll
            for (int i = 0; i < 16; ++i) s2 += v[i];
            if (rr < 15) LNM_LOAD(row + 1);
            float t = s2.x + s2.y;
#pragma unroll
            for (int o = 1; o < 64; o <<= 1) t += __shfl_xor(t, o);
            const float mean = t * (1.0f / D); f32x2 q2 = {0.f, 0.f};
#pragma unroll
            for (int i = 0; i < 16; ++i) { v[i] = v[i] - mean; q2 += v[i] * v[i]; }
            float u = q2.x + q2.y;
#pragma unroll
            for (int o = 1; o < 64; o <<= 1) u += __shfl_xor(u, o);
            const float rstd = 1.0f / sqrtf(u * (1.0f / D) + LN_EPS);
#pragma unroll
            for (int j = 0; j < 4; ++j) { const int c = 512 * j + 8 * lane; f32x2 xo[4];
#pragma unroll
                for (int h = 0; h < 2; ++h) { const f32x4 g = *(const LAS f32x4*)(P_g + c + 4 * h), bb = *(const LAS f32x4*)(P_b + c + 4 * h);
                    xo[2 * h] = v[4 * j + 2 * h] * rstd * (f32x2){g.x, g.y} + (f32x2){bb.x, bb.y}; xo[2 * h + 1] = v[4 * j + 2 * h + 1] * rstd * (f32x2){g.z, g.w} + (f32x2){bb.z, bb.w}; }
                if (L == 1) { *(f32x4*)(F.out + (size_t)row * D + c) = (f32x4){xo[0].x, xo[0].y, xo[1].x, xo[1].y}; *(f32x4*)(F.out + (size_t)row * D + c + 4) = (f32x4){xo[2].x, xo[2].y, xo[3].x, xo[3].y}; }
                else { u32x4 w; w.x = pk2(xo[0].x, xo[0].y); w.y = pk2(xo[1].x, xo[1].y); w.z = pk2(xo[2].x, xo[2].y); w.w = pk2(xo[3].x, xo[3].y); *(u32x4*)(X + (size_t)row * D + c) = w;
                    const f32x4 sa = *(const LAS f32x4*)(P_s + c), sb = *(const LAS f32x4*)(P_s + c + 4), ha = *(const LAS f32x4*)(P_h + c), hb = *(const LAS f32x4*)(P_h + c + 4);
                    const f32x2 y0 = xo[0] * (f32x2){sa.x, sa.y} + (f32x2){ha.x, ha.y}, y1 = xo[1] * (f32x2){sa.z, sa.w} + (f32x2){ha.z, ha.w}, y2 = xo[2] * (f32x2){sb.x, sb.y} + (f32x2){hb.x, hb.y}, y3 = xo[3] * (f32x2){sb.z, sb.w} + (f32x2){hb.z, hb.w};
                    u32x2 hw; hw.x = pk4_fp8(y0.x, y0.y, y1.x, y1.y); hw.y = pk4_fp8(y2.x, y2.y, y3.x, y3.y); *(u32x2*)(H8 + (size_t)row * D + c) = hw; } }
        }
#undef LNM_LOAD
    }
}
__device__ __forceinline__ void spatial_simple(Frame& F) {
    PH_IDS;
    LAS float* vt = (LAS float*)F.lds;
    LAS float* wt = (LAS float*)(F.lds + 65536);
    LAS float* st = (LAS float*)(F.lds + LDSX_OFF + 1024);
    const bf16* UV = WSP(bf16, WS_UV); bf16* GT = (bf16*)F.out; const float* vst = WSP(float, WS_VSTP);
    for (int ch = F.vcu; ch < M / 128; ch += F.G) {
        __syncthreads();
        if (tid < 128) { float s = 0.f, s2 = 0.f; const f32x4* pp = (const f32x4*)(vst + (size_t)(ch * 128 + tid) * 64);
#pragma unroll
            for (int i = 0; i < 16; ++i) { const f32x4 t = pp[i]; s += t.x; s2 += t.y; s += t.z; s2 += t.w; }
            const float mean = s * (1.0f / D); const float var = fmaxf(s2 * (1.0f / D) - mean * mean, 0.f);
            st[tid * 2] = mean; st[tid * 2 + 1] = 1.0f / sqrtf(var + LN_EPS); }
#pragma unroll 1
        for (int g = 0; g < 16; ++g) {
            __syncthreads();
            for (int idx = tid; idx < 16384; idx += 512) { const int q = idx >> 7, c = idx & 127, col = g * 128 + c;
                const float v = bf2f(UV[(size_t)(ch * 128 + q) * 4096 + 2048 + col]);
                vt[idx] = (v - st[q * 2]) * st[q * 2 + 1] * F.in[17][col] + F.in[18][col]; wt[q * 129 + c] = F.in[19][g * 16384 + idx]; }
            __syncthreads();
            const int p = tid & 127, cg = tid >> 7;
            float acc[32];
#pragma unroll
            for (int i = 0; i < 32; ++i) acc[i] = 0.f;
#pragma unroll 1
            for (int q = 0; q < 128; ++q) { const float w = wt[p * 129 + q];
#pragma unroll
                for (int i = 0; i < 32; i += 4) { const f32x4 v = *(const LAS f32x4*)(vt + q * 128 + cg * 32 + i); acc[i] += w * v.x; acc[i + 1] += w * v.y; acc[i + 2] += w * v.z; acc[i + 3] += w * v.w; } }
            const size_t row = (size_t)ch * 128 + p; const float bsv = F.in[20][g * 128 + p];
            const bf16* up = UV + row * 4096 + g * 128 + cg * 32; bf16* op = GT + row * D + g * 128 + cg * 32;
#pragma unroll
            for (int i = 0; i < 32; i += 4) { const f32x4 uu = ld_bf4(up + i); st_bf4(op + i, (f32x4){uu.x * (acc[i] + bsv), uu.y * (acc[i + 1] + bsv), uu.z * (acc[i + 2] + bsv), uu.w * (acc[i + 3] + bsv)}); }
        }
    }
}

__device__ __forceinline__ void spatial_fast(Frame& F) {
    using namespace att;
    PH_IDS; const int wid = wave, r32 = lane & 31, hi = lane >> 5;
    LAS char* lds = (LAS char*)F.lds;
    LAS bf16* ot = (LAS bf16*)(lds + 65536) + wid * (32 * 136);
    LAS float* st = (LAS float*)(lds + 135168);
    const bf16* UV = WSP(bf16, WS_UV); unsigned char* GT = (unsigned char*)F.out; const float* vst = WSP(float, WS_VSTP); const bf16* WSB = WSP(bf16, WS_WSB);
    const int q0 = tid >> 4, cc = tid & 15;
    const int gsw = wid >> 2, pbase = (wid & 3) * 32;
    const int vbase = (int)(unsigned)(uintptr_t)lds + v_rd_base(lane) + gsw * 2 * 16384;
    for (int ch = F.vcu; ch < M / 128; ch += F.G) {
        __syncthreads();
        if (tid < 128) { float s = 0.f, s2 = 0.f; const f32x4* pp = (const f32x4*)(vst + (size_t)(ch * 128 + tid) * 64);
#pragma unroll
            for (int i = 0; i < 16; ++i) { const f32x4 t = pp[i]; s += t.x; s2 += t.y; s += t.z; s2 += t.w; }
            const float mean = s * (1.0f / D); const float var = fmaxf(s2 * (1.0f / D) - mean * mean, 0.f);
            st[tid * 2] = mean; st[tid * 2 + 1] = 1.0f / sqrtf(var + LN_EPS); }
        __syncthreads();
        const char* vsrc = (const char*)(UV + (size_t)ch * 128 * 4096 + 2048); const unsigned voff = (unsigned)(q0 * 4096 + cc * 8) * 2u;
        u32x4 raw[2][4];
#define LOADV(it_) do { _Pragma("unroll") for (int gs = 0; gs < 2; ++gs) _Pragma("unroll") for (int j = 0; j < 4; ++j) \
            raw[gs][j] = *(const u32x4*)(vsrc + voff + (size_t)((2 * (it_) + gs) * 256 + j * 32 * 8192)); } while (0)
        LOADV(0);
#pragma unroll 1
        for (int it = 0; it < 8; ++it) {
#pragma unroll
            for (int gs = 0; gs < 2; ++gs) { const int col = (2 * it + gs) * 128 + cc * 8;
                const f32x4 ga = *(const f32x4*)(F.in[17] + col), gb = *(const f32x4*)(F.in[17] + col + 4), ba = *(const f32x4*)(F.in[18] + col), bb = *(const f32x4*)(F.in[18] + col + 4);
#pragma unroll
                for (int j = 0; j < 4; ++j) { const int q = q0 + 32 * j; const float mean = st[2 * q], rstd = st[2 * q + 1]; const u32x4 w = raw[gs][j]; u32x4 o;
                    o.x = pk2((bf_lo(w.x) - mean) * rstd * ga.x + ba.x, (bf_hi(w.x) - mean) * rstd * ga.y + ba.y); o.y = pk2((bf_lo(w.y) - mean) * rstd * ga.z + ba.z, (bf_hi(w.y) - mean) * rstd * ga.w + ba.w);
                    o.z = pk2((bf_lo(w.z) - mean) * rstd * gb.x + bb.x, (bf_hi(w.z) - mean) * rstd * gb.y + bb.y); o.w = pk2((bf_lo(w.w) - mean) * rstd * gb.z + bb.z, (bf_hi(w.w) - mean) * rstd * gb.w + bb.w);
                    *(LAS u32x4*)(lds + (gs * 2 + (q >> 6)) * 16384 + v_st(q & 63, cc * 8)) = o; } }
            __syncthreads();
            if (it + 1 < 8) LOADV(it + 1);
            const int g = 2 * it + gsw;
            bf16x8 wa[8];
#pragma unroll
            for (int ks = 0; ks < 8; ++ks) wa[ks] = *(const bf16x8*)(WSB + (size_t)(g * 128 + pbase + r32) * 128 + ks * 16 + hi * 8);
            f32x16 o[4] = {};
            pv_d0(o, vbase, wa[0], wa[1], wa[2], wa[3]); pv_d0(o, vbase + 16384, wa[4], wa[5], wa[6], wa[7]);
#pragma unroll
            for (int r = 0; r < 16; ++r) { const float bs = F.in[20][g * 128 + pbase + crow(r, hi)];
#pragma unroll
                for (int d0 = 0; d0 < 4; ++d0) ot[crow(r, hi) * 136 + d0 * 32 + r32] = (bf16)f2bf(o[d0][r] + bs); }
            asm volatile("s_waitcnt lgkmcnt(0)" ::: "memory");
            const size_t tok = (size_t)ch * 128 + pbase + (lane >> 4);
#pragma unroll
            for (int k = 0; k < 8; ++k) { const u32x4 sv = *(const LAS u32x4*)(ot + (k * 4 + (lane >> 4)) * 136 + (lane & 15) * 8);
                const u32x4 uu = *(const u32x4*)(UV + (tok + k * 4) * 4096 + g * 128 + (lane & 15) * 8); u32x2 w;
                w.x = pk4_fp8(bf_lo(uu.x) * bf_lo(sv.x), bf_hi(uu.x) * bf_hi(sv.x), bf_lo(uu.y) * bf_lo(sv.y), bf_hi(uu.y) * bf_hi(sv.y));
                w.y = pk4_fp8(bf_lo(uu.z) * bf_lo(sv.z), bf_hi(uu.z) * bf_hi(sv.z), bf_lo(uu.w) * bf_lo(sv.w), bf_hi(uu.w) * bf_hi(sv.w));
                *(u32x2*)(GT + (tok + k * 4) * D + g * 128 + (lane & 15) * 8) = w; }
            __syncthreads();
        }
#undef LOADV
    }
}

constexpr int NPH = 17;
struct Args { const float* in[27]; float* out; unsigned char* ws; int ph_lo, ph_hi; };
__global__ void __launch_bounds__(NWAVES * 64, 2) mk_fwd(Args args) {
    extern __shared__ __attribute__((aligned(16))) unsigned char lds_raw[];
    Frame F;
    F.lds = (LAS unsigned char*)lds_raw;
    F.MISC = (volatile LAS unsigned*)(F.lds + MISC_OFF);
    F.wave0 = __builtin_amdgcn_readfirstlane((int)threadIdx.x >> 6);
    F.G = gridDim.x; { const int bx = blockIdx.x; F.vcu = (F.G % 8 == 0) ? (bx % 8) * (F.G / 8) + bx / 8 : bx; }
#pragma unroll
    for (int i = 0; i < 27; ++i) F.in[i] = args.in[i];
    F.out = args.out; F.ws = args.ws; F.ctl = (unsigned*)(args.ws + WS_CTL);
    if (threadIdx.x < 64) ((LAS unsigned*)(F.lds + MISC_OFF))[threadIdx.x] = 0u;
    __syncthreads();
    XcdBarrier bar; bar.bar = F.ctl + CW_BAR; bar.x = 0; bar.st = nullptr;
    if (MK_N_LAUNCHES == 1) bar = xcd_barrier_post(F.ctl + CW_BAR, F.MISC + 8, threadIdx.x == 0);
    const int lo = args.ph_lo, hi = args.ph_hi;
#define IN(k) (lo <= (k) && (k) < hi)
#define SEAM(k) do { if (IN(k) && IN((k) + 1)) xcd_barrier(bar, F.wave0 == 0 && fresh_lane() == 0); } while (0)

#define RUN(k, ...) do { if (IN(k)) { constexpr bool dup_pass = false; (void)dup_pass; __VA_ARGS__ } SEAM(k); if (DUP_PHASE == (k) && IN(k)) { constexpr bool dup_pass = true; (void)dup_pass; __VA_ARGS__ xcd_barrier(bar, F.wave0 == 0 && fresh_lane() == 0); } } while (0)
    RUN(0, p0_prologue(F););
    RUN(1, p1_modulate(F););
    RUN(2,
        { LAS float* tabL = (LAS float*)(F.lds + LDSX_OFF); { const int t_ = F.wave0 * 64 + fresh_lane(); for (int i = t_; i < 4096; i += 512) tabL[i] = WSP(float, WS_TAB)[i]; } __syncthreads();
          const unsigned char* h8 = (const unsigned char*)F.out + (size_t)M * D * 2; const unsigned char* w8 = WSP(unsigned char, WS_WINE) + (size_t)3072 * D;
          { Gemm g{(const bf16*)h8, (const bf16*)WSP(unsigned char, WS_WINE), M, 6144, D}; pg8::StaticOrder S; S.init(M, 6144, F.G, (int)blockIdx.x);
            EpiInProj E{WSP(bf16, WS_PROJ), WSP(bf16, WS_Q), WSP(bf16, WS_KB), WSP(bf16, WS_VB), tabL, tabL + 2048, 0};
            GEMM_PHASE_F8(EpiInProj, pg8::StaticOrder, F.lds, g, S, E); }
          { Gemm g{(const bf16*)(h8 + (size_t)M * D), (const bf16*)(w8 + (size_t)1024 * D), MC, 2048, D}; pg8::StaticOrder S; S.init(MC, 2048, F.G, (int)blockIdx.x);
            EpiCtx E{WSP(bf16, WS_KB), WSP(bf16, WS_VB)};
            GEMM_PHASE_F8(EpiCtx, pg8::StaticOrder, F.lds, g, S, E); } }
        if (!dup_pass) { const int c = (int)blockIdx.x;
            if (F.G <= 32) convert_weights<1>(F, c * NWAVES + F.wave0, F.G * NWAVES, F.wave0, fresh_lane(), 0, CW_SPLIT1);
            else if (c >= 32) convert_weights<1>(F, (c - 32) * NWAVES + F.wave0, (F.G - 32) * NWAVES, F.wave0, fresh_lane(), 0, CW_SPLIT1); });
#if USE_FAST_ATTN
    RUN(3, conv_pass(F); attn_fast(F););
#else
    RUN(3, conv_pass(F); attn_simple(F););
    RUN(4, attn_finish(F););
#endif
    RUN(5, { Gemm g{(const bf16*)F.out, WSP(bf16, WS_WOUTE), M, D, D}; pg8::StaticOrder S; S.init(M, D, F.G, (int)blockIdx.x);
        EpiRes<true> E{F.in[0], nullptr, MODP(0, 0, 2), (bf16*)F.out + (size_t)M * D};
        GEMM_PHASE_F8(EpiRes<true>, pg8::StaticOrder, F.lds, g, S, E); });
    RUN(6, ln_route_pass<0>(F););
    RUN(7, { LAS int* tp; LAS int* cnt; const int TP = moe_tables<0>(F, tp, cnt);
        Gemm g{(const bf16*)WSP(unsigned char, WS_H8), (const bf16*)(WSP(unsigned char, WS_WGU)), M, 1024, D}; pg8::MoeOrder<true> S{tp, cnt, WSP(int4, WS_LIST2), 8, TP * 8, F.G, (int)blockIdx.x, tp + 64};
        EpiGU E{WSP(unsigned char, WS_HID), WSP(int4, WS_LIST2)}; GEMM_PHASE_F8(EpiGU, pg8::MoeOrder<true>, F.lds, g, S, E);
        if (!dup_pass) { const int rem = (TP * 8) % F.G; const int c = (int)blockIdx.x;
            if (rem == 0) convert_weights<1>(F, c * NWAVES + F.wave0, F.G * NWAVES, F.wave0, fresh_lane(), CW_SPLIT1, CW_N1);
            else if (c >= rem) convert_weights<1>(F, (c - rem) * NWAVES + F.wave0, (F.G - rem) * NWAVES, F.wave0, fresh_lane(), CW_SPLIT1, CW_N1); } });
    RUN(8, { LAS int* tp; LAS int* cnt; const int TP = moe_tables<0>(F, tp, cnt);
        Gemm g{(const bf16*)WSP(unsigned char, WS_HID), (const bf16*)(WSP(unsigned char, WS_WDN)), M, 2048, 2 * ED, ED}; pg8::MoeOrder<false> S{tp, cnt, WSP(int4, WS_LIST2), 8, TP * 8, F.G, (int)blockIdx.x, tp + 64};
        EpiDown E{WSP(int4, WS_LIST2), WSP(bf16, WS_YB)}; GEMM_PHASE_F8(EpiDown, pg8::MoeOrder<false>, F.lds, g, S, E); });
    RUN(9, ln_moe_pass<0>(F););
    RUN(10, { Gemm g{(const bf16*)WSP(unsigned char, WS_H8), WSP(bf16, WS_WINO), M, 4096, D}; pg8::StaticOrder S; S.init(M, 4096, F.G, (int)blockIdx.x);
        EpiGelu E{WSP(bf16, WS_UV), WSP(float, WS_VSTP)}; GEMM_PHASE_F8(EpiGelu, pg8::StaticOrder, F.lds, g, S, E); });
#if USE_FAST_SPATIAL
    RUN(11, spatial_fast(F););
#else
    RUN(11, spatial_simple(F););
#endif
    RUN(12, { Gemm g{(const bf16*)F.out, WSP(bf16, WS_WOUTO), M, D, D}; pg8::StaticOrder S; S.init(M, D, F.G, (int)blockIdx.x);
        EpiRes<false> E{nullptr, WSP(bf16, WS_X), MODP(1, 0, 2), WSP(bf16, WS_R1)};
        GEMM_PHASE_F8(EpiRes<false>, pg8::StaticOrder, F.lds, g, S, E); });
    RUN(13, ln_route_pass<1>(F););
    RUN(14, { LAS int* tp; LAS int* cnt; const int TP = moe_tables<1>(F, tp, cnt);
        Gemm g{(const bf16*)WSP(unsigned char, WS_H8), (const bf16*)(WSP(unsigned char, WS_WGU) + (size_t)16 * 1024 * D), M, 1024, D}; pg8::MoeOrder<true> S{tp, cnt, WSP(int4, WS_LIST2), 8, TP * 8, F.G, (int)blockIdx.x, tp + 64};
        EpiGU E{WSP(unsigned char, WS_HID), WSP(int4, WS_LIST2)}; GEMM_PHASE_F8(EpiGU, pg8::MoeOrder<true>, F.lds, g, S, E); });
    RUN(15, { LAS int* tp; LAS int* cnt; const int TP = moe_tables<1>(F, tp, cnt);
        Gemm g{(const bf16*)WSP(unsigned char, WS_HID), (const bf16*)(WSP(unsigned char, WS_WDN) + (size_t)16 * D * ED), M, 2048, 2 * ED, ED}; pg8::MoeOrder<false> S{tp, cnt, WSP(int4, WS_LIST2), 8, TP * 8, F.G, (int)blockIdx.x, tp + 64};
        EpiDown E{WSP(int4, WS_LIST2), WSP(bf16, WS_YB)}; GEMM_PHASE_F8(EpiDown, pg8::MoeOrder<false>, F.lds, g, S, E); });
    if (DUP_PHASE == 16) { ln_moe_pass<1>(F); xcd_barrier(bar, F.wave0 == 0 && fresh_lane() == 0); }
    if (IN(16)) { ln_moe_pass<1>(F); }
#undef RUN
#undef IN
#undef SEAM
}

extern "C" void kernel_launch(void* const* d_in, const int* in_sizes, int n_in, void* d_out, int out_size, void* d_ws, size_t ws_size, hipStream_t stream) {
    static int grid = 0;
    if (grid == 0) {
        if (n_in != 27 || in_sizes[0] != M * D || out_size != M * D || ws_size < WS_END) { fprintf(stderr, "kernel_launch: shape/workspace mismatch (n_in %d, ws %zu < %zu)\n", n_in, ws_size, (size_t)WS_END); grid = -1; return; }
        int dev = 0, cus = 0, per_cu = 0;
        if (hipGetDevice(&dev) != hipSuccess || hipDeviceGetAttribute(&cus, hipDeviceAttributeMultiprocessorCount, dev) != hipSuccess) { grid = -1; return; }
        if (hipFuncSetAttribute((const void*)mk_fwd, hipFuncAttributeMaxDynamicSharedMemorySize, LDS_BYTES) != hipSuccess) { fprintf(stderr, "kernel_launch: hipFuncSetAttribute failed\n"); grid = -1; return; }
        if (hipOccupancyMaxActiveBlocksPerMultiprocessor(&per_cu, (const void*)mk_fwd, NWAVES * 64, LDS_BYTES) != hipSuccess || per_cu < 1) fprintf(stderr, "kernel_launch: occupancy query reports %d\n", per_cu);
        (void)hipGetLastError();
        grid = cus;
    }
    if (grid < 0) return;
    if (hipMemsetAsync((char*)d_ws + WS_CTL, 0, CTL_ZERO_BYTES, stream) != hipSuccess) return;
    Args a{};
    for (int i = 0; i < 27; ++i) a.in[i] = (const float*)d_in[i];
    a.out = (float*)d_out; a.ws = (unsigned char*)d_ws;
    if (MK_N_LAUNCHES == 1) { a.ph_lo = 0; a.ph_hi = NPH; hipLaunchKernelGGL(mk_fwd, dim3(grid), dim3(NWAVES * 64), LDS_BYTES, stream, a); }
    else for (int p = 0; p < NPH; ++p) {
#if USE_FAST_ATTN
        if (p == 4) continue;
#endif
        a.ph_lo = p; a.ph_hi = p + 1; hipLaunchKernelGGL(mk_fwd, dim3(grid), dim3(NWAVES * 64), LDS_BYTES, stream, a); }
    const hipError_t le = hipPeekAtLastError();
    if (le != hipSuccess) fprintf(stderr, "kernel_launch: launch failed: %s\n", hipGetErrorName(le));
}
```

```cpp
#include <hip/hip_runtime.h>
#include <cstdio>
#include <cstdint>

#ifndef MK_N_LAUNCHES
#define MK_N_LAUNCHES 1
#endif
#ifndef DUP_PHASE
#define ATT_OVF_LIMIT __builtin_inff()
#define DUP_PHASE -1
#endif
#ifndef USE_FAST_GEMM
#define USE_FAST_GEMM 1
#endif
#ifndef USE_FAST_ATTN
#define USE_FAST_ATTN 1
#endif
#ifndef USE_FAST_SPATIAL
#define USE_FAST_SPATIAL 1
#endif

#define GAS __attribute__((address_space(1)))
#define LAS __attribute__((address_space(3)))
typedef unsigned short bf16;
typedef short bf16x8 __attribute__((ext_vector_type(8)));
typedef float f32x4 __attribute__((ext_vector_type(4)));
typedef float f32x2 __attribute__((ext_vector_type(2)));
typedef unsigned u32x4 __attribute__((ext_vector_type(4)));
typedef unsigned u32x2 __attribute__((ext_vector_type(2)));
typedef GAS unsigned gu32;

constexpr int D = 2048, BATCH = 4, SEQ = 8192, M = BATCH * SEQ, CTXL = 256, MC = BATCH * CTXL, KV = SEQ + CTXL;
constexpr int NE = 16, ED = 512, CAP = 32768, NL = 24;
constexpr float ALPHA = 1.41421356237309515f, LN_EPS = 1e-5f;
constexpr int NWAVES = 8;
constexpr float QSCALE = 0.125f * 1.4426950408889634f;

constexpr size_t MiB = 1u << 20;
constexpr size_t WS_CTL = 0, CTL_ZERO_BYTES = 64 * 1024;
constexpr size_t WS_MOD = 2 * MiB;
constexpr size_t WS_TAB = 3 * MiB;
constexpr size_t WS_WRT = 3 * MiB + 64 * 1024;
constexpr size_t WS_WSB = 3 * MiB + 256 * 1024;
constexpr size_t WS_WRT2 = 24 * MiB;
constexpr size_t WS_RC = 25 * MiB;
constexpr size_t WS_STAT = 26 * MiB;
constexpr size_t WS_LIST = 4 * MiB;
constexpr size_t WS_WINE = 8 * MiB;
constexpr size_t WS_WOUTE = 32 * MiB;
constexpr size_t WS_WINO = 40 * MiB;
constexpr size_t WS_WOUTO = 56 * MiB;
constexpr size_t WS_WGU = 64 * MiB;
constexpr size_t WS_WDN = 192 * MiB;
constexpr size_t WS_A = 256 * MiB;
constexpr size_t WS_R1 = WS_A + 196 * MiB;
constexpr size_t WS_PROJ = WS_A;
constexpr size_t WS_Q = WS_A + 192 * MiB;
constexpr size_t WS_KB = WS_A + 256 * MiB;
constexpr size_t WS_VB = WS_A + 322 * MiB;
constexpr size_t WS_HID = WS_A;
constexpr size_t WS_H8 = WS_A + 324 * MiB;
constexpr size_t WS_YB = WS_A + 68 * MiB;
constexpr size_t WS_UV = WS_A;
constexpr size_t WS_VSTP = WS_A + 256 * MiB;
constexpr size_t WS_H = WS_A + 388 * MiB;
constexpr size_t WS_LIST2 = WS_H;
constexpr size_t WS_X = WS_H + 128 * MiB;
constexpr size_t WS_HC = WS_X + 128 * MiB;
constexpr size_t WS_END = WS_HC + 4 * MiB;
static_assert(WS_VB + (size_t)BATCH * KV * 1024 * 2 <= WS_H && WS_YB + (size_t)M * 2 * 2048 * 2 <= WS_H && WS_END <= 1024 * MiB, "ws map");
constexpr int CW_BAR = 4096;
constexpr int CW_CNT = 8192;
constexpr int CW_VST = 262144;
constexpr int RING_BYTES = 131072, LDSX_OFF = RING_BYTES, MISC_OFF = LDSX_OFF + 24576, LDS_BYTES = 163840;

#define RLX_AGENT __ATOMIC_RELAXED, __HIP_MEMORY_SCOPE_AGENT
#define LDS_WAIT() asm volatile("s_waitcnt lgkmcnt(0)" ::: "memory")
#define VM_WAIT() asm volatile("s_waitcnt vmcnt(0)" ::: "memory")
__device__ __forceinline__ unsigned f2bf(float f) { unsigned u = __builtin_bit_cast(unsigned, f); return (u + 0x7fffu + ((u >> 16) & 1u)) >> 16; }
__device__ __forceinline__ unsigned pk2(float lo, float hi) { unsigned r; asm("v_cvt_pk_bf16_f32 %0, %1, %2" : "=v"(r) : "v"(lo), "v"(hi)); return r; }
__device__ __forceinline__ float bf_lo(unsigned u) { return __uint_as_float(u << 16); }
__device__ __forceinline__ float bf_hi(unsigned u) { return __uint_as_float(u & 0xffff0000u); }
__device__ __forceinline__ float bf2f(bf16 h) { return __uint_as_float((unsigned)h << 16); }
__device__ __forceinline__ f32x4 ld_bf4(const bf16* p) { const u32x2 w = *(const u32x2*)p; return (f32x4){bf_lo(w.x), bf_hi(w.x), bf_lo(w.y), bf_hi(w.y)}; }
__device__ __forceinline__ void st_bf4(bf16* p, f32x4 v) { u32x2 w; w.x = pk2(v.x, v.y); w.y = pk2(v.z, v.w); *(u32x2*)p = w; }
__device__ __forceinline__ float wave_sum(float v) {
#pragma unroll
    for (int o = 1; o < 64; o <<= 1) v += __shfl_xor(v, o);
    return v;
}
__device__ __forceinline__ __amdgpu_buffer_rsrc_t make_rsrc(const void* p, int bytes) {
    const unsigned long long v = (unsigned long long)p; const unsigned lo = __builtin_amdgcn_readfirstlane((unsigned)v), hi = __builtin_amdgcn_readfirstlane((unsigned)(v >> 32));
    return __builtin_amdgcn_make_buffer_rsrc((void*)(((unsigned long long)hi << 32) | lo), 0, bytes, 0x00020000);
}
__device__ __forceinline__ bf16x8 bufld16(__amdgpu_buffer_rsrc_t r, unsigned voff, unsigned soff) { return __builtin_bit_cast(bf16x8, __builtin_amdgcn_raw_buffer_load_b128(r, (int)voff, (int)soff, 0)); }
__device__ __forceinline__ unsigned pk4_fp8(float a, float b, float c, float d) {
    a = __builtin_amdgcn_fmed3f(a, -448.f, 448.f); b = __builtin_amdgcn_fmed3f(b, -448.f, 448.f); c = __builtin_amdgcn_fmed3f(c, -448.f, 448.f); d = __builtin_amdgcn_fmed3f(d, -448.f, 448.f);
    int v = __builtin_amdgcn_cvt_pk_fp8_f32(a, b, 0, false); v = __builtin_amdgcn_cvt_pk_fp8_f32(c, d, v, true); return (unsigned)v; }
__device__ __forceinline__ void st_f8x8(unsigned char* p, f32x4 a, f32x4 b) { u32x2 w; w.x = pk4_fp8(a.x, a.y, a.z, a.w); w.y = pk4_fp8(b.x, b.y, b.z, b.w); *(u32x2*)p = w; }
constexpr float W8_SCALE = 32.0f;
__device__ __forceinline__ float silu_f(float x) { return x * __builtin_amdgcn_rcpf(1.0f + __builtin_amdgcn_exp2f(-1.4426950408889634f * x)); }
__device__ __forceinline__ float gelu_tanh_f(float x) {
    const float w = x * __builtin_fmaf(x * x, -0.1029432396f, -2.3022081981f); return x * __builtin_amdgcn_rcpf(1.0f + __builtin_amdgcn_exp2f(w)); }

#define XB_TMO      128
#define XB_XCNT(j)  (256  + 64 * (j))
#define XB_XSUB(j)  (1280 + 64 * (j))
#define XB_XGEN(j)  (2304 + 64 * (j))
#define XB_TOP      3328
#define XB_TOPGEN   3392
#define XCD_BAR_WORDS 3456
#define XB_SPIN_CAP (1u << 21)
__device__ __forceinline__ unsigned xb_ld(unsigned* p)              { return __hip_atomic_load(p, __ATOMIC_RELAXED, __HIP_MEMORY_SCOPE_AGENT); }
__device__ __forceinline__ unsigned xb_add(unsigned* p, unsigned v) { return __hip_atomic_fetch_add(p, v, __ATOMIC_RELAXED, __HIP_MEMORY_SCOPE_AGENT); }
__device__ __forceinline__ unsigned xb_xcc_id() { return (unsigned)__builtin_amdgcn_s_getreg((3 << 11) | 20) & 0xFu; }
#define XB_SPIN(cond, bar) do { unsigned _sp = 0; while (cond) { __builtin_amdgcn_s_sleep(1); \
    if ((++_sp & 255u) == 0u) { if (xb_ld(&(bar)[XB_TMO])) break; if (_sp > XB_SPIN_CAP) { atomicAdd(&(bar)[XB_TMO], 1u); break; } } } } while (0)
struct XcdBarrier { unsigned* bar; unsigned x; volatile LAS unsigned* st; };
__device__ __forceinline__ XcdBarrier xcd_barrier_post(unsigned* bar, volatile LAS unsigned* st, bool t0) {
    XcdBarrier b; b.bar = bar; b.x = xb_xcc_id(); b.st = st;
    if (t0) (void)xb_add(&bar[XB_XCNT(b.x)], 1u);
    return b;
}
__device__ __forceinline__ void xcd_barrier_complete(unsigned* bar, unsigned x, unsigned& nloc, unsigned& nx) {
    const unsigned G = gridDim.x * gridDim.y * gridDim.z;
    unsigned sum, cnt, mine, sp = 0u;
    for (;;) {
        sum = 0u; cnt = 0u; mine = 0u;
#pragma unroll
        for (unsigned j = 0; j < 16; ++j) { const unsigned c = xb_ld(&bar[XB_XCNT(j)]); sum += c; cnt += (c > 0u) ? 1u : 0u; mine = (j == x) ? c : mine; }
        if (sum == G) break;
        __builtin_amdgcn_s_sleep(1);
        if ((++sp & 255u) == 0u) { if (xb_ld(&bar[XB_TMO])) break; if (sp > XB_SPIN_CAP) { atomicAdd(&bar[XB_TMO], 1u); break; } }
    }
    nloc = mine > 0u ? mine : 1u; nx = cnt > 0u ? cnt : 1u;
}
__device__ __forceinline__ void xcd_barrier(const XcdBarrier& b, bool t0) {
    asm volatile("s_waitcnt vmcnt(0)" ::: "memory");
    __syncthreads();
    if (t0) {
        unsigned* bar = b.bar;
        __builtin_amdgcn_s_waitcnt(0);
        unsigned nloc = b.st[0], nx = b.st[1];
        if (nloc == 0u) { xcd_barrier_complete(bar, b.x, nloc, nx); b.st[0] = nloc; b.st[1] = nx; }
        const unsigned old = xb_add(&bar[XB_XSUB(b.x)], 1u);
        const unsigned gen = old / nloc;
        if (old + 1u == (gen + 1u) * nloc) {
            __builtin_amdgcn_fence(__ATOMIC_RELEASE, "agent");
            asm volatile("s_waitcnt vmcnt(0)" ::: "memory");
            const unsigned og = xb_add(&bar[XB_TOP], 1u);
            const unsigned tg = og / nx;
            if (og + 1u == (tg + 1u) * nx) xb_add(&bar[XB_TOPGEN], 1u);
            else XB_SPIN(xb_ld(&bar[XB_TOPGEN]) == tg, bar);
            __builtin_amdgcn_fence(__ATOMIC_ACQUIRE, "agent");
            xb_add(&bar[XB_XGEN(b.x)], 1u);
            asm volatile("s_waitcnt vmcnt(0)" ::: "memory");
        } else {
            XB_SPIN(xb_ld(&bar[XB_XGEN(b.x)]) == gen, bar);
            __builtin_amdgcn_fence(__ATOMIC_ACQUIRE, "agent");
            asm volatile("s_waitcnt vmcnt(0)" ::: "memory");
        }
    }
    __syncthreads();
}

namespace pg8 {
constexpr int BM = 256, BK = 64, HALF = 128, HTB = HALF * BK * 2, STAGE_BYTES = 8 * HTB, NXCD = 8, WGM = 8;
__host__ __device__ __forceinline__ int lds_byte(int r, int c) { const int st = (r >> 4) * 2 + (c >> 5), rr = r & 15, cc = c & 31, ob = rr * 64 + cc * 2; return st * 1024 + (ob ^ (((ob >> 9) & 1) << 5)); }
__host__ __device__ __forceinline__ void stage_rc(int b, int& R, int& C) { const int st = b / 1024, sb = b % 1024, swz = sb ^ (((sb >> 9) & 1) << 5); R = (st >> 1) * 16 + swz / 64; C = (st & 1) * 32 + (swz % 64) / 2; }
__host__ __device__ __forceinline__ int perm32(int rho) { const int n = rho >> 4, i = rho & 15; return 8 * (i >> 2) + 4 * n + (i & 3); }

struct Unit { int pm, pn, e, lbase, nvalid, pn2, sub; };
struct Gemm { const bf16* A; const bf16* Bt; int M, N, K; int KB = 0; };

struct StaticOrder {
    static constexpr bool GATHER = false;
    int nM, nN, nwg, G, c;
    __device__ void init(int M_, int N_, int G_, int c_) { nM = M_ / BM; nN = N_ / BM; nwg = nM * nN; G = G_; c = c_; }
    __device__ bool next(int i, Unit& u) const {
        const long L = (long)i * G + c; if (L >= nwg) return false;
        int wgid = (int)L; { const int q = nwg / NXCD, r = nwg % NXCD, xcd = wgid % NXCD, off = wgid / NXCD; wgid = (xcd < r ? xcd * (q + 1) : r * (q + 1) + (xcd - r) * q) + off; }
        const int nig = WGM * nN, gid = wgid / nig, fm = gid * WGM, gsz = (nM - fm) < WGM ? (nM - fm) : WGM;
        u.pm = fm + ((wgid % nig) % gsz); u.pn = (wgid % nig) / gsz; u.e = 0; u.lbase = 0; u.nvalid = 256; u.pn2 = u.pn; u.sub = 0; return true;
    }
    __device__ __forceinline__ int arow(const Unit& u, int r) const { return u.pm * BM + r; }
};
template <bool GATHER_> struct MoeOrder {
    static constexpr bool GATHER = GATHER_;
    const LAS int* tp; const LAS int* cnt; const int4* list; int NT, nwg, G, c; const LAS int* ord;
    __device__ bool next(int i, Unit& u) const {
        const long L = (long)i * G + c; if (L >= nwg) return false;
        int w = (int)L; { const int q = nwg / NXCD, r = nwg % NXCD, xcd = w % NXCD, off = w / NXCD; w = (xcd < r ? xcd * (q + 1) : r * (q + 1) + (xcd - r) * q) + off; }
        const int po = w / NT, pnl = w - po * NT, pmg = ord[po];
        typedef int i32x4 __attribute__((ext_vector_type(4)));
        const i32x4 t0 = *(const LAS i32x4*)tp, t1 = *(const LAS i32x4*)(tp + 4), t2 = *(const LAS i32x4*)(tp + 8), t3 = *(const LAS i32x4*)(tp + 12), t4 = *(const LAS i32x4*)(tp + 16), t5 = *(const LAS i32x4*)(tp + 20);
        const int e = (pmg >= t0.y) + (pmg >= t0.z) + (pmg >= t0.w) + (pmg >= t1.x) + (pmg >= t1.y) + (pmg >= t1.z) + (pmg >= t1.w)
                    + (pmg >= t2.x) + (pmg >= t2.y) + (pmg >= t2.z) + (pmg >= t2.w) + (pmg >= t3.x) + (pmg >= t3.y) + (pmg >= t3.z) + (pmg >= t3.w)
                    + (pmg >= t4.x) + (pmg >= t4.y) + (pmg >= t4.z) + (pmg >= t4.w) + (pmg >= t5.x) + (pmg >= t5.y) + (pmg >= t5.z) + (pmg >= t5.w);
        static_assert(NL == 24, "MoeOrder::next reads tp[0..23]");
        const int tile = pmg - tp[e];
        const int g4 = e / 6, p6 = e - 6 * g4, lo = p6 < 3 ? 0 : (p6 < 5 ? 1 : 2), hi = p6 < 3 ? p6 + 1 : (p6 < 5 ? p6 - 1 : 3), elo = 4 * g4 + lo, ehi = 4 * g4 + hi;
        u.pm = pmg; u.e = e; u.sub = pnl; u.lbase = e * CAP + tile * 256; const int nv = cnt[e] - tile * 256; u.nvalid = nv < 256 ? nv : 256;
        if (GATHER_) { u.pn = (pnl < 4 ? elo : ehi) * 4 + (pnl & 3); u.pn2 = u.pn; }
        else { u.pn = elo * NT + pnl; u.pn2 = ehi * NT + pnl; }
        return true;
    }
    __device__ __forceinline__ int arow(const Unit& u, int r) const { if (!GATHER_) return u.pm * BM + r; return r < u.nvalid ? list[u.lbase + r].x : 0; }
};

template <class Epi, class Sched>
__device__ __forceinline__ void gemm_simple(int wid, int lane, const Gemm g, const Sched& S, const Epi& E) {
    const int wr = wid >> 2, wc = wid & 3, fr = lane & 15, fq = lane >> 4;
    const int K = g.K;
    for (int ui = 0;; ++ui) {
        Unit u; if (!S.next(ui, u)) break;
        f32x4 acc[2][2][4][2];
#pragma unroll
        for (int a = 0; a < 2; ++a)
#pragma unroll
            for (int b = 0; b < 2; ++b)
#pragma unroll
                for (int m = 0; m < 4; ++m)
#pragma unroll
                    for (int n = 0; n < 2; ++n) acc[a][b][m][n] = (f32x4){0.f, 0.f, 0.f, 0.f};
        unsigned ap[2][4], bp[2][2];
#pragma unroll
        for (int a = 0; a < 2; ++a)
#pragma unroll
            for (int m = 0; m < 4; ++m) ap[a][m] = (unsigned)S.arow(u, a * HALF + wr * 64 + m * 16 + fr) * (unsigned)K + fq * 8;
#pragma unroll
        for (int b = 0; b < 2; ++b)
#pragma unroll
            for (int n = 0; n < 2; ++n) { const int rho = 16 * n + fr; bp[b][n] = (unsigned)(u.pn * BM + b * HALF + wc * 32 + (Epi::PERM ? perm32(rho) : rho)) * (unsigned)K + fq * 8; }
#pragma unroll 1
        for (int k = 0; k < K; k += 32) {
            bf16x8 Af[2][4], Bf[2][2];
#pragma unroll
            for (int a = 0; a < 2; ++a)
#pragma unroll
                for (int m = 0; m < 4; ++m) Af[a][m] = *(const bf16x8*)(g.A + ap[a][m] + k);
#pragma unroll
            for (int b = 0; b < 2; ++b)
#pragma unroll
                for (int n = 0; n < 2; ++n) Bf[b][n] = *(const bf16x8*)(g.Bt + bp[b][n] + k);
#pragma unroll
            for (int a = 0; a < 2; ++a)
#pragma unroll
                for (int b = 0; b < 2; ++b)
#pragma unroll
                    for (int m = 0; m < 4; ++m)
#pragma unroll
                        for (int n = 0; n < 2; ++n) acc[a][b][m][n] = __builtin_amdgcn_mfma_f32_16x16x32_bf16(Bf[b][n], Af[a][m], acc[a][b][m][n], 0, 0, 0);
        }
        E(acc, u, wr, wc, fr, fq);
    }
}

typedef int v8i32 __attribute__((ext_vector_type(8)));
typedef int v4i32 __attribute__((ext_vector_type(4)));
template <class Epi, class Sched, bool F8 = false>
__device__ __forceinline__ void gemm_phase(int wid, int lane, LAS unsigned char* lds, const Gemm g, const Sched& S, const Epi& E) {
    const int tid = wid * 64 + lane, wr = wid >> 2, wc = wid & 3, fr = lane & 15, fq = lane >> 4;
    const int K = F8 ? g.K / 2 : g.K  , nt = K / BK;
    const int KBr = g.KB ? (F8 ? g.KB / 2 : g.KB) : K  , ntB = KBr / BK;
    unsigned voffA[2], voffB[2]; int Rr[2], Cc[2];
#pragma unroll
    for (int i = 0; i < 2; ++i) { int R, C; stage_rc(tid * 16 + i * 8192, R, C); const int Rb = Epi::PERM ? ((R & ~31) + perm32(R & 31)) : R;
        voffA[i] = (unsigned)(R * K + C) * 2u; voffB[i] = (unsigned)(Rb * KBr + C) * 2u; Rr[i] = R; Cc[i] = C; }
    const unsigned kstep = (unsigned)(BK * 2);
    const unsigned hstep = (unsigned)HALF * (unsigned)K * 2u;
    const unsigned tstep = 2 * hstep;
    const unsigned hstepB = (unsigned)HALF * (unsigned)KBr * 2u, tstepB = 2 * hstepB;
    const __amdgpu_buffer_rsrc_t rsA = make_rsrc(g.A, 0x7fffffff), rsB = make_rsrc(g.Bt, 0x7fffffff);
    const unsigned ldsw = (unsigned)wid * 1024u;
    const int aoff0 = lds_byte(wr * 64 + fr, F8 ? fq * 16 : fq * 8), aoff1 = F8 ? lds_byte(wr * 64 + fr, fq * 16 + 8) : aoff0 + 1024;
    const int boff0 = lds_byte(wc * 32 + fr, F8 ? fq * 16 : fq * 8), boff1 = F8 ? lds_byte(wc * 32 + fr, fq * 16 + 8) : boff0 + 1024;
#define PG8_SA(b, h) (((b) * 2 + (h)) * HTB)
#define PG8_SB(b, h) ((4 + (b) * 2 + (h)) * HTB)
#define PG8_STAGE(bufoff, soff, voff) do { _Pragma("unroll") for (int _i = 0; _i < 2; ++_i) \
        __builtin_amdgcn_raw_ptr_buffer_load_lds(rsB, (LAS void*)(lds + (bufoff) + ldsw + _i * 8192), 16, (int)(voff)[_i], (int)(soff), 0, 0); } while (0)
#define PG8_STAGE_A(bufoff, h, contig_off, kt_bytes, use_next) do { _Pragma("unroll") for (int _i = 0; _i < 2; ++_i) { \
        const unsigned vo_ = Sched::GATHER ? ((use_next) ? gN[h][_i] : gC[h][_i]) : voffA[_i]; const unsigned so_ = Sched::GATHER ? (unsigned)(kt_bytes) : (unsigned)(contig_off); \
        __builtin_amdgcn_raw_ptr_buffer_load_lds(rsA, (LAS void*)(lds + (bufoff) + ldsw + _i * 8192), 16, (int)vo_, (int)so_, 0, 0); } } while (0)
#define PG8_GOFF(u_, o_) do { _Pragma("unroll") for (int _h = 0; _h < 2; ++_h) _Pragma("unroll") for (int _i = 0; _i < 2; ++_i) \
        o_[_h][_i] = ((unsigned)S.arow(u_, _h * HALF + Rr[_i]) * (unsigned)K + (unsigned)Cc[_i]) * 2u; } while (0)
#define PG8_LDA(dst, b, h) do { _Pragma("unroll") for (int m = 0; m < 4; ++m) { dst[m][0] = *(const LAS bf16x8*)(lds + PG8_SA(b, h) + aoff0 + m * 2048); dst[m][1] = *(const LAS bf16x8*)(lds + PG8_SA(b, h) + aoff1 + m * 2048); } } while (0)
#define PG8_LDB(dst, b, h) do { _Pragma("unroll") for (int n = 0; n < 2; ++n) { dst[n][0] = *(const LAS bf16x8*)(lds + PG8_SB(b, h) + boff0 + n * 2048); dst[n][1] = *(const LAS bf16x8*)(lds + PG8_SB(b, h) + boff1 + n * 2048); } } while (0)
#define PG8_V8(x_) __builtin_shufflevector(__builtin_bit_cast(v4i32, (x_)[0]), __builtin_bit_cast(v4i32, (x_)[1]), 0, 1, 2, 3, 4, 5, 6, 7)
#define PG8_MMA(ai, bj, At, Bt) do { __builtin_amdgcn_s_setprio(1); _Pragma("unroll") for (int m = 0; m < 4; ++m) _Pragma("unroll") for (int n = 0; n < 2; ++n) { \
        if constexpr (F8) { const v8i32 b8_ = PG8_V8(Bt[n]), a8_ = PG8_V8(At[m]);   \
            asm volatile("v_mfma_scale_f32_16x16x128_f8f6f4 %0, %1, %2, %0, %3, %4 op_sel_hi:[0,0,0]" : "+v"(acc[ai][bj][m][n]) : "v"(b8_), "v"(a8_), "v"(sc_w), "v"(sc_a)); } \
        else { _Pragma("unroll") for (int k = 0; k < 2; ++k) acc[ai][bj][m][n] = __builtin_amdgcn_mfma_f32_16x16x32_bf16(Bt[n][k], At[m][k], acc[ai][bj][m][n], 0, 0, 0); } } \
        __builtin_amdgcn_s_setprio(0); } while (0)
#define PG8_WAIT_V(n) asm volatile("s_waitcnt vmcnt(" #n ")" ::: "memory")
#define PG8_WAIT_L(n) asm volatile("s_waitcnt lgkmcnt(" #n ")" ::: "memory")
#define PG8_BAR __builtin_amdgcn_s_barrier()
#define PG8_SCHED __builtin_amdgcn_sched_barrier(0)
    const int sc_w = 0x7a7a7a7a  , sc_a = 0x7f7f7f7f  ; (void)sc_w; (void)sc_a;
    Unit cur, nxt; int ui = 0; int relaxN = 0;
    if (!S.next(0, cur)) return;
    unsigned gC[2][2], gN[2][2];
    if constexpr (Sched::GATHER) { PG8_GOFF(cur, gC); }
    else {
#pragma unroll
        for (int h = 0; h < 2; ++h)
#pragma unroll
            for (int i = 0; i < 2; ++i) { gC[h][i] = 0u; gN[h][i] = 0u; } }
    f32x4 acc[2][2][4][2];
#pragma unroll
    for (int a = 0; a < 2; ++a)
#pragma unroll
        for (int b = 0; b < 2; ++b)
#pragma unroll
            for (int m = 0; m < 4; ++m)
#pragma unroll
                for (int n = 0; n < 2; ++n) acc[a][b][m][n] = (f32x4){0.f, 0.f, 0.f, 0.f};
    bf16x8 At[4][2], B0[2][2], B1[2][2];
    unsigned cA = Sched::GATHER ? 0u : (unsigned)cur.pm * tstep, cB = (unsigned)cur.pn * tstepB, cB2 = (unsigned)cur.pn2 * tstepB - (unsigned)ntB * kstep;
    PG8_STAGE(PG8_SB(0, 0), cB, voffB); PG8_STAGE(PG8_SB(0, 1), cB + hstepB, voffB); PG8_STAGE_A(PG8_SA(0, 0), 0, cA, 0, false); PG8_STAGE_A(PG8_SA(0, 1), 1, cA + hstep, 0, false);
    if (wr == 1) PG8_BAR;
    PG8_WAIT_V(2); PG8_BAR;
    PG8_STAGE(PG8_SB(1, 0), cB + kstep, voffB); PG8_STAGE_A(PG8_SA(1, 0), 0, cA + kstep, kstep, false); PG8_STAGE(PG8_SB(1, 1), cB + hstepB + kstep, voffB);
    PG8_WAIT_V(6); PG8_BAR;
    for (;;) {
        const bool has_next = S.next(ui + 1, nxt);
        if constexpr (Sched::GATHER) { if (has_next) { PG8_GOFF(nxt, gN); } else {
#pragma unroll
            for (int h = 0; h < 2; ++h)
#pragma unroll
                for (int i = 0; i < 2; ++i) gN[h][i] = gC[h][i]; } }
        const unsigned nA = (has_next && !Sched::GATHER) ? (unsigned)nxt.pm * tstep : cA, nB = has_next ? (unsigned)nxt.pn * tstepB : cB, nB2 = has_next ? (unsigned)nxt.pn2 * tstepB - (unsigned)ntB * kstep : cB2;
        for (int t = 0; t < nt; t += 2) {
            const bool last = (t == nt - 2);
            const unsigned a1 = cA + (unsigned)(t + 1) * kstep;
            const unsigned a2 = last ? nA : cA + (unsigned)(t + 2) * kstep, b2 = last ? nB : ((t + 2) < ntB ? cB : cB2) + (unsigned)(t + 2) * kstep;
            const unsigned a3 = a2 + kstep, b3 = last ? nB + kstep : ((t + 3) < ntB ? cB : cB2) + (unsigned)(t + 3) * kstep;
            const unsigned k1 = (unsigned)(t + 1) * kstep, k2 = last ? 0u : (unsigned)(t + 2) * kstep, k3 = k2 + kstep;
            const bool first = (t == 0), rlx = first && relaxN > 0, halfu = cur.nvalid <= 128;
#define PG8_WAIT_VR() do { if (rlx) { if (relaxN == 8) PG8_WAIT_V(16); else if (relaxN == 16) PG8_WAIT_V(24); else PG8_WAIT_V(8); } else PG8_WAIT_V(8); } while (0)
            PG8_LDB(B0, 0, 0); PG8_LDB(B1, 0, 1); PG8_SCHED; PG8_LDA(At, 0, 0); if (!(first && ui > 0)) PG8_STAGE_A(PG8_SA(1, 1), 1, a1 + hstep, k1, false);
            PG8_WAIT_VR(); PG8_WAIT_L(0); PG8_BAR; PG8_MMA(0, 0, At, B0); PG8_MMA(0, 1, At, B1); PG8_BAR; PG8_SCHED;
            PG8_LDA(At, 0, 1); PG8_STAGE(PG8_SB(0, 0), b2, voffB); PG8_STAGE(PG8_SB(0, 1), b2 + hstepB, voffB); PG8_STAGE_A(PG8_SA(0, 0), 0, a2, k2, last);
            PG8_WAIT_VR(); PG8_WAIT_L(0); PG8_BAR; if (!halfu) { PG8_MMA(1, 0, At, B0); PG8_MMA(1, 1, At, B1); } PG8_BAR; PG8_SCHED;
            PG8_LDB(B0, 1, 0); PG8_LDB(B1, 1, 1); PG8_SCHED; PG8_LDA(At, 1, 0); PG8_STAGE_A(PG8_SA(0, 1), 1, a2 + hstep, k2, last);
            PG8_WAIT_VR(); PG8_WAIT_L(0); PG8_BAR; PG8_MMA(0, 0, At, B0); PG8_MMA(0, 1, At, B1); PG8_BAR; PG8_SCHED;
            PG8_LDA(At, 1, 1); PG8_STAGE(PG8_SB(1, 0), b3, voffB); PG8_STAGE(PG8_SB(1, 1), b3 + hstepB, voffB); PG8_STAGE_A(PG8_SA(1, 0), 0, a3, k3, last);
            PG8_WAIT_V(8); PG8_WAIT_L(0); PG8_BAR; if (!halfu) { PG8_MMA(1, 0, At, B0); PG8_MMA(1, 1, At, B1); } PG8_BAR; PG8_SCHED;
            if (last && has_next) { PG8_STAGE_A(PG8_SA(1, 1), 1, a3 + hstep, k3, true); PG8_SCHED; }
#undef PG8_WAIT_VR
        }
        if (wr == 0) PG8_BAR;
        if constexpr (F8) asm volatile("s_nop 15\n\ts_nop 15" ::: "memory");
        E(acc, cur, wr, wc, fr, fq);
        relaxN = has_next ? E.stores_lb(cur) : 0;
        if (!has_next) break;
#pragma unroll
        for (int a = 0; a < 2; ++a)
#pragma unroll
            for (int b = 0; b < 2; ++b)
#pragma unroll
                for (int m = 0; m < 4; ++m)
#pragma unroll
                    for (int n = 0; n < 2; ++n) acc[a][b][m][n] = (f32x4){0.f, 0.f, 0.f, 0.f};
        cur = nxt; cA = nA; cB = nB; cB2 = nB2; ++ui;
#pragma unroll
        for (int h = 0; h < 2; ++h)
#pragma unroll
            for (int i = 0; i < 2; ++i) gC[h][i] = gN[h][i];
        if (wr == 1) PG8_BAR;
    }
    PG8_WAIT_V(0);
    PG8_BAR;
#undef PG8_SA
#undef PG8_SB
#undef PG8_STAGE
#undef PG8_STAGE_A
#undef PG8_GOFF
#undef PG8_LDA
#undef PG8_LDB
#undef PG8_MMA
#undef PG8_V8
#undef PG8_WAIT_V
#undef PG8_WAIT_L
#undef PG8_BAR
#undef PG8_SCHED
}
}
using pg8::Unit; using pg8::Gemm; using pg8::HALF; using pg8::BM;

#if USE_FAST_GEMM
#define GEMM_PHASE(EpiT, SchedT, lds, g, S, E) pg8::gemm_phase<EpiT, SchedT>(F.wave0, fresh_lane(), lds, g, S, E)
#define GEMM_PHASE_F8(EpiT, SchedT, lds, g, S, E) pg8::gemm_phase<EpiT, SchedT, true>(F.wave0, fresh_lane(), lds, g, S, E)
#else
#define GEMM_PHASE(EpiT, SchedT, lds, g, S, E) pg8::gemm_simple<EpiT, SchedT>(F.wave0, fresh_lane(), g, S, E)
#endif

__device__ __forceinline__ void st_bf8(bf16* p, f32x4 a, f32x4 b) { u32x4 w; w.x = pk2(a.x, a.y); w.y = pk2(a.z, a.w); w.z = pk2(b.x, b.y); w.w = pk2(b.z, b.w); *(u32x4*)p = w; }
__device__ __forceinline__ float lane32_partner(float v, bool upper) {
    auto rr = __builtin_amdgcn_permlane32_swap(__float_as_uint(v), __float_as_uint(v), false, false); return __uint_as_float(upper ? rr[0] : rr[1]);
}
struct EpiInProj {
    static constexpr bool PERM = true, AFTER_DRAIN = false;
    bf16* PROJ; bf16* Q; bf16* KB; bf16* VB; const LAS float* tabc; const LAS float* tabs; int pn_off;
    __device__ __forceinline__ int stores_lb(const Unit& u) const { return (u.pn + pn_off) < 8 ? 8 : 16; }
    __device__ __forceinline__ void operator()(const f32x4 (&acc)[2][2][4][2], const Unit& u, int wr, int wc, int fr, int fq) const {
        const int pn = u.pn + pn_off;
        if (pn < 8) {
#pragma unroll
            for (int ai = 0; ai < 2; ++ai)
#pragma unroll
                for (int m = 0; m < 4; ++m) { const int row = u.pm * BM + ai * HALF + wr * 64 + m * 16 + fr;
                    st_bf8(PROJ + (size_t)row * 2048 + pn * 128 + wc * 32 + 8 * fq, acc[ai][0][m][0] * acc[ai][1][m][0], acc[ai][0][m][1] * acc[ai][1][m][1]); }
        } else if (pn < 12) {
#pragma unroll
            for (int ai = 0; ai < 2; ++ai)
#pragma unroll
                for (int m = 0; m < 4; ++m) { const int row = u.pm * BM + ai * HALF + wr * 64 + m * 16 + fr; bf16* rp = PROJ + (size_t)row * 2048 + 1024 + (pn - 8) * 256 + wc * 32 + 8 * fq;
#pragma unroll
                    for (int bj = 0; bj < 2; ++bj) st_bf8(rp + bj * HALF, acc[ai][bj][m][0], acc[ai][bj][m][1]); }
        } else if (pn < 20) {
            const bool isq = pn < 16; const int cb = (pn - (isq ? 12 : 16)) * 256 + wc * 32 + 8 * fq; const size_t kb_minus_q = (size_t)((unsigned char*)KB - (unsigned char*)Q); const int axis = wc & 1; const bool upper = fq >= 2; const int fo = 8 * (fq & 1);
#pragma unroll
            for (int ai = 0; ai < 2; ++ai)
#pragma unroll
                for (int m = 0; m < 4; ++m) { const int row = u.pm * BM + ai * HALF + wr * 64 + m * 16 + fr; const int t = row & (SEQ - 1), b = row >> 13;
                    const int pos = axis ? (t & 63) : (t >> 6);
                    f32x4 cs0 = *(const LAS f32x4*)(tabc + pos * 16 + fo), cs1 = *(const LAS f32x4*)(tabc + pos * 16 + fo + 4); f32x4 sn0 = *(const LAS f32x4*)(tabs + pos * 16 + fo), sn1 = *(const LAS f32x4*)(tabs + pos * 16 + fo + 4);
                    if (!upper) { sn0 = -sn0; sn1 = -sn1; }
                    unsigned char* rp = (unsigned char*)Q + (isq ? ((size_t)row * 1024 + cb) : (kb_minus_q + ((size_t)b * KV + CTXL + t) * 1024 + cb));
                    if (isq) { cs0 = cs0 * QSCALE; cs1 = cs1 * QSCALE; sn0 = sn0 * QSCALE; sn1 = sn1 * QSCALE; }
#pragma unroll
                    for (int bj = 0; bj < 2; ++bj) { const f32x4 a0 = acc[ai][bj][m][0], a1 = acc[ai][bj][m][1];
                        const f32x4 p0 = (f32x4){lane32_partner(a0.x, upper), lane32_partner(a0.y, upper), lane32_partner(a0.z, upper), lane32_partner(a0.w, upper)};
                        const f32x4 p1 = (f32x4){lane32_partner(a1.x, upper), lane32_partner(a1.y, upper), lane32_partner(a1.z, upper), lane32_partner(a1.w, upper)};
                        st_f8x8(rp + bj * HALF, a0 * cs0 + p0 * sn0, a1 * cs1 + p1 * sn1); } }
        } else {
            const int cb = (pn - 20) * 256 + wc * 32 + 8 * fq;
#pragma unroll
            for (int ai = 0; ai < 2; ++ai)
#pragma unroll
                for (int m = 0; m < 4; ++m) { const int row = u.pm * BM + ai * HALF + wr * 64 + m * 16 + fr; const int t = row & (SEQ - 1), b = row >> 13;
                    unsigned char* rp = (unsigned char*)VB + ((size_t)b * KV + CTXL + t) * 1024 + cb;
#pragma unroll
                    for (int bj = 0; bj < 2; ++bj) st_f8x8(rp + bj * HALF, acc[ai][bj][m][0], acc[ai][bj][m][1]); }
        }
    }
};
struct EpiCtx {
    static constexpr bool PERM = true, AFTER_DRAIN = false;
    bf16* KB; bf16* VB;
    __device__ __forceinline__ int stores_lb(const Unit&) const { return 16; }
    __device__ __forceinline__ void operator()(const f32x4 (&acc)[2][2][4][2], const Unit& u, int wr, int wc, int fr, int fq) const {
        const bool isk = u.pn < 4; const int cb = (u.pn & 3) * 256 + wc * 32 + 8 * fq;
#pragma unroll
        for (int ai = 0; ai < 2; ++ai)
#pragma unroll
            for (int m = 0; m < 4; ++m) { const int row = u.pm * BM + ai * HALF + wr * 64 + m * 16 + fr; const int t = row & (CTXL - 1), b = row >> 8;
                const size_t eo = ((size_t)b * KV + t) * 1024 + cb;
#pragma unroll
                for (int bj = 0; bj < 2; ++bj) st_f8x8((unsigned char*)(isk ? KB : VB) + eo + bj * HALF, acc[ai][bj][m][0], acc[ai][bj][m][1]); }
    }
};
template <bool RES_F32> struct EpiRes {
    static constexpr bool PERM = true, AFTER_DRAIN = false;
    const float* xf; const bf16* xb; const float* gate  ; bf16* R;
    __device__ __forceinline__ int stores_lb(const Unit&) const { return 16; }
    struct Raw { f32x4 f[2][2][2]; u32x4 h[2][2]; };
    __device__ __forceinline__ void load(Raw& r, const Unit& u, int st, int wr, int fr, int cb) const {
        const int ai = st >> 1, mp = (st & 1) * 2;
#pragma unroll
        for (int mm = 0; mm < 2; ++mm) { const size_t off = (size_t)(u.pm * BM + ai * HALF + wr * 64 + (mp + mm) * 16 + fr) * D + cb;
#pragma unroll
            for (int bj = 0; bj < 2; ++bj) {
                if (RES_F32) { r.f[mm][bj][0] = *(const f32x4*)(xf + off + bj * HALF); r.f[mm][bj][1] = *(const f32x4*)(xf + off + bj * HALF + 4); }
                else r.h[mm][bj] = *(const u32x4*)(xb + off + bj * HALF); } }
    }
    __device__ __forceinline__ void operator()(const f32x4 (&acc)[2][2][4][2], const Unit& u, int wr, int wc, int fr, int fq) const {
        const int cb = u.pn * BM + wc * 32 + 8 * fq; const int b = (u.pm * BM) >> 13;
        f32x4 gv[2][2];
#pragma unroll
        for (int bj = 0; bj < 2; ++bj)
#pragma unroll
            for (int n = 0; n < 2; ++n) gv[bj][n] = *(const f32x4*)(gate + (size_t)b * (6 * D) + cb + bj * HALF + 4 * n);
        Raw ra, rb2; load(ra, u, 0, wr, fr, cb);
#pragma unroll
        for (int st = 0; st < 4; ++st) {
            Raw& cur = (st & 1) ? rb2 : ra; Raw& nxt = (st & 1) ? ra : rb2;
            if (st < 3) load(nxt, u, st + 1, wr, fr, cb);
            const int ai = st >> 1, mp = (st & 1) * 2;
#pragma unroll
            for (int mm = 0; mm < 2; ++mm) { const size_t off = (size_t)(u.pm * BM + ai * HALF + wr * 64 + (mp + mm) * 16 + fr) * D + cb;
#pragma unroll
                for (int bj = 0; bj < 2; ++bj) { f32x4 r0, r1;
                    if (RES_F32) { r0 = cur.f[mm][bj][0]; r1 = cur.f[mm][bj][1]; }
                    else { const u32x4 w = cur.h[mm][bj]; r0 = (f32x4){bf_lo(w.x), bf_hi(w.x), bf_lo(w.y), bf_hi(w.y)}; r1 = (f32x4){bf_lo(w.z), bf_hi(w.z), bf_lo(w.w), bf_hi(w.w)}; }
                    st_bf8(R + off + bj * HALF, r0 * ALPHA + gv[bj][0] * acc[ai][bj][mp + mm][0], r1 * ALPHA + gv[bj][1] * acc[ai][bj][mp + mm][1]); } }
        }
    }
};
struct EpiGU {
    static constexpr bool PERM = true, AFTER_DRAIN = false;
    unsigned char* HID;
    const int4* list;
    __device__ __forceinline__ int stores_lb(const Unit&) const { return 8; }
    __device__ __forceinline__ void operator()(const f32x4 (&acc)[2][2][4][2], const Unit& u, int wr, int wc, int fr, int fq) const {
        const int cb = u.sub * 128 + wc * 32 + 8 * fq; const bool hiw = u.sub >= 4;
        float wgt[2][4];
#pragma unroll
        for (int ai = 0; ai < 2; ++ai)
#pragma unroll
            for (int m = 0; m < 4; ++m) { const int rl = ai * HALF + wr * 64 + m * 16 + fr; const int4 le = list[u.lbase + (rl < u.nvalid ? rl : 0)]; wgt[ai][m] = __int_as_float(hiw ? le.z : le.y); }
#pragma unroll
        for (int ai = 0; ai < 2; ++ai)
#pragma unroll
            for (int m = 0; m < 4; ++m) { const int row = u.pm * BM + ai * HALF + wr * 64 + m * 16 + fr; const float w_ = wgt[ai][m];
                const f32x4 g0 = acc[ai][0][m][0], g1 = acc[ai][0][m][1], u0 = acc[ai][1][m][0] * w_, u1 = acc[ai][1][m][1] * w_; u32x2 w;
                w.x = pk4_fp8(silu_f(g0.x) * u0.x, silu_f(g0.y) * u0.y, silu_f(g0.z) * u0.z, silu_f(g0.w) * u0.w); w.y = pk4_fp8(silu_f(g1.x) * u1.x, silu_f(g1.y) * u1.y, silu_f(g1.z) * u1.z, silu_f(g1.w) * u1.w);
                *(u32x2*)(HID + (size_t)row * (2 * ED) + cb) = w; }
    }
};
struct EpiDown {
    static constexpr bool PERM = true, AFTER_DRAIN = false;
    const int4* list; bf16* YB;
    __device__ __forceinline__ int stores_lb(const Unit& u) const { return u.nvalid == 256 ? 16 : 0; }
    __device__ __forceinline__ void operator()(const f32x4 (&acc)[2][2][4][2], const Unit& u, int wr, int wc, int fr, int fq) const {
        const int cb = u.sub * 256 + wc * 32 + 8 * fq;
        int tok[2][4];
#pragma unroll
        for (int ai = 0; ai < 2; ++ai)
#pragma unroll
            for (int m = 0; m < 4; ++m) { const int rl = ai * HALF + wr * 64 + m * 16 + fr; tok[ai][m] = list[u.lbase + (rl < u.nvalid ? rl : 0)].x; }
#pragma unroll
        for (int ai = 0; ai < 2; ++ai)
#pragma unroll
            for (int m = 0; m < 4; ++m) { const int rl = ai * HALF + wr * 64 + m * 16 + fr;
                if (rl < u.nvalid) { bf16* rp = YB + (size_t)tok[ai][m] * D + cb;
#pragma unroll
                    for (int bj = 0; bj < 2; ++bj) st_bf8(rp + bj * HALF, acc[ai][bj][m][0], acc[ai][bj][m][1]); } }
    }
};
struct EpiGelu {
    static constexpr bool PERM = true, AFTER_DRAIN = false;
    bf16* UV; float* vst;
    __device__ __forceinline__ int stores_lb(const Unit&) const { return 16; }
    __device__ __forceinline__ void operator()(const f32x4 (&acc)[2][2][4][2], const Unit& u, int wr, int wc, int fr, int fq) const {
        const int cb = u.pn * BM + wc * 32 + 8 * fq; const bool isv = u.pn >= 8;
#pragma unroll
        for (int ai = 0; ai < 2; ++ai)
#pragma unroll
            for (int m = 0; m < 4; ++m) { const int row = u.pm * BM + ai * HALF + wr * 64 + m * 16 + fr; bf16* rp = UV + (size_t)row * 4096 + cb; float s = 0.f, s2 = 0.f;
#pragma unroll
                for (int bj = 0; bj < 2; ++bj) { f32x4 v[2];
#pragma unroll
                    for (int n = 0; n < 2; ++n) { const f32x4 a = acc[ai][bj][m][n]; v[n] = (f32x4){gelu_tanh_f(a.x), gelu_tanh_f(a.y), gelu_tanh_f(a.z), gelu_tanh_f(a.w)};
                        s += (v[n].x + v[n].y) + (v[n].z + v[n].w); s2 += (v[n].x * v[n].x + v[n].y * v[n].y) + (v[n].z * v[n].z + v[n].w * v[n].w); }
                    st_bf8(rp + bj * HALF, v[0], v[1]); }
                if (isv) { s += __shfl_xor(s, 16); s += __shfl_xor(s, 32); s2 += __shfl_xor(s2, 16); s2 += __shfl_xor(s2, 32);
                    if (fq == 0) *(f32x2*)(vst + (((size_t)row * 8 + (u.pn - 8)) * 4 + wc) * 2) = (f32x2){s, s2}; } }
    }
};

__device__ __forceinline__ int fresh_lane() { int l; asm volatile("v_mbcnt_lo_u32_b32 %0, -1, 0\n\tv_mbcnt_hi_u32_b32 %0, -1, %0" : "=v"(l)); return l; }
#define fresh_tid() (F.wave0 * 64 + fresh_lane())
#define PH_IDS const int lane = fresh_lane(), wave = F.wave0, tid = wave * 64 + lane; (void)tid; (void)lane; (void)wave
struct Frame {
    LAS unsigned char* lds; volatile LAS unsigned* MISC; unsigned* ctl;
    int vcu, G, wave0;
    const float* in[27]; float* out; unsigned char* ws;
};
#define WSP(T, off) ((T*)(F.ws + (off)))
#define MODP(l, r, i) (WSP(float, WS_MOD) + (((l) * 5 + (r)) * 6 + (i)) * D)

__device__ __forceinline__ void tr_item(const float* W, int N, bf16* WT, int Kd, int item, int mode, LAS float* scr, int lane) {
    const int nblk = N / 32, kb = item / nblk, nb = item - kb * nblk, k0 = 64 * kb, n0 = 32 * nb;
    int d0 = mode ? (((n0 >> 7) << 8) + (n0 & 127) + (mode == 2 ? 128 : 0)) : n0;
    if (mode == 3) { const int c = n0 & 1023; d0 = n0 >= 3072 ? n0 : n0 < 1024 ? (((c >> 7) << 8) + (c & 127)) : n0 < 2048 ? 2048 + c : (((c >> 7) << 8) + 128 + (c & 127)); }
#pragma unroll 8
    for (int i = 0; i < 32; ++i) { const int kk = 2 * i + (lane >> 5); scr[kk * 33 + (lane & 31)] = W[(size_t)(k0 + kk) * N + n0 + (lane & 31)]; }
    LDS_WAIT(); asm volatile("" ::: "memory");
    const int c = lane & 7;
#pragma unroll
    for (int j = 0; j < 4; ++j) { const int n = (lane >> 3) + 8 * j; const LAS float* s = scr + (8 * c) * 33 + n;
        u32x4 o; o.x = pk2(s[0 * 33], s[1 * 33]); o.y = pk2(s[2 * 33], s[3 * 33]); o.z = pk2(s[4 * 33], s[5 * 33]); o.w = pk2(s[6 * 33], s[7 * 33]);
        *(u32x4*)(WT + (size_t)(d0 + n) * Kd + k0 + 8 * c) = o; }
    LDS_WAIT(); asm volatile("" ::: "memory");
}
constexpr int CW_I_EXP = 512, CW_I_GU = 16 * CW_I_EXP, CW_I_SQ = 32 * 64;
struct TrDesc { const float* src; bf16* dst; int N, Kd; bool f8; };
template <int L> __device__ __forceinline__ TrDesc tr_desc(Frame& F, int it) {
    constexpr int I_IN = L == 0 ? 32 * 192 : 32 * 128;
    const float* W; bf16* WT; int N, Kd, mode, q; int r = it;
    bool f8 = false;
    if (r < CW_I_GU) { const int le = L * 16 + (r >> 9); q = r & 511; W = F.in[24] + (size_t)le * D * ED; N = ED; WT = (bf16*)(WSP(unsigned char, WS_WGU) + (size_t)le * 1024 * D); Kd = D; mode = 1; f8 = true; }
    else if (r < 2 * CW_I_GU) { r -= CW_I_GU; const int le = L * 16 + (r >> 9); q = r & 511; W = F.in[25] + (size_t)le * D * ED; N = ED; WT = (bf16*)(WSP(unsigned char, WS_WGU) + (size_t)le * 1024 * D); Kd = D; mode = 2; f8 = true; }
    else if (r < 2 * CW_I_GU + I_IN) { q = r - 2 * CW_I_GU; W = L == 0 ? F.in[8] : F.in[16]; N = L == 0 ? 6144 : 4096; WT = L == 0 ? WSP(bf16, WS_WINE) : WSP(bf16, WS_WINO); Kd = D; mode = L == 0 ? 3 : 0; f8 = L == 1; }
    else if (r < 2 * CW_I_GU + I_IN + CW_I_SQ) { q = r - 2 * CW_I_GU - I_IN; W = L == 0 ? F.in[15] : F.in[21]; N = D; WT = L == 0 ? WSP(bf16, WS_WOUTE) : WSP(bf16, WS_WOUTO); Kd = D; mode = 0; f8 = true; }
    else { r -= 2 * CW_I_GU + I_IN + CW_I_SQ; const int le = L * 16 + (r >> 9); q = r & 511; W = F.in[26] + (size_t)le * ED * D; N = D; WT = (bf16*)(WSP(unsigned char, WS_WDN) + (size_t)le * D * ED); Kd = ED; mode = 0; f8 = true; }
    const int nblk = N / 32, kb = q / nblk, nb = q - kb * nblk, k0 = 64 * kb, n0 = 32 * nb;
    int d0 = mode ? (((n0 >> 7) << 8) + (n0 & 127) + (mode == 2 ? 128 : 0)) : n0;
    if (mode == 3) { const int c = n0 & 1023; d0 = n0 >= 3072 ? n0 : n0 < 1024 ? (((c >> 7) << 8) + (c & 127)) : n0 < 2048 ? 2048 + c : (((c >> 7) << 8) + 128 + (c & 127)); }
    if (mode == 3) f8 = true;
    TrDesc d; d.src = W + (size_t)k0 * N + n0; d.dst = f8 ? (bf16*)((unsigned char*)WT + (size_t)d0 * Kd + k0) : WT + (size_t)d0 * Kd + k0; d.N = N; d.Kd = Kd; d.f8 = f8; return d;
}
template <int L> __device__ __forceinline__ void convert_weights(Frame& F, int gw, int NGW, int wave, int lane, int lo, int hi) {
    LAS float* scr = (LAS float*)(F.lds + wave * 16384);
    int it = lo + gw; if (it >= hi) return;
    float rg[32]; TrDesc cur = tr_desc<L>(F, it);
#pragma unroll
    for (int i = 0; i < 32; ++i) rg[i] = cur.src[(size_t)(2 * i + (lane >> 5)) * cur.N + (lane & 31)];
    for (;;) {
#pragma unroll
        for (int i = 0; i < 32; ++i) scr[(2 * i + (lane >> 5)) * 33 + (lane & 31)] = rg[i];
        LDS_WAIT(); asm volatile("" ::: "memory");
        const int nit = it + NGW; const bool more = nit < hi; TrDesc nx = cur;
        if (more) { nx = tr_desc<L>(F, nit);
#pragma unroll
            for (int i = 0; i < 32; ++i) rg[i] = nx.src[(size_t)(2 * i + (lane >> 5)) * nx.N + (lane & 31)]; }
        if (cur.f8) {
            const int c = lane & 3;
#pragma unroll
            for (int j = 0; j < 2; ++j) { const int n = (lane >> 2) + 16 * j; const LAS float* sp = scr + (16 * c) * 33 + n; u32x4 o;
                o.x = pk4_fp8(sp[0 * 33] * W8_SCALE, sp[1 * 33] * W8_SCALE, sp[2 * 33] * W8_SCALE, sp[3 * 33] * W8_SCALE); o.y = pk4_fp8(sp[4 * 33] * W8_SCALE, sp[5 * 33] * W8_SCALE, sp[6 * 33] * W8_SCALE, sp[7 * 33] * W8_SCALE);
                o.z = pk4_fp8(sp[8 * 33] * W8_SCALE, sp[9 * 33] * W8_SCALE, sp[10 * 33] * W8_SCALE, sp[11 * 33] * W8_SCALE); o.w = pk4_fp8(sp[12 * 33] * W8_SCALE, sp[13 * 33] * W8_SCALE, sp[14 * 33] * W8_SCALE, sp[15 * 33] * W8_SCALE);
                *(u32x4*)((unsigned char*)cur.dst + (size_t)n * cur.Kd + 16 * c) = o; }
        } else {
        const int c = lane & 7;
#pragma unroll
        for (int j = 0; j < 4; ++j) { const int n = (lane >> 3) + 8 * j; const LAS float* sp = scr + (8 * c) * 33 + n;
            u32x4 o; o.x = pk2(sp[0 * 33], sp[1 * 33]); o.y = pk2(sp[2 * 33], sp[3 * 33]); o.z = pk2(sp[4 * 33], sp[5 * 33]); o.w = pk2(sp[6 * 33], sp[7 * 33]);
            *(u32x4*)(cur.dst + (size_t)n * cur.Kd + 8 * c) = o; }
        }
        LDS_WAIT(); asm volatile("" ::: "memory");
        if (!more) break;
        it = nit; cur = nx;
    }
}
constexpr int CW_N0 = 3 * CW_I_GU + 32 * 192 + CW_I_SQ, CW_N1 = 3 * CW_I_GU + 32 * 128 + CW_I_SQ, CW_SPLIT1 = 2 * CW_I_GU;
__device__ __forceinline__ void p0_prologue(Frame& F) {
    PH_IDS;
    {
        LAS float* sl = (LAS float*)F.lds;
        LAS float* part = (LAS float*)(F.lds + 40960);
        for (int i = tid; i < 5 * D; i += 512) { const int r = i >> 11, k = i & (D - 1); const float v = r < 4 ? F.in[1][r * D + k] : F.in[3][k]; sl[i] = silu_f(v); }
        __syncthreads();
        const int kg = tid >> 3, cg = tid & 7;
        for (int it = F.vcu; it < 768; it += F.G) {
            const int l = it / 384, c0 = (it - l * 384) * 32;
            const float* wm = F.in[4] + (size_t)l * D * 12288 + c0 + 4 * cg;
            f32x4 a0 = {0, 0, 0, 0}, a1 = a0, a2 = a0, a3 = a0, a4 = a0;
#pragma unroll 8
            for (int i = 0; i < 32; ++i) { const int k = kg + 64 * i; const f32x4 w = *(const f32x4*)(wm + (size_t)k * 12288);
                a0 += w * sl[k]; a1 += w * sl[D + k]; a2 += w * sl[2 * D + k]; a3 += w * sl[3 * D + k]; a4 += w * sl[4 * D + k]; }
            LAS float* pp = part + kg * 160 + 4 * cg;
            *(LAS f32x4*)(pp) = a0; *(LAS f32x4*)(pp + 32) = a1; *(LAS f32x4*)(pp + 64) = a2; *(LAS f32x4*)(pp + 96) = a3; *(LAS f32x4*)(pp + 128) = a4;
            __syncthreads();
            if (tid < 160) { float s = 0.f;
#pragma unroll 8
                for (int g = 0; g < 64; ++g) s += part[g * 160 + tid];
                const int r = tid >> 5, cc = tid & 31;
                WSP(float, WS_MOD)[(size_t)(l * 5 + r) * 12288 + c0 + cc] = s + F.in[5][l * 12288 + c0 + cc]; }
            __syncthreads();
        }
    }
    {
        const int gid = F.vcu * 512 + tid;
        if (gid < 2048) { const int pos = gid >> 4, f = gid & 15;
            const float inv = exp2f(-(float)f * (13.287712379549449f / 16.0f)); const float ang = (float)pos * inv;
            const float k = rintf(ang * 0.15915494309189535f); float r = fmaf(-k, 6.2831854820251465f, ang); r = fmaf(-k, -1.7484555e-7f, r);
            WSP(float, WS_TAB)[gid] = __cosf(r); WSP(float, WS_TAB)[2048 + gid] = __sinf(r); }
        for (int i = gid; i < 16 * 128 * 128; i += F.G * 512) WSP(bf16, WS_WSB)[i] = (bf16)f2bf(F.in[19][i]);
    }
    convert_weights<0>(F, F.vcu * NWAVES + wave, F.G * NWAVES, wave, lane, 0, CW_N0);
}
__device__ __forceinline__ void p1_modulate(Frame& F) {
    PH_IDS;
    LAS float* P_s = (LAS float*)F.lds; LAS float* P_h = P_s + D;
    for (int rw = F.vcu * NWAVES + wave; rw < 128; rw += F.G * NWAVES) { const int Lr = rw >> 6, br = (rw >> 4) & 3, e = rw & 15; const float* sh = MODP(Lr, br, 3); const float* sc = MODP(Lr, br, 4);
        const float* lg = F.in[6] + (Lr * 2 + 0) * D; const float* lb = F.in[7] + (Lr * 2 + 0) * D;
        bf16* wh = WSP(bf16, WS_WRT2) + (size_t)((Lr * 4 + br) * 32 + e) * D; bf16* wl = wh + 16 * D; float c1 = 0.f, c2 = 0.f;
        for (int k = lane; k < D; k += 64) { const float w0 = F.in[22][k * 16 + e], m1 = 1.0f + sc[k]; const float w = lg[k] * m1 * w0; c2 += (lb[k] * m1 + sh[k]) * w0;
            const unsigned hb = f2bf(w); const float whf = __uint_as_float(hb << 16); const unsigned lob = f2bf(w - whf); wh[k] = (bf16)hb; wl[k] = (bf16)lob; c1 += whf + __uint_as_float(lob << 16); }
#pragma unroll
        for (int o = 1; o < 64; o <<= 1) { c1 += __shfl_xor(c1, o); c2 += __shfl_xor(c2, o); }
        if (lane == 0) { WSP(float, WS_RC)[(Lr * 4 + br) * 32 + e] = c1; WSP(float, WS_RC)[(Lr * 4 + br) * 32 + 16 + e] = c2; } }
    for (int blk = F.vcu; blk < M / 128; blk += F.G) {
        const int rowb = blk * 128 + wave * 16, b = rowb >> 13;
        __syncthreads();
        for (int i = tid; i < D; i += 512) { P_s[i] = 1.0f + MODP(0, b, 1)[i]; P_h[i] = MODP(0, b, 0)[i]; }
        __syncthreads();
        f32x4 rx[8];
#define P1_LOAD(r_) do { _Pragma("unroll") for (int j = 0; j < 4; ++j) { const float* p_ = F.in[0] + (size_t)(r_) * D + 512 * j + 8 * lane; rx[2 * j] = *(const f32x4*)p_; rx[2 * j + 1] = *(const f32x4*)(p_ + 4); } } while (0)
        P1_LOAD(rowb);
#pragma unroll 1
        for (int rr = 0; rr < 16; ++rr) {
            const int row = rowb + rr; u32x2 w8[4];
#pragma unroll
            for (int j = 0; j < 4; ++j) { const int c = 512 * j + 8 * lane;
                const f32x4 sa = *(const LAS f32x4*)(P_s + c), sb = *(const LAS f32x4*)(P_s + c + 4), ha = *(const LAS f32x4*)(P_h + c), hb = *(const LAS f32x4*)(P_h + c + 4);
                const f32x4 y0 = rx[2 * j] * sa + ha, y1 = rx[2 * j + 1] * sb + hb;
                w8[j].x = pk4_fp8(y0.x, y0.y, y0.z, y0.w); w8[j].y = pk4_fp8(y1.x, y1.y, y1.z, y1.w); }
            if (rr < 15) P1_LOAD(row + 1);
#pragma unroll
            for (int j = 0; j < 4; ++j) *(u32x2*)((unsigned char*)F.out + (size_t)M * D * 2 + (size_t)row * D + 512 * j + 8 * lane) = w8[j];
        }
#undef P1_LOAD
    }
    { const int gw = F.vcu * NWAVES + wave, NGW = F.G * NWAVES; const float* sh = MODP(0, 4, 0); const float* sc = MODP(0, 4, 1);
      for (int row = gw; row < MC; row += NGW) { const float* src = F.in[2] + (size_t)row * D; unsigned char* dst = (unsigned char*)F.out + (size_t)M * D * 2 + (size_t)M * D + (size_t)row * D;
#pragma unroll
          for (int j = 0; j < 8; ++j) { const int c = 256 * j + 4 * lane; const f32x4 v = *(const f32x4*)(src + c), s = *(const f32x4*)(sc + c), t = *(const f32x4*)(sh + c); const f32x4 y = v * (1.0f + s) + t; *(unsigned*)(dst + c) = pk4_fp8(y.x, y.y, y.z, y.w); } } }
}
__device__ __forceinline__ void conv_z(const bf16* proj, size_t row, int ch, float (&z)[8]) {
    const u32x4 w = *(const u32x4*)(proj + row * 2048 + ch);
    z[0] = bf_lo(w.x); z[1] = bf_hi(w.x); z[2] = bf_lo(w.y); z[3] = bf_hi(w.y); z[4] = bf_lo(w.z); z[5] = bf_hi(w.z); z[6] = bf_lo(w.w); z[7] = bf_hi(w.w);
}
__device__ __forceinline__ void conv_pass(Frame& F) {
    PH_IDS; const int gw = F.vcu * NWAVES + wave, NGW = F.G * NWAVES;
    const bf16* proj = WSP(bf16, WS_PROJ); unsigned char* mix = (unsigned char*)F.out;
    for (int it = gw; it < 2048; it += NGW) {
        const int run = it >> 1, ch = (it & 1) * 512 + lane * 8; const int r0 = run * 32;
        float w0[8], w1[8], w2[8];
#pragma unroll
        for (int i = 0; i < 8; ++i) { w0[i] = F.in[9][ch + i]; w1[i] = F.in[9][1024 + ch + i]; w2[i] = F.in[9][2048 + ch + i]; }
        u32x4 zq[6], bq[4];
        const bool first = (r0 & (SEQ - 1)) == 0, lastrun = ((r0 + 32) & (SEQ - 1)) == 0;
        zq[0] = first ? (u32x4){0u, 0u, 0u, 0u} : *(const u32x4*)(proj + ((size_t)r0 - 1) * 2048 + ch);
        zq[1] = *(const u32x4*)(proj + (size_t)r0 * 2048 + ch);
#pragma unroll 1
        for (int t = 0; t < 32; t += 4) { const size_t row = (size_t)r0 + t;
#pragma unroll
            for (int k = 0; k < 4; ++k) { const bool edge = lastrun && (t + k + 1 == 32);
                zq[2 + k] = edge ? (u32x4){0u, 0u, 0u, 0u} : *(const u32x4*)(proj + (row + k + 1) * 2048 + ch);
                bq[k] = *(const u32x4*)(proj + (row + k) * 2048 + 1024 + ch); }
#pragma unroll
            for (int k = 0; k < 4; ++k) { const u32x4 zp = zq[k], zc = zq[k + 1], zn = zq[k + 2], bg = bq[k]; float o[8];
#define CV_E(i_, W_, HI_) o[i_] = w0[i_] * (HI_ ? bf_hi(zp.W_) : bf_lo(zp.W_)) + w1[i_] * (HI_ ? bf_hi(zc.W_) : bf_lo(zc.W_)) + w2[i_] * (HI_ ? bf_hi(zn.W_) : bf_lo(zn.W_))
                CV_E(0, x, 0); CV_E(1, x, 1); CV_E(2, y, 0); CV_E(3, y, 1); CV_E(4, z, 0); CV_E(5, z, 1); CV_E(6, w, 0); CV_E(7, w, 1);
#undef CV_E
                u32x2 w; w.x = pk4_fp8(bf_lo(bg.x) * o[0], bf_hi(bg.x) * o[1], bf_lo(bg.y) * o[2], bf_hi(bg.y) * o[3]);
                w.y = pk4_fp8(bf_lo(bg.z) * o[4], bf_hi(bg.z) * o[5], bf_lo(bg.w) * o[6], bf_hi(bg.w) * o[7]);
                *(u32x2*)(mix + (row + k) * D + ch) = w; }
            zq[0] = zq[4]; zq[1] = zq[5];
        }
    }
}
__device__ __forceinline__ float lam_value(Frame& F, int lane) {
    const float a = wave_sum(F.in[10][lane] * F.in[11][lane]), b = wave_sum(F.in[12][lane] * F.in[13][lane]);
    return __expf(a) - __expf(b) + 0.2f;
}
__device__ __forceinline__ void attn_simple(Frame& F) {
    PH_IDS; const int gw = F.vcu * NWAVES + wave, NGW = F.G * NWAVES;
    const float lam = lam_value(F, lane);
    const bf16* Q = WSP(bf16, WS_Q); const bf16* KBp = WSP(bf16, WS_KB); const bf16* VBp = WSP(bf16, WS_VB); float* TMP = WSP(float, WS_H);
    for (int it = gw; it < 8192; it += NGW) {
        const int qb = it & 127, vc = (it >> 7) & 1, h = (it >> 8) & 7, b = it >> 11;
        const size_t qrow = (size_t)b * SEQ + qb * 64 + lane;
        float* tmp = TMP + (qrow * 8 + h) * 128 + vc * 64;
#pragma unroll 1
        for (int m = 0; m < 2; ++m) {
            float q[64], acc[64];
#pragma unroll
            for (int c = 0; c < 8; ++c) { const u32x4 w = *(const u32x4*)(Q + qrow * 1024 + h * 128 + m * 64 + c * 8); const float sc = 1.0f;
                q[8 * c + 0] = bf_lo(w.x) * sc; q[8 * c + 1] = bf_hi(w.x) * sc; q[8 * c + 2] = bf_lo(w.y) * sc; q[8 * c + 3] = bf_hi(w.y) * sc;
                q[8 * c + 4] = bf_lo(w.z) * sc; q[8 * c + 5] = bf_hi(w.z) * sc; q[8 * c + 6] = bf_lo(w.w) * sc; q[8 * c + 7] = bf_hi(w.w) * sc; }
#pragma unroll
            for (int i = 0; i < 64; ++i) acc[i] = 0.f;
            float mx = -1e30f, l = 0.f;
            const bf16* kp = KBp + (size_t)b * KV * 1024 + h * 128 + m * 64; const bf16* vp = VBp + (size_t)b * KV * 1024 + h * 128 + vc * 64;
#pragma unroll 1
            for (int j = 0; j < KV; ++j) {
                float s = 0.f;
#pragma unroll
                for (int c = 0; c < 8; ++c) { const u32x4 w = *(const u32x4*)(kp + (size_t)j * 1024 + c * 8);
                    s += q[8 * c + 0] * bf_lo(w.x) + q[8 * c + 1] * bf_hi(w.x) + q[8 * c + 2] * bf_lo(w.y) + q[8 * c + 3] * bf_hi(w.y)
                       + q[8 * c + 4] * bf_lo(w.z) + q[8 * c + 5] * bf_hi(w.z) + q[8 * c + 6] * bf_lo(w.w) + q[8 * c + 7] * bf_hi(w.w); }
                const float mn = fmaxf(mx, s), sc = exp2f(mx - mn), p = exp2f(s - mn); l = l * sc + p; mx = mn;
#pragma unroll
                for (int c = 0; c < 8; ++c) { const u32x4 w = *(const u32x4*)(vp + (size_t)j * 1024 + c * 8);
                    acc[8 * c + 0] = acc[8 * c + 0] * sc + p * bf_lo(w.x); acc[8 * c + 1] = acc[8 * c + 1] * sc + p * bf_hi(w.x);
                    acc[8 * c + 2] = acc[8 * c + 2] * sc + p * bf_lo(w.y); acc[8 * c + 3] = acc[8 * c + 3] * sc + p * bf_hi(w.y);
                    acc[8 * c + 4] = acc[8 * c + 4] * sc + p * bf_lo(w.z); acc[8 * c + 5] = acc[8 * c + 5] * sc + p * bf_hi(w.z);
                    acc[8 * c + 6] = acc[8 * c + 6] * sc + p * bf_lo(w.w); acc[8 * c + 7] = acc[8 * c + 7] * sc + p * bf_hi(w.w); }
            }
            const float inv = 1.0f / l;
            if (m == 0) {
#pragma unroll
                for (int i = 0; i < 64; i += 4) *(f32x4*)(tmp + i) = (f32x4){acc[i] * inv, acc[i + 1] * inv, acc[i + 2] * inv, acc[i + 3] * inv};
            } else {
#pragma unroll
                for (int i = 0; i < 64; i += 4) { const f32x4 t0 = *(const f32x4*)(tmp + i);
                    *(f32x4*)(tmp + i) = (f32x4){t0.x - lam * acc[i] * inv, t0.y - lam * acc[i + 1] * inv, t0.z - lam * acc[i + 2] * inv, t0.w - lam * acc[i + 3] * inv}; }
            }
        }
    }
}
__device__ __forceinline__ void attn_finish(Frame& F) {
    PH_IDS; const int gw = F.vcu * NWAVES + wave, NGW = F.G * NWAVES;
    const float* TMP = WSP(float, WS_H); bf16* mix = (bf16*)F.out;
    for (int row = gw; row < M; row += NGW) {
        f32x4 v[4]; float ss = 0.f;
#pragma unroll
        for (int i = 0; i < 4; ++i) { v[i] = *(const f32x4*)(TMP + (size_t)row * 1024 + lane * 16 + 4 * i); ss += (v[i].x * v[i].x + v[i].y * v[i].y) + (v[i].z * v[i].z + v[i].w * v[i].w); }
        ss += __shfl_xor(ss, 1); ss += __shfl_xor(ss, 2); ss += __shfl_xor(ss, 4);
        const float rs = 0.8f / sqrtf(ss * (1.0f / 128.0f) + LN_EPS);
#pragma unroll
        for (int i = 0; i < 4; ++i) { const f32x4 g = *(const f32x4*)(F.in[14] + ((lane * 16 + 4 * i) & 127)); st_bf4(mix + (size_t)row * D + 1024 + lane * 16 + 4 * i, v[i] * g * rs); }
    }
}
namespace att {
using f32x16 = __attribute__((ext_vector_type(16))) float;
using s16x4 = __attribute__((ext_vector_type(4))) short;
constexpr int QBLK = 32, KVBLK = 64, SHM_V = 16384, SHM_K = 8192, L_K = 0, L_V = 4 * SHM_K, L_WS = L_V + 4 * SHM_V, L_OST = 0, OST_LD = 136;
constexpr float SCALE = 0.125f, THR = 8.f;
#define ATT_KSW(row, c) ((row) * 128 + ((((c) ^ ((row) >> 1)) & 7) << 4))
#define ATT_SBAR() __builtin_amdgcn_sched_barrier(0)
__device__ __forceinline__ int crow(int r, int hi) { return (r & 3) + 8 * (r >> 2) + 4 * hi; }
__device__ __forceinline__ unsigned cvtpk(float lo, float hi) { unsigned r; asm volatile("v_cvt_pk_bf16_f32 %0, %1, %2" : "=v"(r) : "v"(lo), "v"(hi)); return r; }
template <bool FIRST> __device__ __forceinline__ void partialSM(f32x16& p0, f32x16& p1, f32x16& negm, float& alpha) {
    constexpr float THR2 = 8.0f, PBIAS = 4.0f;
    float m0 = fmaxf(fmaxf(p0[0], p0[1]), p0[2]), m1 = fmaxf(fmaxf(p1[0], p1[1]), p1[2]);
#pragma unroll
    for (int r = 3; r < 15; r += 2) { m0 = fmaxf(fmaxf(m0, p0[r]), p0[r + 1]); m1 = fmaxf(fmaxf(m1, p1[r]), p1[r + 1]); }
    float pmax = fmaxf(fmaxf(m0, p0[15]), fmaxf(m1, p1[15]));
    { auto rr = __builtin_amdgcn_permlane32_swap(__float_as_uint(pmax), __float_as_uint(pmax), false, false);
      pmax = fmaxf(__uint_as_float(rr[0]), __uint_as_float(rr[1])); }
    if (!FIRST && __builtin_expect(__all(pmax <= THR2), 1)) { alpha = 1.f; }
    else { const float dl = FIRST ? pmax - PBIAS : fmaxf(pmax - PBIAS, 0.f); alpha = __builtin_amdgcn_exp2f(-dl);
#pragma unroll
        for (int r = 0; r < 16; ++r) { p0[r] -= dl; p1[r] -= dl; negm[r] -= dl; } }
#pragma unroll
    for (int r = 0; r < 16; ++r) p0[r] = __builtin_amdgcn_exp2f(p0[r]);
}
__device__ __forceinline__ void finishSM(f32x16& p0, f32x16& p1, float alpha, float& l_reg, bf16x8& pa0, bf16x8& pa1, bf16x8& pa2, bf16x8& pa3) {
#pragma unroll
    for (int r = 0; r < 16; ++r) p1[r] = __builtin_amdgcn_exp2f(p1[r]);
    float s0 = p0[0] + p0[1], s1 = p0[2] + p0[3], s2 = p1[0] + p1[1], s3 = p1[2] + p1[3];
#pragma unroll
    for (int r = 4; r < 16; r += 4) { s0 += p0[r]; s1 += p0[r + 1]; s2 += p0[r + 2]; s3 += p0[r + 3]; s0 += p1[r]; s1 += p1[r + 1]; s2 += p1[r + 2]; s3 += p1[r + 3]; }
    float ps = (s0 + s1) + (s2 + s3);
    { auto rr = __builtin_amdgcn_permlane32_swap(__float_as_uint(ps), __float_as_uint(ps), false, false); ps = __uint_as_float(rr[0]) + __uint_as_float(rr[1]); }
    l_reg = l_reg * alpha + ps;
#define ATT_PK4(P, BASE, OUT) do { unsigned a0 = cvtpk(P[BASE + 0], P[BASE + 1]), a1 = cvtpk(P[BASE + 2], P[BASE + 3]);   \
    unsigned b0 = cvtpk(P[BASE + 4], P[BASE + 5]), b1 = cvtpk(P[BASE + 6], P[BASE + 7]);                              \
    auto r0 = __builtin_amdgcn_permlane32_swap(a0, b0, false, false); auto r1 = __builtin_amdgcn_permlane32_swap(a1, b1, false, false); \
    u32x4 w = {r0[0], r1[0], r0[1], r1[1]}; OUT = __builtin_bit_cast(bf16x8, w); } while (0)
    ATT_PK4(p0, 0, pa0); ATT_PK4(p0, 8, pa1); ATT_PK4(p1, 0, pa2); ATT_PK4(p1, 8, pa3);
#undef ATT_PK4
}
#define ATT_K8(row, c) ((row) * 64 + ((((c) ^ ((row) >> 2)) & 3) << 4))
__device__ __forceinline__ void qkt(f32x16& p0, f32x16& p1, const LAS char* Ks, const pg8::v8i32& qf, const f32x16& negm, int r32, int hi) {
    const pg8::v4i32 a0 = *(const LAS pg8::v4i32*)(Ks + ATT_K8(r32, 2 * hi)), a1 = *(const LAS pg8::v4i32*)(Ks + ATT_K8(r32, 2 * hi + 1));
    const pg8::v4i32 b0 = *(const LAS pg8::v4i32*)(Ks + ATT_K8(32 + r32, 2 * hi)), b1 = *(const LAS pg8::v4i32*)(Ks + ATT_K8(32 + r32, 2 * hi + 1));
    p0 = __builtin_amdgcn_mfma_scale_f32_32x32x64_f8f6f4(__builtin_shufflevector(a0, a1, 0, 1, 2, 3, 4, 5, 6, 7), qf, negm, 0, 0, 0, 0x7f7f7f7f, 0, 0x7f7f7f7f);
    p1 = __builtin_amdgcn_mfma_scale_f32_32x32x64_f8f6f4(__builtin_shufflevector(b0, b1, 0, 1, 2, 3, 4, 5, 6, 7), qf, negm, 0, 0, 0, 0x7f7f7f7f, 0, 0x7f7f7f7f);
}
__device__ __forceinline__ int v_st(int k, int c) { const int kk = (k & ~0xC) | ((k & 4) << 1) | ((k & 8) >> 1); return ((kk >> 3) * 4 + (c >> 5)) * 512 + ((kk & 7) * 32 + (c & 31)) * 2; }
__device__ __forceinline__ int v_rd_base(int lane) { return ((lane & 3) << 3) | (((lane >> 2) & 3) << 6) | (((lane >> 4) & 1) << 5) | (((lane >> 5) & 1) << 8); }
constexpr int v_rd_off(int d0, int ks, int half) { return d0 * 512 + ks * 4096 + half * 2048; }
template <int OFF> __device__ __forceinline__ s16x4 tr_read(int vb) { s16x4 r; asm volatile("ds_read_b64_tr_b16 %0, %1 offset:%2" : "=&v"(r) : "v"(vb), "i"(OFF) : "memory"); return r; }
template <int D0> __device__ __forceinline__ void pv_one(f32x16& od, int vb, bf16x8 pa0, bf16x8 pa1, bf16x8 pa2, bf16x8 pa3) {
    const s16x4 l0 = tr_read<v_rd_off(D0, 0, 0)>(vb), h0 = tr_read<v_rd_off(D0, 0, 1)>(vb), l1 = tr_read<v_rd_off(D0, 1, 0)>(vb), h1 = tr_read<v_rd_off(D0, 1, 1)>(vb);
    const s16x4 l2 = tr_read<v_rd_off(D0, 2, 0)>(vb), h2 = tr_read<v_rd_off(D0, 2, 1)>(vb), l3 = tr_read<v_rd_off(D0, 3, 0)>(vb), h3 = tr_read<v_rd_off(D0, 3, 1)>(vb);
    asm volatile("s_waitcnt lgkmcnt(0)" ::: "memory"); ATT_SBAR();
#define ATT_PK(L, H) (bf16x8){L[0], L[1], L[2], L[3], H[0], H[1], H[2], H[3]}
    od = __builtin_amdgcn_mfma_f32_32x32x16_bf16(pa0, ATT_PK(l0, h0), od, 0, 0, 0);
    od = __builtin_amdgcn_mfma_f32_32x32x16_bf16(pa1, ATT_PK(l1, h1), od, 0, 0, 0);
    od = __builtin_amdgcn_mfma_f32_32x32x16_bf16(pa2, ATT_PK(l2, h2), od, 0, 0, 0);
    od = __builtin_amdgcn_mfma_f32_32x32x16_bf16(pa3, ATT_PK(l3, h3), od, 0, 0, 0);
#undef ATT_PK
}
__device__ __forceinline__ void pv_d0(f32x16* o, int vb, bf16x8 pa0, bf16x8 pa1, bf16x8 pa2, bf16x8 pa3) {
    pv_one<0>(o[0], vb, pa0, pa1, pa2, pa3); pv_one<1>(o[1], vb, pa0, pa1, pa2, pa3); pv_one<2>(o[2], vb, pa0, pa1, pa2, pa3); pv_one<3>(o[3], vb, pa0, pa1, pa2, pa3);
}
__device__ __forceinline__ void psum(f32x16& osum, bf16x8 pa0, bf16x8 pa1, bf16x8 pa2, bf16x8 pa3) {
    const bf16x8 ones = {0x3F80, 0x3F80, 0x3F80, 0x3F80, 0x3F80, 0x3F80, 0x3F80, 0x3F80};
    osum = __builtin_amdgcn_mfma_f32_32x32x16_bf16(pa0, ones, osum, 0, 0, 0); osum = __builtin_amdgcn_mfma_f32_32x32x16_bf16(pa1, ones, osum, 0, 0, 0);
    osum = __builtin_amdgcn_mfma_f32_32x32x16_bf16(pa2, ones, osum, 0, 0, 0); osum = __builtin_amdgcn_mfma_f32_32x32x16_bf16(pa3, ones, osum, 0, 0, 0);
}
struct VFrag { s16x4 l0, h0, l1, h1, l2, h2, l3, h3; };
__device__ __forceinline__ void pv_rd0(VFrag& f, int vb) {
    f.l0 = tr_read<v_rd_off(0, 0, 0)>(vb); f.h0 = tr_read<v_rd_off(0, 0, 1)>(vb); f.l1 = tr_read<v_rd_off(0, 1, 0)>(vb); f.h1 = tr_read<v_rd_off(0, 1, 1)>(vb);
    f.l2 = tr_read<v_rd_off(0, 2, 0)>(vb); f.h2 = tr_read<v_rd_off(0, 2, 1)>(vb); f.l3 = tr_read<v_rd_off(0, 3, 0)>(vb); f.h3 = tr_read<v_rd_off(0, 3, 1)>(vb);
}
__device__ __forceinline__ void pv_d0_pre(f32x16* o, int vb, const VFrag& f, bf16x8 pa0, bf16x8 pa1, bf16x8 pa2, bf16x8 pa3) {
    asm volatile("s_waitcnt lgkmcnt(0)" ::: "memory"); ATT_SBAR();
#define ATT_PK(L, H) (bf16x8){L[0], L[1], L[2], L[3], H[0], H[1], H[2], H[3]}
    o[0] = __builtin_amdgcn_mfma_f32_32x32x16_bf16(pa0, ATT_PK(f.l0, f.h0), o[0], 0, 0, 0);
    o[0] = __builtin_amdgcn_mfma_f32_32x32x16_bf16(pa1, ATT_PK(f.l1, f.h1), o[0], 0, 0, 0);
    o[0] = __builtin_amdgcn_mfma_f32_32x32x16_bf16(pa2, ATT_PK(f.l2, f.h2), o[0], 0, 0, 0);
    o[0] = __builtin_amdgcn_mfma_f32_32x32x16_bf16(pa3, ATT_PK(f.l3, f.h3), o[0], 0, 0, 0);
#undef ATT_PK
    pv_one<1>(o[1], vb, pa0, pa1, pa2, pa3); pv_one<2>(o[2], vb, pa0, pa1, pa2, pa3); pv_one<3>(o[3], vb, pa0, pa1, pa2, pa3);
}
__device__ __forceinline__ int v8_sw(int key) { return (((key >> 1) & 1) << 1) | (((key >> 3) & 1) << 2); }
__device__ __forceinline__ int v8_st(int key, int chunk) { return key * 128 + ((chunk ^ v8_sw(key)) << 4); }
__device__ __forceinline__ int v8_rd_base(int lane, int d0) { const int i = lane & 15, q = i >> 1, p = i & 1, g1 = (lane >> 4) & 1, hi = lane >> 5; const int key0 = (q & 3) + 8 * (q >> 2) + 4 * hi;
    return key0 * 128 + ((((2 * d0 + g1) ^ v8_sw(key0)) & 7) << 4) + 8 * p; }
template <int OFF> __device__ __forceinline__ u32x2 tr8_read(int vb) { u32x2 r; asm volatile("ds_read_b64_tr_b8 %0, %1 offset:%2" : "=&v"(r) : "v"(vb), "i"(OFF) : "memory"); return r; }
struct V8Frag { u32x2 r0, r1, r2, r3; };
__device__ __forceinline__ void pv8_rd(V8Frag& f, int vb) { f.r0 = tr8_read<0>(vb); f.r1 = tr8_read<2048>(vb); f.r2 = tr8_read<4096>(vb); f.r3 = tr8_read<6144>(vb); }
template <int SO> __device__ __forceinline__ void pv8_rds(V8Frag& f, int vb) { f.r0 = tr8_read<SO>(vb); f.r1 = tr8_read<SO + 2048>(vb); f.r2 = tr8_read<SO + 4096>(vb); f.r3 = tr8_read<SO + 6144>(vb); }
__device__ __forceinline__ void pv8_mm(f32x16& od, const V8Frag& f, const pg8::v8i32& pa, int sc1) {
    const pg8::v8i32 bf = {(int)f.r0.x, (int)f.r0.y, (int)f.r1.x, (int)f.r1.y, (int)f.r2.x, (int)f.r2.y, (int)f.r3.x, (int)f.r3.y};
    asm volatile("v_mfma_scale_f32_32x32x64_f8f6f4 %0, %1, %2, %0, %3, %3 op_sel_hi:[0,0,0]" : "+v"(od) : "v"(pa), "v"(bf), "v"(sc1));
}
__device__ __forceinline__ void pv8_one(f32x16& od, int vb, const pg8::v8i32& pa, int sc1) { V8Frag f; pv8_rd(f, vb); asm volatile("s_waitcnt lgkmcnt(0)" ::: "memory"); ATT_SBAR(); pv8_mm(od, f, pa, sc1); }
__device__ __forceinline__ void pv8_d0(f32x16* o, const int (&vb)[4], int so, const pg8::v8i32& pa, int sc1) {
    pv8_one(o[0], vb[0] + so, pa, sc1); pv8_one(o[1], vb[1] + so, pa, sc1); pv8_one(o[2], vb[2] + so, pa, sc1); pv8_one(o[3], vb[3] + so, pa, sc1); }
__device__ __forceinline__ void pv8_d0_pre(f32x16* o, const int (&vb)[4], int so, const V8Frag& f, const pg8::v8i32& pa, int sc1) {
    asm volatile("s_waitcnt lgkmcnt(0)" ::: "memory"); ATT_SBAR(); pv8_mm(o[0], f, pa, sc1);
    pv8_one(o[1], vb[1] + so, pa, sc1); pv8_one(o[2], vb[2] + so, pa, sc1); pv8_one(o[3], vb[3] + so, pa, sc1); }
__device__ __forceinline__ void finishSM8(f32x16& p0, f32x16& p1, pg8::v8i32& pa) {
#pragma unroll
    for (int r = 0; r < 16; ++r) p1[r] = __builtin_amdgcn_exp2f(p1[r]);
#define ATT_F8(P, B) __builtin_amdgcn_cvt_pk_fp8_f32(P[B + 2], P[B + 3], __builtin_amdgcn_cvt_pk_fp8_f32(P[B], P[B + 1], 0, false), true)
    pa = (pg8::v8i32){ATT_F8(p0, 0), ATT_F8(p0, 4), ATT_F8(p0, 8), ATT_F8(p0, 12), ATT_F8(p1, 0), ATT_F8(p1, 4), ATT_F8(p1, 8), ATT_F8(p1, 12)};
#undef ATT_F8
}
__device__ __forceinline__ void psum8(f32x4& lacc, const pg8::v8i32& mask, const pg8::v8i32& pa, int sc1) {
    asm volatile("v_mfma_scale_f32_16x16x128_f8f6f4 %0, %1, %2, %0, %3, %3 op_sel_hi:[0,0,0]" : "+v"(lacc) : "v"(mask), "v"(pa), "v"(sc1));
}
struct KFrag { pg8::v4i32 a0, a1, b0, b1; };
__device__ __forceinline__ void k_read(KFrag& k, const LAS char* Ks, int r32, int hi) {
    k.a0 = *(const LAS pg8::v4i32*)(Ks + ATT_K8(r32, 2 * hi)); k.a1 = *(const LAS pg8::v4i32*)(Ks + ATT_K8(r32, 2 * hi + 1));
    k.b0 = *(const LAS pg8::v4i32*)(Ks + ATT_K8(32 + r32, 2 * hi)); k.b1 = *(const LAS pg8::v4i32*)(Ks + ATT_K8(32 + r32, 2 * hi + 1)); }
__device__ __forceinline__ void qk_mm(f32x16& p0, f32x16& p1, const KFrag& k, const pg8::v8i32& qf, const f32x16& negm) {
    p0 = __builtin_amdgcn_mfma_scale_f32_32x32x64_f8f6f4(__builtin_shufflevector(k.a0, k.a1, 0, 1, 2, 3, 4, 5, 6, 7), qf, negm, 0, 0, 0, 0x7f7f7f7f, 0, 0x7f7f7f7f);
    p1 = __builtin_amdgcn_mfma_scale_f32_32x32x64_f8f6f4(__builtin_shufflevector(k.b0, k.b1, 0, 1, 2, 3, 4, 5, 6, 7), qf, negm, 0, 0, 0, 0x7f7f7f7f, 0, 0x7f7f7f7f); }
template <int LO, int N> __device__ __forceinline__ void exp_n(f32x16& p) {
#pragma unroll
    for (int r = LO; r < LO + N; ++r) p[r] = __builtin_amdgcn_exp2f(p[r]);
    asm volatile("" : "+v"(p)); }
__device__ __forceinline__ int cvt4_fp8(float a, float b, float c, float d) { int r;
    asm("v_cvt_pk_fp8_f32 %0, %1, %2\n\tv_cvt_pk_fp8_f32 %0, %3, %4 op_sel:[0,0,1]" : "=&v"(r) : "v"(a), "v"(b), "v"(c), "v"(d)); return r; }
__device__ __forceinline__ void cvt_pa(pg8::v8i32& pa, const f32x16& p0, const f32x16& p1) {
#define ATT_F8(P, B) cvt4_fp8(P[B], P[B + 1], P[B + 2], P[B + 3])
    pa = (pg8::v8i32){ATT_F8(p0, 0), ATT_F8(p0, 4), ATT_F8(p0, 8), ATT_F8(p0, 12), ATT_F8(p1, 0), ATT_F8(p1, 4), ATT_F8(p1, 8), ATT_F8(p1, 12)};
#undef ATT_F8
}
__device__ __forceinline__ void sm_decide(f32x16& p0, f32x16& p1, f32x16& negm, float& alpha) {
    constexpr float THR2 = 8.0f, PBIAS = 4.0f;
    float m0 = fmaxf(fmaxf(p0[0], p0[1]), p0[2]), m1 = fmaxf(fmaxf(p1[0], p1[1]), p1[2]);
#pragma unroll
    for (int r = 3; r < 15; r += 2) { m0 = fmaxf(fmaxf(m0, p0[r]), p0[r + 1]); m1 = fmaxf(fmaxf(m1, p1[r]), p1[r + 1]); }
    float pmax = fmaxf(fmaxf(m0, p0[15]), fmaxf(m1, p1[15]));
    { auto rr = __builtin_amdgcn_permlane32_swap(__float_as_uint(pmax), __float_as_uint(pmax), false, false);
      pmax = fmaxf(__uint_as_float(rr[0]), __uint_as_float(rr[1])); }
    if (__builtin_expect(__all(pmax <= THR2), 1)) { alpha = 1.f; }
    else { const float dl = fmaxf(pmax - PBIAS, 0.f); alpha = __builtin_amdgcn_exp2f(-dl);
#pragma unroll
        for (int r = 0; r < 16; ++r) { p0[r] -= dl; p1[r] -= dl; negm[r] -= dl; } }
}
__device__ __forceinline__ void psum8z(f32x4& ts, const pg8::v8i32& mask, const pg8::v8i32& pa, int sc1) {
    asm volatile("v_mfma_scale_f32_16x16x128_f8f6f4 %0, %1, %2, 0, %3, %3 op_sel_hi:[0,0,0]" : "=&v"(ts) : "v"(mask), "v"(pa), "v"(sc1));
}
__device__ __forceinline__ void sm_redo(f32x16& p0, f32x16& p1, f32x16& negm, float& alpha, float& dl) {
    constexpr float PBIAS = 4.0f;
    float m0 = fmaxf(fmaxf(p0[0], p0[1]), p0[2]), m1 = fmaxf(fmaxf(p1[0], p1[1]), p1[2]);
#pragma unroll
    for (int r = 3; r < 15; r += 2) { m0 = fmaxf(fmaxf(m0, p0[r]), p0[r + 1]); m1 = fmaxf(fmaxf(m1, p1[r]), p1[r + 1]); }
    float pmax = fmaxf(fmaxf(m0, p0[15]), fmaxf(m1, p1[15]));
    { auto rr = __builtin_amdgcn_permlane32_swap(__float_as_uint(pmax), __float_as_uint(pmax), false, false);
      pmax = fmaxf(__uint_as_float(rr[0]), __uint_as_float(rr[1])); }
    dl = fmaxf(pmax - PBIAS, 0.f); alpha = __builtin_amdgcn_exp2f(-dl);
#pragma unroll
    for (int r = 0; r < 16; ++r) { p0[r] -= dl; p1[r] -= dl; negm[r] -= dl; }
}
}
__device__ __forceinline__ void attn_fast(Frame& F) {
    using namespace att;
    PH_IDS; const int wid = wave, r32 = lane & 31, hi = lane >> 5;
    const float lam = __builtin_bit_cast(float, __builtin_amdgcn_readfirstlane(__builtin_bit_cast(int, lam_value(F, lane))));
    LAS char* lds = (LAS char*)F.lds; LAS char* V_lds = lds + L_V; LAS char* K_lds = lds + L_K;
    LAS float* wsf = (LAS float*)(lds + L_WS) + wid * 64; LAS float* li_l = wsf; LAS float* al_l = wsf + 32;
    const bf16* Qg = WSP(bf16, WS_Q); const bf16* KBp = WSP(bf16, WS_KB); const bf16* VBp = WSP(bf16, WS_VB); unsigned char* mix = (unsigned char*)F.out;
    const int vkey = tid >> 3, vst0 = v8_st(vkey, tid & 7);
    const int kr = (tid >> 2) & 63, kc = tid & 3, kst = ATT_K8(kr, kc);
    int vb8[4];
#pragma unroll
    for (int d0 = 0; d0 < 4; ++d0) vb8[d0] = (int)(unsigned)(uintptr_t)V_lds + v8_rd_base(lane, d0);
    const int sc1 = 0x7f7f7f7f;
    pg8::v8i32 lmask;
    { const int mk = (((lane >> 4) ^ lane) & 1) ? 0 : 0x38383838; int m0, m1, m2, m3, m4, m5, m6, m7;
      asm volatile("v_mov_b32 %0, %8\n\tv_mov_b32 %1, %8\n\tv_mov_b32 %2, %8\n\tv_mov_b32 %3, %8\n\tv_mov_b32 %4, %8\n\tv_mov_b32 %5, %8\n\tv_mov_b32 %6, %8\n\tv_mov_b32 %7, %8"
                   : "=&v"(m0), "=&v"(m1), "=&v"(m2), "=&v"(m3), "=&v"(m4), "=&v"(m5), "=&v"(m6), "=&v"(m7) : "v"(mk));
      lmask = (pg8::v8i32){m0, m1, m2, m3, m4, m5, m6, m7}; }
    const unsigned voffV0 = (unsigned)(vkey * 1024 + (tid & 7) * 16), voffK = (unsigned)(kr * 1024 + kc * 16);
    constexpr int NT = KV / KVBLK;
    const int bx = (int)blockIdx.x;
    for (int ui = 0;; ++ui) {
        int unit;
        if (F.G == 256) { if (ui >= 4) break; unit = (ui * 8 + (bx & 7)) * 32 + (bx >> 3); }
        else { unit = ui * F.G + bx; if (unit >= 1024) break; }
        const int bh = unit >> 5, qb = unit & 31, b = bh >> 3, h = bh & 7;
        const size_t row0 = (size_t)b * SEQ + qb * 256;
#pragma unroll 1
        for (int mp = 0; mp < 2; ++mp) {
            const unsigned char* Kh = (const unsigned char*)KBp + (size_t)b * KV * 1024 + h * 128 + mp * 64; const unsigned char* Vh = (const unsigned char*)VBp + (size_t)b * KV * 1024 + h * 128;
            const __amdgpu_buffer_rsrc_t rsK = make_rsrc(Kh, KV * 1024), rsV = make_rsrc(Vh, KV * 1024);
            f32x16 o[4] = {}; f32x16 negm = {}; float l0 = 0.f, l1 = 0.f; f32x4 ts;
            const __amdgpu_buffer_rsrc_t rsQ = make_rsrc((const unsigned char*)Qg + (row0 + wid * QBLK) * 1024 + h * 128 + mp * 64, 32 * 1024);
            const int lq = fresh_lane(); const unsigned qoff = (unsigned)((lq & 31) * 1024 + (lq >> 5) * 32);
            const pg8::v8i32 qr = __builtin_shufflevector(__builtin_bit_cast(pg8::v4i32, bufld16(rsQ, qoff, 0)), __builtin_bit_cast(pg8::v4i32, bufld16(rsQ, qoff + 16, 0)), 0, 1, 2, 3, 4, 5, 6, 7);
            struct { bf16x8 vs0, ks0; } sr_;
#define SLOAD(t_) do { const unsigned so_ = (unsigned)(t_) * (unsigned)(KVBLK * 1024); \
    sr_.vs0 = bufld16(rsV, voffV0, so_); if (wid < 4) sr_.ks0 = bufld16(rsK, voffK, so_); } while (0)
#define SWRITE(t_) do { const int sl_ = (t_) & 3; *(LAS bf16x8*)(V_lds + sl_ * SHM_V + vst0) = sr_.vs0; \
    if (wid < 4) *(LAS bf16x8*)(K_lds + sl_ * SHM_K + kst) = sr_.ks0; } while (0)
#define KSLOT(t_) (K_lds + ((t_) & 3) * SHM_K)
#define VSLOT(t_) (((t_) & 3) * SHM_V)
#define RESC(a) do { if (__any((a) < 1.f)) { if (hi == 0) al_l[r32] = (a); asm volatile("s_nop 15\n\ts_nop 15\n\ts_waitcnt lgkmcnt(0)" ::: "memory");   \
    _Pragma("unroll") for (int r = 0; r < 16; ++r) { const float f_ = al_l[crow(r, hi)]; _Pragma("unroll") for (int d = 0; d < 4; ++d) o[d][r] *= f_; } \
    l0 *= al_l[r32 & 15]; l1 *= al_l[16 + (r32 & 15)]; } } while (0)
            f32x16 pA0, pA1, pB0, pB1; float alA; pg8::v8i32 pa;
            __syncthreads();
            SLOAD(0); SWRITE(0); SLOAD(1); SWRITE(1);
            __syncthreads();
            if (wid >= 4) __syncthreads();
            SLOAD(2); qkt(pA0, pA1, KSLOT(0), qr, negm, r32, hi);
            __syncthreads();
            partialSM<true>(pA0, pA1, negm, alA); SWRITE(2);
            __syncthreads();
            V8Frag vf;
#define ATT_WAITL(n_) asm volatile("s_waitcnt lgkmcnt(" #n_ ")" ::: "memory")
#define OVF_CHECK(PY0, PY1, PX0, PX1, SLP_, HAVE_PX) do { \
    asm volatile("s_nop 7\n\ts_nop 3" ::: "memory");        \
    if (__builtin_expect(__any(!(ts[0] < ATT_OVF_LIMIT) || !(ts[1] < ATT_OVF_LIMIT)), 0)) { \
        KFrag kq_; k_read(kq_, K_lds + (SLP_) * SHM_K, r32, hi); qk_mm(PY0, PY1, kq_, qr, negm); \
        float al_, dl_; sm_redo(PY0, PY1, negm, al_, dl_); \
        if (HAVE_PX) { _Pragma("unroll") for (int r = 0; r < 16; ++r) { PX0[r] -= dl_; PX1[r] -= dl_; } } \
        exp_n<0, 16>(PY0); exp_n<0, 16>(PY1); cvt_pa(pa, PY0, PY1); psum8z(ts, lmask, pa, sc1); \
        RESC(al_); \
        asm volatile("s_nop 7\n\ts_nop 3" ::: "memory"); } \
    l0 += ts[0]; l1 += ts[1]; asm volatile("" :: "v"(ts));   } while (0)
#define SLOADT(t_) do { const unsigned so_ = (unsigned)(t_) * (unsigned)(KVBLK * 1024); sr_.vs0 = bufld16(rsV, voffV0, so_); if (wid < 4) sr_.ks0 = bufld16(rsK, voffK, so_); } while (0)
#define SWRITES(SL_) do { *(LAS bf16x8*)(V_lds + (SL_) * SHM_V + vst0) = sr_.vs0; if (wid < 4) *(LAS bf16x8*)(K_lds + (SL_) * SHM_K + kst) = sr_.ks0; } while (0)
#define SEG_A(PX0, PX1, PY0, PY1, t_, SL_, ld_) do { \
    if (ld_) SLOADT((t_) + 2); \
    ATT_SBAR(); KFrag kf_; k_read(kf_, K_lds + (SL_) * SHM_K, r32, hi); ATT_SBAR(); \
    exp_n<0, 16>(PY1); ATT_SBAR(); \
    qk_mm(PX0, PX1, kf_, qr, negm); ATT_SBAR(); \
    cvt_pa(pa, PY0, PY1); psum8z(ts, lmask, pa, sc1); ATT_SBAR(); \
    pv8_rds<(((SL_) + 3) & 3) * SHM_V>(vf, vb8[0]); \
    __syncthreads(); } while (0)
#define SEG_B(PX0, PX1, PY0, PY1, SL_, ld_) do { \
    V8Frag vg_; constexpr int so_ = (((SL_) + 3) & 3) * SHM_V; \
    pv8_rds<so_>(vg_, vb8[1]); ATT_SBAR(); \
    OVF_CHECK(PY0, PY1, PX0, PX1, ((SL_) + 3) & 3, true); ATT_SBAR(); \
    ATT_WAITL(4); ATT_SBAR(); pv8_mm(o[0], vf, pa, sc1); \
    pv8_rds<so_>(vf, vb8[2]); ATT_SBAR(); \
    exp_n<0, 8>(PX0); ATT_SBAR(); \
    ATT_WAITL(4); ATT_SBAR(); pv8_mm(o[1], vg_, pa, sc1); \
    pv8_rds<so_>(vg_, vb8[3]); ATT_SBAR(); \
    exp_n<8, 8>(PX0); ATT_SBAR(); \
    ATT_WAITL(4); ATT_SBAR(); pv8_mm(o[2], vf, pa, sc1); ATT_SBAR(); \
    ATT_WAITL(0); ATT_SBAR(); pv8_mm(o[3], vg_, pa, sc1); ATT_SBAR(); \
    if (ld_) SWRITES(((SL_) + 2) & 3); \
    __syncthreads(); } while (0)
            static_assert(NT % 4 == 0 && NT >= 8, "the tile loop is unrolled over the 4 ring slots");
            SEG_A(pB0, pB1, pA0, pA1, 1, 1, true); SEG_B(pB0, pB1, pA0, pA1, 1, true);
#pragma unroll 1
            for (int t = 2; t + 3 < NT; t += 4) {
                SEG_A(pA0, pA1, pB0, pB1, t, 2, true); SEG_B(pA0, pA1, pB0, pB1, 2, true);
                SEG_A(pB0, pB1, pA0, pA1, t + 1, 3, true); SEG_B(pB0, pB1, pA0, pA1, 3, true);
                SEG_A(pA0, pA1, pB0, pB1, t + 2, 0, true); SEG_B(pA0, pA1, pB0, pB1, 0, true);
                SEG_A(pB0, pB1, pA0, pA1, t + 3, 1, true); SEG_B(pB0, pB1, pA0, pA1, 1, true);
            }
            SEG_A(pA0, pA1, pB0, pB1, NT - 2, 2, false); SEG_B(pA0, pA1, pB0, pB1, 2, false);
            SEG_A(pB0, pB1, pA0, pA1, NT - 1, 3, false); SEG_B(pB0, pB1, pA0, pA1, 3, false);
#undef SEG_A
#undef SEG_B
            exp_n<0, 16>(pB1); cvt_pa(pa, pB0, pB1); psum8z(ts, lmask, pa, sc1); ATT_SBAR();
            OVF_CHECK(pB0, pB1, pB0, pB1, 3, false); ATT_SBAR();
            pv8_d0(o, vb8, VSLOT(NT - 1), pa, sc1);
#undef OVF_CHECK
            asm volatile("s_nop 15\n\ts_nop 15" ::: "memory");
            if (wid < 4) __syncthreads();
            __syncthreads();
#undef KSLOT
#undef VSLOT
#undef SLOAD
#undef SWRITE
#undef RESC
            const int lane2 = fresh_lane(), t2 = wid * 64 + lane2, r32b = lane2 & 31, hi2 = lane2 >> 5;
            if (hi2 == 0) li_l[r32b] = (lane2 & 16) ? l1 : l0; asm volatile("s_waitcnt lgkmcnt(0)" ::: "memory");
            float rli[16];
#pragma unroll
            for (int r = 0; r < 16; ++r) rli[r] = 1.0f / li_l[crow(r, hi2)];
            float* SCR = WSP(float, WS_H) + ((size_t)blockIdx.x * 512 + t2) * 64;
            if (mp == 0) {
#pragma unroll
                for (int d0 = 0; d0 < 4; ++d0)
#pragma unroll
                    for (int r = 0; r < 16; r += 4) *(f32x4*)(SCR + d0 * 16 + r) = (f32x4){o[d0][r] * rli[r], o[d0][r + 1] * rli[r + 1], o[d0][r + 2] * rli[r + 2], o[d0][r + 3] * rli[r + 3]};
            } else {
                LAS bf16* ot = (LAS bf16*)(lds + L_OST) + wid * (32 * OST_LD);
                float gsub[4];
#pragma unroll
                for (int d0 = 0; d0 < 4; ++d0) gsub[d0] = F.in[14][d0 * 32 + r32b];
#pragma unroll
                for (int r = 0; r < 16; ++r) { float a = 0.f;
#pragma unroll
                    for (int d0 = 0; d0 < 4; ++d0) { const float t = SCR[d0 * 16 + r] - lam * (o[d0][r] * rli[r]); o[d0][r] = t; a += t * t; }
#define SWZ_ADD(x_, k_) x_ += __builtin_bit_cast(float, __builtin_amdgcn_ds_swizzle(__builtin_bit_cast(int, x_), ((k_) << 10) | 0x1F))
                    SWZ_ADD(a, 1); SWZ_ADD(a, 2); SWZ_ADD(a, 4); SWZ_ADD(a, 8); SWZ_ADD(a, 16);
#undef SWZ_ADD
                    const float ssr = 0.8f / sqrtf(a * (1.0f / 128.0f) + LN_EPS);
#pragma unroll
                    for (int d0 = 0; d0 < 4; ++d0) ot[crow(r, hi2) * OST_LD + d0 * 32 + r32b] = (bf16)f2bf(o[d0][r] * ssr * gsub[d0]); }
                asm volatile("s_waitcnt lgkmcnt(0)" ::: "memory");
                unsigned char* Ow = mix + (row0 + wid * QBLK + (lane2 >> 4)) * D + 1024 + h * 128 + (lane2 & 15) * 8;
#pragma unroll
                for (int k = 0; k < 8; ++k) { const u32x4 w = *(const LAS u32x4*)(ot + (k * 4 + (lane2 >> 4)) * OST_LD + (lane2 & 15) * 8); u32x2 w8;
                    w8.x = pk4_fp8(bf_lo(w.x), bf_hi(w.x), bf_lo(w.y), bf_hi(w.y)); w8.y = pk4_fp8(bf_lo(w.z), bf_hi(w.z), bf_lo(w.w), bf_hi(w.w)); *(u32x2*)(Ow + (size_t)k * 4 * D) = w8; }
            }
        }
    }
}
template <int L> __device__ __forceinline__ void ln_route_pass(Frame& F) {
    PH_IDS;
    LAS float* P_g = (LAS float*)F.lds;
    LAS float* P_b = P_g + D;
    LAS float* P_s = P_b + D;
    LAS float* P_h = P_s + D;
    LAS int* lcnt = (LAS int*)(F.lds + LDSX_OFF + 1024);
    LAS int* lbase = lcnt + 32;
    LAS int* rec = lcnt + 64;
    LAS float* recw = (LAS float*)(lcnt + 64 + 256);
    LAS float* lgt = (LAS float*)(F.lds + LDSX_OFF + 8192);
    LAS float* rst = (LAS float*)(lcnt + 64 + 256 + 256);
    const bf16* R = L == 0 ? (const bf16*)F.out + (size_t)M * D : WSP(bf16, WS_R1); unsigned char* H8 = WSP(unsigned char, WS_H8); float* stat = WSP(float, WS_STAT);
    const float* lng = F.in[6] + (L * 2 + 0) * D; const float* lnb = F.in[7] + (L * 2 + 0) * D;
    unsigned* gcnt = F.ctl + CW_CNT + L * 32; int4* list = WSP(int4, WS_LIST2);
    for (int blk = F.vcu; blk < M / 128; blk += F.G) {
        if (tid < 32) lcnt[tid] = 0;
        __syncthreads();
        const int rowb = blk * 128 + wave * 16, b = rowb >> 13;
        { const float* sh = MODP(L, b, 3); const float* sc = MODP(L, b, 4);
          for (int i = tid; i < D; i += 512) { P_g[i] = lng[i]; P_b[i] = lnb[i]; P_s[i] = 1.0f + sc[i]; P_h[i] = sh[i]; } }
        __syncthreads();
        u32x4 raw0[4], raw1[4];
#pragma unroll
        for (int j = 0; j < 4; ++j) { raw0[j] = *(const u32x4*)(R + (size_t)rowb * D + 512 * j + 8 * lane); raw1[j] = *(const u32x4*)(R + (size_t)(rowb + 1) * D + 512 * j + 8 * lane); }
#pragma unroll 1
        for (int pp = 0; pp < 8; ++pp) {
            const int row = rowb + 2 * pp;
            f32x2 v0[16], v1[16]; f32x2 s0 = {0.f, 0.f}, s1 = {0.f, 0.f};
#pragma unroll
            for (int j = 0; j < 4; ++j) {
                v0[4 * j + 0] = (f32x2){bf_lo(raw0[j].x), bf_hi(raw0[j].x)}; v0[4 * j + 1] = (f32x2){bf_lo(raw0[j].y), bf_hi(raw0[j].y)}; v0[4 * j + 2] = (f32x2){bf_lo(raw0[j].z), bf_hi(raw0[j].z)}; v0[4 * j + 3] = (f32x2){bf_lo(raw0[j].w), bf_hi(raw0[j].w)};
                v1[4 * j + 0] = (f32x2){bf_lo(raw1[j].x), bf_hi(raw1[j].x)}; v1[4 * j + 1] = (f32x2){bf_lo(raw1[j].y), bf_hi(raw1[j].y)}; v1[4 * j + 2] = (f32x2){bf_lo(raw1[j].z), bf_hi(raw1[j].z)}; v1[4 * j + 3] = (f32x2){bf_lo(raw1[j].w), bf_hi(raw1[j].w)}; }
#pragma unroll
            for (int i = 0; i < 16; ++i) { s0 += v0[i]; s1 += v1[i]; }
            if (pp < 7) {
#pragma unroll
                for (int j = 0; j < 4; ++j) { raw0[j] = *(const u32x4*)(R + (size_t)(row + 2) * D + 512 * j + 8 * lane); raw1[j] = *(const u32x4*)(R + (size_t)(row + 3) * D + 512 * j + 8 * lane); } }
            float t0 = s0.x + s0.y, t1 = s1.x + s1.y;
#pragma unroll
            for (int o = 1; o < 64; o <<= 1) { t0 += __shfl_xor(t0, o); t1 += __shfl_xor(t1, o); }
            const float mean0 = t0 * (1.0f / D), mean1 = t1 * (1.0f / D); f32x2 q0 = {0.f, 0.f}, q1 = {0.f, 0.f};
#pragma unroll
            for (int i = 0; i < 16; ++i) { v0[i] = v0[i] - mean0; v1[i] = v1[i] - mean1; q0 += v0[i] * v0[i]; q1 += v1[i] * v1[i]; }
            float u0 = q0.x + q0.y, u1 = q1.x + q1.y;
#pragma unroll
            for (int o = 1; o < 64; o <<= 1) { u0 += __shfl_xor(u0, o); u1 += __shfl_xor(u1, o); }
            const float rstd0 = 1.0f / sqrtf(u0 * (1.0f / D) + LN_EPS), rstd1 = 1.0f / sqrtf(u1 * (1.0f / D) + LN_EPS);
            if (lane == 0) { *(LAS f32x4*)(rst + (wave * 16 + 2 * pp) * 2) = (f32x4){mean0, rstd0, mean1, rstd1}; *(f32x4*)(stat + (size_t)row * 2) = (f32x4){mean0, rstd0, mean1, rstd1}; }
#pragma unroll
            for (int j = 0; j < 4; ++j) { const int c = 512 * j + 8 * lane; u32x2 h80, h81;
#pragma unroll
                for (int h = 0; h < 2; ++h) { const f32x4 g = *(const LAS f32x4*)(P_g + c + 4 * h), bb = *(const LAS f32x4*)(P_b + c + 4 * h), scv = *(const LAS f32x4*)(P_s + c + 4 * h), shv = *(const LAS f32x4*)(P_h + c + 4 * h);
                    const f32x2 ga = {g.x, g.y}, gb = {g.z, g.w}, ba = {bb.x, bb.y}, bc = {bb.z, bb.w}, sa = {scv.x, scv.y}, sb = {scv.z, scv.w}, ha = {shv.x, shv.y}, hb = {shv.z, shv.w};
                    const f32x2 xa0 = v0[4 * j + 2 * h] * rstd0 * ga + ba, xb0 = v0[4 * j + 2 * h + 1] * rstd0 * gb + bc, xa1 = v1[4 * j + 2 * h] * rstd1 * ga + ba, xb1 = v1[4 * j + 2 * h + 1] * rstd1 * gb + bc;
                    const f32x2 ya0 = xa0 * sa + ha, yb0 = xb0 * sb + hb, ya1 = xa1 * sa + ha, yb1 = xb1 * sb + hb;
                    if (h == 0) { h80.x = pk4_fp8(ya0.x, ya0.y, yb0.x, yb0.y); h81.x = pk4_fp8(ya1.x, ya1.y, yb1.x, yb1.y); } else { h80.y = pk4_fp8(ya0.x, ya0.y, yb0.x, yb0.y); h81.y = pk4_fp8(ya1.x, ya1.y, yb1.x, yb1.y); }
                }
                *(u32x2*)(H8 + (size_t)row * D + c) = h80; *(u32x2*)(H8 + (size_t)(row + 1) * D + c) = h81; }
        }
        {
            const int l2 = fresh_lane(), i16 = l2 & 15, kq = l2 >> 4;
            const bf16* hp = R + (size_t)(rowb + i16) * D + 8 * kq; const bf16* whp = WSP(bf16, WS_WRT2) + (size_t)((L * 4 + b) * 32 + i16) * D + 8 * kq; const bf16* wlp = whp + 16 * D;
            f32x4 lacc = {0.f, 0.f, 0.f, 0.f};
#pragma unroll 8
            for (int ks = 0; ks < 64; ++ks) { const bf16x8 af = *(const bf16x8*)(hp + 32 * ks); const bf16x8 bh = *(const bf16x8*)(whp + 32 * ks), bl = *(const bf16x8*)(wlp + 32 * ks);
                lacc = __builtin_amdgcn_mfma_f32_16x16x32_bf16(af, bh, lacc, 0, 0, 0); lacc = __builtin_amdgcn_mfma_f32_16x16x32_bf16(af, bl, lacc, 0, 0, 0); }
            LAS float* lp = lgt + (wave * 16 + 4 * kq) * 16 + i16; const float c1 = WSP(float, WS_RC)[(L * 4 + b) * 32 + i16], c2 = WSP(float, WS_RC)[(L * 4 + b) * 32 + 16 + i16];
            const LAS float* rs = rst + (wave * 16 + 4 * kq) * 2;
            const f32x4 s01 = *(const LAS f32x4*)rs, s23 = *(const LAS f32x4*)(rs + 4);
            lp[0] = s01.y * (lacc.x - s01.x * c1) + c2; lp[16] = s01.w * (lacc.y - s01.z * c1) + c2; lp[32] = s23.y * (lacc.z - s23.x * c1) + c2; lp[48] = s23.w * (lacc.w - s23.z * c1) + c2;
        }
        LDS_WAIT();
        if (lane < 16) {
            const int rl = wave * 16 + fresh_lane(); float sco[16], sel[16];
#pragma unroll
            for (int e4 = 0; e4 < 4; ++e4) { const f32x4 lg = *(const LAS f32x4*)(lgt + rl * 16 + 4 * e4);
                sco[4 * e4 + 0] = 1.0f / (1.0f + __expf(-lg.x)); sco[4 * e4 + 1] = 1.0f / (1.0f + __expf(-lg.y)); sco[4 * e4 + 2] = 1.0f / (1.0f + __expf(-lg.z)); sco[4 * e4 + 3] = 1.0f / (1.0f + __expf(-lg.w)); }
#pragma unroll
            for (int e = 0; e < 16; ++e) sel[e] = sco[e] + F.in[23][e];
            int bg = 0; float bgs = -1e30f;
#pragma unroll
            for (int g = 0; g < 4; ++g) { float m1 = -1e30f, m2 = -1e30f;
#pragma unroll
                for (int i = 0; i < 4; ++i) { const float x = sel[4 * g + i]; if (x > m1) { m2 = m1; m1 = x; } else if (x > m2) m2 = x; }
                const float gs = m1 + m2; if (gs > bgs) { bgs = gs; bg = g; } }
            float s4[4], c4[4];
#pragma unroll
            for (int i = 0; i < 4; ++i) { s4[i] = bg == 0 ? sel[i] : bg == 1 ? sel[4 + i] : bg == 2 ? sel[8 + i] : sel[12 + i]; c4[i] = bg == 0 ? sco[i] : bg == 1 ? sco[4 + i] : bg == 2 ? sco[8 + i] : sco[12 + i]; }
            int i1 = 0; float b1 = s4[0];
#pragma unroll
            for (int i = 1; i < 4; ++i) if (s4[i] > b1) { b1 = s4[i]; i1 = i; }
            int i2 = -1; float b2 = -1e30f;
#pragma unroll
            for (int i = 0; i < 4; ++i) if (i != i1 && s4[i] > b2) { b2 = s4[i]; i2 = i; }
            const float cw1 = i1 == 0 ? c4[0] : i1 == 1 ? c4[1] : i1 == 2 ? c4[2] : c4[3], cw2 = i2 == 0 ? c4[0] : i2 == 1 ? c4[1] : i2 == 2 ? c4[2] : c4[3];
            const float inv = 1.0f / (cw1 + cw2);
            const bool sw = i2 < i1; const int lo_i = sw ? i2 : i1, hi_i = sw ? i1 : i2;
            const int pid = bg * 6 + ((lo_i * (7 - lo_i)) >> 1) + hi_i - lo_i - 1;
            const int r1 = atomicAdd((int*)(lcnt + pid), 1);
            rec[rl] = pid | (r1 << 8); recw[rl * 2] = (sw ? cw2 : cw1) * inv; recw[rl * 2 + 1] = (sw ? cw1 : cw2) * inv;
        }
        __syncthreads();
        if (tid < NL) lbase[tid] = (int)atomicAdd(gcnt + tid, (unsigned)lcnt[tid]);
        __syncthreads();
        if (tid < 128) { const int v = rec[tid], e = v & 255, rank = v >> 8;
            list[e * CAP + lbase[e] + rank] = make_int4(blk * 128 + tid, __float_as_int(recw[tid * 2]), __float_as_int(recw[tid * 2 + 1]), 0); }
        __syncthreads();
    }
}
template <int L> __device__ __forceinline__ int moe_tables(Frame& F, LAS int*& tp, LAS int*& cnt) {
    tp = (LAS int*)(F.lds + LDSX_OFF + 16384); cnt = tp + 32;
    LAS int* ord = tp + 64; LAS int* tpf = tp + 352  ; LAS int* pix = tp + 384  ;
    if (F.wave0 == 0 && fresh_lane() == 0) { int acc = 0, fa = 0, pa = 0;
        for (int e = 0; e < NL; ++e) { const int c = (int)__hip_atomic_load(F.ctl + CW_CNT + L * 32 + e, RLX_AGENT); cnt[e] = c; tp[e] = acc; acc += (c + 255) >> 8; tpf[e] = fa; fa += c >> 8; pix[e] = pa; pa += (c & 255) ? 1 : 0; }
        tp[NL] = acc; tpf[NL] = fa; }
    __syncthreads();
    { const int t_ = F.wave0 * 64 + fresh_lane();
      if (t_ < NL) { const int c = cnt[t_], full = c >> 8, base = tp[t_], fo = tpf[t_]; for (int k = 0; k < full; ++k) ord[fo + k] = base + k; if (c & 255) ord[tpf[NL] + pix[t_]] = base + full; } }
    __syncthreads();
    return tp[NL];
}
template <int L> __device__ __forceinline__ void ln_moe_pass(Frame& F) {
    PH_IDS;
    bf16* X = WSP(bf16, WS_X); unsigned char* H8 = WSP(unsigned char, WS_H8); const bf16* YB = WSP(bf16, WS_YB);
    const bf16* R = L == 0 ? (const bf16*)F.out + (size_t)M * D : WSP(bf16, WS_R1); const float* stat = WSP(float, WS_STAT);
    LAS float* P_g2 = (LAS float*)F.lds; LAS float* P_g = P_g2 + D; LAS float* P_b = P_g + D; LAS float* P_s = P_b + D; LAS float* P_h = P_s + D; LAS float* P_g1 = P_h + D; LAS float* P_b1 = P_g1 + D;
    for (int blk = F.vcu; blk < M / 128; blk += F.G) {
        const int rowb = blk * 128 + wave * 16, b = rowb >> 13;
        __syncthreads();
        for (int i = tid; i < D; i += 512) { P_g2[i] = MODP(L, b, 5)[i]; P_g[i] = F.in[6][(L * 2 + 1) * D + i]; P_b[i] = F.in[7][(L * 2 + 1) * D + i]; P_g1[i] = F.in[6][(L * 2 + 0) * D + i]; P_b1[i] = F.in[7][(L * 2 + 0) * D + i];
            if (L == 0) { P_s[i] = 1.0f + MODP(1, b, 1)[i]; P_h[i] = MODP(1, b, 0)[i]; } }
        __syncthreads();
        u32x4 rx[4], ry0[4]; f32x2 rstt;
#define LNM_LOAD(r_) do { _Pragma("unroll") for (int j = 0; j < 4; ++j) { const int c = 512 * j + 8 * lane; rx[j] = *(const u32x4*)(R + (size_t)(r_) * D + c); \
            ry0[j] = *(const u32x4*)(YB + (size_t)(r_) * D + c); } rstt = *(const f32x2*)(stat + (size_t)(r_) * 2); } while (0)
        LNM_LOAD(rowb);
#pragma unroll 1
        for (int rr = 0; rr < 16; ++rr) {
            const int row = rowb + rr;
            f32x2 v[16]; f32x2 s2 = {0.f, 0.f}; const float ra = rstt.y, rc = -rstt.x * rstt.y;
#pragma unroll
            for (int j = 0; j < 4; ++j) { const int c = 512 * j + 8 * lane;
                const f32x4 ga = *(const LAS f32x4*)(P_g2 + c), gb = *(const LAS f32x4*)(P_g2 + c + 4), g1a = *(const LAS f32x4*)(P_g1 + c), g1b = *(const LAS f32x4*)(P_g1 + c + 4), b1a = *(const LAS f32x4*)(P_b1 + c), b1b = *(const LAS f32x4*)(P_b1 + c + 4);
#define LNM_E(k_, W_, G0_, G1_, A0_, A1_, B0_, B1_) v[4 * j + k_] = (((f32x2){bf_lo(rx[j].W_), bf_hi(rx[j].W_)} * ra + rc) * (f32x2){A0_, A1_} + (f32x2){B0_, B1_}) * ALPHA + (f32x2){G0_, G1_} * (f32x2){bf_lo(ry0[j].W_), bf_hi(ry0[j].W_)}
                LNM_E(0, x, ga.x, ga.y, g1a.x, g1a.y, b1a.x, b1a.y); LNM_E(1, y, ga.z, ga.w, g1a.z, g1a.w, b1a.z, b1a.w); LNM_E(2, z, gb.x, gb.y, g1b.x, g1b.y, b1b.x, b1b.y); LNM_E(3, w, gb.z, gb.w, g1b.z, g1b.w, b1b.z, b1b.w);
#undef LNM_E
            }
#pragma unroll
            for (int i = 0; i < 16; ++i) s2 += v[i];
            if (rr < 15) LNM_LOAD(row + 1);
            float t = s2.x + s2.y;
#pragma unroll
            for (int o = 1; o < 64; o <<= 1) t += __shfl_xor(t, o);
            const float mean = t * (1.0f / D); f32x2 q2 = {0.f, 0.f};
#pragma unroll
            for (int i = 0; i < 16; ++i) { v[i] = v[i] - mean; q2 += v[i] * v[i]; }
            float u = q2.x + q2.y;
#pragma unroll
            for (int o = 1; o < 64; o <<= 1) u += __shfl_xor(u, o);
            const float rstd = 1.0f / sqrtf(u * (1.0f / D) + LN_EPS);
#pragma unroll
            for (int j = 0; j < 4; ++j) { const int c = 512 * j + 8 * lane; f32x2 xo[4];
#pragma unroll
                for (int h = 0; h < 2; ++h) { const f32x4 g = *(const LAS f32x4*)(P_g + c + 4 * h), bb = *(const LAS f32x4*)(P_b + c + 4 * h);
                    xo[2 * h] = v[4 * j + 2 * h] * rstd * (f32x2){g.x, g.y} + (f32x2){bb.x, bb.y}; xo[2 * h + 1] = v[4 * j + 2 * h + 1] * rstd * (f32x2){g.z, g.w} + (f32x2){bb.z, bb.w}; }
                if (L == 1) { *(f32x4*)(F.out + (size_t)row * D + c) = (f32x4){xo[0].x, xo[0].y, xo[1].x, xo[1].y}; *(f32x4*)(F.out + (size_t)row * D + c + 4) = (f32x4){xo[2].x, xo[2].y, xo[3].x, xo[3].y}; }
                else { u32x4 w; w.x = pk2(xo[0].x, xo[0].y); w.y = pk2(xo[1].x, xo[1].y); w.z = pk2(xo[2].x, xo[2].y); w.w = pk2(xo[3].x, xo[3].y); *(u32x4*)(X + (size_t)row * D + c) = w;
                    const f32x4 sa = *(const LAS f32x4*)(P_s + c), sb = *(const LAS f32x4*)(P_s + c + 4), ha = *(const LAS f32x4*)(P_h + c), hb = *(const LAS f32x4*)(P_h + c + 4);
                    const f32x2 y0 = xo[0] * (f32x2){sa.x, sa.y} + (f32x2){ha.x, ha.y}, y1 = xo[1] * (f32x2){sa.z, sa.w} + (f32x2){ha.z, ha.w}, y2 = xo[2] * (f32x2){sb.x, sb.y} + (f32x2){hb.x, hb.y}, y3 = xo[3] * (f32x2){sb.z, sb.w} + (f32x2){hb.z, hb.w};
                    u32x2 hw; hw.x = pk4_fp8(y0.x, y0.y, y1.x, y1.y); hw.y = pk4_fp8(y2.x, y2.y, y3.x, y3.y); *(u32x2*)(H8 + (size_t)row * D + c) = hw; } }
        }
#undef LNM_LOAD
    }
}
__device__ __forceinline__ void spatial_simple(Frame& F) {
    PH_IDS;
    LAS float* vt = (LAS float*)F.lds;
    LAS float* wt = (LAS float*)(F.lds + 65536);
    LAS float* st = (LAS float*)(F.lds + LDSX_OFF + 1024);
    const bf16* UV = WSP(bf16, WS_UV); bf16* GT = (bf16*)F.out; const float* vst = WSP(float, WS_VSTP);
    for (int ch = F.vcu; ch < M / 128; ch += F.G) {
        __syncthreads();
        if (tid < 128) { float s = 0.f, s2 = 0.f; const f32x4* pp = (const f32x4*)(vst + (size_t)(ch * 128 + tid) * 64);
#pragma unroll
            for (int i = 0; i < 16; ++i) { const f32x4 t = pp[i]; s += t.x; s2 += t.y; s += t.z; s2 += t.w; }
            const float mean = s * (1.0f / D); const float var = fmaxf(s2 * (1.0f / D) - mean * mean, 0.f);
            st[tid * 2] = mean; st[tid * 2 + 1] = 1.0f / sqrtf(var + LN_EPS); }
#pragma unroll 1
        for (int g = 0; g < 16; ++g) {
            __syncthreads();
            for (int idx = tid; idx < 16384; idx += 512) { const int q = idx >> 7, c = idx & 127, col = g * 128 + c;
                const float v = bf2f(UV[(size_t)(ch * 128 + q) * 4096 + 2048 + col]);
                vt[idx] = (v - st[q * 2]) * st[q * 2 + 1] * F.in[17][col] + F.in[18][col]; wt[q * 129 + c] = F.in[19][g * 16384 + idx]; }
            __syncthreads();
            const int p = tid & 127, cg = tid >> 7;
            float acc[32];
#pragma unroll
            for (int i = 0; i < 32; ++i) acc[i] = 0.f;
#pragma unroll 1
            for (int q = 0; q < 128; ++q) { const float w = wt[p * 129 + q];
#pragma unroll
                for (int i = 0; i < 32; i += 4) { const f32x4 v = *(const LAS f32x4*)(vt + q * 128 + cg * 32 + i); acc[i] += w * v.x; acc[i + 1] += w * v.y; acc[i + 2] += w * v.z; acc[i + 3] += w * v.w; } }
            const size_t row = (size_t)ch * 128 + p; const float bsv = F.in[20][g * 128 + p];
            const bf16* up = UV + row * 4096 + g * 128 + cg * 32; bf16* op = GT + row * D + g * 128 + cg * 32;
#pragma unroll
            for (int i = 0; i < 32; i += 4) { const f32x4 uu = ld_bf4(up + i); st_bf4(op + i, (f32x4){uu.x * (acc[i] + bsv), uu.y * (acc[i + 1] + bsv), uu.z * (acc[i + 2] + bsv), uu.w * (acc[i + 3] + bsv)}); }
        }
    }
}

__device__ __forceinline__ void spatial_fast(Frame& F) {
    using namespace att;
    PH_IDS; const int wid = wave, r32 = lane & 31, hi = lane >> 5;
    LAS char* lds = (LAS char*)F.lds;
    LAS bf16* ot = (LAS bf16*)(lds + 65536) + wid * (32 * 136);
    LAS float* st = (LAS float*)(lds + 135168);
    const bf16* UV = WSP(bf16, WS_UV); unsigned char* GT = (unsigned char*)F.out; const float* vst = WSP(float, WS_VSTP); const bf16* WSB = WSP(bf16, WS_WSB);
    const int q0 = tid >> 4, cc = tid & 15;
    const int gsw = wid >> 2, pbase = (wid & 3) * 32;
    const int vbase = (int)(unsigned)(uintptr_t)lds + v_rd_base(lane) + gsw * 2 * 16384;
    for (int ch = F.vcu; ch < M / 128; ch += F.G) {
        __syncthreads();
        if (tid < 128) { float s = 0.f, s2 = 0.f; const f32x4* pp = (const f32x4*)(vst + (size_t)(ch * 128 + tid) * 64);
#pragma unroll
            for (int i = 0; i < 16; ++i) { const f32x4 t = pp[i]; s += t.x; s2 += t.y; s += t.z; s2 += t.w; }
            const float mean = s * (1.0f / D); const float var = fmaxf(s2 * (1.0f / D) - mean * mean, 0.f);
            st[tid * 2] = mean; st[tid * 2 + 1] = 1.0f / sqrtf(var + LN_EPS); }
        __syncthreads();
        const char* vsrc = (const char*)(UV + (size_t)ch * 128 * 4096 + 2048); const unsigned voff = (unsigned)(q0 * 4096 + cc * 8) * 2u;
        u32x4 raw[2][4];
#define LOADV(it_) do { _Pragma("unroll") for (int gs = 0; gs < 2; ++gs) _Pragma("unroll") for (int j = 0; j < 4; ++j) \
            raw[gs][j] = *(const u32x4*)(vsrc + voff + (size_t)((2 * (it_) + gs) * 256 + j * 32 * 8192)); } while (0)
        LOADV(0);
#pragma unroll 1
        for (int it = 0; it < 8; ++it) {
#pragma unroll
            for (int gs = 0; gs < 2; ++gs) { const int col = (2 * it + gs) * 128 + cc * 8;
                const f32x4 ga = *(const f32x4*)(F.in[17] + col), gb = *(const f32x4*)(F.in[17] + col + 4), ba = *(const f32x4*)(F.in[18] + col), bb = *(const f32x4*)(F.in[18] + col + 4);
#pragma unroll
                for (int j = 0; j < 4; ++j) { const int q = q0 + 32 * j; const float mean = st[2 * q], rstd = st[2 * q + 1]; const u32x4 w = raw[gs][j]; u32x4 o;
                    o.x = pk2((bf_lo(w.x) - mean) * rstd * ga.x + ba.x, (bf_hi(w.x) - mean) * rstd * ga.y + ba.y); o.y = pk2((bf_lo(w.y) - mean) * rstd * ga.z + ba.z, (bf_hi(w.y) - mean) * rstd * ga.w + ba.w);
                    o.z = pk2((bf_lo(w.z) - mean) * rstd * gb.x + bb.x, (bf_hi(w.z) - mean) * rstd * gb.y + bb.y); o.w = pk2((bf_lo(w.w) - mean) * rstd * gb.z + bb.z, (bf_hi(w.w) - mean) * rstd * gb.w + bb.w);
                    *(LAS u32x4*)(lds + (gs * 2 + (q >> 6)) * 16384 + v_st(q & 63, cc * 8)) = o; } }
            __syncthreads();
            if (it + 1 < 8) LOADV(it + 1);
            const int g = 2 * it + gsw;
            bf16x8 wa[8];
#pragma unroll
            for (int ks = 0; ks < 8; ++ks) wa[ks] = *(const bf16x8*)(WSB + (size_t)(g * 128 + pbase + r32) * 128 + ks * 16 + hi * 8);
            f32x16 o[4] = {};
            pv_d0(o, vbase, wa[0], wa[1], wa[2], wa[3]); pv_d0(o, vbase + 16384, wa[4], wa[5], wa[6], wa[7]);
#pragma unroll
            for (int r = 0; r < 16; ++r) { const float bs = F.in[20][g * 128 + pbase + crow(r, hi)];
#pragma unroll
                for (int d0 = 0; d0 < 4; ++d0) ot[crow(r, hi) * 136 + d0 * 32 + r32] = (bf16)f2bf(o[d0][r] + bs); }
            asm volatile("s_waitcnt lgkmcnt(0)" ::: "memory");
            const size_t tok = (size_t)ch * 128 + pbase + (lane >> 4);
#pragma unroll
            for (int k = 0; k < 8; ++k) { const u32x4 sv = *(const LAS u32x4*)(ot + (k * 4 + (lane >> 4)) * 136 + (lane & 15) * 8);
                const u32x4 uu = *(const u32x4*)(UV + (tok + k * 4) * 4096 + g * 128 + (lane & 15) * 8); u32x2 w;
                w.x = pk4_fp8(bf_lo(uu.x) * bf_lo(sv.x), bf_hi(uu.x) * bf_hi(sv.x), bf_lo(uu.y) * bf_lo(sv.y), bf_hi(uu.y) * bf_hi(sv.y));
                w.y = pk4_fp8(bf_lo(uu.z) * bf_lo(sv.z), bf_hi(uu.z) * bf_hi(sv.z), bf_lo(uu.w) * bf_lo(sv.w), bf_hi(uu.w) * bf_hi(sv.w));
                *(u32x2*)(GT + (tok + k * 4) * D + g * 128 + (lane & 15) * 8) = w; }
            __syncthreads();
        }
#undef LOADV
    }
}

constexpr int NPH = 17;
struct Args { const float* in[27]; float* out; unsigned char* ws; int ph_lo, ph_hi; };
__global__ void __launch_bounds__(NWAVES * 64, 2) mk_fwd(Args args) {
    extern __shared__ __attribute__((aligned(16))) unsigned char lds_raw[];
    Frame F;
    F.lds = (LAS unsigned char*)lds_raw;
    F.MISC = (volatile LAS unsigned*)(F.lds + MISC_OFF);
    F.wave0 = __builtin_amdgcn_readfirstlane((int)threadIdx.x >> 6);
    F.G = gridDim.x; { const int bx = blockIdx.x; F.vcu = (F.G % 8 == 0) ? (bx % 8) * (F.G / 8) + bx / 8 : bx; }
#pragma unroll
    for (int i = 0; i < 27; ++i) F.in[i] = args.in[i];
    F.out = args.out; F.ws = args.ws; F.ctl = (unsigned*)(args.ws + WS_CTL);
    if (threadIdx.x < 64) ((LAS unsigned*)(F.lds + MISC_OFF))[threadIdx.x] = 0u;
    __syncthreads();
    XcdBarrier bar; bar.bar = F.ctl + CW_BAR; bar.x = 0; bar.st = nullptr;
    if (MK_N_LAUNCHES == 1) bar = xcd_barrier_post(F.ctl + CW_BAR, F.MISC + 8, threadIdx.x == 0);
    const int lo = args.ph_lo, hi = args.ph_hi;
#define IN(k) (lo <= (k) && (k) < hi)
#define SEAM(k) do { if (IN(k) && IN((k) + 1)) xcd_barrier(bar, F.wave0 == 0 && fresh_lane() == 0); } while (0)

#define RUN(k, ...) do { if (IN(k)) { constexpr bool dup_pass = false; (void)dup_pass; __VA_ARGS__ } SEAM(k); if (DUP_PHASE == (k) && IN(k)) { constexpr bool dup_pass = true; (void)dup_pass; __VA_ARGS__ xcd_barrier(bar, F.wave0 == 0 && fresh_lane() == 0); } } while (0)
    RUN(0, p0_prologue(F););
    RUN(1, p1_modulate(F););
    RUN(2,
        { LAS float* tabL = (LAS float*)(F.lds + LDSX_OFF); { const int t_ = F.wave0 * 64 + fresh_lane(); for (int i = t_; i < 4096; i += 512) tabL[i] = WSP(float, WS_TAB)[i]; } __syncthreads();
          const unsigned char* h8 = (const unsigned char*)F.out + (size_t)M * D * 2; const unsigned char* w8 = WSP(unsigned char, WS_WINE) + (size_t)3072 * D;
          { Gemm g{(const bf16*)h8, (const bf16*)WSP(unsigned char, WS_WINE), M, 6144, D}; pg8::StaticOrder S; S.init(M, 6144, F.G, (int)blockIdx.x);
            EpiInProj E{WSP(bf16, WS_PROJ), WSP(bf16, WS_Q), WSP(bf16, WS_KB), WSP(bf16, WS_VB), tabL, tabL + 2048, 0};
            GEMM_PHASE_F8(EpiInProj, pg8::StaticOrder, F.lds, g, S, E); }
          { Gemm g{(const bf16*)(h8 + (size_t)M * D), (const bf16*)(w8 + (size_t)1024 * D), MC, 2048, D}; pg8::StaticOrder S; S.init(MC, 2048, F.G, (int)blockIdx.x);
            EpiCtx E{WSP(bf16, WS_KB), WSP(bf16, WS_VB)};
            GEMM_PHASE_F8(EpiCtx, pg8::StaticOrder, F.lds, g, S, E); } }
        if (!dup_pass) { const int c = (int)blockIdx.x;
            if (F.G <= 32) convert_weights<1>(F, c * NWAVES + F.wave0, F.G * NWAVES, F.wave0, fresh_lane(), 0, CW_SPLIT1);
            else if (c >= 32) convert_weights<1>(F, (c - 32) * NWAVES + F.wave0, (F.G - 32) * NWAVES, F.wave0, fresh_lane(), 0, CW_SPLIT1); });
#if USE_FAST_ATTN
    RUN(3, conv_pass(F); attn_fast(F););
#else
    RUN(3, conv_pass(F); attn_simple(F););
    RUN(4, attn_finish(F););
#endif
    RUN(5, { Gemm g{(const bf16*)F.out, WSP(bf16, WS_WOUTE), M, D, D}; pg8::StaticOrder S; S.init(M, D, F.G, (int)blockIdx.x);
        EpiRes<true> E{F.in[0], nullptr, MODP(0, 0, 2), (bf16*)F.out + (size_t)M * D};
        GEMM_PHASE_F8(EpiRes<true>, pg8::StaticOrder, F.lds, g, S, E); });
    RUN(6, ln_route_pass<0>(F););
    RUN(7, { LAS int* tp; LAS int* cnt; const int TP = moe_tables<0>(F, tp, cnt);
        Gemm g{(const bf16*)WSP(unsigned char, WS_H8), (const bf16*)(WSP(unsigned char, WS_WGU)), M, 1024, D}; pg8::MoeOrder<true> S{tp, cnt, WSP(int4, WS_LIST2), 8, TP * 8, F.G, (int)blockIdx.x, tp + 64};
        EpiGU E{WSP(unsigned char, WS_HID), WSP(int4, WS_LIST2)}; GEMM_PHASE_F8(EpiGU, pg8::MoeOrder<true>, F.lds, g, S, E);
        if (!dup_pass) { const int rem = (TP * 8) % F.G; const int c = (int)blockIdx.x;
            if (rem == 0) convert_weights<1>(F, c * NWAVES + F.wave0, F.G * NWAVES, F.wave0, fresh_lane(), CW_SPLIT1, CW_N1);
            else if (c >= rem) convert_weights<1>(F, (c - rem) * NWAVES + F.wave0, (F.G - rem) * NWAVES, F.wave0, fresh_lane(), CW_SPLIT1, CW_N1); } });
    RUN(8, { LAS int* tp; LAS int* cnt; const int TP = moe_tables<0>(F, tp, cnt);
        Gemm g{(const bf16*)WSP(unsigned char, WS_HID), (const bf16*)(WSP(unsigned char, WS_WDN)), M, 2048, 2 * ED, ED}; pg8::MoeOrder<false> S{tp, cnt, WSP(int4, WS_LIST2), 8, TP * 8, F.G, (int)blockIdx.x, tp + 64};
        EpiDown E{WSP(int4, WS_LIST2), WSP(bf16, WS_YB)}; GEMM_PHASE_F8(EpiDown, pg8::MoeOrder<false>, F.lds, g, S, E); });
    RUN(9, ln_moe_pass<0>(F););
    RUN(10, { Gemm g{(const bf16*)WSP(unsigned char, WS_H8), WSP(bf16, WS_WINO), M, 4096, D}; pg8::StaticOrder S; S.init(M, 4096, F.G, (int)blockIdx.x);
        EpiGelu E{WSP(bf16, WS_UV), WSP(float, WS_VSTP)}; GEMM_PHASE_F8(EpiGelu, pg8::StaticOrder, F.lds, g, S, E); });
#if USE_FAST_SPATIAL
    RUN(11, spatial_fast(F););
#else
    RUN(11, spatial_simple(F););
#endif
    RUN(12, { Gemm g{(const bf16*)F.out, WSP(bf16, WS_WOUTO), M, D, D}; pg8::StaticOrder S; S.init(M, D, F.G, (int)blockIdx.x);
        EpiRes<false> E{nullptr, WSP(bf16, WS_X), MODP(1, 0, 2), WSP(bf16, WS_R1)};
        GEMM_PHASE_F8(EpiRes<false>, pg8::StaticOrder, F.lds, g, S, E); });
    RUN(13, ln_route_pass<1>(F););
    RUN(14, { LAS int* tp; LAS int* cnt; const int TP = moe_tables<1>(F, tp, cnt);
        Gemm g{(const bf16*)WSP(unsigned char, WS_H8), (const bf16*)(WSP(unsigned char, WS_WGU) + (size_t)16 * 1024 * D), M, 1024, D}; pg8::MoeOrder<true> S{tp, cnt, WSP(int4, WS_LIST2), 8, TP * 8, F.G, (int)blockIdx.x, tp + 64};
        EpiGU E{WSP(unsigned char, WS_HID), WSP(int4, WS_LIST2)}; GEMM_PHASE_F8(EpiGU, pg8::MoeOrder<true>, F.lds, g, S, E); });
    RUN(15, { LAS int* tp; LAS int* cnt; const int TP = moe_tables<1>(F, tp, cnt);
        Gemm g{(const bf16*)WSP(unsigned char, WS_HID), (const bf16*)(WSP(unsigned char, WS_WDN) + (size_t)16 * D * ED), M, 2048, 2 * ED, ED}; pg8::MoeOrder<false> S{tp, cnt, WSP(int4, WS_LIST2), 8, TP * 8, F.G, (int)blockIdx.x, tp + 64};
        EpiDown E{WSP(int4, WS_LIST2), WSP(bf16, WS_YB)}; GEMM_PHASE_F8(EpiDown, pg8::MoeOrder<false>, F.lds, g, S, E); });
    if (DUP_PHASE == 16) { ln_moe_pass<1>(F); xcd_barrier(bar, F.wave0 == 0 && fresh_lane() == 0); }
    if (IN(16)) { ln_moe_pass<1>(F); }
#undef RUN
#undef IN
#undef SEAM
}

extern "C" void kernel_launch(void* const* d_in, const int* in_sizes, int n_in, void* d_out, int out_size, void* d_ws, size_t ws_size, hipStream_t stream) {
    static int grid = 0;
    if (grid == 0) {
        if (n_in != 27 || in_sizes[0] != M * D || out_size != M * D || ws_size < WS_END) { fprintf(stderr, "kernel_launch: shape/workspace mismatch (n_in %d, ws %zu < %zu)\n", n_in, ws_size, (size_t)WS_END); grid = -1; return; }
        int dev = 0, cus = 0, per_cu = 0;
        if (hipGetDevice(&dev) != hipSuccess || hipDeviceGetAttribute(&cus, hipDeviceAttributeMultiprocessorCount, dev) != hipSuccess) { grid = -1; return; }
        if (hipFuncSetAttribute((const void*)mk_fwd, hipFuncAttributeMaxDynamicSharedMemorySize, LDS_BYTES) != hipSuccess) { fprintf(stderr, "kernel_launch: hipFuncSetAttribute failed\n"); grid = -1; return; }
        if (hipOccupancyMaxActiveBlocksPerMultiprocessor(&per_cu, (const void*)mk_fwd, NWAVES * 64, LDS_BYTES) != hipSuccess || per_cu < 1) fprintf(stderr, "kernel_launch: occupancy query reports %d\n", per_cu);
        (void)hipGetLastError();
        grid = cus;
    }
    if (grid < 0) return;
    if (hipMemsetAsync((char*)d_ws + WS_CTL, 0, CTL_ZERO_BYTES, stream) != hipSuccess) return;
    Args a{};
    for (int i = 0; i < 27; ++i) a.in[i] = (const float*)d_in[i];
    a.out = (float*)d_out; a.ws = (unsigned char*)d_ws;
    if (MK_N_LAUNCHES == 1) { a.ph_lo = 0; a.ph_hi = NPH; hipLaunchKernelGGL(mk_fwd, dim3(grid), dim3(NWAVES * 64), LDS_BYTES, stream, a); }
    else for (int p = 0; p < NPH; ++p) {
#if USE_FAST_ATTN
        if (p == 4) continue;
#endif
        a.ph_lo = p; a.ph_hi = p + 1; hipLaunchKernelGGL(mk_fwd, dim3(grid), dim3(NWAVES * 64), LDS_BYTES, stream, a); }
    const hipError_t le = hipPeekAtLastError();
    if (le != hipSuccess) fprintf(stderr, "kernel_launch: launch failed: %s\n", hipGetErrorName(le));
}
```

```cpp
#include <hip/hip_runtime.h>
#include <cstdio>
#include <cstdint>

#ifndef MK_N_LAUNCHES
#define MK_N_LAUNCHES 1
#endif
#ifndef DUP_PHASE
#define ATT_OVF_LIMIT __builtin_inff()
#define DUP_PHASE -1
#endif
#ifndef USE_FAST_GEMM
#define USE_FAST_GEMM 1
#endif
#ifndef USE_FAST_ATTN
#define USE_FAST_ATTN 1
#endif
#ifndef USE_FAST_SPATIAL
#define USE_FAST_SPATIAL 1
#endif

#define GAS __attribute__((address_space(1)))
#define LAS __attribute__((address_space(3)))
typedef unsigned short bf16;
typedef short bf16x8 __attribute__((ext_vector_type(8)));
typedef float f32x4 __attribute__((ext_vector_type(4)));
typedef float f32x2 __attribute__((ext_vector_type(2)));
typedef unsigned u32x4 __attribute__((ext_vector_type(4)));
typedef unsigned u32x2 __attribute__((ext_vector_type(2)));
typedef GAS unsigned gu32;

constexpr int D = 2048, BATCH = 4, SEQ = 8192, M = BATCH * SEQ, CTXL = 256, MC = BATCH * CTXL, KV = SEQ + CTXL;
constexpr int NE = 16, ED = 512, CAP = 32768, NL = 24;
constexpr float ALPHA = 1.41421356237309515f, LN_EPS = 1e-5f;
constexpr int NWAVES = 8;
constexpr float QSCALE = 0.125f * 1.4426950408889634f;

constexpr size_t MiB = 1u << 20;
constexpr size_t WS_CTL = 0, CTL_ZERO_BYTES = 64 * 1024;
constexpr size_t WS_MOD = 2 * MiB;
constexpr size_t WS_TAB = 3 * MiB;
constexpr size_t WS_WRT = 3 * MiB + 64 * 1024;
constexpr size_t WS_WSB = 3 * MiB + 256 * 1024;
constexpr size_t WS_WRT2 = 24 * MiB;
constexpr size_t WS_RC = 25 * MiB;
constexpr size_t WS_STAT = 26 * MiB;
constexpr size_t WS_LIST = 4 * MiB;
constexpr size_t WS_WINE = 8 * MiB;
constexpr size_t WS_WOUTE = 32 * MiB;
constexpr size_t WS_WINO = 40 * MiB;
constexpr size_t WS_WOUTO = 56 * MiB;
constexpr size_t WS_WGU = 64 * MiB;
constexpr size_t WS_WDN = 192 * MiB;
constexpr size_t WS_A = 256 * MiB;
constexpr size_t WS_R1 = WS_A + 196 * MiB;
constexpr size_t WS_PROJ = WS_A;
constexpr size_t WS_Q = WS_A + 192 * MiB;
constexpr size_t WS_KB = WS_A + 256 * MiB;
constexpr size_t WS_VB = WS_A + 322 * MiB;
constexpr size_t WS_HID = WS_A;
constexpr size_t WS_H8 = WS_A + 324 * MiB;
constexpr size_t WS_YB = WS_A + 68 * MiB;
constexpr size_t WS_UV = WS_A;
constexpr size_t WS_VSTP = WS_A + 256 * MiB;
constexpr size_t WS_H = WS_A + 388 * MiB;
constexpr size_t WS_LIST2 = WS_H;
constexpr size_t WS_X = WS_H + 128 * MiB;
constexpr size_t WS_HC = WS_X + 128 * MiB;
constexpr size_t WS_END = WS_HC + 4 * MiB;
static_assert(WS_VB + (size_t)BATCH * KV * 1024 * 2 <= WS_H && WS_YB + (size_t)M * 2 * 2048 * 2 <= WS_H && WS_END <= 1024 * MiB, "ws map");
constexpr int CW_BAR = 4096;
constexpr int CW_CNT = 8192;
constexpr int CW_VST = 262144;
constexpr int RING_BYTES = 131072, LDSX_OFF = RING_BYTES, MISC_OFF = LDSX_OFF + 24576, LDS_BYTES = 163840;

#define RLX_AGENT __ATOMIC_RELAXED, __HIP_MEMORY_SCOPE_AGENT
#define LDS_WAIT() asm volatile("s_waitcnt lgkmcnt(0)" ::: "memory")
#define VM_WAIT() asm volatile("s_waitcnt vmcnt(0)" ::: "memory")
__device__ __forceinline__ unsigned f2bf(float f) { unsigned u = __builtin_bit_cast(unsigned, f); return (u + 0x7fffu + ((u >> 16) & 1u)) >> 16; }
__device__ __forceinline__ unsigned pk2(float lo, float hi) { unsigned r; asm("v_cvt_pk_bf16_f32 %0, %1, %2" : "=v"(r) : "v"(lo), "v"(hi)); return r; }
__device__ __forceinline__ float bf_lo(unsigned u) { return __uint_as_float(u << 16); }
__device__ __forceinline__ float bf_hi(unsigned u) { return __uint_as_float(u & 0xffff0000u); }
__device__ __forceinline__ float bf2f(bf16 h) { return __uint_as_float((unsigned)h << 16); }
__device__ __forceinline__ f32x4 ld_bf4(const bf16* p) { const u32x2 w = *(const u32x2*)p; return (f32x4){bf_lo(w.x), bf_hi(w.x), bf_lo(w.y), bf_hi(w.y)}; }
__device__ __forceinline__ void st_bf4(bf16* p, f32x4 v) { u32x2 w; w.x = pk2(v.x, v.y); w.y = pk2(v.z, v.w); *(u32x2*)p = w; }
__device__ __forceinline__ float wave_sum(float v) {
#pragma unroll
    for (int o = 1; o < 64; o <<= 1) v += __shfl_xor(v, o);
    return v;
}
__device__ __forceinline__ __amdgpu_buffer_rsrc_t make_rsrc(const void* p, int bytes) {
    const unsigned long long v = (unsigned long long)p; const unsigned lo = __builtin_amdgcn_readfirstlane((unsigned)v), hi = __builtin_amdgcn_readfirstlane((unsigned)(v >> 32));
    return __builtin_amdgcn_make_buffer_rsrc((void*)(((unsigned long long)hi << 32) | lo), 0, bytes, 0x00020000);
}
__device__ __forceinline__ bf16x8 bufld16(__amdgpu_buffer_rsrc_t r, unsigned voff, unsigned soff) { return __builtin_bit_cast(bf16x8, __builtin_amdgcn_raw_buffer_load_b128(r, (int)voff, (int)soff, 0)); }
__device__ __forceinline__ unsigned pk4_fp8(float a, float b, float c, float d) {
    a = __builtin_amdgcn_fmed3f(a, -448.f, 448.f); b = __builtin_amdgcn_fmed3f(b, -448.f, 448.f); c = __builtin_amdgcn_fmed3f(c, -448.f, 448.f); d = __builtin_amdgcn_fmed3f(d, -448.f, 448.f);
    int v = __builtin_amdgcn_cvt_pk_fp8_f32(a, b, 0, false); v = __builtin_amdgcn_cvt_pk_fp8_f32(c, d, v, true); return (unsigned)v; }
__device__ __forceinline__ void st_f8x8(unsigned char* p, f32x4 a, f32x4 b) { u32x2 w; w.x = pk4_fp8(a.x, a.y, a.z, a.w); w.y = pk4_fp8(b.x, b.y, b.z, b.w); *(u32x2*)p = w; }
constexpr float W8_SCALE = 32.0f;
__device__ __forceinline__ float silu_f(float x) { return x * __builtin_amdgcn_rcpf(1.0f + __builtin_amdgcn_exp2f(-1.4426950408889634f * x)); }
__device__ __forceinline__ float gelu_tanh_f(float x) {
    const float w = x * __builtin_fmaf(x * x, -0.1029432396f, -2.3022081981f); return x * __builtin_amdgcn_rcpf(1.0f + __builtin_amdgcn_exp2f(w)); }

#define XB_TMO      128
#define XB_XCNT(j)  (256  + 64 * (j))
#define XB_XSUB(j)  (1280 + 64 * (j))
#define XB_XGEN(j)  (2304 + 64 * (j))
#define XB_TOP      3328
#define XB_TOPGEN   3392
#define XCD_BAR_WORDS 3456
#define XB_SPIN_CAP (1u << 21)
__device__ __forceinline__ unsigned xb_ld(unsigned* p)              { return __hip_atomic_load(p, __ATOMIC_RELAXED, __HIP_MEMORY_SCOPE_AGENT); }
__device__ __forceinline__ unsigned xb_add(unsigned* p, unsigned v) { return __hip_atomic_fetch_add(p, v, __ATOMIC_RELAXED, __HIP_MEMORY_SCOPE_AGENT); }
__device__ __forceinline__ unsigned xb_xcc_id() { return (unsigned)__builtin_amdgcn_s_getreg((3 << 11) | 20) & 0xFu; }
#define XB_SPIN(cond, bar) do { unsigned _sp = 0; while (cond) { __builtin_amdgcn_s_sleep(1); \
    if ((++_sp & 255u) == 0u) { if (xb_ld(&(bar)[XB_TMO])) break; if (_sp > XB_SPIN_CAP) { atomicAdd(&(bar)[XB_TMO], 1u); break; } } } } while (0)
struct XcdBarrier { unsigned* bar; unsigned x; volatile LAS unsigned* st; };
__device__ __forceinline__ XcdBarrier xcd_barrier_post(unsigned* bar, volatile LAS unsigned* st, bool t0) {
    XcdBarrier b; b.bar = bar; b.x = xb_xcc_id(); b.st = st;
    if (t0) (void)xb_add(&bar[XB_XCNT(b.x)], 1u);
    return b;
}
__device__ __forceinline__ void xcd_barrier_complete(unsigned* bar, unsigned x, unsigned& nloc, unsigned& nx) {
    const unsigned G = gridDim.x * gridDim.y * gridDim.z;
    unsigned sum, cnt, mine, sp = 0u;
    for (;;) {
        sum = 0u; cnt = 0u; mine = 0u;
#pragma unroll
        for (unsigned j = 0; j < 16; ++j) { const unsigned c = xb_ld(&bar[XB_XCNT(j)]); sum += c; cnt += (c > 0u) ? 1u : 0u; mine = (j == x) ? c : mine; }
        if (sum == G) break;
        __builtin_amdgcn_s_sleep(1);
        if ((++sp & 255u) == 0u) { if (xb_ld(&bar[XB_TMO])) break; if (sp > XB_SPIN_CAP) { atomicAdd(&bar[XB_TMO], 1u); break; } }
    }
    nloc = mine > 0u ? mine : 1u; nx = cnt > 0u ? cnt : 1u;
}
__device__ __forceinline__ void xcd_barrier(const XcdBarrier& b, bool t0) {
    asm volatile("s_waitcnt vmcnt(0)" ::: "memory");
    __syncthreads();
    if (t0) {
        unsigned* bar = b.bar;
        __builtin_amdgcn_s_waitcnt(0);
        unsigned nloc = b.st[0], nx = b.st[1];
        if (nloc == 0u) { xcd_barrier_complete(bar, b.x, nloc, nx); b.st[0] = nloc; b.st[1] = nx; }
        const unsigned old = xb_add(&bar[XB_XSUB(b.x)], 1u);
        const unsigned gen = old / nloc;
        if (old + 1u == (gen + 1u) * nloc) {
            __builtin_amdgcn_fence(__ATOMIC_RELEASE, "agent");
            asm volatile("s_waitcnt vmcnt(0)" ::: "memory");
            const unsigned og = xb_add(&bar[XB_TOP], 1u);
            const unsigned tg = og / nx;
            if (og + 1u == (tg + 1u) * nx) xb_add(&bar[XB_TOPGEN], 1u);
            else XB_SPIN(xb_ld(&bar[XB_TOPGEN]) == tg, bar);
            __builtin_amdgcn_fence(__ATOMIC_ACQUIRE, "agent");
            xb_add(&bar[XB_XGEN(b.x)], 1u);
            asm volatile("s_waitcnt vmcnt(0)" ::: "memory");
        } else {
            XB_SPIN(xb_ld(&bar[XB_XGEN(b.x)]) == gen, bar);
            __builtin_amdgcn_fence(__ATOMIC_ACQUIRE, "agent");
            asm volatile("s_waitcnt vmcnt(0)" ::: "memory");
        }
    }
    __syncthreads();
}

namespace pg8 {
constexpr int BM = 256, BK = 64, HALF = 128, HTB = HALF * BK * 2, STAGE_BYTES = 8 * HTB, NXCD = 8, WGM = 4;
__host__ __device__ __forceinline__ int lds_byte(int r, int c) { const int st = (r >> 4) * 2 + (c >> 5), rr = r & 15, cc = c & 31, ob = rr * 64 + cc * 2; return st * 1024 + (ob ^ (((ob >> 9) & 1) << 5)); }
__host__ __device__ __forceinline__ void stage_rc(int b, int& R, int& C) { const int st = b / 1024, sb = b % 1024, swz = sb ^ (((sb >> 9) & 1) << 5); R = (st >> 1) * 16 + swz / 64; C = (st & 1) * 32 + (swz % 64) / 2; }
__host__ __device__ __forceinline__ int perm32(int rho) { const int n = rho >> 4, i = rho & 15; return 8 * (i >> 2) + 4 * n + (i & 3); }

struct Unit { int pm, pn, e, lbase, nvalid, pn2, sub; };
struct Gemm { const bf16* A; const bf16* Bt; int M, N, K; int KB = 0; };

struct StaticOrder {
    static constexpr bool GATHER = false;
    int nM, nN, nwg, G, c;
    __device__ void init(int M_, int N_, int G_, int c_) { nM = M_ / BM; nN = N_ / BM; nwg = nM * nN; G = G_; c = c_; }
    __device__ bool next(int i, Unit& u) const {
        const long L = (long)i * G + c; if (L >= nwg) return false;
        int wgid = (int)L; { const int q = nwg / NXCD, r = nwg % NXCD, xcd = wgid % NXCD, off = wgid / NXCD; wgid = (xcd < r ? xcd * (q + 1) : r * (q + 1) + (xcd - r) * q) + off; }
        const int nig = WGM * nN, gid = wgid / nig, fm = gid * WGM, gsz = (nM - fm) < WGM ? (nM - fm) : WGM;
        u.pm = fm + ((wgid % nig) % gsz); u.pn = (wgid % nig) / gsz; u.e = 0; u.lbase = 0; u.nvalid = 256; u.pn2 = u.pn; u.sub = 0; return true;
    }
    __device__ __forceinline__ int arow(const Unit& u, int r) const { return u.pm * BM + r; }
};
template <bool GATHER_> struct MoeOrder {
    static constexpr bool GATHER = GATHER_;
    const LAS int* tp; const LAS int* cnt; const int4* list; int NT, nwg, G, c; const LAS int* ord;
    __device__ bool next(int i, Unit& u) const {
        const long L = (long)i * G + c; if (L >= nwg) return false;
        int w = (int)L; { const int q = nwg / NXCD, r = nwg % NXCD, xcd = w % NXCD, off = w / NXCD; w = (xcd < r ? xcd * (q + 1) : r * (q + 1) + (xcd - r) * q) + off; }
        const int po = w / NT, pnl = w - po * NT, pmg = ord[po];
        typedef int i32x4 __attribute__((ext_vector_type(4)));
        const i32x4 t0 = *(const LAS i32x4*)tp, t1 = *(const LAS i32x4*)(tp + 4), t2 = *(const LAS i32x4*)(tp + 8), t3 = *(const LAS i32x4*)(tp + 12), t4 = *(const LAS i32x4*)(tp + 16), t5 = *(const LAS i32x4*)(tp + 20);
        const int e = (pmg >= t0.y) + (pmg >= t0.z) + (pmg >= t0.w) + (pmg >= t1.x) + (pmg >= t1.y) + (pmg >= t1.z) + (pmg >= t1.w)
                    + (pmg >= t2.x) + (pmg >= t2.y) + (pmg >= t2.z) + (pmg >= t2.w) + (pmg >= t3.x) + (pmg >= t3.y) + (pmg >= t3.z) + (pmg >= t3.w)
                    + (pmg >= t4.x) + (pmg >= t4.y) + (pmg >= t4.z) + (pmg >= t4.w) + (pmg >= t5.x) + (pmg >= t5.y) + (pmg >= t5.z) + (pmg >= t5.w);
        static_assert(NL == 24, "MoeOrder::next reads tp[0..23]");
        const int tile = pmg - tp[e];
        const int g4 = e / 6, p6 = e - 6 * g4, lo = p6 < 3 ? 0 : (p6 < 5 ? 1 : 2), hi = p6 < 3 ? p6 + 1 : (p6 < 5 ? p6 - 1 : 3), elo = 4 * g4 + lo, ehi = 4 * g4 + hi;
        u.pm = pmg; u.e = e; u.sub = pnl; u.lbase = e * CAP + tile * 256; const int nv = cnt[e] - tile * 256; u.nvalid = nv < 256 ? nv : 256;
        if (GATHER_) { u.pn = (pnl < 4 ? elo : ehi) * 4 + (pnl & 3); u.pn2 = u.pn; }
        else { u.pn = elo * NT + pnl; u.pn2 = ehi * NT + pnl; }
        return true;
    }
    __device__ __forceinline__ int arow(const Unit& u, int r) const { if (!GATHER_) return u.pm * BM + r; return r < u.nvalid ? list[u.lbase + r].x : 0; }
};

template <class Epi, class Sched>
__device__ __forceinline__ void gemm_simple(int wid, int lane, const Gemm g, const Sched& S, const Epi& E) {
    const int wr = wid >> 2, wc = wid & 3, fr = lane & 15, fq = lane >> 4;
    const int K = g.K;
    for (int ui = 0;; ++ui) {
        Unit u; if (!S.next(ui, u)) break;
        f32x4 acc[2][2][4][2];
#pragma unroll
        for (int a = 0; a < 2; ++a)
#pragma unroll
            for (int b = 0; b < 2; ++b)
#pragma unroll
                for (int m = 0; m < 4; ++m)
#pragma unroll
                    for (int n = 0; n < 2; ++n) acc[a][b][m][n] = (f32x4){0.f, 0.f, 0.f, 0.f};
        unsigned ap[2][4], bp[2][2];
#pragma unroll
        for (int a = 0; a < 2; ++a)
#pragma unroll
            for (int m = 0; m < 4; ++m) ap[a][m] = (unsigned)S.arow(u, a * HALF + wr * 64 + m * 16 + fr) * (unsigned)K + fq * 8;
#pragma unroll
        for (int b = 0; b < 2; ++b)
#pragma unroll
            for (int n = 0; n < 2; ++n) { const int rho = 16 * n + fr; bp[b][n] = (unsigned)(u.pn * BM + b * HALF + wc * 32 + (Epi::PERM ? perm32(rho) : rho)) * (unsigned)K + fq * 8; }
#pragma unroll 1
        for (int k = 0; k < K; k += 32) {
            bf16x8 Af[2][4], Bf[2][2];
#pragma unroll
            for (int a = 0; a < 2; ++a)
#pragma unroll
                for (int m = 0; m < 4; ++m) Af[a][m] = *(const bf16x8*)(g.A + ap[a][m] + k);
#pragma unroll
            for (int b = 0; b < 2; ++b)
#pragma unroll
                for (int n = 0; n < 2; ++n) Bf[b][n] = *(const bf16x8*)(g.Bt + bp[b][n] + k);
#pragma unroll
            for (int a = 0; a < 2; ++a)
#pragma unroll
                for (int b = 0; b < 2; ++b)
#pragma unroll
                    for (int m = 0; m < 4; ++m)
#pragma unroll
                        for (int n = 0; n < 2; ++n) acc[a][b][m][n] = __builtin_amdgcn_mfma_f32_16x16x32_bf16(Bf[b][n], Af[a][m], acc[a][b][m][n], 0, 0, 0);
        }
        E(acc, u, wr, wc, fr, fq);
    }
}

typedef int v8i32 __attribute__((ext_vector_type(8)));
typedef int v4i32 __attribute__((ext_vector_type(4)));
template <class Epi, class Sched, bool F8 = false>
__device__ __forceinline__ void gemm_phase(int wid, int lane, LAS unsigned char* lds, const Gemm g, const Sched& S, const Epi& E) {
    const int tid = wid * 64 + lane, wr = wid >> 2, wc = wid & 3, fr = lane & 15, fq = lane >> 4;
    const int K = F8 ? g.K / 2 : g.K  , nt = K / BK;
    const int KBr = g.KB ? (F8 ? g.KB / 2 : g.KB) : K  , ntB = KBr / BK;
    unsigned voffA[2], voffB[2]; int Rr[2], Cc[2];
#pragma unroll
    for (int i = 0; i < 2; ++i) { int R, C; stage_rc(tid * 16 + i * 8192, R, C); const int Rb = Epi::PERM ? ((R & ~31) + perm32(R & 31)) : R;
        voffA[i] = (unsigned)(R * K + C) * 2u; voffB[i] = (unsigned)(Rb * KBr + C) * 2u; Rr[i] = R; Cc[i] = C; }
    const unsigned kstep = (unsigned)(BK * 2);
    const unsigned hstep = (unsigned)HALF * (unsigned)K * 2u;
    const unsigned tstep = 2 * hstep;
    const unsigned hstepB = (unsigned)HALF * (unsigned)KBr * 2u, tstepB = 2 * hstepB;
    const __amdgpu_buffer_rsrc_t rsA = make_rsrc(g.A, 0x7fffffff), rsB = make_rsrc(g.Bt, 0x7fffffff);
    const unsigned ldsw = (unsigned)wid * 1024u;
    const int aoff0 = lds_byte(wr * 64 + fr, F8 ? fq * 16 : fq * 8), aoff1 = F8 ? lds_byte(wr * 64 + fr, fq * 16 + 8) : aoff0 + 1024;
    const int boff0 = lds_byte(wc * 32 + fr, F8 ? fq * 16 : fq * 8), boff1 = F8 ? lds_byte(wc * 32 + fr, fq * 16 + 8) : boff0 + 1024;
#define PG8_SA(b, h) (((b) * 2 + (h)) * HTB)
#define PG8_SB(b, h) ((4 + (b) * 2 + (h)) * HTB)
#define PG8_STAGE(bufoff, soff, voff) do { _Pragma("unroll") for (int _i = 0; _i < 2; ++_i) \
        __builtin_amdgcn_raw_ptr_buffer_load_lds(rsB, (LAS void*)(lds + (bufoff) + ldsw + _i * 8192), 16, (int)(voff)[_i], (int)(soff), 0, 0); } while (0)
#define PG8_STAGE_A(bufoff, h, contig_off, kt_bytes, use_next) do { _Pragma("unroll") for (int _i = 0; _i < 2; ++_i) { \
        const unsigned vo_ = Sched::GATHER ? ((use_next) ? gN[h][_i] : gC[h][_i]) : voffA[_i]; const unsigned so_ = Sched::GATHER ? (unsigned)(kt_bytes) : (unsigned)(contig_off); \
        __builtin_amdgcn_raw_ptr_buffer_load_lds(rsA, (LAS void*)(lds + (bufoff) + ldsw + _i * 8192), 16, (int)vo_, (int)so_, 0, 0); } } while (0)
#define PG8_GOFF(u_, o_) do { _Pragma("unroll") for (int _h = 0; _h < 2; ++_h) _Pragma("unroll") for (int _i = 0; _i < 2; ++_i) \
        o_[_h][_i] = ((unsigned)S.arow(u_, _h * HALF + Rr[_i]) * (unsigned)K + (unsigned)Cc[_i]) * 2u; } while (0)
#define PG8_LDA(dst, b, h) do { _Pragma("unroll") for (int m = 0; m < 4; ++m) { dst[m][0] = *(const LAS bf16x8*)(lds + PG8_SA(b, h) + aoff0 + m * 2048); dst[m][1] = *(const LAS bf16x8*)(lds + PG8_SA(b, h) + aoff1 + m * 2048); } } while (0)
#define PG8_LDB(dst, b, h) do { _Pragma("unroll") for (int n = 0; n < 2; ++n) { dst[n][0] = *(const LAS bf16x8*)(lds + PG8_SB(b, h) + boff0 + n * 2048); dst[n][1] = *(const LAS bf16x8*)(lds + PG8_SB(b, h) + boff1 + n * 2048); } } while (0)
#define PG8_V8(x_) __builtin_shufflevector(__builtin_bit_cast(v4i32, (x_)[0]), __builtin_bit_cast(v4i32, (x_)[1]), 0, 1, 2, 3, 4, 5, 6, 7)
#define PG8_MMA(ai, bj, At, Bt) do { __builtin_amdgcn_s_setprio(1); _Pragma("unroll") for (int m = 0; m < 4; ++m) _Pragma("unroll") for (int n = 0; n < 2; ++n) { \
        if constexpr (F8) { const v8i32 b8_ = PG8_V8(Bt[n]), a8_ = PG8_V8(At[m]);   \
            asm volatile("v_mfma_scale_f32_16x16x128_f8f6f4 %0, %1, %2, %0, %3, %4 op_sel_hi:[0,0,0]" : "+v"(acc[ai][bj][m][n]) : "v"(b8_), "v"(a8_), "v"(sc_w), "v"(sc_a)); } \
        else { _Pragma("unroll") for (int k = 0; k < 2; ++k) acc[ai][bj][m][n] = __builtin_amdgcn_mfma_f32_16x16x32_bf16(Bt[n][k], At[m][k], acc[ai][bj][m][n], 0, 0, 0); } } \
        __builtin_amdgcn_s_setprio(0); } while (0)
#define PG8_WAIT_V(n) asm volatile("s_waitcnt vmcnt(" #n ")" ::: "memory")
#define PG8_WAIT_L(n) asm volatile("s_waitcnt lgkmcnt(" #n ")" ::: "memory")
#define PG8_BAR __builtin_amdgcn_s_barrier()
#define PG8_SCHED __builtin_amdgcn_sched_barrier(0)
    const int sc_w = 0x7a7a7a7a  , sc_a = 0x7f7f7f7f  ; (void)sc_w; (void)sc_a;
    Unit cur, nxt; int ui = 0; int relaxN = 0;
    if (!S.next(0, cur)) return;
    unsigned gC[2][2], gN[2][2];
    if constexpr (Sched::GATHER) { PG8_GOFF(cur, gC); }
    else {
#pragma unroll
        for (int h = 0; h < 2; ++h)
#pragma unroll
            for (int i = 0; i < 2; ++i) { gC[h][i] = 0u; gN[h][i] = 0u; } }
    f32x4 acc[2][2][4][2];
#pragma unroll
    for (int a = 0; a < 2; ++a)
#pragma unroll
        for (int b = 0; b < 2; ++b)
#pragma unroll
            for (int m = 0; m < 4; ++m)
#pragma unroll
                for (int n = 0; n < 2; ++n) acc[a][b][m][n] = (f32x4){0.f, 0.f, 0.f, 0.f};
    bf16x8 At[4][2], B0[2][2], B1[2][2];
    unsigned cA = Sched::GATHER ? 0u : (unsigned)cur.pm * tstep, cB = (unsigned)cur.pn * tstepB, cB2 = (unsigned)cur.pn2 * tstepB - (unsigned)ntB * kstep;
    PG8_STAGE(PG8_SB(0, 0), cB, voffB); PG8_STAGE(PG8_SB(0, 1), cB + hstepB, voffB); PG8_STAGE_A(PG8_SA(0, 0), 0, cA, 0, false); PG8_STAGE_A(PG8_SA(0, 1), 1, cA + hstep, 0, false);
    if (wr == 1) PG8_BAR;
    PG8_WAIT_V(2); PG8_BAR;
    PG8_STAGE(PG8_SB(1, 0), cB + kstep, voffB); PG8_STAGE_A(PG8_SA(1, 0), 0, cA + kstep, kstep, false); PG8_STAGE(PG8_SB(1, 1), cB + hstepB + kstep, voffB);
    PG8_WAIT_V(6); PG8_BAR;
    for (;;) {
        const bool has_next = S.next(ui + 1, nxt);
        int gtok[2][2];
        if constexpr (Sched::GATHER) {
#pragma unroll
            for (int h = 0; h < 2; ++h)
#pragma unroll
                for (int i = 0; i < 2; ++i) gtok[h][i] = has_next ? S.arow(nxt, h * HALF + Rr[i]) : 0; }
        const unsigned nA = (has_next && !Sched::GATHER) ? (unsigned)nxt.pm * tstep : cA, nB = has_next ? (unsigned)nxt.pn * tstepB : cB, nB2 = has_next ? (unsigned)nxt.pn2 * tstepB - (unsigned)ntB * kstep : cB2;
        for (int t = 0; t < nt; t += 2) {
            const bool last = (t == nt - 2);
            const unsigned a1 = cA + (unsigned)(t + 1) * kstep;
            const unsigned a2 = last ? nA : cA + (unsigned)(t + 2) * kstep, b2 = last ? nB : ((t + 2) < ntB ? cB : cB2) + (unsigned)(t + 2) * kstep;
            const unsigned a3 = a2 + kstep, b3 = last ? nB + kstep : ((t + 3) < ntB ? cB : cB2) + (unsigned)(t + 3) * kstep;
            const unsigned k1 = (unsigned)(t + 1) * kstep, k2 = last ? 0u : (unsigned)(t + 2) * kstep, k3 = k2 + kstep;
            if constexpr (Sched::GATHER) { if (last) {
#pragma unroll
                for (int h = 0; h < 2; ++h)
#pragma unroll
                    for (int i = 0; i < 2; ++i) gN[h][i] = has_next ? ((unsigned)gtok[h][i] * (unsigned)K + (unsigned)Cc[i]) * 2u : gC[h][i]; } }
            const bool first = (t == 0), rlx = first && relaxN > 0, halfu = cur.nvalid <= 128;
#define PG8_WAIT_VR() do { if (rlx) { if (relaxN == 8) PG8_WAIT_V(16); else if (relaxN == 16) PG8_WAIT_V(24); else PG8_WAIT_V(8); } else PG8_WAIT_V(8); } while (0)
            PG8_LDB(B0, 0, 0); PG8_LDB(B1, 0, 1); PG8_SCHED; PG8_LDA(At, 0, 0); if (!(first && ui > 0)) PG8_STAGE_A(PG8_SA(1, 1), 1, a1 + hstep, k1, false);
            PG8_WAIT_VR(); PG8_WAIT_L(0); PG8_BAR; PG8_MMA(0, 0, At, B0); PG8_MMA(0, 1, At, B1); PG8_BAR; PG8_SCHED;
            PG8_LDA(At, 0, 1); PG8_STAGE(PG8_SB(0, 0), b2, voffB); PG8_STAGE(PG8_SB(0, 1), b2 + hstepB, voffB); PG8_STAGE_A(PG8_SA(0, 0), 0, a2, k2, last);
            PG8_WAIT_VR(); PG8_WAIT_L(0); PG8_BAR; if (!halfu) { PG8_MMA(1, 0, At, B0); PG8_MMA(1, 1, At, B1); } PG8_BAR; PG8_SCHED;
            PG8_LDB(B0, 1, 0); PG8_LDB(B1, 1, 1); PG8_SCHED; PG8_LDA(At, 1, 0); PG8_STAGE_A(PG8_SA(0, 1), 1, a2 + hstep, k2, last);
            PG8_WAIT_VR(); PG8_WAIT_L(0); PG8_BAR; PG8_MMA(0, 0, At, B0); PG8_MMA(0, 1, At, B1); PG8_BAR; PG8_SCHED;
            PG8_LDA(At, 1, 1); PG8_STAGE(PG8_SB(1, 0), b3, voffB); PG8_STAGE(PG8_SB(1, 1), b3 + hstepB, voffB); PG8_STAGE_A(PG8_SA(1, 0), 0, a3, k3, last);
            PG8_WAIT_V(8); PG8_WAIT_L(0); PG8_BAR; if (!halfu) { PG8_MMA(1, 0, At, B0); PG8_MMA(1, 1, At, B1); } PG8_BAR; PG8_SCHED;
            if (last && has_next) { PG8_STAGE_A(PG8_SA(1, 1), 1, a3 + hstep, k3, true); PG8_SCHED; }
#undef PG8_WAIT_VR
        }
        if (wr == 0) PG8_BAR;
        if constexpr (F8) asm volatile("s_nop 15\n\ts_nop 15" ::: "memory");
        E(acc, cur, wr, wc, fr, fq);
        relaxN = has_next ? E.stores_lb(cur) : 0;
        if (!has_next) break;
#pragma unroll
        for (int a = 0; a < 2; ++a)
#pragma unroll
            for (int b = 0; b < 2; ++b)
#pragma unroll
                for (int m = 0; m < 4; ++m)
#pragma unroll
                    for (int n = 0; n < 2; ++n) acc[a][b][m][n] = (f32x4){0.f, 0.f, 0.f, 0.f};
        cur = nxt; cA = nA; cB = nB; cB2 = nB2; ++ui;
#pragma unroll
        for (int h = 0; h < 2; ++h)
#pragma unroll
            for (int i = 0; i < 2; ++i) gC[h][i] = gN[h][i];
        if (wr == 1) PG8_BAR;
    }
    PG8_WAIT_V(0);
    PG8_BAR;
#undef PG8_SA
#undef PG8_SB
#undef PG8_STAGE
#undef PG8_STAGE_A
#undef PG8_GOFF
#undef PG8_LDA
#undef PG8_LDB
#undef PG8_MMA
#undef PG8_V8
#undef PG8_WAIT_V
#undef PG8_WAIT_L
#undef PG8_BAR
#undef PG8_SCHED
}
}
using pg8::Unit; using pg8::Gemm; using pg8::HALF; using pg8::BM;

#if USE_FAST_GEMM
#define GEMM_PHASE(EpiT, SchedT, lds, g, S, E) pg8::gemm_phase<EpiT, SchedT>(F.wave0, fresh_lane(), lds, g, S, E)
#define GEMM_PHASE_F8(EpiT, SchedT, lds, g, S, E) pg8::gemm_phase<EpiT, SchedT, true>(F.wave0, fresh_lane(), lds, g, S, E)
#else
#define GEMM_PHASE(EpiT, SchedT, lds, g, S, E) pg8::gemm_simple<EpiT, SchedT>(F.wave0, fresh_lane(), g, S, E)
#endif

__device__ __forceinline__ void st_bf8(bf16* p, f32x4 a, f32x4 b) { u32x4 w; w.x = pk2(a.x, a.y); w.y = pk2(a.z, a.w); w.z = pk2(b.x, b.y); w.w = pk2(b.z, b.w); *(u32x4*)p = w; }
__device__ __forceinline__ float lane32_partner(float v, bool upper) {
    auto rr = __builtin_amdgcn_permlane32_swap(__float_as_uint(v), __float_as_uint(v), false, false); return __uint_as_float(upper ? rr[0] : rr[1]);
}
struct EpiInProj {
    static constexpr bool PERM = true, AFTER_DRAIN = false;
    bf16* PROJ; bf16* Q; bf16* KB; bf16* VB; const LAS float* tabc; const LAS float* tabs; int pn_off;
    __device__ __forceinline__ int stores_lb(const Unit& u) const { return (u.pn + pn_off) < 8 ? 8 : 16; }
    __device__ __forceinline__ void operator()(const f32x4 (&acc)[2][2][4][2], const Unit& u, int wr, int wc, int fr, int fq) const {
        const int pn = u.pn + pn_off;
        if (pn < 8) {
#pragma unroll
            for (int ai = 0; ai < 2; ++ai)
#pragma unroll
                for (int m = 0; m < 4; ++m) { const int row = u.pm * BM + ai * HALF + wr * 64 + m * 16 + fr;
                    st_bf8(PROJ + (size_t)row * 2048 + pn * 128 + wc * 32 + 8 * fq, acc[ai][0][m][0] * acc[ai][1][m][0], acc[ai][0][m][1] * acc[ai][1][m][1]); }
        } else if (pn < 12) {
#pragma unroll
            for (int ai = 0; ai < 2; ++ai)
#pragma unroll
                for (int m = 0; m < 4; ++m) { const int row = u.pm * BM + ai * HALF + wr * 64 + m * 16 + fr; bf16* rp = PROJ + (size_t)row * 2048 + 1024 + (pn - 8) * 256 + wc * 32 + 8 * fq;
#pragma unroll
                    for (int bj = 0; bj < 2; ++bj) st_bf8(rp + bj * HALF, acc[ai][bj][m][0], acc[ai][bj][m][1]); }
        } else if (pn < 20) {
            const bool isq = pn < 16; const int cb = (pn - (isq ? 12 : 16)) * 256 + wc * 32 + 8 * fq; const size_t kb_minus_q = (size_t)((unsigned char*)KB - (unsigned char*)Q); const int axis = wc & 1; const bool upper = fq >= 2; const int fo = 8 * (fq & 1);
#pragma unroll
            for (int ai = 0; ai < 2; ++ai)
#pragma unroll
                for (int m = 0; m < 4; ++m) { const int row = u.pm * BM + ai * HALF + wr * 64 + m * 16 + fr; const int t = row & (SEQ - 1), b = row >> 13;
                    const int pos = axis ? (t & 63) : (t >> 6);
                    f32x4 cs0 = *(const LAS f32x4*)(tabc + pos * 16 + fo), cs1 = *(const LAS f32x4*)(tabc + pos * 16 + fo + 4); f32x4 sn0 = *(const LAS f32x4*)(tabs + pos * 16 + fo), sn1 = *(const LAS f32x4*)(tabs + pos * 16 + fo + 4);
                    if (!upper) { sn0 = -sn0; sn1 = -sn1; }
                    unsigned char* rp = (unsigned char*)Q + (isq ? ((size_t)row * 1024 + cb) : (kb_minus_q + ((size_t)b * KV + CTXL + t) * 1024 + cb));
                    if (isq) { cs0 = cs0 * QSCALE; cs1 = cs1 * QSCALE; sn0 = sn0 * QSCALE; sn1 = sn1 * QSCALE; }
#pragma unroll
                    for (int bj = 0; bj < 2; ++bj) { const f32x4 a0 = acc[ai][bj][m][0], a1 = acc[ai][bj][m][1];
                        const f32x4 p0 = (f32x4){lane32_partner(a0.x, upper), lane32_partner(a0.y, upper), lane32_partner(a0.z, upper), lane32_partner(a0.w, upper)};
                        const f32x4 p1 = (f32x4){lane32_partner(a1.x, upper), lane32_partner(a1.y, upper), lane32_partner(a1.z, upper), lane32_partner(a1.w, upper)};
                        st_f8x8(rp + bj * HALF, a0 * cs0 + p0 * sn0, a1 * cs1 + p1 * sn1); } }
        } else {
            const int cb = (pn - 20) * 256 + wc * 32 + 8 * fq;
#pragma unroll
            for (int ai = 0; ai < 2; ++ai)
#pragma unroll
                for (int m = 0; m < 4; ++m) { const int row = u.pm * BM + ai * HALF + wr * 64 + m * 16 + fr; const int t = row & (SEQ - 1), b = row >> 13;
                    unsigned char* rp = (unsigned char*)VB + ((size_t)b * KV + CTXL + t) * 1024 + cb;
#pragma unroll
                    for (int bj = 0; bj < 2; ++bj) st_f8x8(rp + bj * HALF, acc[ai][bj][m][0], acc[ai][bj][m][1]); }
        }
    }
};
struct EpiCtx {
    static constexpr bool PERM = true, AFTER_DRAIN = false;
    bf16* KB; bf16* VB;
    __device__ __forceinline__ int stores_lb(const Unit&) const { return 16; }
    __device__ __forceinline__ void operator()(const f32x4 (&acc)[2][2][4][2], const Unit& u, int wr, int wc, int fr, int fq) const {
        const bool isk = u.pn < 4; const int cb = (u.pn & 3) * 256 + wc * 32 + 8 * fq;
#pragma unroll
        for (int ai = 0; ai < 2; ++ai)
#pragma unroll
            for (int m = 0; m < 4; ++m) { const int row = u.pm * BM + ai * HALF + wr * 64 + m * 16 + fr; const int t = row & (CTXL - 1), b = row >> 8;
                const size_t eo = ((size_t)b * KV + t) * 1024 + cb;
#pragma unroll
                for (int bj = 0; bj < 2; ++bj) st_f8x8((unsigned char*)(isk ? KB : VB) + eo + bj * HALF, acc[ai][bj][m][0], acc[ai][bj][m][1]); }
    }
};
template <bool RES_F32> struct EpiRes {
    static constexpr bool PERM = true, AFTER_DRAIN = false;
    const float* xf; const bf16* xb; const float* gate  ; bf16* R;
    __device__ __forceinline__ int stores_lb(const Unit&) const { return 16; }
    struct Raw { f32x4 f[2][2][2]; u32x4 h[2][2]; };
    __device__ __forceinline__ void load(Raw& r, const Unit& u, int st, int wr, int fr, int cb) const {
        const int ai = st >> 1, mp = (st & 1) * 2;
#pragma unroll
        for (int mm = 0; mm < 2; ++mm) { const size_t off = (size_t)(u.pm * BM + ai * HALF + wr * 64 + (mp + mm) * 16 + fr) * D + cb;
#pragma unroll
            for (int bj = 0; bj < 2; ++bj) {
                if (RES_F32) { r.f[mm][bj][0] = *(const f32x4*)(xf + off + bj * HALF); r.f[mm][bj][1] = *(const f32x4*)(xf + off + bj * HALF + 4); }
                else r.h[mm][bj] = *(const u32x4*)(xb + off + bj * HALF); } }
    }
    __device__ __forceinline__ void operator()(const f32x4 (&acc)[2][2][4][2], const Unit& u, int wr, int wc, int fr, int fq) const {
        const int cb = u.pn * BM + wc * 32 + 8 * fq; const int b = (u.pm * BM) >> 13;
        f32x4 gv[2][2];
#pragma unroll
        for (int bj = 0; bj < 2; ++bj)
#pragma unroll
            for (int n = 0; n < 2; ++n) gv[bj][n] = *(const f32x4*)(gate + (size_t)b * (6 * D) + cb + bj * HALF + 4 * n);
        Raw ra, rb2; load(ra, u, 0, wr, fr, cb);
#pragma unroll
        for (int st = 0; st < 4; ++st) {
            Raw& cur = (st & 1) ? rb2 : ra; Raw& nxt = (st & 1) ? ra : rb2;
            if (st < 3) load(nxt, u, st + 1, wr, fr, cb);
            const int ai = st >> 1, mp = (st & 1) * 2;
#pragma unroll
            for (int mm = 0; mm < 2; ++mm) { const size_t off = (size_t)(u.pm * BM + ai * HALF + wr * 64 + (mp + mm) * 16 + fr) * D + cb;
#pragma unroll
                for (int bj = 0; bj < 2; ++bj) { f32x4 r0, r1;
                    if (RES_F32) { r0 = cur.f[mm][bj][0]; r1 = cur.f[mm][bj][1]; }
                    else { const u32x4 w = cur.h[mm][bj]; r0 = (f32x4){bf_lo(w.x), bf_hi(w.x), bf_lo(w.y), bf_hi(w.y)}; r1 = (f32x4){bf_lo(w.z), bf_hi(w.z), bf_lo(w.w), bf_hi(w.w)}; }
                    st_bf8(R + off + bj * HALF, r0 * ALPHA + gv[bj][0] * acc[ai][bj][mp + mm][0], r1 * ALPHA + gv[bj][1] * acc[ai][bj][mp + mm][1]); } }
        }
    }
};
struct EpiGU {
    static constexpr bool PERM = true, AFTER_DRAIN = false;
    unsigned char* HID;
    const int4* list;
    __device__ __forceinline__ int stores_lb(const Unit&) const { return 8; }
    __device__ __forceinline__ void operator()(const f32x4 (&acc)[2][2][4][2], const Unit& u, int wr, int wc, int fr, int fq) const {
        const int cb = u.sub * 128 + wc * 32 + 8 * fq; const bool hiw = u.sub >= 4;
        float wgt[2][4];
#pragma unroll
        for (int ai = 0; ai < 2; ++ai)
#pragma unroll
            for (int m = 0; m < 4; ++m) { const int rl = ai * HALF + wr * 64 + m * 16 + fr; const int4 le = list[u.lbase + (rl < u.nvalid ? rl : 0)]; wgt[ai][m] = __int_as_float(hiw ? le.z : le.y); }
#pragma unroll
        for (int ai = 0; ai < 2; ++ai)
#pragma unroll
            for (int m = 0; m < 4; ++m) { const int row = u.pm * BM + ai * HALF + wr * 64 + m * 16 + fr; const float w_ = wgt[ai][m];
                const f32x4 g0 = acc[ai][0][m][0], g1 = acc[ai][0][m][1], u0 = acc[ai][1][m][0] * w_, u1 = acc[ai][1][m][1] * w_; u32x2 w;
                w.x = pk4_fp8(silu_f(g0.x) * u0.x, silu_f(g0.y) * u0.y, silu_f(g0.z) * u0.z, silu_f(g0.w) * u0.w); w.y = pk4_fp8(silu_f(g1.x) * u1.x, silu_f(g1.y) * u1.y, silu_f(g1.z) * u1.z, silu_f(g1.w) * u1.w);
                *(u32x2*)(HID + (size_t)row * (2 * ED) + cb) = w; }
    }
};
struct EpiDown {
    static constexpr bool PERM = true, AFTER_DRAIN = false;
    const int4* list; bf16* YB;
    __device__ __forceinline__ int stores_lb(const Unit& u) const { return u.nvalid == 256 ? 16 : 0; }
    __device__ __forceinline__ void operator()(const f32x4 (&acc)[2][2][4][2], const Unit& u, int wr, int wc, int fr, int fq) const {
        const int cb = u.sub * 256 + wc * 32 + 8 * fq;
        int tok[2][4];
#pragma unroll
        for (int ai = 0; ai < 2; ++ai)
#pragma unroll
            for (int m = 0; m < 4; ++m) { const int rl = ai * HALF + wr * 64 + m * 16 + fr; tok[ai][m] = list[u.lbase + (rl < u.nvalid ? rl : 0)].x; }
#pragma unroll
        for (int ai = 0; ai < 2; ++ai)
#pragma unroll
            for (int m = 0; m < 4; ++m) { const int rl = ai * HALF + wr * 64 + m * 16 + fr;
                if (rl < u.nvalid) { bf16* rp = YB + (size_t)tok[ai][m] * D + cb;
#pragma unroll
                    for (int bj = 0; bj < 2; ++bj) st_bf8(rp + bj * HALF, acc[ai][bj][m][0], acc[ai][bj][m][1]); } }
    }
};
struct EpiGelu {
    static constexpr bool PERM = true, AFTER_DRAIN = false;
    bf16* UV; float* vst;
    __device__ __forceinline__ int stores_lb(const Unit&) const { return 16; }
    __device__ __forceinline__ void operator()(const f32x4 (&acc)[2][2][4][2], const Unit& u, int wr, int wc, int fr, int fq) const {
        const int cb = u.pn * BM + wc * 32 + 8 * fq; const bool isv = u.pn >= 8;
#pragma unroll
        for (int ai = 0; ai < 2; ++ai)
#pragma unroll
            for (int m = 0; m < 4; ++m) { const int row = u.pm * BM + ai * HALF + wr * 64 + m * 16 + fr; bf16* rp = UV + (size_t)row * 4096 + cb; float s = 0.f, s2 = 0.f;
#pragma unroll
                for (int bj = 0; bj < 2; ++bj) { f32x4 v[2];
#pragma unroll
                    for (int n = 0; n < 2; ++n) { const f32x4 a = acc[ai][bj][m][n]; v[n] = (f32x4){gelu_tanh_f(a.x), gelu_tanh_f(a.y), gelu_tanh_f(a.z), gelu_tanh_f(a.w)};
                        s += (v[n].x + v[n].y) + (v[n].z + v[n].w); s2 += (v[n].x * v[n].x + v[n].y * v[n].y) + (v[n].z * v[n].z + v[n].w * v[n].w); }
                    st_bf8(rp + bj * HALF, v[0], v[1]); }
                if (isv) { s += __shfl_xor(s, 16); s += __shfl_xor(s, 32); s2 += __shfl_xor(s2, 16); s2 += __shfl_xor(s2, 32);
                    if (fq == 0) *(f32x2*)(vst + (((size_t)row * 8 + (u.pn - 8)) * 4 + wc) * 2) = (f32x2){s, s2}; } }
    }
};

__device__ __forceinline__ int fresh_lane() { int l; asm volatile("v_mbcnt_lo_u32_b32 %0, -1, 0\n\tv_mbcnt_hi_u32_b32 %0, -1, %0" : "=v"(l)); return l; }
#define fresh_tid() (F.wave0 * 64 + fresh_lane())
#define PH_IDS const int lane = fresh_lane(), wave = F.wave0, tid = wave * 64 + lane; (void)tid; (void)lane; (void)wave
struct Frame {
    LAS unsigned char* lds; volatile LAS unsigned* MISC; unsigned* ctl;
    int vcu, G, wave0;
    const float* in[27]; float* out; unsigned char* ws;
};
#define WSP(T, off) ((T*)(F.ws + (off)))
#define MODP(l, r, i) (WSP(float, WS_MOD) + (((l) * 5 + (r)) * 6 + (i)) * D)

__device__ __forceinline__ void tr_item(const float* W, int N, bf16* WT, int Kd, int item, int mode, LAS float* scr, int lane) {
    const int nblk = N / 32, kb = item / nblk, nb = item - kb * nblk, k0 = 64 * kb, n0 = 32 * nb;
    int d0 = mode ? (((n0 >> 7) << 8) + (n0 & 127) + (mode == 2 ? 128 : 0)) : n0;
    if (mode == 3) { const int c = n0 & 1023; d0 = n0 >= 3072 ? n0 : n0 < 1024 ? (((c >> 7) << 8) + (c & 127)) : n0 < 2048 ? 2048 + c : (((c >> 7) << 8) + 128 + (c & 127)); }
#pragma unroll 8
    for (int i = 0; i < 32; ++i) { const int kk = 2 * i + (lane >> 5); scr[kk * 33 + (lane & 31)] = W[(size_t)(k0 + kk) * N + n0 + (lane & 31)]; }
    LDS_WAIT(); asm volatile("" ::: "memory");
    const int c = lane & 7;
#pragma unroll
    for (int j = 0; j < 4; ++j) { const int n = (lane >> 3) + 8 * j; const LAS float* s = scr + (8 * c) * 33 + n;
        u32x4 o; o.x = pk2(s[0 * 33], s[1 * 33]); o.y = pk2(s[2 * 33], s[3 * 33]); o.z = pk2(s[4 * 33], s[5 * 33]); o.w = pk2(s[6 * 33], s[7 * 33]);
        *(u32x4*)(WT + (size_t)(d0 + n) * Kd + k0 + 8 * c) = o; }
    LDS_WAIT(); asm volatile("" ::: "memory");
}
constexpr int CW_I_EXP = 512, CW_I_GU = 16 * CW_I_EXP, CW_I_SQ = 32 * 64;
struct TrDesc { const float* src; bf16* dst; int N, Kd; bool f8; };
template <int L> __device__ __forceinline__ TrDesc tr_desc(Frame& F, int it) {
    constexpr int I_IN = L == 0 ? 32 * 192 : 32 * 128;
    const float* W; bf16* WT; int N, Kd, mode, q; int r = it;
    bool f8 = false;
    if (r < CW_I_GU) { const int le = L * 16 + (r >> 9); q = r & 511; W = F.in[24] + (size_t)le * D * ED; N = ED; WT = (bf16*)(WSP(unsigned char, WS_WGU) + (size_t)le * 1024 * D); Kd = D; mode = 1; f8 = true; }
    else if (r < 2 * CW_I_GU) { r -= CW_I_GU; const int le = L * 16 + (r >> 9); q = r & 511; W = F.in[25] + (size_t)le * D * ED; N = ED; WT = (bf16*)(WSP(unsigned char, WS_WGU) + (size_t)le * 1024 * D); Kd = D; mode = 2; f8 = true; }
    else if (r < 2 * CW_I_GU + I_IN) { q = r - 2 * CW_I_GU; W = L == 0 ? F.in[8] : F.in[16]; N = L == 0 ? 6144 : 4096; WT = L == 0 ? WSP(bf16, WS_WINE) : WSP(bf16, WS_WINO); Kd = D; mode = L == 0 ? 3 : 0; f8 = L == 1; }
    else if (r < 2 * CW_I_GU + I_IN + CW_I_SQ) { q = r - 2 * CW_I_GU - I_IN; W = L == 0 ? F.in[15] : F.in[21]; N = D; WT = L == 0 ? WSP(bf16, WS_WOUTE) : WSP(bf16, WS_WOUTO); Kd = D; mode = 0; f8 = true; }
    else { r -= 2 * CW_I_GU + I_IN + CW_I_SQ; const int le = L * 16 + (r >> 9); q = r & 511; W = F.in[26] + (size_t)le * ED * D; N = D; WT = (bf16*)(WSP(unsigned char, WS_WDN) + (size_t)le * D * ED); Kd = ED; mode = 0; f8 = true; }
    const int nblk = N / 32, kb = q / nblk, nb = q - kb * nblk, k0 = 64 * kb, n0 = 32 * nb;
    int d0 = mode ? (((n0 >> 7) << 8) + (n0 & 127) + (mode == 2 ? 128 : 0)) : n0;
    if (mode == 3) { const int c = n0 & 1023; d0 = n0 >= 3072 ? n0 : n0 < 1024 ? (((c >> 7) << 8) + (c & 127)) : n0 < 2048 ? 2048 + c : (((c >> 7) << 8) + 128 + (c & 127)); }
    if (mode == 3) f8 = true;
    TrDesc d; d.src = W + (size_t)k0 * N + n0; d.dst = f8 ? (bf16*)((unsigned char*)WT + (size_t)d0 * Kd + k0) : WT + (size_t)d0 * Kd + k0; d.N = N; d.Kd = Kd; d.f8 = f8; return d;
}
template <int L> __device__ __forceinline__ void convert_weights(Frame& F, int gw, int NGW, int wave, int lane, int lo, int hi) {
    LAS float* scr = (LAS float*)(F.lds + wave * 16384);
    int it = lo + gw; if (it >= hi) return;
    float rg[32]; TrDesc cur = tr_desc<L>(F, it);
#pragma unroll
    for (int i = 0; i < 32; ++i) rg[i] = cur.src[(size_t)(2 * i + (lane >> 5)) * cur.N + (lane & 31)];
    for (;;) {
#pragma unroll
        for (int i = 0; i < 32; ++i) scr[(2 * i + (lane >> 5)) * 33 + (lane & 31)] = rg[i];
        LDS_WAIT(); asm volatile("" ::: "memory");
        const int nit = it + NGW; const bool more = nit < hi; TrDesc nx = cur;
        if (more) { nx = tr_desc<L>(F, nit);
#pragma unroll
            for (int i = 0; i < 32; ++i) rg[i] = nx.src[(size_t)(2 * i + (lane >> 5)) * nx.N + (lane & 31)]; }
        if (cur.f8) {
            const int c = lane & 3;
#pragma unroll
            for (int j = 0; j < 2; ++j) { const int n = (lane >> 2) + 16 * j; const LAS float* sp = scr + (16 * c) * 33 + n; u32x4 o;
                o.x = pk4_fp8(sp[0 * 33] * W8_SCALE, sp[1 * 33] * W8_SCALE, sp[2 * 33] * W8_SCALE, sp[3 * 33] * W8_SCALE); o.y = pk4_fp8(sp[4 * 33] * W8_SCALE, sp[5 * 33] * W8_SCALE, sp[6 * 33] * W8_SCALE, sp[7 * 33] * W8_SCALE);
                o.z = pk4_fp8(sp[8 * 33] * W8_SCALE, sp[9 * 33] * W8_SCALE, sp[10 * 33] * W8_SCALE, sp[11 * 33] * W8_SCALE); o.w = pk4_fp8(sp[12 * 33] * W8_SCALE, sp[13 * 33] * W8_SCALE, sp[14 * 33] * W8_SCALE, sp[15 * 33] * W8_SCALE);
                *(u32x4*)((unsigned char*)cur.dst + (size_t)n * cur.Kd + 16 * c) = o; }
        } else {
        const int c = lane & 7;
#pragma unroll
        for (int j = 0; j < 4; ++j) { const int n = (lane >> 3) + 8 * j; const LAS float* sp = scr + (8 * c) * 33 + n;
            u32x4 o; o.x = pk2(sp[0 * 33], sp[1 * 33]); o.y = pk2(sp[2 * 33], sp[3 * 33]); o.z = pk2(sp[4 * 33], sp[5 * 33]); o.w = pk2(sp[6 * 33], sp[7 * 33]);
            *(u32x4*)(cur.dst + (size_t)n * cur.Kd + 8 * c) = o; }
        }
        LDS_WAIT(); asm volatile("" ::: "memory");
        if (!more) break;
        it = nit; cur = nx;
    }
}
constexpr int CW_N0 = 3 * CW_I_GU + 32 * 192 + CW_I_SQ, CW_N1 = 3 * CW_I_GU + 32 * 128 + CW_I_SQ, CW_SPLIT1 = 2 * CW_I_GU;
__device__ __forceinline__ void p0_prologue(Frame& F) {
    PH_IDS;
    {
        LAS float* sl = (LAS float*)F.lds;
        LAS float* part = (LAS float*)(F.lds + 40960);
        for (int i = tid; i < 5 * D; i += 512) { const int r = i >> 11, k = i & (D - 1); const float v = r < 4 ? F.in[1][r * D + k] : F.in[3][k]; sl[i] = silu_f(v); }
        __syncthreads();
        const int kg = tid >> 3, cg = tid & 7;
        for (int it = F.vcu; it < 768; it += F.G) {
            const int l = it / 384, c0 = (it - l * 384) * 32;
            const float* wm = F.in[4] + (size_t)l * D * 12288 + c0 + 4 * cg;
            f32x4 a0 = {0, 0, 0, 0}, a1 = a0, a2 = a0, a3 = a0, a4 = a0;
#pragma unroll 8
            for (int i = 0; i < 32; ++i) { const int k = kg + 64 * i; const f32x4 w = *(const f32x4*)(wm + (size_t)k * 12288);
                a0 += w * sl[k]; a1 += w * sl[D + k]; a2 += w * sl[2 * D + k]; a3 += w * sl[3 * D + k]; a4 += w * sl[4 * D + k]; }
            LAS float* pp = part + kg * 160 + 4 * cg;
            *(LAS f32x4*)(pp) = a0; *(LAS f32x4*)(pp + 32) = a1; *(LAS f32x4*)(pp + 64) = a2; *(LAS f32x4*)(pp + 96) = a3; *(LAS f32x4*)(pp + 128) = a4;
            __syncthreads();
            if (tid < 160) { float s = 0.f;
#pragma unroll 8
                for (int g = 0; g < 64; ++g) s += part[g * 160 + tid];
                const int r = tid >> 5, cc = tid & 31;
                WSP(float, WS_MOD)[(size_t)(l * 5 + r) * 12288 + c0 + cc] = s + F.in[5][l * 12288 + c0 + cc]; }
            __syncthreads();
        }
    }
    {
        const int gid = F.vcu * 512 + tid;
        if (gid < 2048) { const int pos = gid >> 4, f = gid & 15;
            const float inv = exp2f(-(float)f * (13.287712379549449f / 16.0f)); const float ang = (float)pos * inv;
            const float k = rintf(ang * 0.15915494309189535f); float r = fmaf(-k, 6.2831854820251465f, ang); r = fmaf(-k, -1.7484555e-7f, r);
            WSP(float, WS_TAB)[gid] = __cosf(r); WSP(float, WS_TAB)[2048 + gid] = __sinf(r); }
        for (int i = gid; i < 16 * 128 * 128; i += F.G * 512) WSP(bf16, WS_WSB)[i] = (bf16)f2bf(F.in[19][i]);
    }
    convert_weights<0>(F, F.vcu * NWAVES + wave, F.G * NWAVES, wave, lane, 0, CW_N0);
}
__device__ __forceinline__ void p1_modulate(Frame& F) {
    PH_IDS;
    LAS float* P_s = (LAS float*)F.lds; LAS float* P_h = P_s + D;
    for (int rw = F.vcu * NWAVES + wave; rw < 128; rw += F.G * NWAVES) { const int Lr = rw >> 6, br = (rw >> 4) & 3, e = rw & 15; const float* sh = MODP(Lr, br, 3); const float* sc = MODP(Lr, br, 4);
        const float* lg = F.in[6] + (Lr * 2 + 0) * D; const float* lb = F.in[7] + (Lr * 2 + 0) * D;
        bf16* wh = WSP(bf16, WS_WRT2) + (size_t)((Lr * 4 + br) * 32 + e) * D; bf16* wl = wh + 16 * D; float c1 = 0.f, c2 = 0.f;
        for (int k = lane; k < D; k += 64) { const float w0 = F.in[22][k * 16 + e], m1 = 1.0f + sc[k]; const float w = lg[k] * m1 * w0; c2 += (lb[k] * m1 + sh[k]) * w0;
            const unsigned hb = f2bf(w); const float whf = __uint_as_float(hb << 16); const unsigned lob = f2bf(w - whf); wh[k] = (bf16)hb; wl[k] = (bf16)lob; c1 += whf + __uint_as_float(lob << 16); }
#pragma unroll
        for (int o = 1; o < 64; o <<= 1) { c1 += __shfl_xor(c1, o); c2 += __shfl_xor(c2, o); }
        if (lane == 0) { WSP(float, WS_RC)[(Lr * 4 + br) * 32 + e] = c1; WSP(float, WS_RC)[(Lr * 4 + br) * 32 + 16 + e] = c2; } }
    for (int blk = F.vcu; blk < M / 128; blk += F.G) {
        const int rowb = blk * 128 + wave * 16, b = rowb >> 13;
        __syncthreads();
        for (int i = tid; i < D; i += 512) { P_s[i] = 1.0f + MODP(0, b, 1)[i]; P_h[i] = MODP(0, b, 0)[i]; }
        __syncthreads();
        f32x4 rx[8];
#define P1_LOAD(r_) do { _Pragma("unroll") for (int j = 0; j < 4; ++j) { const float* p_ = F.in[0] + (size_t)(r_) * D + 512 * j + 8 * lane; rx[2 * j] = *(const f32x4*)p_; rx[2 * j + 1] = *(const f32x4*)(p_ + 4); } } while (0)
        P1_LOAD(rowb);
#pragma unroll 1
        for (int rr = 0; rr < 16; ++rr) {
            const int row = rowb + rr; u32x2 w8[4];
#pragma unroll
            for (int j = 0; j < 4; ++j) { const int c = 512 * j + 8 * lane;
                const f32x4 sa = *(const LAS f32x4*)(P_s + c), sb = *(const LAS f32x4*)(P_s + c + 4), ha = *(const LAS f32x4*)(P_h + c), hb = *(const LAS f32x4*)(P_h + c + 4);
                const f32x4 y0 = rx[2 * j] * sa + ha, y1 = rx[2 * j + 1] * sb + hb;
                w8[j].x = pk4_fp8(y0.x, y0.y, y0.z, y0.w); w8[j].y = pk4_fp8(y1.x, y1.y, y1.z, y1.w); }
            if (rr < 15) P1_LOAD(row + 1);
#pragma unroll
            for (int j = 0; j < 4; ++j) *(u32x2*)((unsigned char*)F.out + (size_t)M * D * 2 + (size_t)row * D + 512 * j + 8 * lane) = w8[j];
        }
#undef P1_LOAD
    }
    { const int gw = F.vcu * NWAVES + wave, NGW = F.G * NWAVES; const float* sh = MODP(0, 4, 0); const float* sc = MODP(0, 4, 1);
      for (int row = gw; row < MC; row += NGW) { const float* src = F.in[2] + (size_t)row * D; unsigned char* dst = (unsigned char*)F.out + (size_t)M * D * 2 + (size_t)M * D + (size_t)row * D;
#pragma unroll
          for (int j = 0; j < 8; ++j) { const int c = 256 * j + 4 * lane; const f32x4 v = *(const f32x4*)(src + c), s = *(const f32x4*)(sc + c), t = *(const f32x4*)(sh + c); const f32x4 y = v * (1.0f + s) + t; *(unsigned*)(dst + c) = pk4_fp8(y.x, y.y, y.z, y.w); } } }
}
__device__ __forceinline__ void conv_z(const bf16* proj, size_t row, int ch, float (&z)[8]) {
    const u32x4 w = *(const u32x4*)(proj + row * 2048 + ch);
    z[0] = bf_lo(w.x); z[1] = bf_hi(w.x); z[2] = bf_lo(w.y); z[3] = bf_hi(w.y); z[4] = bf_lo(w.z); z[5] = bf_hi(w.z); z[6] = bf_lo(w.w); z[7] = bf_hi(w.w);
}
__device__ __forceinline__ void conv_pass(Frame& F) {
    PH_IDS; const int gw = F.vcu * NWAVES + wave, NGW = F.G * NWAVES;
    const bf16* proj = WSP(bf16, WS_PROJ); unsigned char* mix = (unsigned char*)F.out;
    for (int it = gw; it < 2048; it += NGW) {
        const int run = it >> 1, ch = (it & 1) * 512 + lane * 8; const int r0 = run * 32;
        float w0[8], w1[8], w2[8];
#pragma unroll
        for (int i = 0; i < 8; ++i) { w0[i] = F.in[9][ch + i]; w1[i] = F.in[9][1024 + ch + i]; w2[i] = F.in[9][2048 + ch + i]; }
        u32x4 zq[6], bq[4];
        const bool first = (r0 & (SEQ - 1)) == 0, lastrun = ((r0 + 32) & (SEQ - 1)) == 0;
        zq[0] = first ? (u32x4){0u, 0u, 0u, 0u} : *(const u32x4*)(proj + ((size_t)r0 - 1) * 2048 + ch);
        zq[1] = *(const u32x4*)(proj + (size_t)r0 * 2048 + ch);
#pragma unroll 1
        for (int t = 0; t < 32; t += 4) { const size_t row = (size_t)r0 + t;
#pragma unroll
            for (int k = 0; k < 4; ++k) { const bool edge = lastrun && (t + k + 1 == 32);
                zq[2 + k] = edge ? (u32x4){0u, 0u, 0u, 0u} : *(const u32x4*)(proj + (row + k + 1) * 2048 + ch);
                bq[k] = *(const u32x4*)(proj + (row + k) * 2048 + 1024 + ch); }
#pragma unroll
            for (int k = 0; k < 4; ++k) { const u32x4 zp = zq[k], zc = zq[k + 1], zn = zq[k + 2], bg = bq[k]; float o[8];
#define CV_E(i_, W_, HI_) o[i_] = w0[i_] * (HI_ ? bf_hi(zp.W_) : bf_lo(zp.W_)) + w1[i_] * (HI_ ? bf_hi(zc.W_) : bf_lo(zc.W_)) + w2[i_] * (HI_ ? bf_hi(zn.W_) : bf_lo(zn.W_))
                CV_E(0, x, 0); CV_E(1, x, 1); CV_E(2, y, 0); CV_E(3, y, 1); CV_E(4, z, 0); CV_E(5, z, 1); CV_E(6, w, 0); CV_E(7, w, 1);
#undef CV_E
                u32x2 w; w.x = pk4_fp8(bf_lo(bg.x) * o[0], bf_hi(bg.x) * o[1], bf_lo(bg.y) * o[2], bf_hi(bg.y) * o[3]);
                w.y = pk4_fp8(bf_lo(bg.z) * o[4], bf_hi(bg.z) * o[5], bf_lo(bg.w) * o[6], bf_hi(bg.w) * o[7]);
                *(u32x2*)(mix + (row + k) * D + ch) = w; }
            zq[0] = zq[4]; zq[1] = zq[5];
        }
    }
}
__device__ __forceinline__ float lam_value(Frame& F, int lane) {
    const float a = wave_sum(F.in[10][lane] * F.in[11][lane]), b = wave_sum(F.in[12][lane] * F.in[13][lane]);
    return __expf(a) - __expf(b) + 0.2f;
}
__device__ __forceinline__ void attn_simple(Frame& F) {
    PH_IDS; const int gw = F.vcu * NWAVES + wave, NGW = F.G * NWAVES;
    const float lam = lam_value(F, lane);
    const bf16* Q = WSP(bf16, WS_Q); const bf16* KBp = WSP(bf16, WS_KB); const bf16* VBp = WSP(bf16, WS_VB); float* TMP = WSP(float, WS_H);
    for (int it = gw; it < 8192; it += NGW) {
        const int qb = it & 127, vc = (it >> 7) & 1, h = (it >> 8) & 7, b = it >> 11;
        const size_t qrow = (size_t)b * SEQ + qb * 64 + lane;
        float* tmp = TMP + (qrow * 8 + h) * 128 + vc * 64;
#pragma unroll 1
        for (int m = 0; m < 2; ++m) {
            float q[64], acc[64];
#pragma unroll
            for (int c = 0; c < 8; ++c) { const u32x4 w = *(const u32x4*)(Q + qrow * 1024 + h * 128 + m * 64 + c * 8); const float sc = 1.0f;
                q[8 * c + 0] = bf_lo(w.x) * sc; q[8 * c + 1] = bf_hi(w.x) * sc; q[8 * c + 2] = bf_lo(w.y) * sc; q[8 * c + 3] = bf_hi(w.y) * sc;
                q[8 * c + 4] = bf_lo(w.z) * sc; q[8 * c + 5] = bf_hi(w.z) * sc; q[8 * c + 6] = bf_lo(w.w) * sc; q[8 * c + 7] = bf_hi(w.w) * sc; }
#pragma unroll
            for (int i = 0; i < 64; ++i) acc[i] = 0.f;
            float mx = -1e30f, l = 0.f;
            const bf16* kp = KBp + (size_t)b * KV * 1024 + h * 128 + m * 64; const bf16* vp = VBp + (size_t)b * KV * 1024 + h * 128 + vc * 64;
#pragma unroll 1
            for (int j = 0; j < KV; ++j) {
                float s = 0.f;
#pragma unroll
                for (int c = 0; c < 8; ++c) { const u32x4 w = *(const u32x4*)(kp + (size_t)j * 1024 + c * 8);
                    s += q[8 * c + 0] * bf_lo(w.x) + q[8 * c + 1] * bf_hi(w.x) + q[8 * c + 2] * bf_lo(w.y) + q[8 * c + 3] * bf_hi(w.y)
                       + q[8 * c + 4] * bf_lo(w.z) + q[8 * c + 5] * bf_hi(w.z) + q[8 * c + 6] * bf_lo(w.w) + q[8 * c + 7] * bf_hi(w.w); }
                const float mn = fmaxf(mx, s), sc = exp2f(mx - mn), p = exp2f(s - mn); l = l * sc + p; mx = mn;
#pragma unroll
                for (int c = 0; c < 8; ++c) { const u32x4 w = *(const u32x4*)(vp + (size_t)j * 1024 + c * 8);
                    acc[8 * c + 0] = acc[8 * c + 0] * sc + p * bf_lo(w.x); acc[8 * c + 1] = acc[8 * c + 1] * sc + p * bf_hi(w.x);
                    acc[8 * c + 2] = acc[8 * c + 2] * sc + p * bf_lo(w.y); acc[8 * c + 3] = acc[8 * c + 3] * sc + p * bf_hi(w.y);
                    acc[8 * c + 4] = acc[8 * c + 4] * sc + p * bf_lo(w.z); acc[8 * c + 5] = acc[8 * c + 5] * sc + p * bf_hi(w.z);
                    acc[8 * c + 6] = acc[8 * c + 6] * sc + p * bf_lo(w.w); acc[8 * c + 7] = acc[8 * c + 7] * sc + p * bf_hi(w.w); }
            }
            const float inv = 1.0f / l;
            if (m == 0) {
#pragma unroll
                for (int i = 0; i < 64; i += 4) *(f32x4*)(tmp + i) = (f32x4){acc[i] * inv, acc[i + 1] * inv, acc[i + 2] * inv, acc[i + 3] * inv};
            } else {
#pragma unroll
                for (int i = 0; i < 64; i += 4) { const f32x4 t0 = *(const f32x4*)(tmp + i);
                    *(f32x4*)(tmp + i) = (f32x4){t0.x - lam * acc[i] * inv, t0.y - lam * acc[i + 1] * inv, t0.z - lam * acc[i + 2] * inv, t0.w - lam * acc[i + 3] * inv}; }
            }
        }
    }
}
__device__ __forceinline__ void attn_finish(Frame& F) {
    PH_IDS; const int gw = F.vcu * NWAVES + wave, NGW = F.G * NWAVES;
    const float* TMP = WSP(float, WS_H); bf16* mix = (bf16*)F.out;
    for (int row = gw; row < M; row += NGW) {
        f32x4 v[4]; float ss = 0.f;
#pragma unroll
        for (int i = 0; i < 4; ++i) { v[i] = *(const f32x4*)(TMP + (size_t)row * 1024 + lane * 16 + 4 * i); ss += (v[i].x * v[i].x + v[i].y * v[i].y) + (v[i].z * v[i].z + v[i].w * v[i].w); }
        ss += __shfl_xor(ss, 1); ss += __shfl_xor(ss, 2); ss += __shfl_xor(ss, 4);
        const float rs = 0.8f / sqrtf(ss * (1.0f / 128.0f) + LN_EPS);
#pragma unroll
        for (int i = 0; i < 4; ++i) { const f32x4 g = *(const f32x4*)(F.in[14] + ((lane * 16 + 4 * i) & 127)); st_bf4(mix + (size_t)row * D + 1024 + lane * 16 + 4 * i, v[i] * g * rs); }
    }
}
namespace att {
using f32x16 = __attribute__((ext_vector_type(16))) float;
using s16x4 = __attribute__((ext_vector_type(4))) short;
constexpr int QBLK = 32, KVBLK = 64, SHM_V = 16384, SHM_K = 8192, L_K = 0, L_V = 4 * SHM_K, L_WS = L_V + 4 * SHM_V, L_OST = 0, OST_LD = 136;
constexpr float SCALE = 0.125f, THR = 8.f;
#define ATT_KSW(row, c) ((row) * 128 + ((((c) ^ ((row) >> 1)) & 7) << 4))
#define ATT_SBAR() __builtin_amdgcn_sched_barrier(0)
__device__ __forceinline__ int crow(int r, int hi) { return (r & 3) + 8 * (r >> 2) + 4 * hi; }
__device__ __forceinline__ unsigned cvtpk(float lo, float hi) { unsigned r; asm volatile("v_cvt_pk_bf16_f32 %0, %1, %2" : "=v"(r) : "v"(lo), "v"(hi)); return r; }
template <bool FIRST> __device__ __forceinline__ void partialSM(f32x16& p0, f32x16& p1, f32x16& negm, float& alpha) {
    constexpr float THR2 = 8.0f, PBIAS = 4.0f;
    float m0 = fmaxf(fmaxf(p0[0], p0[1]), p0[2]), m1 = fmaxf(fmaxf(p1[0], p1[1]), p1[2]);
#pragma unroll
    for (int r = 3; r < 15; r += 2) { m0 = fmaxf(fmaxf(m0, p0[r]), p0[r + 1]); m1 = fmaxf(fmaxf(m1, p1[r]), p1[r + 1]); }
    float pmax = fmaxf(fmaxf(m0, p0[15]), fmaxf(m1, p1[15]));
    { auto rr = __builtin_amdgcn_permlane32_swap(__float_as_uint(pmax), __float_as_uint(pmax), false, false);
      pmax = fmaxf(__uint_as_float(rr[0]), __uint_as_float(rr[1])); }
    if (!FIRST && __builtin_expect(__all(pmax <= THR2), 1)) { alpha = 1.f; }
    else { const float dl = FIRST ? pmax - PBIAS : fmaxf(pmax - PBIAS, 0.f); alpha = __builtin_amdgcn_exp2f(-dl);
#pragma unroll
        for (int r = 0; r < 16; ++r) { p0[r] -= dl; p1[r] -= dl; negm[r] -= dl; } }
#pragma unroll
    for (int r = 0; r < 16; ++r) p0[r] = __builtin_amdgcn_exp2f(p0[r]);
}
__device__ __forceinline__ void finishSM(f32x16& p0, f32x16& p1, float alpha, float& l_reg, bf16x8& pa0, bf16x8& pa1, bf16x8& pa2, bf16x8& pa3) {
#pragma unroll
    for (int r = 0; r < 16; ++r) p1[r] = __builtin_amdgcn_exp2f(p1[r]);
    float s0 = p0[0] + p0[1], s1 = p0[2] + p0[3], s2 = p1[0] + p1[1], s3 = p1[2] + p1[3];
#pragma unroll
    for (int r = 4; r < 16; r += 4) { s0 += p0[r]; s1 += p0[r + 1]; s2 += p0[r + 2]; s3 += p0[r + 3]; s0 += p1[r]; s1 += p1[r + 1]; s2 += p1[r + 2]; s3 += p1[r + 3]; }
    float ps = (s0 + s1) + (s2 + s3);
    { auto rr = __builtin_amdgcn_permlane32_swap(__float_as_uint(ps), __float_as_uint(ps), false, false); ps = __uint_as_float(rr[0]) + __uint_as_float(rr[1]); }
    l_reg = l_reg * alpha + ps;
#define ATT_PK4(P, BASE, OUT) do { unsigned a0 = cvtpk(P[BASE + 0], P[BASE + 1]), a1 = cvtpk(P[BASE + 2], P[BASE + 3]);   \
    unsigned b0 = cvtpk(P[BASE + 4], P[BASE + 5]), b1 = cvtpk(P[BASE + 6], P[BASE + 7]);                              \
    auto r0 = __builtin_amdgcn_permlane32_swap(a0, b0, false, false); auto r1 = __builtin_amdgcn_permlane32_swap(a1, b1, false, false); \
    u32x4 w = {r0[0], r1[0], r0[1], r1[1]}; OUT = __builtin_bit_cast(bf16x8, w); } while (0)
    ATT_PK4(p0, 0, pa0); ATT_PK4(p0, 8, pa1); ATT_PK4(p1, 0, pa2); ATT_PK4(p1, 8, pa3);
#undef ATT_PK4
}
#define ATT_K8(row, c) ((row) * 64 + ((((c) ^ ((row) >> 2)) & 3) << 4))
__device__ __forceinline__ void qkt(f32x16& p0, f32x16& p1, const LAS char* Ks, const pg8::v8i32& qf, const f32x16& negm, int r32, int hi) {
    const pg8::v4i32 a0 = *(const LAS pg8::v4i32*)(Ks + ATT_K8(r32, 2 * hi)), a1 = *(const LAS pg8::v4i32*)(Ks + ATT_K8(r32, 2 * hi + 1));
    const pg8::v4i32 b0 = *(const LAS pg8::v4i32*)(Ks + ATT_K8(32 + r32, 2 * hi)), b1 = *(const LAS pg8::v4i32*)(Ks + ATT_K8(32 + r32, 2 * hi + 1));
    p0 = __builtin_amdgcn_mfma_scale_f32_32x32x64_f8f6f4(__builtin_shufflevector(a0, a1, 0, 1, 2, 3, 4, 5, 6, 7), qf, negm, 0, 0, 0, 0x7f7f7f7f, 0, 0x7f7f7f7f);
    p1 = __builtin_amdgcn_mfma_scale_f32_32x32x64_f8f6f4(__builtin_shufflevector(b0, b1, 0, 1, 2, 3, 4, 5, 6, 7), qf, negm, 0, 0, 0, 0x7f7f7f7f, 0, 0x7f7f7f7f);
}
__device__ __forceinline__ int v_st(int k, int c) { const int kk = (k & ~0xC) | ((k & 4) << 1) | ((k & 8) >> 1); return ((kk >> 3) * 4 + (c >> 5)) * 512 + ((kk & 7) * 32 + (c & 31)) * 2; }
__device__ __forceinline__ int v_rd_base(int lane) { return ((lane & 3) << 3) | (((lane >> 2) & 3) << 6) | (((lane >> 4) & 1) << 5) | (((lane >> 5) & 1) << 8); }
constexpr int v_rd_off(int d0, int ks, int half) { return d0 * 512 + ks * 4096 + half * 2048; }
template <int OFF> __device__ __forceinline__ s16x4 tr_read(int vb) { s16x4 r; asm volatile("ds_read_b64_tr_b16 %0, %1 offset:%2" : "=&v"(r) : "v"(vb), "i"(OFF) : "memory"); return r; }
template <int D0> __device__ __forceinline__ void pv_one(f32x16& od, int vb, bf16x8 pa0, bf16x8 pa1, bf16x8 pa2, bf16x8 pa3) {
    const s16x4 l0 = tr_read<v_rd_off(D0, 0, 0)>(vb), h0 = tr_read<v_rd_off(D0, 0, 1)>(vb), l1 = tr_read<v_rd_off(D0, 1, 0)>(vb), h1 = tr_read<v_rd_off(D0, 1, 1)>(vb);
    const s16x4 l2 = tr_read<v_rd_off(D0, 2, 0)>(vb), h2 = tr_read<v_rd_off(D0, 2, 1)>(vb), l3 = tr_read<v_rd_off(D0, 3, 0)>(vb), h3 = tr_read<v_rd_off(D0, 3, 1)>(vb);
    asm volatile("s_waitcnt lgkmcnt(0)" ::: "memory"); ATT_SBAR();
#define ATT_PK(L, H) (bf16x8){L[0], L[1], L[2], L[3], H[0], H[1], H[2], H[3]}
    od = __builtin_amdgcn_mfma_f32_32x32x16_bf16(pa0, ATT_PK(l0, h0), od, 0, 0, 0);
    od = __builtin_amdgcn_mfma_f32_32x32x16_bf16(pa1, ATT_PK(l1, h1), od, 0, 0, 0);
    od = __builtin_amdgcn_mfma_f32_32x32x16_bf16(pa2, ATT_PK(l2, h2), od, 0, 0, 0);
    od = __builtin_amdgcn_mfma_f32_32x32x16_bf16(pa3, ATT_PK(l3, h3), od, 0, 0, 0);
#undef ATT_PK
}
__device__ __forceinline__ void pv_d0(f32x16* o, int vb, bf16x8 pa0, bf16x8 pa1, bf16x8 pa2, bf16x8 pa3) {
    pv_one<0>(o[0], vb, pa0, pa1, pa2, pa3); pv_one<1>(o[1], vb, pa0, pa1, pa2, pa3); pv_one<2>(o[2], vb, pa0, pa1, pa2, pa3); pv_one<3>(o[3], vb, pa0, pa1, pa2, pa3);
}
__device__ __forceinline__ void psum(f32x16& osum, bf16x8 pa0, bf16x8 pa1, bf16x8 pa2, bf16x8 pa3) {
    const bf16x8 ones = {0x3F80, 0x3F80, 0x3F80, 0x3F80, 0x3F80, 0x3F80, 0x3F80, 0x3F80};
    osum = __builtin_amdgcn_mfma_f32_32x32x16_bf16(pa0, ones, osum, 0, 0, 0); osum = __builtin_amdgcn_mfma_f32_32x32x16_bf16(pa1, ones, osum, 0, 0, 0);
    osum = __builtin_amdgcn_mfma_f32_32x32x16_bf16(pa2, ones, osum, 0, 0, 0); osum = __builtin_amdgcn_mfma_f32_32x32x16_bf16(pa3, ones, osum, 0, 0, 0);
}
struct VFrag { s16x4 l0, h0, l1, h1, l2, h2, l3, h3; };
__device__ __forceinline__ void pv_rd0(VFrag& f, int vb) {
    f.l0 = tr_read<v_rd_off(0, 0, 0)>(vb); f.h0 = tr_read<v_rd_off(0, 0, 1)>(vb); f.l1 = tr_read<v_rd_off(0, 1, 0)>(vb); f.h1 = tr_read<v_rd_off(0, 1, 1)>(vb);
    f.l2 = tr_read<v_rd_off(0, 2, 0)>(vb); f.h2 = tr_read<v_rd_off(0, 2, 1)>(vb); f.l3 = tr_read<v_rd_off(0, 3, 0)>(vb); f.h3 = tr_read<v_rd_off(0, 3, 1)>(vb);
}
__device__ __forceinline__ void pv_d0_pre(f32x16* o, int vb, const VFrag& f, bf16x8 pa0, bf16x8 pa1, bf16x8 pa2, bf16x8 pa3) {
    asm volatile("s_waitcnt lgkmcnt(0)" ::: "memory"); ATT_SBAR();
#define ATT_PK(L, H) (bf16x8){L[0], L[1], L[2], L[3], H[0], H[1], H[2], H[3]}
    o[0] = __builtin_amdgcn_mfma_f32_32x32x16_bf16(pa0, ATT_PK(f.l0, f.h0), o[0], 0, 0, 0);
    o[0] = __builtin_amdgcn_mfma_f32_32x32x16_bf16(pa1, ATT_PK(f.l1, f.h1), o[0], 0, 0, 0);
    o[0] = __builtin_amdgcn_mfma_f32_32x32x16_bf16(pa2, ATT_PK(f.l2, f.h2), o[0], 0, 0, 0);
    o[0] = __builtin_amdgcn_mfma_f32_32x32x16_bf16(pa3, ATT_PK(f.l3, f.h3), o[0], 0, 0, 0);
#undef ATT_PK
    pv_one<1>(o[1], vb, pa0, pa1, pa2, pa3); pv_one<2>(o[2], vb, pa0, pa1, pa2, pa3); pv_one<3>(o[3], vb, pa0, pa1, pa2, pa3);
}
__device__ __forceinline__ int v8_sw(int key) { return (((key >> 1) & 1) << 1) | (((key >> 3) & 1) << 2); }
__device__ __forceinline__ int v8_st(int key, int chunk) { return key * 128 + ((chunk ^ v8_sw(key)) << 4); }
__device__ __forceinline__ int v8_rd_base(int lane, int d0) { const int i = lane & 15, q = i >> 1, p = i & 1, g1 = (lane >> 4) & 1, hi = lane >> 5; const int key0 = (q & 3) + 8 * (q >> 2) + 4 * hi;
    return key0 * 128 + ((((2 * d0 + g1) ^ v8_sw(key0)) & 7) << 4) + 8 * p; }
template <int OFF> __device__ __forceinline__ u32x2 tr8_read(int vb) { u32x2 r; asm volatile("ds_read_b64_tr_b8 %0, %1 offset:%2" : "=&v"(r) : "v"(vb), "i"(OFF) : "memory"); return r; }
struct V8Frag { u32x2 r0, r1, r2, r3; };
__device__ __forceinline__ void pv8_rd(V8Frag& f, int vb) { f.r0 = tr8_read<0>(vb); f.r1 = tr8_read<2048>(vb); f.r2 = tr8_read<4096>(vb); f.r3 = tr8_read<6144>(vb); }
template <int SO> __device__ __forceinline__ void pv8_rds(V8Frag& f, int vb) { f.r0 = tr8_read<SO>(vb); f.r1 = tr8_read<SO + 2048>(vb); f.r2 = tr8_read<SO + 4096>(vb); f.r3 = tr8_read<SO + 6144>(vb); }
__device__ __forceinline__ void pv8_mm(f32x16& od, const V8Frag& f, const pg8::v8i32& pa, int sc1, int scP) {
    const pg8::v8i32 bf = {(int)f.r0.x, (int)f.r0.y, (int)f.r1.x, (int)f.r1.y, (int)f.r2.x, (int)f.r2.y, (int)f.r3.x, (int)f.r3.y};
    asm volatile("v_mfma_scale_f32_32x32x64_f8f6f4 %0, %1, %2, %0, %3, %4 op_sel_hi:[0,0,0]" : "+v"(od) : "v"(pa), "v"(bf), "v"(scP), "v"(sc1));
}
__device__ __forceinline__ void pv8_one(f32x16& od, int vb, const pg8::v8i32& pa, int sc1, int scP) { V8Frag f; pv8_rd(f, vb); asm volatile("s_waitcnt lgkmcnt(0)" ::: "memory"); ATT_SBAR(); pv8_mm(od, f, pa, sc1, scP); }
__device__ __forceinline__ void pv8_d0(f32x16* o, const int (&vb)[4], int so, const pg8::v8i32& pa, int sc1, int scP) {
    pv8_one(o[0], vb[0] + so, pa, sc1, scP); pv8_one(o[1], vb[1] + so, pa, sc1, scP); pv8_one(o[2], vb[2] + so, pa, sc1, scP); pv8_one(o[3], vb[3] + so, pa, sc1, scP); }
__device__ __forceinline__ void finishSM8(f32x16& p0, f32x16& p1, pg8::v8i32& pa) {
#pragma unroll
    for (int r = 0; r < 16; ++r) p1[r] = __builtin_amdgcn_exp2f(p1[r]);
#define ATT_F8(P, B) __builtin_amdgcn_cvt_pk_fp8_f32(P[B + 2], P[B + 3], __builtin_amdgcn_cvt_pk_fp8_f32(P[B], P[B + 1], 0, false), true)
    pa = (pg8::v8i32){ATT_F8(p0, 0), ATT_F8(p0, 4), ATT_F8(p0, 8), ATT_F8(p0, 12), ATT_F8(p1, 0), ATT_F8(p1, 4), ATT_F8(p1, 8), ATT_F8(p1, 12)};
#undef ATT_F8
}
__device__ __forceinline__ void psum8(f32x4& lacc, const pg8::v8i32& mask, const pg8::v8i32& pa, int sc1) {
    asm volatile("v_mfma_scale_f32_16x16x128_f8f6f4 %0, %1, %2, %0, %3, %3 op_sel_hi:[0,0,0]" : "+v"(lacc) : "v"(mask), "v"(pa), "v"(sc1));
}
struct KFrag { pg8::v4i32 a0, a1, b0, b1; };
__device__ __forceinline__ void k_read(KFrag& k, const LAS char* Ks, int r32, int hi) {
    k.a0 = *(const LAS pg8::v4i32*)(Ks + ATT_K8(r32, 2 * hi)); k.a1 = *(const LAS pg8::v4i32*)(Ks + ATT_K8(r32, 2 * hi + 1));
    k.b0 = *(const LAS pg8::v4i32*)(Ks + ATT_K8(32 + r32, 2 * hi)); k.b1 = *(const LAS pg8::v4i32*)(Ks + ATT_K8(32 + r32, 2 * hi + 1)); }
__device__ __forceinline__ void qk_mm(f32x16& p0, f32x16& p1, const KFrag& k, const pg8::v8i32& qf, const f32x16& negm) {
    p0 = __builtin_amdgcn_mfma_scale_f32_32x32x64_f8f6f4(__builtin_shufflevector(k.a0, k.a1, 0, 1, 2, 3, 4, 5, 6, 7), qf, negm, 0, 0, 0, 0x7f7f7f7f, 0, 0x7f7f7f7f);
    p1 = __builtin_amdgcn_mfma_scale_f32_32x32x64_f8f6f4(__builtin_shufflevector(k.b0, k.b1, 0, 1, 2, 3, 4, 5, 6, 7), qf, negm, 0, 0, 0, 0x7f7f7f7f, 0, 0x7f7f7f7f); }
template <int LO, int N> __device__ __forceinline__ void exp_n(f32x16& p) {
#pragma unroll
    for (int r = LO; r < LO + N; ++r) p[r] = __builtin_amdgcn_exp2f(p[r]);
    asm volatile("" : "+v"(p)); }
__device__ __forceinline__ int cvt4_fp8(float a, float b, float c, float d) { int r;
    asm("v_cvt_pk_fp8_f32 %0, %1, %2\n\tv_cvt_pk_fp8_f32 %0, %3, %4 op_sel:[0,0,1]" : "=&v"(r) : "v"(a), "v"(b), "v"(c), "v"(d)); return r; }
__device__ __forceinline__ void cvt_pa(pg8::v8i32& pa, const f32x16& p0, const f32x16& p1) {
#define ATT_F8(P, B) cvt4_fp8(P[B], P[B + 1], P[B + 2], P[B + 3])
    pa = (pg8::v8i32){ATT_F8(p0, 0), ATT_F8(p0, 4), ATT_F8(p0, 8), ATT_F8(p0, 12), ATT_F8(p1, 0), ATT_F8(p1, 4), ATT_F8(p1, 8), ATT_F8(p1, 12)};
#undef ATT_F8
}
__device__ __forceinline__ void sm_decide(f32x16& p0, f32x16& p1, f32x16& negm, float& alpha) {
    constexpr float THR2 = 8.0f, PBIAS = 4.0f;
    float m0 = fmaxf(fmaxf(p0[0], p0[1]), p0[2]), m1 = fmaxf(fmaxf(p1[0], p1[1]), p1[2]);
#pragma unroll
    for (int r = 3; r < 15; r += 2) { m0 = fmaxf(fmaxf(m0, p0[r]), p0[r + 1]); m1 = fmaxf(fmaxf(m1, p1[r]), p1[r + 1]); }
    float pmax = fmaxf(fmaxf(m0, p0[15]), fmaxf(m1, p1[15]));
    { auto rr = __builtin_amdgcn_permlane32_swap(__float_as_uint(pmax), __float_as_uint(pmax), false, false);
      pmax = fmaxf(__uint_as_float(rr[0]), __uint_as_float(rr[1])); }
    if (__builtin_expect(__all(pmax <= THR2), 1)) { alpha = 1.f; }
    else { const float dl = fmaxf(pmax - PBIAS, 0.f); alpha = __builtin_amdgcn_exp2f(-dl);
#pragma unroll
        for (int r = 0; r < 16; ++r) { p0[r] -= dl; p1[r] -= dl; negm[r] -= dl; } }
}
__device__ __forceinline__ void psum8z(f32x4& ts, const pg8::v8i32& mask, const pg8::v8i32& pa, int sc1) {
    asm volatile("v_mfma_scale_f32_16x16x128_f8f6f4 %0, %1, %2, 0, %3, %3 op_sel_hi:[0,0,0]" : "=&v"(ts) : "v"(mask), "v"(pa), "v"(sc1));
}
__device__ __forceinline__ void sm_redo(f32x16& p0, f32x16& p1, f32x16& negm, float& alpha, float& dl) {
    constexpr float PBIAS = 4.0f;
    float m0 = fmaxf(fmaxf(p0[0], p0[1]), p0[2]), m1 = fmaxf(fmaxf(p1[0], p1[1]), p1[2]);
#pragma unroll
    for (int r = 3; r < 15; r += 2) { m0 = fmaxf(fmaxf(m0, p0[r]), p0[r + 1]); m1 = fmaxf(fmaxf(m1, p1[r]), p1[r + 1]); }
    float pmax = fmaxf(fmaxf(m0, p0[15]), fmaxf(m1, p1[15]));
    { auto rr = __builtin_amdgcn_permlane32_swap(__float_as_uint(pmax), __float_as_uint(pmax), false, false);
      pmax = fmaxf(__uint_as_float(rr[0]), __uint_as_float(rr[1])); }
    dl = ceilf(fmaxf(pmax - PBIAS, 0.f)); alpha = __builtin_amdgcn_exp2f(-dl);
#pragma unroll
    for (int r = 0; r < 16; ++r) { p0[r] -= dl; p1[r] -= dl; negm[r] -= dl; }
}
}
__device__ __forceinline__ void attn_fast(Frame& F) {
    using namespace att;
    PH_IDS; const int wid = wave, r32 = lane & 31, hi = lane >> 5;
    const float lam = __builtin_bit_cast(float, __builtin_amdgcn_readfirstlane(__builtin_bit_cast(int, lam_value(F, lane))));
    LAS char* lds = (LAS char*)F.lds; LAS char* V_lds = lds + L_V; LAS char* K_lds = lds + L_K;
    LAS float* wsf = (LAS float*)(lds + L_WS) + wid * 64; LAS float* li_l = wsf; LAS float* al_l = wsf + 32;
    const bf16* Qg = WSP(bf16, WS_Q); const bf16* KBp = WSP(bf16, WS_KB); const bf16* VBp = WSP(bf16, WS_VB); unsigned char* mix = (unsigned char*)F.out;
    const int vkey = tid >> 3, vst0 = v8_st(vkey, tid & 7);
    const int kr = (tid >> 2) & 63, kc = tid & 3, kst = ATT_K8(kr, kc);
    int vb8[4];
#pragma unroll
    for (int d0 = 0; d0 < 4; ++d0) vb8[d0] = (int)(unsigned)(uintptr_t)V_lds + v8_rd_base(lane, d0);
    const int sc1 = 0x7f7f7f7f;
    pg8::v8i32 lmask;
    { const int mk = (((lane >> 4) ^ lane) & 1) ? 0 : 0x38383838; int m0, m1, m2, m3, m4, m5, m6, m7;
      asm volatile("v_mov_b32 %0, %8\n\tv_mov_b32 %1, %8\n\tv_mov_b32 %2, %8\n\tv_mov_b32 %3, %8\n\tv_mov_b32 %4, %8\n\tv_mov_b32 %5, %8\n\tv_mov_b32 %6, %8\n\tv_mov_b32 %7, %8"
                   : "=&v"(m0), "=&v"(m1), "=&v"(m2), "=&v"(m3), "=&v"(m4), "=&v"(m5), "=&v"(m6), "=&v"(m7) : "v"(mk));
      lmask = (pg8::v8i32){m0, m1, m2, m3, m4, m5, m6, m7}; }
    const unsigned voffV0 = (unsigned)(vkey * 1024 + (tid & 7) * 16), voffK = (unsigned)(kr * 1024 + kc * 16);
    constexpr int NT = KV / KVBLK;
    const int bx = (int)blockIdx.x;
    for (int ui = 0;; ++ui) {
        int unit;
        if (F.G == 256) { if (ui >= 4) break; unit = (ui * 8 + (bx & 7)) * 32 + (bx >> 3); }
        else { unit = ui * F.G + bx; if (unit >= 1024) break; }
        const int bh = unit >> 5, qb = unit & 31, b = bh >> 3, h = bh & 7;
        const size_t row0 = (size_t)b * SEQ + qb * 256;
#pragma unroll 1
        for (int mp = 0; mp < 2; ++mp) {
            const unsigned char* Kh = (const unsigned char*)KBp + (size_t)b * KV * 1024 + h * 128 + mp * 64; const unsigned char* Vh = (const unsigned char*)VBp + (size_t)b * KV * 1024 + h * 128;
            const __amdgpu_buffer_rsrc_t rsK = make_rsrc(Kh, KV * 1024), rsV = make_rsrc(Vh, KV * 1024);
            f32x16 o[4] = {}; f32x16 negm = {}; float l0 = 0.f, l1 = 0.f; f32x4 ts; int scP = 0x7f7f7f7f; float kown = 1.f, kf0 = 1.f, kf1 = 1.f;
            const __amdgpu_buffer_rsrc_t rsQ = make_rsrc((const unsigned char*)Qg + (row0 + wid * QBLK) * 1024 + h * 128 + mp * 64, 32 * 1024);
            const int lq = fresh_lane(); const unsigned qoff = (unsigned)((lq & 31) * 1024 + (lq >> 5) * 32);
            const pg8::v8i32 qr = __builtin_shufflevector(__builtin_bit_cast(pg8::v4i32, bufld16(rsQ, qoff, 0)), __builtin_bit_cast(pg8::v4i32, bufld16(rsQ, qoff + 16, 0)), 0, 1, 2, 3, 4, 5, 6, 7);
            struct { bf16x8 vs0, ks0; } sr_;
#define SLOAD(t_) do { const unsigned so_ = (unsigned)(t_) * (unsigned)(KVBLK * 1024); \
    sr_.vs0 = bufld16(rsV, voffV0, so_); if (wid < 4) sr_.ks0 = bufld16(rsK, voffK, so_); } while (0)
#define SWRITE(t_) do { const int sl_ = (t_) & 3; *(LAS bf16x8*)(V_lds + sl_ * SHM_V + vst0) = sr_.vs0; \
    if (wid < 4) *(LAS bf16x8*)(K_lds + sl_ * SHM_K + kst) = sr_.ks0; } while (0)
#define KSLOT(t_) (K_lds + ((t_) & 3) * SHM_K)
#define VSLOT(t_) (((t_) & 3) * SHM_V)
            f32x16 pA0, pA1, pB0, pB1; float alA; pg8::v8i32 pa;
            __syncthreads();
            SLOAD(0); SWRITE(0); SLOAD(1); SWRITE(1);
            __syncthreads();
            if (wid >= 4) __syncthreads();
            SLOAD(2); qkt(pA0, pA1, KSLOT(0), qr, negm, r32, hi);
            __syncthreads();
            partialSM<true>(pA0, pA1, negm, alA); SWRITE(2);
            __syncthreads();
            V8Frag vf; KFrag kfn;
#define ATT_WAITL(n_) asm volatile("s_waitcnt lgkmcnt(" #n_ ")" ::: "memory")
#define OVF_CHECK(PY0, PY1, PX0, PX1, SLP_, HAVE_PX) do { \
    asm volatile("s_nop 7\n\ts_nop 3" ::: "memory");        \
    if (__builtin_expect(__any(!(ts[0] < ATT_OVF_LIMIT) || !(ts[1] < ATT_OVF_LIMIT)), 0)) { \
        asm volatile("s_waitcnt lgkmcnt(0)" ::: "memory"); ATT_SBAR();        \
        KFrag kq_; k_read(kq_, K_lds + (SLP_) * SHM_K, r32, hi); qk_mm(PY0, PY1, kq_, qr, negm); \
        float al_, dl_; sm_redo(PY0, PY1, negm, al_, dl_); scP += (int)dl_ * 0x01010101; kown *= __builtin_amdgcn_exp2f(dl_);        \
        { auto kr_ = __builtin_amdgcn_permlane16_swap(__float_as_uint(kown), __float_as_uint(kown), false, false); kf0 = __uint_as_float(kr_[0]); kf1 = __uint_as_float(kr_[1]); } \
        if (HAVE_PX) {   (void)al_; \
            _Pragma("unroll") for (int r = 0; r < 16; ++r) { PX0[r] -= dl_; PX1[r] -= dl_; } } \
        exp_n<0, 16>(PY0); exp_n<0, 16>(PY1); cvt_pa(pa, PY0, PY1); psum8z(ts, lmask, pa, sc1); \
        asm volatile("s_nop 7\n\ts_nop 3" ::: "memory"); } \
    l0 += ts[0] * kf0; l1 += ts[1] * kf1; asm volatile("" :: "v"(ts));   } while (0)
#define SLOADT(t_) do { const unsigned so_ = (unsigned)(t_) * (unsigned)(KVBLK * 1024); sr_.vs0 = bufld16(rsV, voffV0, so_); if (wid < 4) sr_.ks0 = bufld16(rsK, voffK, so_); } while (0)
#define SWRITES(SL_) do { *(LAS bf16x8*)(V_lds + (SL_) * SHM_V + vst0) = sr_.vs0; if (wid < 4) *(LAS bf16x8*)(K_lds + (SL_) * SHM_K + kst) = sr_.ks0; } while (0)
#define SEG_A(PX0, PX1, PY0, PY1, t_, SL_, ld_) do { \
    if (ld_) SLOADT((t_) + 2); \
    ATT_SBAR(); qk_mm(PX0, PX1, kfn, qr, negm); ATT_SBAR(); \
    exp_n<0, 16>(PY1); ATT_SBAR(); \
    cvt_pa(pa, PY0, PY1); psum8z(ts, lmask, pa, sc1); ATT_SBAR(); \
    pv8_rds<(((SL_) + 3) & 3) * SHM_V>(vf, vb8[0]); ATT_SBAR(); \
    OVF_CHECK(PY0, PY1, PX0, PX1, ((SL_) + 3) & 3, true); ATT_SBAR();        \
    __syncthreads(); } while (0)
#define SEG_B(PX0, PX1, PY0, PY1, SL_, ld_, nk_) do { \
    V8Frag vg_; constexpr int so_ = (((SL_) + 3) & 3) * SHM_V; \
    pv8_rds<so_>(vg_, vb8[1]); ATT_SBAR(); \
    ATT_WAITL(4); ATT_SBAR(); pv8_mm(o[0], vf, pa, sc1, scP); \
    pv8_rds<so_>(vf, vb8[2]); ATT_SBAR(); \
    exp_n<0, 6>(PX0); ATT_SBAR();        \
    ATT_WAITL(4); ATT_SBAR(); pv8_mm(o[1], vg_, pa, sc1, scP); ATT_SBAR(); \
    if (nk_) { k_read(kfn, K_lds + (((SL_) + 1) & 3) * SHM_K, r32, hi); } ATT_SBAR(); \
    pv8_rds<so_>(vg_, vb8[3]); ATT_SBAR(); \
    exp_n<6, 6>(PX0); ATT_SBAR(); \
    if (nk_) ATT_WAITL(8); else ATT_WAITL(4); ATT_SBAR(); pv8_mm(o[2], vf, pa, sc1, scP); ATT_SBAR(); \
    exp_n<12, 4>(PX0); ATT_SBAR(); \
    if (ld_) SWRITES(((SL_) + 2) & 3); ATT_SBAR();        \
    if (ld_) ATT_WAITL(1); else ATT_WAITL(0); ATT_SBAR(); pv8_mm(o[3], vg_, pa, sc1, scP); ATT_SBAR(); \
    __syncthreads(); } while (0)
            static_assert(NT % 4 == 0 && NT >= 8, "the tile loop is unrolled over the 4 ring slots");
            k_read(kfn, K_lds + 1 * SHM_K, r32, hi);
            SEG_A(pB0, pB1, pA0, pA1, 1, 1, true); SEG_B(pB0, pB1, pA0, pA1, 1, true, true);
#pragma unroll 1
            for (int t = 2; t + 3 < NT; t += 4) {
                SEG_A(pA0, pA1, pB0, pB1, t, 2, true); SEG_B(pA0, pA1, pB0, pB1, 2, true, true);
                SEG_A(pB0, pB1, pA0, pA1, t + 1, 3, true); SEG_B(pB0, pB1, pA0, pA1, 3, true, true);
                SEG_A(pA0, pA1, pB0, pB1, t + 2, 0, true); SEG_B(pA0, pA1, pB0, pB1, 0, true, true);
                SEG_A(pB0, pB1, pA0, pA1, t + 3, 1, true); SEG_B(pB0, pB1, pA0, pA1, 1, true, true);
            }
            SEG_A(pA0, pA1, pB0, pB1, NT - 2, 2, false); SEG_B(pA0, pA1, pB0, pB1, 2, false, true);
            SEG_A(pB0, pB1, pA0, pA1, NT - 1, 3, false); SEG_B(pB0, pB1, pA0, pA1, 3, false, false);
#undef SEG_A
#undef SEG_B
            exp_n<0, 16>(pB1); cvt_pa(pa, pB0, pB1); psum8z(ts, lmask, pa, sc1); ATT_SBAR();
            OVF_CHECK(pB0, pB1, pB0, pB1, 3, false); ATT_SBAR();
            pv8_d0(o, vb8, VSLOT(NT - 1), pa, sc1, scP);
#undef OVF_CHECK
            asm volatile("s_nop 15\n\ts_nop 15" ::: "memory");
            if (wid < 4) __syncthreads();
            __syncthreads();
#undef KSLOT
#undef VSLOT
#undef SLOAD
#undef SWRITE
            const int lane2 = fresh_lane(), t2 = wid * 64 + lane2, r32b = lane2 & 31, hi2 = lane2 >> 5;
            if (hi2 == 0) li_l[r32b] = (lane2 & 16) ? l1 : l0; asm volatile("s_waitcnt lgkmcnt(0)" ::: "memory");
            float rli[16];
#pragma unroll
            for (int r = 0; r < 16; ++r) rli[r] = 1.0f / li_l[crow(r, hi2)];
            float* SCR = WSP(float, WS_H) + (size_t)blockIdx.x * 512 * 64 + (size_t)t2 * 4;
            if (mp == 0) {
#pragma unroll
                for (int d0 = 0; d0 < 4; ++d0)
#pragma unroll
                    for (int r = 0; r < 16; r += 4) *(f32x4*)(SCR + (size_t)(d0 * 4 + (r >> 2)) * 2048) = (f32x4){o[d0][r] * rli[r], o[d0][r + 1] * rli[r + 1], o[d0][r + 2] * rli[r + 2], o[d0][r + 3] * rli[r + 3]};
            } else {
                LAS bf16* ot = (LAS bf16*)(lds + L_OST) + wid * (32 * OST_LD);
                float gsub[4];
#pragma unroll
                for (int d0 = 0; d0 < 4; ++d0) gsub[d0] = F.in[14][d0 * 32 + r32b];
                f32x4 sv[4][4];
#pragma unroll
                for (int d0 = 0; d0 < 4; ++d0)
#pragma unroll
                    for (int r4 = 0; r4 < 4; ++r4) sv[d0][r4] = *(const f32x4*)(SCR + (size_t)(d0 * 4 + r4) * 2048);
#pragma unroll
                for (int r = 0; r < 16; ++r) { float a = 0.f;
#pragma unroll
                    for (int d0 = 0; d0 < 4; ++d0) { const float t = sv[d0][r >> 2][r & 3] - lam * (o[d0][r] * rli[r]); o[d0][r] = t; a += t * t; }
#define SWZ_ADD(x_, k_) x_ += __builtin_bit_cast(float, __builtin_amdgcn_ds_swizzle(__builtin_bit_cast(int, x_), ((k_) << 10) | 0x1F))
                    SWZ_ADD(a, 1); SWZ_ADD(a, 2); SWZ_ADD(a, 4); SWZ_ADD(a, 8); SWZ_ADD(a, 16);
#undef SWZ_ADD
                    const float ssr = 0.8f / sqrtf(a * (1.0f / 128.0f) + LN_EPS);
#pragma unroll
                    for (int d0 = 0; d0 < 4; ++d0) ot[crow(r, hi2) * OST_LD + d0 * 32 + r32b] = (bf16)f2bf(o[d0][r] * ssr * gsub[d0]); }
                asm volatile("s_waitcnt lgkmcnt(0)" ::: "memory");
                unsigned char* Ow = mix + (row0 + wid * QBLK + (lane2 >> 4)) * D + 1024 + h * 128 + (lane2 & 15) * 8;
#pragma unroll
                for (int k = 0; k < 8; ++k) { const u32x4 w = *(const LAS u32x4*)(ot + (k * 4 + (lane2 >> 4)) * OST_LD + (lane2 & 15) * 8); u32x2 w8;
                    w8.x = pk4_fp8(bf_lo(w.x), bf_hi(w.x), bf_lo(w.y), bf_hi(w.y)); w8.y = pk4_fp8(bf_lo(w.z), bf_hi(w.z), bf_lo(w.w), bf_hi(w.w)); *(u32x2*)(Ow + (size_t)k * 4 * D) = w8; }
            }
        }
    }
}
template <int L> __device__ __forceinline__ void ln_route_pass(Frame& F) {
    PH_IDS;
    LAS float* P_g = (LAS float*)F.lds;
    LAS float* P_b = P_g + D;
    LAS float* P_s = P_b + D;
    LAS float* P_h = P_s + D;
    LAS int* lcnt = (LAS int*)(F.lds + LDSX_OFF + 1024);
    LAS int* lbase = lcnt + 32;
    LAS int* rec = lcnt + 64;
    LAS float* recw = (LAS float*)(lcnt + 64 + 256);
    LAS float* lgt = (LAS float*)(F.lds + LDSX_OFF + 8192);
    LAS float* rst = (LAS float*)(lcnt + 64 + 256 + 256);
    const bf16* R = L == 0 ? (const bf16*)F.out + (size_t)M * D : WSP(bf16, WS_R1); unsigned char* H8 = WSP(unsigned char, WS_H8); float* stat = WSP(float, WS_STAT);
    const float* lng = F.in[6] + (L * 2 + 0) * D; const float* lnb = F.in[7] + (L * 2 + 0) * D;
    unsigned* gcnt = F.ctl + CW_CNT + L * 32; int4* list = WSP(int4, WS_LIST2);
    for (int blk = F.vcu; blk < M / 128; blk += F.G) {
        if (tid < 32) lcnt[tid] = 0;
        __syncthreads();
        const int rowb = blk * 128 + wave * 16, b = rowb >> 13;
        { const float* sh = MODP(L, b, 3); const float* sc = MODP(L, b, 4);
          for (int i = tid; i < D; i += 512) { P_g[i] = lng[i]; P_b[i] = lnb[i]; P_s[i] = 1.0f + sc[i]; P_h[i] = sh[i]; } }
        __syncthreads();
        u32x4 raw0[4], raw1[4];
#pragma unroll
        for (int j = 0; j < 4; ++j) { raw0[j] = *(const u32x4*)(R + (size_t)rowb * D + 512 * j + 8 * lane); raw1[j] = *(const u32x4*)(R + (size_t)(rowb + 1) * D + 512 * j + 8 * lane); }
#pragma unroll 1
        for (int pp = 0; pp < 8; ++pp) {
            const int row = rowb + 2 * pp;
            f32x2 v0[16], v1[16]; f32x2 s0 = {0.f, 0.f}, s1 = {0.f, 0.f};
#pragma unroll
            for (int j = 0; j < 4; ++j) {
                v0[4 * j + 0] = (f32x2){bf_lo(raw0[j].x), bf_hi(raw0[j].x)}; v0[4 * j + 1] = (f32x2){bf_lo(raw0[j].y), bf_hi(raw0[j].y)}; v0[4 * j + 2] = (f32x2){bf_lo(raw0[j].z), bf_hi(raw0[j].z)}; v0[4 * j + 3] = (f32x2){bf_lo(raw0[j].w), bf_hi(raw0[j].w)};
                v1[4 * j + 0] = (f32x2){bf_lo(raw1[j].x), bf_hi(raw1[j].x)}; v1[4 * j + 1] = (f32x2){bf_lo(raw1[j].y), bf_hi(raw1[j].y)}; v1[4 * j + 2] = (f32x2){bf_lo(raw1[j].z), bf_hi(raw1[j].z)}; v1[4 * j + 3] = (f32x2){bf_lo(raw1[j].w), bf_hi(raw1[j].w)}; }
#pragma unroll
            for (int i = 0; i < 16; ++i) { s0 += v0[i]; s1 += v1[i]; }
            if (pp < 7) {
#pragma unroll
                for (int j = 0; j < 4; ++j) { raw0[j] = *(const u32x4*)(R + (size_t)(row + 2) * D + 512 * j + 8 * lane); raw1[j] = *(const u32x4*)(R + (size_t)(row + 3) * D + 512 * j + 8 * lane); } }
            float t0 = s0.x + s0.y, t1 = s1.x + s1.y;
#pragma unroll
            for (int o = 1; o < 64; o <<= 1) { t0 += __shfl_xor(t0, o); t1 += __shfl_xor(t1, o); }
            const float mean0 = t0 * (1.0f / D), mean1 = t1 * (1.0f / D); f32x2 q0 = {0.f, 0.f}, q1 = {0.f, 0.f};
#pragma unroll
            for (int i = 0; i < 16; ++i) { v0[i] = v0[i] - mean0; v1[i] = v1[i] - mean1; q0 += v0[i] * v0[i]; q1 += v1[i] * v1[i]; }
            float u0 = q0.x + q0.y, u1 = q1.x + q1.y;
#pragma unroll
            for (int o = 1; o < 64; o <<= 1) { u0 += __shfl_xor(u0, o); u1 += __shfl_xor(u1, o); }
            const float rstd0 = 1.0f / sqrtf(u0 * (1.0f / D) + LN_EPS), rstd1 = 1.0f / sqrtf(u1 * (1.0f / D) + LN_EPS);
            if (lane == 0) { *(LAS f32x4*)(rst + (wave * 16 + 2 * pp) * 2) = (f32x4){mean0, rstd0, mean1, rstd1}; *(f32x4*)(stat + (size_t)row * 2) = (f32x4){mean0, rstd0, mean1, rstd1}; }
#pragma unroll
            for (int j = 0; j < 4; ++j) { const int c = 512 * j + 8 * lane; u32x2 h80, h81;
#pragma unroll
                for (int h = 0; h < 2; ++h) { const f32x4 g = *(const LAS f32x4*)(P_g + c + 4 * h), bb = *(const LAS f32x4*)(P_b + c + 4 * h), scv = *(const LAS f32x4*)(P_s + c + 4 * h), shv = *(const LAS f32x4*)(P_h + c + 4 * h);
                    const f32x2 ga = {g.x, g.y}, gb = {g.z, g.w}, ba = {bb.x, bb.y}, bc = {bb.z, bb.w}, sa = {scv.x, scv.y}, sb = {scv.z, scv.w}, ha = {shv.x, shv.y}, hb = {shv.z, shv.w};
                    const f32x2 xa0 = v0[4 * j + 2 * h] * rstd0 * ga + ba, xb0 = v0[4 * j + 2 * h + 1] * rstd0 * gb + bc, xa1 = v1[4 * j + 2 * h] * rstd1 * ga + ba, xb1 = v1[4 * j + 2 * h + 1] * rstd1 * gb + bc;
                    const f32x2 ya0 = xa0 * sa + ha, yb0 = xb0 * sb + hb, ya1 = xa1 * sa + ha, yb1 = xb1 * sb + hb;
                    if (h == 0) { h80.x = pk4_fp8(ya0.x, ya0.y, yb0.x, yb0.y); h81.x = pk4_fp8(ya1.x, ya1.y, yb1.x, yb1.y); } else { h80.y = pk4_fp8(ya0.x, ya0.y, yb0.x, yb0.y); h81.y = pk4_fp8(ya1.x, ya1.y, yb1.x, yb1.y); }
                }
                *(u32x2*)(H8 + (size_t)row * D + c) = h80; *(u32x2*)(H8 + (size_t)(row + 1) * D + c) = h81; }
        }
        {
            const int l2 = fresh_lane(), i16 = l2 & 15, kq = l2 >> 4;
            const bf16* hp = R + (size_t)(rowb + i16) * D + 8 * kq; const bf16* whp = WSP(bf16, WS_WRT2) + (size_t)((L * 4 + b) * 32 + i16) * D + 8 * kq; const bf16* wlp = whp + 16 * D;
            f32x4 lacc = {0.f, 0.f, 0.f, 0.f};
#pragma unroll 8
            for (int ks = 0; ks < 64; ++ks) { const bf16x8 af = *(const bf16x8*)(hp + 32 * ks); const bf16x8 bh = *(const bf16x8*)(whp + 32 * ks), bl = *(const bf16x8*)(wlp + 32 * ks);
                lacc = __builtin_amdgcn_mfma_f32_16x16x32_bf16(af, bh, lacc, 0, 0, 0); lacc = __builtin_amdgcn_mfma_f32_16x16x32_bf16(af, bl, lacc, 0, 0, 0); }
            LAS float* lp = lgt + (wave * 16 + 4 * kq) * 16 + i16; const float c1 = WSP(float, WS_RC)[(L * 4 + b) * 32 + i16], c2 = WSP(float, WS_RC)[(L * 4 + b) * 32 + 16 + i16];
            const LAS float* rs = rst + (wave * 16 + 4 * kq) * 2;
            const f32x4 s01 = *(const LAS f32x4*)rs, s23 = *(const LAS f32x4*)(rs + 4);
            lp[0] = s01.y * (lacc.x - s01.x * c1) + c2; lp[16] = s01.w * (lacc.y - s01.z * c1) + c2; lp[32] = s23.y * (lacc.z - s23.x * c1) + c2; lp[48] = s23.w * (lacc.w - s23.z * c1) + c2;
        }
        LDS_WAIT();
        if (lane < 16) {
            const int rl = wave * 16 + fresh_lane(); float sco[16], sel[16];
#pragma unroll
            for (int e4 = 0; e4 < 4; ++e4) { const f32x4 lg = *(const LAS f32x4*)(lgt + rl * 16 + 4 * e4);
                sco[4 * e4 + 0] = 1.0f / (1.0f + __expf(-lg.x)); sco[4 * e4 + 1] = 1.0f / (1.0f + __expf(-lg.y)); sco[4 * e4 + 2] = 1.0f / (1.0f + __expf(-lg.z)); sco[4 * e4 + 3] = 1.0f / (1.0f + __expf(-lg.w)); }
#pragma unroll
            for (int e = 0; e < 16; ++e) sel[e] = sco[e] + F.in[23][e];
            int bg = 0; float bgs = -1e30f;
#pragma unroll
            for (int g = 0; g < 4; ++g) { float m1 = -1e30f, m2 = -1e30f;
#pragma unroll
                for (int i = 0; i < 4; ++i) { const float x = sel[4 * g + i]; if (x > m1) { m2 = m1; m1 = x; } else if (x > m2) m2 = x; }
                const float gs = m1 + m2; if (gs > bgs) { bgs = gs; bg = g; } }
            float s4[4], c4[4];
#pragma unroll
            for (int i = 0; i < 4; ++i) { s4[i] = bg == 0 ? sel[i] : bg == 1 ? sel[4 + i] : bg == 2 ? sel[8 + i] : sel[12 + i]; c4[i] = bg == 0 ? sco[i] : bg == 1 ? sco[4 + i] : bg == 2 ? sco[8 + i] : sco[12 + i]; }
            int i1 = 0; float b1 = s4[0];
#pragma unroll
            for (int i = 1; i < 4; ++i) if (s4[i] > b1) { b1 = s4[i]; i1 = i; }
            int i2 = -1; float b2 = -1e30f;
#pragma unroll
            for (int i = 0; i < 4; ++i) if (i != i1 && s4[i] > b2) { b2 = s4[i]; i2 = i; }
            const float cw1 = i1 == 0 ? c4[0] : i1 == 1 ? c4[1] : i1 == 2 ? c4[2] : c4[3], cw2 = i2 == 0 ? c4[0] : i2 == 1 ? c4[1] : i2 == 2 ? c4[2] : c4[3];
            const float inv = 1.0f / (cw1 + cw2);
            const bool sw = i2 < i1; const int lo_i = sw ? i2 : i1, hi_i = sw ? i1 : i2;
            const int pid = bg * 6 + ((lo_i * (7 - lo_i)) >> 1) + hi_i - lo_i - 1;
            const int r1 = atomicAdd((int*)(lcnt + pid), 1);
            rec[rl] = pid | (r1 << 8); recw[rl * 2] = (sw ? cw2 : cw1) * inv; recw[rl * 2 + 1] = (sw ? cw1 : cw2) * inv;
        }
        __syncthreads();
        if (tid < NL) lbase[tid] = (int)atomicAdd(gcnt + tid, (unsigned)lcnt[tid]);
        __syncthreads();
        if (tid < 128) { const int v = rec[tid], e = v & 255, rank = v >> 8;
            list[e * CAP + lbase[e] + rank] = make_int4(blk * 128 + tid, __float_as_int(recw[tid * 2]), __float_as_int(recw[tid * 2 + 1]), 0); }
        __syncthreads();
    }
}
template <int L> __device__ __forceinline__ int moe_tables(Frame& F, LAS int*& tp, LAS int*& cnt) {
    tp = (LAS int*)(F.lds + LDSX_OFF + 16384); cnt = tp + 32;
    LAS int* ord = tp + 64; LAS int* tpf = tp + 352  ; LAS int* pix = tp + 384  ;
    if (F.wave0 == 0 && fresh_lane() == 0) { int acc = 0, fa = 0, pa = 0;
        for (int e = 0; e < NL; ++e) { const int c = (int)__hip_atomic_load(F.ctl + CW_CNT + L * 32 + e, RLX_AGENT); cnt[e] = c; tp[e] = acc; acc += (c + 255) >> 8; tpf[e] = fa; fa += c >> 8; pix[e] = pa; pa += (c & 255) ? 1 : 0; }
        tp[NL] = acc; tpf[NL] = fa; }
    __syncthreads();
    { const int t_ = F.wave0 * 64 + fresh_lane();
      if (t_ < NL) { const int c = cnt[t_], full = c >> 8, base = tp[t_], fo = tpf[t_]; const int Fn = tpf[NL], Pn = tp[NL] - Fn;
          for (int k = 0; k < full; ++k) { const int sidx = fo + k; int x = 0; while (x < 7 && ((x + 1) * Fn) / 8 <= sidx) ++x; ord[sidx + (x * Pn) / 8] = base + k; }
          if (c & 255) { const int j = pix[t_]; int x = 0; while (x < 7 && ((x + 1) * Pn) / 8 <= j) ++x; ord[((x + 1) * Fn) / 8 + j] = base + full; } } }
    __syncthreads();
    return tp[NL];
}
template <int L> __device__ __forceinline__ void ln_moe_pass(Frame& F) {
    PH_IDS;
    bf16* X = WSP(bf16, WS_X); unsigned char* H8 = WSP(unsigned char, WS_H8); const bf16* YB = WSP(bf16, WS_YB);
    const bf16* R = L == 0 ? (const bf16*)F.out + (size_t)M * D : WSP(bf16, WS_R1); const float* stat = WSP(float, WS_STAT);
    LAS float* P_g2 = (LAS float*)F.lds; LAS float* P_g = P_g2 + D; LAS float* P_b = P_g + D; LAS float* P_s = P_b + D; LAS float* P_h = P_s + D; LAS float* P_g1 = P_h + D; LAS float* P_b1 = P_g1 + D;
    for (int blk = F.vcu; blk < M / 128; blk += F.G) {
        const int rowb = blk * 128 + wave * 16, b = rowb >> 13;
        __syncthreads();
        for (int i = tid; i < D; i += 512) { P_g2[i] = MODP(L, b, 5)[i]; P_g[i] = F.in[6][(L * 2 + 1) * D + i]; P_b[i] = F.in[7][(L * 2 + 1) * D + i]; P_g1[i] = F.in[6][(L * 2 + 0) * D + i]; P_b1[i] = F.in[7][(L * 2 + 0) * D + i];
            if (L == 0) { P_s[i] = 1.0f + MODP(1, b, 1)[i]; P_h[i] = MODP(1, b, 0)[i]; } }
        __syncthreads();
        if constexpr (L == 1) {
        u32x2 rx[8], ry0[8]; f32x2 rstt;
#define LNM_LOAD1(r_) do { _Pragma("unroll") for (int j = 0; j < 8; ++j) { const int c = 256 * j + 4 * lane; rx[j] = *(const u32x2*)(R + (size_t)(r_) * D + c); \
            ry0[j] = *(const u32x2*)(YB + (size_t)(r_) * D + c); } rstt = *(const f32x2*)(stat + (size_t)(r_) * 2); } while (0)
        LNM_LOAD1(rowb);
#pragma unroll 1
        for (int rr = 0; rr < 16; ++rr) {
            const int row = rowb + rr;
            f32x2 v[16]; f32x2 s2 = {0.f, 0.f}; const float ra = rstt.y, rc = -rstt.x * rstt.y;
#pragma unroll
            for (int j = 0; j < 8; ++j) { const int c = 256 * j + 4 * lane;
                const f32x4 ga = *(const LAS f32x4*)(P_g2 + c), g1a = *(const LAS f32x4*)(P_g1 + c), b1a = *(const LAS f32x4*)(P_b1 + c);
                v[2 * j] = (((f32x2){bf_lo(rx[j].x), bf_hi(rx[j].x)} * ra + rc) * (f32x2){g1a.x, g1a.y} + (f32x2){b1a.x, b1a.y}) * ALPHA + (f32x2){ga.x, ga.y} * (f32x2){bf_lo(ry0[j].x), bf_hi(ry0[j].x)};
                v[2 * j + 1] = (((f32x2){bf_lo(rx[j].y), bf_hi(rx[j].y)} * ra + rc) * (f32x2){g1a.z, g1a.w} + (f32x2){b1a.z, b1a.w}) * ALPHA + (f32x2){ga.z, ga.w} * (f32x2){bf_lo(ry0[j].y), bf_hi(ry0[j].y)};
            }
#pragma unroll
            for (int i = 0; i < 16; ++i) s2 += v[i];
            if (rr < 15) LNM_LOAD1(row + 1);
            float t = s2.x + s2.y;
#pragma unroll
            for (int o = 1; o < 64; o <<= 1) t += __shfl_xor(t, o);
            const float mean = t * (1.0f / D); f32x2 q2 = {0.f, 0.f};
#pragma unroll
            for (int i = 0; i < 16; ++i) { v[i] = v[i] - mean; q2 += v[i] * v[i]; }
            float u = q2.x + q2.y;
#pragma unroll
            for (int o = 1; o < 64; o <<= 1) u += __shfl_xor(u, o);
            const float rstd = 1.0f / sqrtf(u * (1.0f / D) + LN_EPS);
#pragma unroll
            for (int j = 0; j < 8; ++j) { const int c = 256 * j + 4 * lane;
                const f32x4 g = *(const LAS f32x4*)(P_g + c), bb = *(const LAS f32x4*)(P_b + c);
                const f32x2 x0 = v[2 * j] * rstd * (f32x2){g.x, g.y} + (f32x2){bb.x, bb.y}, x1 = v[2 * j + 1] * rstd * (f32x2){g.z, g.w} + (f32x2){bb.z, bb.w};
                *(f32x4*)(F.out + (size_t)row * D + c) = (f32x4){x0.x, x0.y, x1.x, x1.y}; }
        }
#undef LNM_LOAD1
        } else {
        u32x4 rx[4], ry0[4]; f32x2 rstt;
#define LNM_LOAD(r_) do { _Pragma("unroll") for (int j = 0; j < 4; ++j) { const int c = 512 * j + 8 * lane; rx[j] = *(const u32x4*)(R + (size_t)(r_) * D + c); \
            ry0[j] = *(const u32x4*)(YB + (size_t)(r_) * D + c); } rstt = *(const f32x2*)(stat + (size_t)(r_) * 2); } while (0)
        LNM_LOAD(rowb);
#pragma unroll 1
        for (int rr = 0; rr < 16; ++rr) {
            const int row = rowb + rr;
            f32x2 v[16]; f32x2 s2 = {0.f, 0.f}; const float ra = rstt.y, rc = -rstt.x * rstt.y;
#pragma unroll
            for (int j = 0; j < 4; ++j) { const int c = 512 * j + 8 * lane;
                const f32x4 ga = *(const LAS f32x4*)(P_g2 + c), gb = *(const LAS f32x4*)(P_g2 + c + 4), g1a = *(const LAS f32x4*)(P_g1 + c), g1b = *(const LAS f32x4*)(P_g1 + c + 4), b1a = *(const LAS f32x4*)(P_b1 + c), b1b = *(const LAS f32x4*)(P_b1 + c + 4);
#define LNM_E(k_, W_, G0_, G1_, A0_, A1_, B0_, B1_) v[4 * j + k_] = (((f32x2){bf_lo(rx[j].W_), bf_hi(rx[j].W_)} * ra + rc) * (f32x2){A0_, A1_} + (f32x2){B0_, B1_}) * ALPHA + (f32x2){G0_, G1_} * (f32x2){bf_lo(ry0[j].W_), bf_hi(ry0[j].W_)}
                LNM_E(0, x, ga.x, ga.y, g1a.x, g1a.y, b1a.x, b1a.y); LNM_E(1, y, ga.z, ga.w, g1a.z, g1a.w, b1a.z, b1a.w); LNM_E(2, z, gb.x, gb.y, g1b.x, g1b.y, b1b.x, b1b.y); LNM_E(3, w, gb.z, gb.w, g1b.z, g1b.w, b1b.z, b1b.w);
#undef LNM_E
            }
#pragma unroll
            for (int i = 0; i < 16; ++i) s2 += v[i];
            if (rr < 15) LNM_LOAD(row + 1);
            float t = s2.x + s2.y;
#pragma unroll
            for (int o = 1; o < 64; o <<= 1) t += __shfl_xor(t, o);
            const float mean = t * (1.0f / D); f32x2 q2 = {0.f, 0.f};
#pragma unroll
            for (int i = 0; i < 16; ++i) { v[i] = v[i] - mean; q2 += v[i] * v[i]; }
            float u = q2.x + q2.y;
#pragma unroll
            for (int o = 1; o < 64; o <<= 1) u += __shfl_xor(u, o);
            const float rstd = 1.0f / sqrtf(u * (1.0f / D) + LN_EPS);
#pragma unroll
            for (int j = 0; j < 4; ++j) { const int c = 512 * j + 8 * lane; f32x2 xo[4];
#pragma unroll
                for (int h = 0; h < 2; ++h) { const f32x4 g = *(const LAS f32x4*)(P_g + c + 4 * h), bb = *(const LAS f32x4*)(P_b + c + 4 * h);
                    xo[2 * h] = v[4 * j + 2 * h] * rstd * (f32x2){g.x, g.y} + (f32x2){bb.x, bb.y}; xo[2 * h + 1] = v[4 * j + 2 * h + 1] * rstd * (f32x2){g.z, g.w} + (f32x2){bb.z, bb.w}; }
                if (L == 1) { *(f32x4*)(F.out + (size_t)row * D + c) = (f32x4){xo[0].x, xo[0].y, xo[1].x, xo[1].y}; *(f32x4*)(F.out + (size_t)row * D + c + 4) = (f32x4){xo[2].x, xo[2].y, xo[3].x, xo[3].y}; }
                else { u32x4 w; w.x = pk2(xo[0].x, xo[0].y); w.y = pk2(xo[1].x, xo[1].y); w.z = pk2(xo[2].x, xo[2].y); w.w = pk2(xo[3].x, xo[3].y); *(u32x4*)(X + (size_t)row * D + c) = w;
                    const f32x4 sa = *(const LAS f32x4*)(P_s + c), sb = *(const LAS f32x4*)(P_s + c + 4), ha = *(const LAS f32x4*)(P_h + c), hb = *(const LAS f32x4*)(P_h + c + 4);
                    const f32x2 y0 = xo[0] * (f32x2){sa.x, sa.y} + (f32x2){ha.x, ha.y}, y1 = xo[1] * (f32x2){sa.z, sa.w} + (f32x2){ha.z, ha.w}, y2 = xo[2] * (f32x2){sb.x, sb.y} + (f32x2){hb.x, hb.y}, y3 = xo[3] * (f32x2){sb.z, sb.w} + (f32x2){hb.z, hb.w};
                    u32x2 hw; hw.x = pk4_fp8(y0.x, y0.y, y1.x, y1.y); hw.y = pk4_fp8(y2.x, y2.y, y3.x, y3.y); *(u32x2*)(H8 + (size_t)row * D + c) = hw; } }
        }
#undef LNM_LOAD
        }
    }
}
__device__ __forceinline__ void spatial_simple(Frame& F) {
    PH_IDS;
    LAS float* vt = (LAS float*)F.lds;
    LAS float* wt = (LAS float*)(F.lds + 65536);
    LAS float* st = (LAS float*)(F.lds + LDSX_OFF + 1024);
    const bf16* UV = WSP(bf16, WS_UV); bf16* GT = (bf16*)F.out; const float* vst = WSP(float, WS_VSTP);
    for (int ch = F.vcu; ch < M / 128; ch += F.G) {
        __syncthreads();
        if (tid < 128) { float s = 0.f, s2 = 0.f; const f32x4* pp = (const f32x4*)(vst + (size_t)(ch * 128 + tid) * 64);
#pragma unroll
            for (int i = 0; i < 16; ++i) { const f32x4 t = pp[i]; s += t.x; s2 += t.y; s += t.z; s2 += t.w; }
            const float mean = s * (1.0f / D); const float var = fmaxf(s2 * (1.0f / D) - mean * mean, 0.f);
            st[tid * 2] = mean; st[tid * 2 + 1] = 1.0f / sqrtf(var + LN_EPS); }
#pragma unroll 1
        for (int g = 0; g < 16; ++g) {
            __syncthreads();
            for (int idx = tid; idx < 16384; idx += 512) { const int q = idx >> 7, c = idx & 127, col = g * 128 + c;
                const float v = bf2f(UV[(size_t)(ch * 128 + q) * 4096 + 2048 + col]);
                vt[idx] = (v - st[q * 2]) * st[q * 2 + 1] * F.in[17][col] + F.in[18][col]; wt[q * 129 + c] = F.in[19][g * 16384 + idx]; }
            __syncthreads();
            const int p = tid & 127, cg = tid >> 7;
            float acc[32];
#pragma unroll
            for (int i = 0; i < 32; ++i) acc[i] = 0.f;
#pragma unroll 1
            for (int q = 0; q < 128; ++q) { const float w = wt[p * 129 + q];
#pragma unroll
                for (int i = 0; i < 32; i += 4) { const f32x4 v = *(const LAS f32x4*)(vt + q * 128 + cg * 32 + i); acc[i] += w * v.x; acc[i + 1] += w * v.y; acc[i + 2] += w * v.z; acc[i + 3] += w * v.w; } }
            const size_t row = (size_t)ch * 128 + p; const float bsv = F.in[20][g * 128 + p];
            const bf16* up = UV + row * 4096 + g * 128 + cg * 32; bf16* op = GT + row * D + g * 128 + cg * 32;
#pragma unroll
            for (int i = 0; i < 32; i += 4) { const f32x4 uu = ld_bf4(up + i); st_bf4(op + i, (f32x4){uu.x * (acc[i] + bsv), uu.y * (acc[i + 1] + bsv), uu.z * (acc[i + 2] + bsv), uu.w * (acc[i + 3] + bsv)}); }
        }
    }
}

__device__ __forceinline__ void spatial_fast(Frame& F) {
    using namespace att;
    PH_IDS; const int wid = wave, r32 = lane & 31, hi = lane >> 5;
    LAS char* lds = (LAS char*)F.lds;
    LAS bf16* ot = (LAS bf16*)(lds + 65536) + wid * (32 * 136);
    LAS float* st = (LAS float*)(lds + 135168);
    LAS float* P_g = (LAS float*)(lds + 136192); LAS float* P_b = P_g + 2048; LAS float* P_s1 = P_b + 2048  ; LAS float* P_s2 = (LAS float*)(lds + MISC_OFF + 256)  ;
    static_assert(136192 + 16384 + 6 * 512 <= MISC_OFF && MISC_OFF + 256 + 10 * 512 <= LDS_BYTES, "spatial_fast LDS map");
    const bf16* UV = WSP(bf16, WS_UV); unsigned char* GT = (unsigned char*)F.out; const float* vst = WSP(float, WS_VSTP); const bf16* WSB = WSP(bf16, WS_WSB);
    const int q0 = tid >> 4, cc = tid & 15;
    const int gsw = wid >> 2, pbase = (wid & 3) * 32;
    const int vbase = (int)(unsigned)(uintptr_t)lds + v_rd_base(lane) + gsw * 2 * 16384;
    for (int ch = F.vcu; ch < M / 128; ch += F.G) {
        __syncthreads();
        if (tid < 128) { float s = 0.f, s2 = 0.f; const f32x4* pp = (const f32x4*)(vst + (size_t)(ch * 128 + tid) * 64);
#pragma unroll
            for (int i = 0; i < 16; ++i) { const f32x4 t = pp[i]; s += t.x; s2 += t.y; s += t.z; s2 += t.w; }
            const float mean = s * (1.0f / D); const float var = fmaxf(s2 * (1.0f / D) - mean * mean, 0.f);
            st[tid * 2] = mean; st[tid * 2 + 1] = 1.0f / sqrtf(var + LN_EPS); }
        for (int i = tid; i < 2048; i += 512) { P_g[i] = F.in[17][i]; P_b[i] = F.in[18][i]; const float sb = F.in[20][i]; if (i < 768) P_s1[i] = sb; else P_s2[i - 768] = sb; }
        __syncthreads();
        const char* vsrc = (const char*)(UV + (size_t)ch * 128 * 4096 + 2048); const unsigned voff = (unsigned)(q0 * 4096 + cc * 8) * 2u;
        u32x4 raw[2][4]; bf16x8 wa[8]; u32x4 uu[8];
#define LOADV(it_) do { _Pragma("unroll") for (int gs = 0; gs < 2; ++gs) _Pragma("unroll") for (int j = 0; j < 4; ++j) \
            raw[gs][j] = *(const u32x4*)(vsrc + voff + (size_t)((2 * (it_) + gs) * 256 + j * 32 * 8192)); } while (0)
#define LOADW(g_) do { _Pragma("unroll") for (int ks = 0; ks < 8; ++ks) wa[ks] = *(const bf16x8*)(WSB + (size_t)((g_) * 128 + pbase + r32) * 128 + ks * 16 + hi * 8); } while (0)
        LOADV(0); LOADW(gsw);
        const size_t tok = (size_t)ch * 128 + pbase + (lane >> 4);
#pragma unroll 1
        for (int it = 0; it < 8; ++it) {
#pragma unroll
            for (int gs = 0; gs < 2; ++gs) { const int col = (2 * it + gs) * 128 + cc * 8;
                const f32x4 ga = *(const LAS f32x4*)(P_g + col), gb = *(const LAS f32x4*)(P_g + col + 4), ba = *(const LAS f32x4*)(P_b + col), bb = *(const LAS f32x4*)(P_b + col + 4);
#pragma unroll
                for (int j = 0; j < 4; ++j) { const int q = q0 + 32 * j; const float mean = st[2 * q], rstd = st[2 * q + 1]; const u32x4 w = raw[gs][j]; u32x4 o;
                    o.x = pk2((bf_lo(w.x) - mean) * rstd * ga.x + ba.x, (bf_hi(w.x) - mean) * rstd * ga.y + ba.y); o.y = pk2((bf_lo(w.y) - mean) * rstd * ga.z + ba.z, (bf_hi(w.y) - mean) * rstd * ga.w + ba.w);
                    o.z = pk2((bf_lo(w.z) - mean) * rstd * gb.x + bb.x, (bf_hi(w.z) - mean) * rstd * gb.y + bb.y); o.w = pk2((bf_lo(w.w) - mean) * rstd * gb.z + bb.z, (bf_hi(w.w) - mean) * rstd * gb.w + bb.w);
                    *(LAS u32x4*)(lds + (gs * 2 + (q >> 6)) * 16384 + v_st(q & 63, cc * 8)) = o; } }
            __syncthreads();
            const int g = 2 * it + gsw;
#pragma unroll
            for (int k = 0; k < 8; ++k) uu[k] = *(const u32x4*)(UV + (tok + k * 4) * 4096 + g * 128 + (lane & 15) * 8);
            if (it + 1 < 8) LOADV(it + 1);
            ATT_SBAR();
            f32x16 o[4] = {};
            pv_d0(o, vbase, wa[0], wa[1], wa[2], wa[3]); pv_d0(o, vbase + 16384, wa[4], wa[5], wa[6], wa[7]);
            ATT_SBAR();
            if (it + 1 < 8) LOADW(g + 2);
            ATT_SBAR();
            const LAS float* bsp = (g < 6 ? P_s1 + g * 128 : P_s2 + (g - 6) * 128) + pbase;
#pragma unroll
            for (int r = 0; r < 16; ++r) { const float bs = bsp[crow(r, hi)];
#pragma unroll
                for (int d0 = 0; d0 < 4; ++d0) ot[crow(r, hi) * 136 + d0 * 32 + r32] = (bf16)pk2(o[d0][r] + bs, 0.f); }
            asm volatile("s_waitcnt lgkmcnt(0)" ::: "memory");
#pragma unroll
            for (int k = 0; k < 8; ++k) { const u32x4 sv = *(const LAS u32x4*)(ot + (k * 4 + (lane >> 4)) * 136 + (lane & 15) * 8);
                const u32x4 u_ = uu[k]; u32x2 w;
                w.x = pk4_fp8(bf_lo(u_.x) * bf_lo(sv.x), bf_hi(u_.x) * bf_hi(sv.x), bf_lo(u_.y) * bf_lo(sv.y), bf_hi(u_.y) * bf_hi(sv.y));
                w.y = pk4_fp8(bf_lo(u_.z) * bf_lo(sv.z), bf_hi(u_.z) * bf_hi(sv.z), bf_lo(u_.w) * bf_lo(sv.w), bf_hi(u_.w) * bf_hi(sv.w));
                *(u32x2*)(GT + (tok + k * 4) * D + g * 128 + (lane & 15) * 8) = w; }
            __syncthreads();
        }
#undef LOADV
#undef LOADW
    }
}

constexpr int NPH = 17;
struct Args { const float* in[27]; float* out; unsigned char* ws; int ph_lo, ph_hi; };
__global__ void __launch_bounds__(NWAVES * 64, 2) mk_fwd(Args args) {
    extern __shared__ __attribute__((aligned(16))) unsigned char lds_raw[];
    Frame F;
    F.lds = (LAS unsigned char*)lds_raw;
    F.MISC = (volatile LAS unsigned*)(F.lds + MISC_OFF);
    F.wave0 = __builtin_amdgcn_readfirstlane((int)threadIdx.x >> 6);
    F.G = gridDim.x; { const int bx = blockIdx.x; F.vcu = (F.G % 8 == 0) ? (bx % 8) * (F.G / 8) + bx / 8 : bx; }
#pragma unroll
    for (int i = 0; i < 27; ++i) F.in[i] = args.in[i];
    F.out = args.out; F.ws = args.ws; F.ctl = (unsigned*)(args.ws + WS_CTL);
    if (threadIdx.x < 64) ((LAS unsigned*)(F.lds + MISC_OFF))[threadIdx.x] = 0u;
    __syncthreads();
    XcdBarrier bar; bar.bar = F.ctl + CW_BAR; bar.x = 0; bar.st = nullptr;
    if (MK_N_LAUNCHES == 1) bar = xcd_barrier_post(F.ctl + CW_BAR, F.MISC + 8, threadIdx.x == 0);
    const int lo = args.ph_lo, hi = args.ph_hi;
#define IN(k) (lo <= (k) && (k) < hi)
#define SEAM(k) do { if (IN(k) && IN((k) + 1)) xcd_barrier(bar, F.wave0 == 0 && fresh_lane() == 0); } while (0)

#define RUN(k, ...) do { if (IN(k)) { constexpr bool dup_pass = false; (void)dup_pass; __VA_ARGS__ } SEAM(k); if (DUP_PHASE == (k) && IN(k)) { constexpr bool dup_pass = true; (void)dup_pass; __VA_ARGS__ xcd_barrier(bar, F.wave0 == 0 && fresh_lane() == 0); } } while (0)
    RUN(0, p0_prologue(F););
    RUN(1, p1_modulate(F););
    RUN(2,
        { LAS float* tabL = (LAS float*)(F.lds + LDSX_OFF); { const int t_ = F.wave0 * 64 + fresh_lane(); for (int i = t_; i < 4096; i += 512) tabL[i] = WSP(float, WS_TAB)[i]; } __syncthreads();
          const unsigned char* h8 = (const unsigned char*)F.out + (size_t)M * D * 2; const unsigned char* w8 = WSP(unsigned char, WS_WINE) + (size_t)3072 * D;
          { Gemm g{(const bf16*)h8, (const bf16*)WSP(unsigned char, WS_WINE), M, 6144, D}; pg8::StaticOrder S; S.init(M, 6144, F.G, (int)blockIdx.x);
            EpiInProj E{WSP(bf16, WS_PROJ), WSP(bf16, WS_Q), WSP(bf16, WS_KB), WSP(bf16, WS_VB), tabL, tabL + 2048, 0};
            GEMM_PHASE_F8(EpiInProj, pg8::StaticOrder, F.lds, g, S, E); }
          { Gemm g{(const bf16*)(h8 + (size_t)M * D), (const bf16*)(w8 + (size_t)1024 * D), MC, 2048, D}; pg8::StaticOrder S; S.init(MC, 2048, F.G, (int)blockIdx.x);
            EpiCtx E{WSP(bf16, WS_KB), WSP(bf16, WS_VB)};
            GEMM_PHASE_F8(EpiCtx, pg8::StaticOrder, F.lds, g, S, E); } }
        if (!dup_pass) { const int c = (int)blockIdx.x;
            if (F.G <= 32) convert_weights<1>(F, c * NWAVES + F.wave0, F.G * NWAVES, F.wave0, fresh_lane(), 0, CW_SPLIT1);
            else if (c >= 32) convert_weights<1>(F, (c - 32) * NWAVES + F.wave0, (F.G - 32) * NWAVES, F.wave0, fresh_lane(), 0, CW_SPLIT1); });
#if USE_FAST_ATTN
    RUN(3, conv_pass(F); attn_fast(F););
#else
    RUN(3, conv_pass(F); attn_simple(F););
    RUN(4, attn_finish(F););
#endif
    RUN(5, { Gemm g{(const bf16*)F.out, WSP(bf16, WS_WOUTE), M, D, D}; pg8::StaticOrder S; S.init(M, D, F.G, (int)blockIdx.x);
        EpiRes<true> E{F.in[0], nullptr, MODP(0, 0, 2), (bf16*)F.out + (size_t)M * D};
        GEMM_PHASE_F8(EpiRes<true>, pg8::StaticOrder, F.lds, g, S, E); });
    RUN(6, ln_route_pass<0>(F););
    RUN(7, { LAS int* tp; LAS int* cnt; const int TP = moe_tables<0>(F, tp, cnt);
        Gemm g{(const bf16*)WSP(unsigned char, WS_H8), (const bf16*)(WSP(unsigned char, WS_WGU)), M, 1024, D}; pg8::MoeOrder<true> S{tp, cnt, WSP(int4, WS_LIST2), 8, TP * 8, F.G, (int)blockIdx.x, tp + 64};
        EpiGU E{WSP(unsigned char, WS_HID), WSP(int4, WS_LIST2)}; GEMM_PHASE_F8(EpiGU, pg8::MoeOrder<true>, F.lds, g, S, E);
        if (!dup_pass) { const int rem = (TP * 8) % F.G; const int c = (int)blockIdx.x;
            if (rem == 0) convert_weights<1>(F, c * NWAVES + F.wave0, F.G * NWAVES, F.wave0, fresh_lane(), CW_SPLIT1, CW_N1);
            else if (c >= rem) convert_weights<1>(F, (c - rem) * NWAVES + F.wave0, (F.G - rem) * NWAVES, F.wave0, fresh_lane(), CW_SPLIT1, CW_N1); } });
    RUN(8, { LAS int* tp; LAS int* cnt; const int TP = moe_tables<0>(F, tp, cnt);
        Gemm g{(const bf16*)WSP(unsigned char, WS_HID), (const bf16*)(WSP(unsigned char, WS_WDN)), M, 2048, 2 * ED, ED}; pg8::MoeOrder<false> S{tp, cnt, WSP(int4, WS_LIST2), 8, TP * 8, F.G, (int)blockIdx.x, tp + 64};
        EpiDown E{WSP(int4, WS_LIST2), WSP(bf16, WS_YB)}; GEMM_PHASE_F8(EpiDown, pg8::MoeOrder<false>, F.lds, g, S, E); });
    RUN(9, ln_moe_pass<0>(F););
    RUN(10, { Gemm g{(const bf16*)WSP(unsigned char, WS_H8), WSP(bf16, WS_WINO), M, 4096, D}; pg8::StaticOrder S; S.init(M, 4096, F.G, (int)blockIdx.x);
        EpiGelu E{WSP(bf16, WS_UV), WSP(float, WS_VSTP)}; GEMM_PHASE_F8(EpiGelu, pg8::StaticOrder, F.lds, g, S, E); });
#if USE_FAST_SPATIAL
    RUN(11, spatial_fast(F););
#else
    RUN(11, spatial_simple(F););
#endif
    RUN(12, { Gemm g{(const bf16*)F.out, WSP(bf16, WS_WOUTO), M, D, D}; pg8::StaticOrder S; S.init(M, D, F.G, (int)blockIdx.x);
        EpiRes<false> E{nullptr, WSP(bf16, WS_X), MODP(1, 0, 2), WSP(bf16, WS_R1)};
        GEMM_PHASE_F8(EpiRes<false>, pg8::StaticOrder, F.lds, g, S, E); });
    RUN(13, ln_route_pass<1>(F););
    RUN(14, { LAS int* tp; LAS int* cnt; const int TP = moe_tables<1>(F, tp, cnt);
        Gemm g{(const bf16*)WSP(unsigned char, WS_H8), (const bf16*)(WSP(unsigned char, WS_WGU) + (size_t)16 * 1024 * D), M, 1024, D}; pg8::MoeOrder<true> S{tp, cnt, WSP(int4, WS_LIST2), 8, TP * 8, F.G, (int)blockIdx.x, tp + 64};
        EpiGU E{WSP(unsigned char, WS_HID), WSP(int4, WS_LIST2)}; GEMM_PHASE_F8(EpiGU, pg8::MoeOrder<true>, F.lds, g, S, E); });
    RUN(15, { LAS int* tp; LAS int* cnt; const int TP = moe_tables<1>(F, tp, cnt);
        Gemm g{(const bf16*)WSP(unsigned char, WS_HID), (const bf16*)(WSP(unsigned char, WS_WDN) + (size_t)16 * D * ED), M, 2048, 2 * ED, ED}; pg8::MoeOrder<false> S{tp, cnt, WSP(int4, WS_LIST2), 8, TP * 8, F.G, (int)blockIdx.x, tp + 64};
        EpiDown E{WSP(int4, WS_LIST2), WSP(bf16, WS_YB)}; GEMM_PHASE_F8(EpiDown, pg8::MoeOrder<false>, F.lds, g, S, E); });
    if (DUP_PHASE == 16) { ln_moe_pass<1>(F); xcd_barrier(bar, F.wave0 == 0 && fresh_lane() == 0); }
    if (IN(16)) { ln_moe_pass<1>(F); }
#undef RUN
#undef IN
#undef SEAM
}

extern "C" void kernel_launch(void* const* d_in, const int* in_sizes, int n_in, void* d_out, int out_size, void* d_ws, size_t ws_size, hipStream_t stream) {
    static int grid = 0;
    if (grid == 0) {
        if (n_in != 27 || in_sizes[0] != M * D || out_size != M * D || ws_size < WS_END) { fprintf(stderr, "kernel_launch: shape/workspace mismatch (n_in %d, ws %zu < %zu)\n", n_in, ws_size, (size_t)WS_END); grid = -1; return; }
        int dev = 0, cus = 0, per_cu = 0;
        if (hipGetDevice(&dev) != hipSuccess || hipDeviceGetAttribute(&cus, hipDeviceAttributeMultiprocessorCount, dev) != hipSuccess) { grid = -1; return; }
        if (hipFuncSetAttribute((const void*)mk_fwd, hipFuncAttributeMaxDynamicSharedMemorySize, LDS_BYTES) != hipSuccess) { fprintf(stderr, "kernel_launch: hipFuncSetAttribute failed\n"); grid = -1; return; }
        if (hipOccupancyMaxActiveBlocksPerMultiprocessor(&per_cu, (const void*)mk_fwd, NWAVES * 64, LDS_BYTES) != hipSuccess || per_cu < 1) fprintf(stderr, "kernel_launch: occupancy query reports %d\n", per_cu);
        (void)hipGetLastError();
        grid = cus;
    }
    if (grid < 0) return;
    if (hipMemsetAsync((char*)d_ws + WS_CTL, 0, CTL_ZERO_BYTES, stream) != hipSuccess) return;
    Args a{};
    for (int i = 0; i < 27; ++i) a.in[i] = (const float*)d_in[i];
    a.out = (float*)d_out; a.ws = (unsigned char*)d_ws;
    if (MK_N_LAUNCHES == 1) { a.ph_lo = 0; a.ph_hi = NPH; hipLaunchKernelGGL(mk_fwd, dim3(grid), dim3(NWAVES * 64), LDS_BYTES, stream, a); }
    else for (int p = 0; p < NPH; ++p) {
#if USE_FAST_ATTN
        if (p == 4) continue;
#endif
        a.ph_lo = p; a.ph_hi = p + 1; hipLaunchKernelGGL(mk_fwd, dim3(grid), dim3(NWAVES * 64), LDS_BYTES, stream, a); }
    const hipError_t le = hipPeekAtLastError();
    if (le != hipSuccess) fprintf(stderr, "kernel_launch: launch failed: %s\n", hipGetErrorName(le));
}
```
